# Optimizing an MI355X kernel written in HIP

```python
import jax
import jax.numpy as jnp
from jax import lax
import numpy as np

D_MODEL = 2048
BATCH = 2
SEQ = 16384
DEPTH = 4
DEC_BATCH = 1
DEC_SEQ = 16384
PAST_LEN = 128

HEAD_DIM = 128
SCALE = HEAD_DIM ** -0.5
Q_BLOCK = 128
GRID_W = 64
A_GROUPS = ((128, 1), (512, 4), (2048, 16))
A_HEADS_PER_GROUP = 4
A_HEADS = 12
B_Q_HEADS = 8
B_KV_HEADS = 2
ROPE_THETA = 10000.0
C_Q_HEADS = 8
C_KV_HEADS = 2
C_HALF_WINDOW = 128
N_BRANCHES = 3
D_FF = 5632
NORM_EPS = 1e-6
NEG_INF = -1e30
SPLIT_SIZES = (A_HEADS * HEAD_DIM, A_HEADS * HEAD_DIM, A_HEADS * HEAD_DIM,
               B_Q_HEADS * HEAD_DIM, B_KV_HEADS * HEAD_DIM, B_KV_HEADS * HEAD_DIM,
               C_Q_HEADS * HEAD_DIM, C_KV_HEADS * HEAD_DIM, C_KV_HEADS * HEAD_DIM,
               N_BRANCHES * D_MODEL)
IN_COLS = 13824
A_OUT = A_HEADS_PER_GROUP * HEAD_DIM
B_OUT = B_Q_HEADS * HEAD_DIM
C_OUT = C_Q_HEADS * HEAD_DIM

kernel_name = "hybrid_dilated_axial_window_encoder"


def rms_norm(x, g):
    xf = x.astype(jnp.float32)
    y = xf * lax.rsqrt(jnp.mean(xf * xf, axis=-1, keepdims=True) + NORM_EPS)
    return (y * g.astype(jnp.float32)).astype(x.dtype)


def swiglu(x, w_in, w_out):
    a, b = jnp.split(x @ w_in, 2, axis=-1)
    return (jax.nn.silu(a) * b) @ w_out


def alibi_slopes(n):
    return 2.0 ** (-8.0 * jnp.arange(1, n + 1, dtype=jnp.float32) / n)


def banded_attention(q, k, v, half_w, slopes, dist_scale, sink=None):
    bb, n, hq, hd = q.shape
    hk = k.shape[2]
    g = hq // hk
    nb = -(-n // Q_BLOCK)
    n_pad = nb * Q_BLOCK
    span = Q_BLOCK + 2 * half_w
    qp = jnp.pad(q, ((0, 0), (0, n_pad - n), (0, 0), (0, 0))).reshape(bb, nb, Q_BLOCK, hk, g, hd)
    pad_k = ((0, 0), (half_w, n_pad - n + half_w), (0, 0), (0, 0))
    kidx = jnp.arange(nb)[:, None] * Q_BLOCK + jnp.arange(span)[None, :]
    kb = jnp.pad(k, pad_k)[:, kidx]
    vb = jnp.pad(v, pad_k)[:, kidx]
    qpos = jnp.arange(nb)[:, None] * Q_BLOCK + jnp.arange(Q_BLOCK)[None, :]
    kpos = kidx - half_w
    rel = jnp.abs(kpos[:, None, :] - qpos[:, :, None])
    valid = (rel <= half_w) & (kpos >= 0)[:, None, :] & (kpos < n)[:, None, :]
    dist = (rel * dist_scale).astype(jnp.float32)
    s = jnp.einsum('bnqkgd,bnskd->bnkgqs', qp, kb).astype(jnp.float32) * SCALE
    s = s - slopes.reshape(1, 1, hk, g, 1, 1) * dist[None, :, None, None]
    s = jnp.where(valid[None, :, None, None], s, NEG_INF)
    m = jnp.max(s, axis=-1, keepdims=True)
    if sink is not None:
        sk = sink.astype(jnp.float32).reshape(1, 1, hk, g, 1, 1)
        m = jnp.maximum(m, sk)
    p = jnp.exp(s - m)
    denom = jnp.sum(p, axis=-1, keepdims=True)
    if sink is not None:
        denom = denom + jnp.exp(sk - m)
    out = jnp.einsum('bnkgqs,bnskd->bnqkgd', (p / denom).astype(vb.dtype), vb)
    out = out.reshape(bb, n_pad, hq, hd)[:, :n]
    lse = (m + jnp.log(denom))[..., 0]
    lse = lse.transpose(0, 1, 4, 2, 3).reshape(bb, n_pad, hq)[:, :n]
    return out.astype(q.dtype), lse


def to_sub(x, r):
    b, t = x.shape[:2]
    rest = x.shape[2:]
    return jnp.moveaxis(x.reshape(b, t // r, r, *rest), 2, 1).reshape(b * r, t // r, *rest)


def from_sub(x, r, b, t):
    rest = x.shape[2:]
    return jnp.moveaxis(x.reshape(b, r, t // r, *rest), 1, 2).reshape(b, t, *rest)


def dilated_attention(q, k, v, slopes):
    b, t = q.shape[:2]
    outs, lses = [], []
    for gi, (window, r) in enumerate(A_GROUPS):
        hs = slice(gi * A_HEADS_PER_GROUP, (gi + 1) * A_HEADS_PER_GROUP)
        o, l = banded_attention(to_sub(q[:, :, hs], r), to_sub(k[:, :, hs], r), to_sub(v[:, :, hs], r),
                                (window // 2) // r, slopes[hs], r)
        outs.append(from_sub(o, r, b, t))
        lses.append(from_sub(l, r, b, t))
    alpha = jax.nn.softmax(jnp.stack(lses), axis=0)
    out = jnp.sum(alpha[..., None] * jnp.stack(outs).astype(jnp.float32), axis=0)
    return out.astype(q.dtype)


def axial_rope(x, t):
    rows = t // GRID_W
    row = jnp.repeat(jnp.arange(rows, dtype=jnp.float32), GRID_W)
    col = jnp.tile(jnp.arange(GRID_W, dtype=jnp.float32), rows)
    n_freq = HEAD_DIM // 4
    inv = ROPE_THETA ** (-jnp.arange(n_freq, dtype=jnp.float32) / n_freq)
    ang = jnp.concatenate([row[:, None] * inv, col[:, None] * inv], axis=-1)
    cos = jnp.cos(ang)[None, :, None, :]
    sin = jnp.sin(ang)[None, :, None, :]
    xp = x.reshape(*x.shape[:-1], HEAD_DIM // 2, 2)
    x0, x1 = xp[..., 0], xp[..., 1]
    return jnp.stack([x0 * cos - x1 * sin, x0 * sin + x1 * cos], axis=-1).reshape(x.shape)


def dense_gqa(q, k, v):
    b, t, hq, hd = q.shape
    hk = k.shape[2]
    g = hq // hk
    nb = t // Q_BLOCK
    qb = q.reshape(b, nb, Q_BLOCK, hk, g, hd).transpose(1, 0, 2, 3, 4, 5)

    def block(qi):
        s = jnp.einsum('bqkgd,btkd->bkgqt', qi, k).astype(jnp.float32) * SCALE
        p = jax.nn.softmax(s, axis=-1)
        return jnp.einsum('bkgqt,btkd->bqkgd', p.astype(v.dtype), v).astype(q.dtype)

    o = lax.map(block, qb)
    return o.transpose(1, 0, 2, 3, 4, 5).reshape(b, t, hq, hd)


def mixer(u, w_in, qn_g, kn_g, sink, w_a, w_b, w_c, w_o):
    b, t, _ = u.shape
    points = np.cumsum(SPLIT_SIZES)[:-1].tolist()
    aq, ak, av, bq, bk, bv, cq, ck, cv, gl = jnp.split(u @ w_in, points, axis=-1)
    heads = lambda z: z.reshape(b, t, -1, HEAD_DIM)
    o_a = dilated_attention(heads(aq), heads(ak), heads(av), alibi_slopes(A_HEADS))
    o_a = o_a.reshape(b, t, A_OUT) @ w_a
    qb_ = axial_rope(rms_norm(heads(bq), qn_g).astype(jnp.float32), t).astype(u.dtype)
    kb_ = axial_rope(rms_norm(heads(bk), kn_g).astype(jnp.float32), t).astype(u.dtype)
    o_b = dense_gqa(qb_, kb_, heads(bv)).reshape(b, t, B_OUT) @ w_b
    o_c, _ = banded_attention(heads(cq), heads(ck), heads(cv), C_HALF_WINDOW, alibi_slopes(C_Q_HEADS), 1, sink)
    o_c = o_c.reshape(b, t, C_OUT) @ w_c
    gates = jax.nn.sigmoid(gl.astype(jnp.float32)).reshape(b, t, N_BRANCHES, D_MODEL).astype(u.dtype)
    merged = gates[:, :, 0] * o_a + gates[:, :, 1] * o_b + gates[:, :, 2] * o_c
    return merged @ w_o


def trunk(x, norm_ffn1, ffn1_w_in, ffn1_w_out, norm_mix, w_in, qk_norm_q, qk_norm_k, sink_c,
          w_br_a, w_br_b, w_br_c, w_out, norm_ffn2, ffn2_w_in, ffn2_w_out, norm_final):
    for l in range(DEPTH):
        x = x + 0.5 * swiglu(rms_norm(x, norm_ffn1[l]), ffn1_w_in[l], ffn1_w_out[l])
        x = x + mixer(rms_norm(x, norm_mix[l]), w_in[l], qk_norm_q[l], qk_norm_k[l], sink_c[l],
                      w_br_a[l], w_br_b[l], w_br_c[l], w_out[l])
        x = x + 0.5 * swiglu(rms_norm(x, norm_ffn2[l]), ffn2_w_in[l], ffn2_w_out[l])
    return rms_norm(x, norm_final)


def setup_inputs(seed: int = 0) -> dict:
    key = jax.random.key(seed)
    ks = jax.random.split(key, 20)
    f32 = jnp.float32

    def w(k, shape, fan_in):
        return jax.random.normal(k, shape, f32) * fan_in ** -0.5

    def gain(k, shape):
        return 1.0 + 0.02 * jax.random.normal(k, shape, f32)

    return {
        "x_prompt": jax.random.normal(ks[0], (BATCH, SEQ, D_MODEL), f32),
        "x_sample": jax.random.normal(ks[1], (DEC_BATCH, DEC_SEQ, D_MODEL), f32),
        "norm_ffn1": gain(ks[2], (DEPTH, D_MODEL)),
        "ffn1_w_in": w(ks[3], (DEPTH, D_MODEL, 2 * D_FF), D_MODEL),
        "ffn1_w_out": w(ks[4], (DEPTH, D_FF, D_MODEL), D_FF),
        "norm_mix": gain(ks[5], (DEPTH, D_MODEL)),
        "w_in": w(ks[6], (DEPTH, D_MODEL, IN_COLS), D_MODEL),
        "qk_norm_q": gain(ks[7], (DEPTH, HEAD_DIM)),
        "qk_norm_k": gain(ks[8], (DEPTH, HEAD_DIM)),
        "sink_c": jax.random.normal(ks[9], (DEPTH, C_Q_HEADS), f32),
        "w_br_a": w(ks[10], (DEPTH, A_OUT, D_MODEL), A_OUT),
        "w_br_b": w(ks[11], (DEPTH, B_OUT, D_MODEL), B_OUT),
        "w_br_c": w(ks[12], (DEPTH, C_OUT, D_MODEL), C_OUT),
        "w_out": w(ks[13], (DEPTH, D_MODEL, D_MODEL), D_MODEL),
        "norm_ffn2": gain(ks[14], (DEPTH, D_MODEL)),
        "ffn2_w_in": w(ks[15], (DEPTH, D_MODEL, 2 * D_FF), D_MODEL),
        "ffn2_w_out": w(ks[16], (DEPTH, D_FF, D_MODEL), D_FF),
        "norm_final": gain(ks[17], (D_MODEL,)),
    }


def reference(x_prompt, x_sample, norm_ffn1, ffn1_w_in, ffn1_w_out, norm_mix, w_in, qk_norm_q, qk_norm_k,
              sink_c, w_br_a, w_br_b, w_br_c, w_out, norm_ffn2, ffn2_w_in, ffn2_w_out, norm_final):
    y_prompt = trunk(x_prompt, norm_ffn1, ffn1_w_in, ffn1_w_out, norm_mix, w_in, qk_norm_q, qk_norm_k, sink_c,
                     w_br_a, w_br_b, w_br_c, w_out, norm_ffn2, ffn2_w_in, ffn2_w_out, norm_final)
    y_sample = trunk(x_sample, norm_ffn1, ffn1_w_in, ffn1_w_out, norm_mix, w_in, qk_norm_q, qk_norm_k, sink_c,
                     w_br_a, w_br_b, w_br_c, w_out, norm_ffn2, ffn2_w_in, ffn2_w_out, norm_final)
    return (y_prompt, y_sample)
```

```cpp
#include <hip/hip_runtime.h>
#include <cstdio>
#include <cstdint>

#ifndef MK_PER_PHASE
#define MK_PER_PHASE 1
#endif

namespace pg8 {
#define PG8_LAS __attribute__((address_space(3)))
typedef unsigned short bf16_t;
typedef short bf16x8 __attribute__((ext_vector_type(8)));
typedef float f32x4 __attribute__((ext_vector_type(4)));
typedef unsigned u32x4 __attribute__((ext_vector_type(4)));
typedef unsigned u32x2 __attribute__((ext_vector_type(2)));
constexpr int BM = 256, BK = 64, HALF = 128, HTB = HALF * BK * 2, STAGE_BYTES = 8 * HTB, NXCD = 8, WGM = 8;

__host__ __device__ __forceinline__ int lds_byte(int r, int c) { const int st = (r >> 4) * 2 + (c >> 5), rr = r & 15, cc = c & 31, ob = rr * 64 + cc * 2; return st * 1024 + (ob ^ (((ob >> 9) & 1) << 5)); }
__host__ __device__ __forceinline__ void stage_rc(int b, int& R, int& C) { const int st = b / 1024, sb = b % 1024, swz = sb ^ (((sb >> 9) & 1) << 5); R = (st >> 1) * 16 + swz / 64; C = (st & 1) * 32 + (swz % 64) / 2; }
__host__ __device__ __forceinline__ int perm32(int rho) { const int n = rho >> 4, i = rho & 15; return 8 * (i >> 2) + 4 * n + (i & 3); }

struct Unit { int pm, pn; };
struct Gemm { const bf16_t* A; const bf16_t* Bt; int M, N, K; };

struct StaticOrder {
    int nM, nN, nwg, G, c;
    __host__ __device__ void init(int M, int N, int G_, int c_) { nM = M / BM; nN = N / BM; nwg = nM * nN; G = G_; c = c_; }
    __host__ __device__ bool next(int i, Unit& u) const {
        const long L = (long)i * G + c; if (L >= nwg) return false;
        int wgid = (int)L; { const int q = nwg / NXCD, r = nwg % NXCD, xcd = wgid % NXCD, off = wgid / NXCD; wgid = (xcd < r ? xcd * (q + 1) : r * (q + 1) + (xcd - r) * q) + off; }
        const int nig = WGM * nN, gid = wgid / nig, fm = gid * WGM, gsz = (nM - fm) < WGM ? (nM - fm) : WGM;
        u.pm = fm + ((wgid % nig) % gsz); u.pn = (wgid % nig) / gsz; return true;
    }
    __device__ __forceinline__ void a_ready(const Unit&) const {}
    __device__ __forceinline__ void done(const Unit&) const {}
};

__device__ __forceinline__ unsigned cvt_pk_bf16(float lo, float hi) { unsigned r; asm volatile("v_cvt_pk_bf16_f32 %0, %1, %2" : "=v"(r) : "v"(lo), "v"(hi)); return r; }
__device__ __forceinline__ float bf_lo(unsigned w) { return __uint_as_float(w << 16); }
__device__ __forceinline__ float bf_hi(unsigned w) { return __uint_as_float(w & 0xffff0000u); }
__device__ __forceinline__ float sigmoidf_(float x) { return __builtin_amdgcn_rcpf(1.0f + __builtin_amdgcn_exp2f(-1.4426950408889634f * x)); }

struct EpiBf16 {
    static constexpr bool PERM = true, AFTER_DRAIN = false;
    bf16_t* O; int ldc;
    __device__ __forceinline__ void operator()(const f32x4 (&acc)[2][2][4][2], const Unit& u, int wr, int wc, int fr, int fq) const {
        const int row0 = u.pm * BM + wr * 64 + fr, col0 = u.pn * BM + wc * 32 + 8 * fq;
#pragma unroll
        for (int ai = 0; ai < 2; ++ai)
#pragma unroll
            for (int m = 0; m < 4; ++m) { bf16_t* rowp = O + (size_t)(row0 + ai * HALF + m * 16) * ldc + col0;
#pragma unroll
                for (int bj = 0; bj < 2; ++bj) { const f32x4 v0 = acc[ai][bj][m][0], v1 = acc[ai][bj][m][1];
                    u32x4 w; w.x = cvt_pk_bf16(v0[0], v0[1]); w.y = cvt_pk_bf16(v0[2], v0[3]); w.z = cvt_pk_bf16(v1[0], v1[1]); w.w = cvt_pk_bf16(v1[2], v1[3]);
                    *(u32x4*)(rowp + bj * HALF) = w; } }
    }
};
struct EpiSwiglu {
    static constexpr bool PERM = true, AFTER_DRAIN = false;
    bf16_t* H; int ldc;
    __device__ __forceinline__ void operator()(const f32x4 (&acc)[2][2][4][2], const Unit& u, int wr, int wc, int fr, int fq) const {
        const int row0 = u.pm * BM + wr * 64 + fr, col0 = u.pn * HALF + wc * 32 + 8 * fq;
#pragma unroll
        for (int ai = 0; ai < 2; ++ai)
#pragma unroll
            for (int m = 0; m < 4; ++m) { bf16_t* rowp = H + (size_t)(row0 + ai * HALF + m * 16) * ldc + col0;
                float h[8];
#pragma unroll
                for (int n = 0; n < 2; ++n)
#pragma unroll
                    for (int e = 0; e < 4; ++e) { const float a = acc[ai][0][m][n][e], b = acc[ai][1][m][n][e]; h[n * 4 + e] = a * sigmoidf_(a) * b; }
                u32x4 w; w.x = cvt_pk_bf16(h[0], h[1]); w.y = cvt_pk_bf16(h[2], h[3]); w.z = cvt_pk_bf16(h[4], h[5]); w.w = cvt_pk_bf16(h[6], h[7]);
                *(u32x4*)rowp = w; }
    }
};
struct EpiResid {
    static constexpr bool PERM = false, AFTER_DRAIN = false;
    float* X; int ldc; float scale;
    __device__ __forceinline__ void operator()(const f32x4 (&acc)[2][2][4][2], const Unit& u, int wr, int wc, int fr, int fq) const {
        const int row0 = u.pm * BM + wr * 64 + fr, col0 = u.pn * BM + wc * 32 + 4 * fq;
#pragma unroll
        for (int ai = 0; ai < 2; ++ai)
#pragma unroll
            for (int m = 0; m < 4; ++m) { float* rowp = X + (size_t)(row0 + ai * HALF + m * 16) * ldc + col0;
#pragma unroll
                for (int bj = 0; bj < 2; ++bj)
#pragma unroll
                    for (int n = 0; n < 2; ++n) { f32x4* p = (f32x4*)(rowp + bj * HALF + n * 16); *p = *p + acc[ai][bj][m][n] * scale; }
                if (m & 1) asm volatile("" ::: "memory"); }
    }
};
struct EpiGate {
    static constexpr bool PERM = true, AFTER_DRAIN = false;
    const bf16_t* GL; int ldg; float* MG; bf16_t* MB; int ldc; int mode;
    __device__ __forceinline__ void operator()(const f32x4 (&acc)[2][2][4][2], const Unit& u, int wr, int wc, int fr, int fq) const {
        const int row0 = u.pm * BM + wr * 64 + fr, col0 = u.pn * BM + wc * 32 + 8 * fq;
#pragma unroll
        for (int ai = 0; ai < 2; ++ai)
#pragma unroll
            for (int m = 0; m < 4; ++m) { const size_t row = (size_t)(row0 + ai * HALF + m * 16);
#pragma unroll
                for (int bj = 0; bj < 2; ++bj) { const int col = col0 + bj * HALF;
                    const u32x4 g = *(const u32x4*)(GL + row * ldg + col);
                    f32x4 v0 = acc[ai][bj][m][0], v1 = acc[ai][bj][m][1];
                    v0[0] *= sigmoidf_(bf_lo(g.x)); v0[1] *= sigmoidf_(bf_hi(g.x)); v0[2] *= sigmoidf_(bf_lo(g.y)); v0[3] *= sigmoidf_(bf_hi(g.y));
                    v1[0] *= sigmoidf_(bf_lo(g.z)); v1[1] *= sigmoidf_(bf_hi(g.z)); v1[2] *= sigmoidf_(bf_lo(g.w)); v1[3] *= sigmoidf_(bf_hi(g.w));
                    float* mp = MG + row * ldc + col;
                    if (mode > 0) { v0 = v0 + *(const f32x4*)mp; v1 = v1 + *(const f32x4*)(mp + 4); }
                    if (mode < 2) { *(f32x4*)mp = v0; *(f32x4*)(mp + 4) = v1; }
                    else { u32x4 w; w.x = cvt_pk_bf16(v0[0], v0[1]); w.y = cvt_pk_bf16(v0[2], v0[3]); w.z = cvt_pk_bf16(v1[0], v1[1]); w.w = cvt_pk_bf16(v1[2], v1[3]);
                        *(u32x4*)(MB + row * ldc + col) = w; } }
                asm volatile("" ::: "memory"); }
    }
};

template <class Epi, class Sched, bool ALIGN_EPI = false, bool SP2 = false>
__device__ __forceinline__ void gemm_phase(PG8_LAS unsigned char* lds, const Gemm g, const Sched& S, const Epi& E, const int tid) {
    const int wid = __builtin_amdgcn_readfirstlane(tid >> 6), lane = tid & 63, wr = wid >> 2, wc = wid & 3, fr = lane & 15, fq = lane >> 4;
    const int K = g.K, nt = K / BK;
    unsigned voffA[2], voffB[2];
#pragma unroll
    for (int i = 0; i < 2; ++i) { int R, C; stage_rc(tid * 16 + i * 8192, R, C); const int Rb = Epi::PERM ? ((R & ~31) + perm32(R & 31)) : R;
        voffA[i] = (unsigned)(R * K + C) * 2u; voffB[i] = (unsigned)(Rb * K + C) * 2u; }
    const size_t kstep = (size_t)(BK * 2);
    const size_t hstep = (size_t)HALF * K * 2;
    const size_t tstep = 2 * hstep;
    const unsigned ldsw = (unsigned)wid * 1024u;
    const int aoff = lds_byte(wr * 64 + fr, fq * 8), boff = lds_byte(wc * 32 + fr, fq * 8);
#define PG8_SA(b, h) (((b) * 2 + (h)) * HTB)
#define PG8_SB(b, h) ((4 + (b) * 2 + (h)) * HTB)
#define PG8_STAGE(bufoff, gbase, voff) do { _Pragma("unroll") for (int _i = 0; _i < 2; ++_i) \
        __builtin_amdgcn_global_load_lds((const unsigned*)((const char*)(gbase) + (voff)[_i]), (PG8_LAS unsigned*)(lds + (bufoff) + ldsw + _i * 8192), 16, 0, 0); } while (0)
#define PG8_LDA(dst, b, h) do { _Pragma("unroll") for (int m = 0; m < 4; ++m) _Pragma("unroll") for (int k = 0; k < 2; ++k) dst[m][k] = *(const PG8_LAS bf16x8*)(lds + PG8_SA(b, h) + aoff + m * 2048 + k * 1024); } while (0)
#define PG8_LDB(dst, b, h) do { _Pragma("unroll") for (int n = 0; n < 2; ++n) _Pragma("unroll") for (int k = 0; k < 2; ++k) dst[n][k] = *(const PG8_LAS bf16x8*)(lds + PG8_SB(b, h) + boff + n * 2048 + k * 1024); } while (0)
#define PG8_MMA(ai, bj, At, Bt) do { __builtin_amdgcn_s_setprio(1); _Pragma("unroll") for (int m = 0; m < 4; ++m) _Pragma("unroll") for (int n = 0; n < 2; ++n) _Pragma("unroll") for (int k = 0; k < 2; ++k) \
        acc[ai][bj][m][n] = __builtin_amdgcn_mfma_f32_16x16x32_bf16(Bt[n][k], At[m][k], acc[ai][bj][m][n], 0, 0, 0); __builtin_amdgcn_s_setprio(0); } while (0)
#define PG8_WAIT_V(n) asm volatile("s_waitcnt vmcnt(" #n ")" ::: "memory")
#define PG8_WAIT_L(n) asm volatile("s_waitcnt lgkmcnt(" #n ")" ::: "memory")
#define PG8_BAR __builtin_amdgcn_s_barrier()
#define PG8_SCHED __builtin_amdgcn_sched_barrier(0)
    Unit cur, nxt; int ui = 0;
    if (!S.next(0, cur)) return;
    f32x4 acc[2][2][4][2];
#pragma unroll
    for (int a = 0; a < 2; ++a)
#pragma unroll
        for (int b = 0; b < 2; ++b)
#pragma unroll
            for (int m = 0; m < 4; ++m)
#pragma unroll
                for (int n = 0; n < 2; ++n) acc[a][b][m][n] = (f32x4){0.f, 0.f, 0.f, 0.f};
    bf16x8 At[4][2], B0[2][2], B1[2][2];
    const char* cA = (const char*)g.A + (size_t)cur.pm * tstep; const char* cB = (const char*)g.Bt + (size_t)cur.pn * tstep;
    S.a_ready(cur);
    if constexpr (SP2) {
        PG8_STAGE(PG8_SB(0, 0), cB, voffB); PG8_STAGE(PG8_SB(0, 1), cB + hstep, voffB); PG8_STAGE(PG8_SA(0, 0), cA, voffA); PG8_STAGE(PG8_SA(0, 1), cA + hstep, voffA);
        if (wr == 1) PG8_BAR;
        PG8_WAIT_V(2); PG8_BAR;
        PG8_STAGE(PG8_SB(1, 0), cB + kstep, voffB); PG8_STAGE(PG8_SA(1, 0), cA + kstep, voffA); PG8_STAGE(PG8_SB(1, 1), cB + hstep + kstep, voffB);
        PG8_WAIT_V(6); PG8_BAR;
    } else {
        PG8_STAGE(PG8_SB(0, 0), cB, voffB); PG8_STAGE(PG8_SA(0, 0), cA, voffA); PG8_STAGE(PG8_SB(0, 1), cB + hstep, voffB); PG8_STAGE(PG8_SA(0, 1), cA + hstep, voffA);
        if (wr == 1) PG8_BAR;
        PG8_WAIT_V(4); PG8_BAR;
        PG8_STAGE(PG8_SB(1, 0), cB + kstep, voffB); PG8_STAGE(PG8_SA(1, 0), cA + kstep, voffA); PG8_STAGE(PG8_SB(1, 1), cB + hstep + kstep, voffB);
        PG8_WAIT_V(6); PG8_BAR;
    }
    for (;;) {
        const bool has_next = S.next(ui + 1, nxt);
        const char* nA = has_next ? (const char*)g.A + (size_t)nxt.pm * tstep : cA; const char* nB = has_next ? (const char*)g.Bt + (size_t)nxt.pn * tstep : cB;
        for (int t = 0; t < nt; t += 2) {
            const bool last = (t == nt - 2);
            const char* a1 = cA + (size_t)(t + 1) * kstep;
            const char* a2 = last ? nA : cA + (size_t)(t + 2) * kstep; const char* b2 = last ? nB : cB + (size_t)(t + 2) * kstep;
            const char* a3 = a2 + kstep; const char* b3 = b2 + kstep;
            if (last && has_next) S.a_ready(nxt);
            if constexpr (SP2) {
            PG8_LDB(B0, 0, 0); PG8_LDB(B1, 0, 1); PG8_SCHED; PG8_LDA(At, 0, 0); PG8_STAGE(PG8_SA(1, 1), a1 + hstep, voffA);
            PG8_WAIT_V(8); PG8_WAIT_L(0); PG8_BAR; PG8_MMA(0, 0, At, B0); PG8_MMA(0, 1, At, B1); PG8_BAR; PG8_SCHED;
            PG8_LDA(At, 0, 1); PG8_STAGE(PG8_SB(0, 0), b2, voffB); PG8_STAGE(PG8_SB(0, 1), b2 + hstep, voffB); PG8_STAGE(PG8_SA(0, 0), a2, voffA);
            PG8_WAIT_V(8); PG8_WAIT_L(0); PG8_BAR; PG8_MMA(1, 0, At, B0); PG8_MMA(1, 1, At, B1); PG8_BAR; PG8_SCHED;
            PG8_LDB(B0, 1, 0); PG8_LDB(B1, 1, 1); PG8_SCHED; PG8_LDA(At, 1, 0); PG8_STAGE(PG8_SA(0, 1), a2 + hstep, voffA);
            PG8_WAIT_V(8); PG8_WAIT_L(0); PG8_BAR; PG8_MMA(0, 0, At, B0); PG8_MMA(0, 1, At, B1); PG8_BAR; PG8_SCHED;
            PG8_LDA(At, 1, 1); PG8_STAGE(PG8_SB(1, 0), b3, voffB); PG8_STAGE(PG8_SB(1, 1), b3 + hstep, voffB); PG8_STAGE(PG8_SA(1, 0), a3, voffA);
            PG8_WAIT_V(8); PG8_WAIT_L(0); PG8_BAR; PG8_MMA(1, 0, At, B0); PG8_MMA(1, 1, At, B1); PG8_BAR; PG8_SCHED;
            } else {
            PG8_LDB(B0, 0, 0); PG8_SCHED; PG8_LDA(At, 0, 0); PG8_STAGE(PG8_SA(1, 1), a1 + hstep, voffA);
            PG8_WAIT_L(8); PG8_BAR; PG8_WAIT_L(0); PG8_MMA(0, 0, At, B0); PG8_BAR; PG8_SCHED;
            PG8_LDB(B1, 0, 1); PG8_STAGE(PG8_SB(0, 0), b2, voffB);
            PG8_BAR; PG8_WAIT_L(0); PG8_MMA(0, 1, At, B1); PG8_BAR;
            PG8_LDA(At, 0, 1); PG8_STAGE(PG8_SA(0, 0), a2, voffA);
            PG8_BAR; PG8_WAIT_L(0); PG8_MMA(1, 0, At, B0); PG8_BAR; PG8_SCHED;
            PG8_STAGE(PG8_SB(0, 1), b2 + hstep, voffB);
            PG8_WAIT_V(6); PG8_BAR; PG8_MMA(1, 1, At, B1); PG8_BAR;
            PG8_LDB(B0, 1, 0); PG8_SCHED; PG8_LDA(At, 1, 0); PG8_STAGE(PG8_SA(0, 1), a2 + hstep, voffA);
            PG8_WAIT_L(8); PG8_BAR; PG8_WAIT_L(0); PG8_MMA(0, 0, At, B0); PG8_BAR; PG8_SCHED;
            PG8_LDB(B1, 1, 1); PG8_STAGE(PG8_SB(1, 0), b3, voffB);
            PG8_BAR; PG8_WAIT_L(0); PG8_MMA(0, 1, At, B1); PG8_BAR;
            PG8_LDA(At, 1, 1); PG8_STAGE(PG8_SA(1, 0), a3, voffA);
            PG8_BAR; PG8_WAIT_L(0); PG8_MMA(1, 0, At, B0); PG8_BAR; PG8_SCHED;
            PG8_STAGE(PG8_SB(1, 1), b3 + hstep, voffB);
            PG8_WAIT_V(6); PG8_BAR; PG8_MMA(1, 1, At, B1); PG8_BAR;
            }
        }
        if constexpr (ALIGN_EPI) { if (wr == 0) PG8_BAR; }
        E(acc, cur, wr, wc, fr, fq); S.done(cur);
        if (!has_next) break;
#pragma unroll
        for (int a = 0; a < 2; ++a)
#pragma unroll
            for (int b = 0; b < 2; ++b)
#pragma unroll
                for (int m = 0; m < 4; ++m)
#pragma unroll
                    for (int n = 0; n < 2; ++n) acc[a][b][m][n] = (f32x4){0.f, 0.f, 0.f, 0.f};
        cur = nxt; cA = nA; cB = nB; ++ui;
        if constexpr (ALIGN_EPI) { if (wr == 1) PG8_BAR; }
    }
    PG8_WAIT_V(0);
    if constexpr (!ALIGN_EPI) { if (wr == 0) PG8_BAR; }
    PG8_BAR;
#undef PG8_SA
#undef PG8_SB
#undef PG8_STAGE
#undef PG8_LDA
#undef PG8_LDB
#undef PG8_MMA
#undef PG8_WAIT_V
#undef PG8_WAIT_L
#undef PG8_BAR
#undef PG8_SCHED
}
}

namespace att {
typedef unsigned short bf16;
using bf16x8 = __attribute__((ext_vector_type(8))) short;
using s16x4  = __attribute__((ext_vector_type(4))) short;
using f32x16 = __attribute__((ext_vector_type(16))) float;
using u32x4  = __attribute__((ext_vector_type(4))) unsigned;
constexpr int D = 128, NW = 8, QBLK = 32, KVBLK = 64;
constexpr float SCALE = 0.088388347648318440f;
constexpr float THR = 8.f;
constexpr int SHM_V = KVBLK * D * 2, SHM_K = KVBLK * D * 2, SHM_ATTN = 2 * SHM_V + 2 * SHM_K + NW * 64 * 4;
#define KSWZ(row, colB) ((row) * 256 + ((colB) ^ (((row) & 7) << 4)))
#define SBAR() __builtin_amdgcn_sched_barrier(0)
__device__ __forceinline__ int crow(int r, int hi) { return (r & 3) + 8 * (r >> 2) + 4 * hi; }
__device__ __forceinline__ unsigned cvtpk(float lo, float hi) { unsigned r; asm volatile("v_cvt_pk_bf16_f32 %0, %1, %2" : "=v"(r) : "v"(lo), "v"(hi)); return r; }

__device__ __forceinline__ void partialSM(f32x16& p0, f32x16& p1, float& m_reg, float& mn, float& alpha) {
  constexpr float C = SCALE * 1.4426950408889634f;
  float pmax = p0[0];
#pragma unroll
  for (int r = 1; r < 16; ++r) pmax = fmaxf(pmax, p0[r]);
#pragma unroll
  for (int r = 0; r < 16; ++r) pmax = fmaxf(pmax, p1[r]);
  { auto rr = __builtin_amdgcn_permlane32_swap(__float_as_uint(pmax), __float_as_uint(pmax), false, false);
    pmax = fmaxf(__uint_as_float(rr[0]), __uint_as_float(rr[1])); }
  if (__builtin_expect(__all(pmax - m_reg <= THR / SCALE), 1)) { mn = m_reg; alpha = 1.f; }
  else { mn = fmaxf(m_reg, pmax); alpha = __builtin_amdgcn_exp2f((m_reg - mn) * C); m_reg = mn; }
  float mnC = -mn * C;
#pragma unroll
  for (int r = 0; r < 16; ++r) p0[r] = fmaf(p0[r], C, mnC);
#pragma unroll
  for (int r = 0; r < 16; ++r) p1[r] = fmaf(p1[r], C, mnC);
#pragma unroll
  for (int r = 0; r < 16; ++r) p0[r] = __builtin_amdgcn_exp2f(p0[r]);
}
__device__ __forceinline__ void finishSM(f32x16& p0, f32x16& p1, float alpha, float& l_reg, bf16x8& pa0, bf16x8& pa1, bf16x8& pa2, bf16x8& pa3) {
#pragma unroll
  for (int r = 0; r < 16; ++r) p1[r] = __builtin_amdgcn_exp2f(p1[r]);
  float ps = 0;
#pragma unroll
  for (int r = 0; r < 16; ++r) ps += p0[r];
#pragma unroll
  for (int r = 0; r < 16; ++r) ps += p1[r];
  { auto rr = __builtin_amdgcn_permlane32_swap(__float_as_uint(ps), __float_as_uint(ps), false, false);
    ps = __uint_as_float(rr[0]) + __uint_as_float(rr[1]); }
  l_reg = l_reg * alpha + ps;
#define PK4(P, BASE, OUT) do { unsigned a0 = cvtpk(P[BASE + 0], P[BASE + 1]), a1 = cvtpk(P[BASE + 2], P[BASE + 3]);   \
    unsigned b0 = cvtpk(P[BASE + 4], P[BASE + 5]), b1 = cvtpk(P[BASE + 6], P[BASE + 7]);                              \
    auto r0 = __builtin_amdgcn_permlane32_swap(a0, b0, false, false); auto r1 = __builtin_amdgcn_permlane32_swap(a1, b1, false, false); \
    u32x4 w = {r0[0], r1[0], r0[1], r1[1]}; OUT = *reinterpret_cast<bf16x8*>(&w); } while (0)
  PK4(p0, 0, pa0); PK4(p0, 8, pa1); PK4(p1, 0, pa2); PK4(p1, 8, pa3);
#undef PK4
}
__device__ __forceinline__ void qkt(f32x16& p0, f32x16& p1, const char* Ks, const bf16x8* qr, int r32, int hi) {
  p0 = f32x16{}; p1 = f32x16{};
#pragma unroll
  for (int d0 = 0; d0 < 8; ++d0) { int cb = (d0 * 16 + hi * 8) * 2;
    bf16x8 b0 = *reinterpret_cast<const bf16x8*>(Ks + KSWZ(r32, cb));
    bf16x8 b1 = *reinterpret_cast<const bf16x8*>(Ks + KSWZ(32 + r32, cb));
    p0 = __builtin_amdgcn_mfma_f32_32x32x16_bf16(b0, qr[d0], p0, 0, 0, 0);
    p1 = __builtin_amdgcn_mfma_f32_32x32x16_bf16(b1, qr[d0], p1, 0, 0, 0); }
}
__device__ __forceinline__ int v_st(int k, int c) { const int kk = (k & ~0xC) | ((k & 4) << 1) | ((k & 8) >> 1); return ((kk >> 3) * 4 + (c >> 5)) * 512 + ((kk & 7) * 32 + (c & 31)) * 2; }
__device__ __forceinline__ int v_rd_base(int lane) { return ((lane & 3) << 3) | (((lane >> 2) & 3) << 6) | (((lane >> 4) & 1) << 5) | (((lane >> 5) & 1) << 8); }
constexpr int v_rd_off(int d0, int ks, int half) { return d0 * 512 + ks * 4096 + half * 2048; }
template <int OFF> __device__ __forceinline__ s16x4 tr_read(int vb) {
  s16x4 r; asm volatile("ds_read_b64_tr_b16 %0, %1 offset:%2" : "=&v"(r) : "v"(vb), "i"(OFF) : "memory"); return r;
}
template <int D0> __device__ __forceinline__ void pv_one(f32x16& od, int vb, bf16x8 pa0, bf16x8 pa1, bf16x8 pa2, bf16x8 pa3) {
  const s16x4 l0 = tr_read<v_rd_off(D0, 0, 0)>(vb), h0 = tr_read<v_rd_off(D0, 0, 1)>(vb), l1 = tr_read<v_rd_off(D0, 1, 0)>(vb), h1 = tr_read<v_rd_off(D0, 1, 1)>(vb);
  const s16x4 l2 = tr_read<v_rd_off(D0, 2, 0)>(vb), h2 = tr_read<v_rd_off(D0, 2, 1)>(vb), l3 = tr_read<v_rd_off(D0, 3, 0)>(vb), h3 = tr_read<v_rd_off(D0, 3, 1)>(vb);
  asm volatile("s_waitcnt lgkmcnt(0)" ::: "memory"); SBAR();
#define PK(L, H) (bf16x8){L[0], L[1], L[2], L[3], H[0], H[1], H[2], H[3]}
  od = __builtin_amdgcn_mfma_f32_32x32x16_bf16(pa0, PK(l0, h0), od, 0, 0, 0);
  od = __builtin_amdgcn_mfma_f32_32x32x16_bf16(pa1, PK(l1, h1), od, 0, 0, 0);
  od = __builtin_amdgcn_mfma_f32_32x32x16_bf16(pa2, PK(l2, h2), od, 0, 0, 0);
  od = __builtin_amdgcn_mfma_f32_32x32x16_bf16(pa3, PK(l3, h3), od, 0, 0, 0);
#undef PK
}
__device__ __forceinline__ void pv_d0(f32x16* o, int vb, bf16x8 pa0, bf16x8 pa1, bf16x8 pa2, bf16x8 pa3) {
  pv_one<0>(o[0], vb, pa0, pa1, pa2, pa3); pv_one<1>(o[1], vb, pa0, pa1, pa2, pa3); pv_one<2>(o[2], vb, pa0, pa1, pa2, pa3); pv_one<3>(o[3], vb, pa0, pa1, pa2, pa3);
}

struct Unit {
  const bf16* Q; const bf16* K; const bf16* V; bf16* O; float* lse;
  int qstride, kstride, ostride, lse_stride;
  int NT;
  int kb0, n, qi0, hw;
  float slope_raw;
  float sink; int has_sink;
};

template <bool BAND>
__device__ __forceinline__ void attn_unit(const Unit& U, char* lds, const int tid) {
  const int wid = tid >> 6, lane = tid & 63, r32 = lane & 31, hi = lane >> 5;
  char* V_lds = lds; char* K_lds = lds + 2 * SHM_V;
  float* ws = (float*)(lds + 2 * SHM_V + 2 * SHM_K) + wid * 64; float* li_l = ws; float* al_l = ws + 32;
  float m_reg = -1e30f, l_reg = 0; f32x16 o[4] = {}; bf16x8 qr[8];
  { const unsigned qoff = (unsigned)(wid * QBLK + r32) * (unsigned)U.qstride + (unsigned)(hi * 8);
#pragma unroll
    for (int d0 = 0; d0 < 8; ++d0) qr[d0] = *reinterpret_cast<const bf16x8*>(U.Q + qoff + d0 * 16); }
  const int sr = tid >> 4, sc = (tid & 15) * 8, vst0 = v_st(sr, sc), vst1 = v_st(32 + sr, sc);
  const int vb0 = (int)(uintptr_t)V_lds + v_rd_base(lane);
  struct { bf16x8 vs0, vs1, ks0, ks1; } sr_[2];
  float flo = 0.f, fhi = 0.f, fdq = 0.f;
  if constexpr (BAND) { const int qi = U.qi0 + wid * QBLK + r32; const int lo = -U.hw > -qi ? -U.hw : -qi; const int hh = U.hw < U.n - 1 - qi ? U.hw : U.n - 1 - qi;
    flo = (float)lo; fhi = (float)hh; fdq = (float)(U.kb0 + 4 * hi - qi); }
#define ROWOF(k) ((k) < 0 ? 0 : ((k) >= U.n ? U.n - 1 : (k)))
#define SLOAD(i, k0) do { unsigned _o0, _o1; \
    if constexpr (BAND) { const int _ka = U.kb0 + (k0) + sr; _o0 = (unsigned)ROWOF(_ka) * (unsigned)U.kstride + (unsigned)sc; _o1 = (unsigned)ROWOF(_ka + 32) * (unsigned)U.kstride + (unsigned)sc; } \
    else { _o0 = (unsigned)((k0) + sr) * (unsigned)U.kstride + (unsigned)sc; _o1 = _o0 + 32u * (unsigned)U.kstride; } \
    sr_[i].vs0 = *reinterpret_cast<const bf16x8*>(U.V + _o0); sr_[i].vs1 = *reinterpret_cast<const bf16x8*>(U.V + _o1); \
    sr_[i].ks0 = *reinterpret_cast<const bf16x8*>(U.K + _o0); sr_[i].ks1 = *reinterpret_cast<const bf16x8*>(U.K + _o1); } while (0)
#define SWRITE(b, i) do { *(bf16x8*)(V_lds + (b) * SHM_V + vst0) = sr_[i].vs0;          \
    *(bf16x8*)(V_lds + (b) * SHM_V + vst1) = sr_[i].vs1; int kc = sc * 2;               \
    *(bf16x8*)(K_lds + (b) * SHM_K + KSWZ(sr, kc)) = sr_[i].ks0;                       \
    *(bf16x8*)(K_lds + (b) * SHM_K + KSWZ(32 + sr, kc)) = sr_[i].ks1; } while (0)
#define SWAIT() asm volatile("s_waitcnt vmcnt(4)" ::: "memory")
#define RESC(a) do { if (__any((a) < 1.f)) { if (hi == 0) al_l[r32] = (a); asm volatile("s_waitcnt lgkmcnt(0)" ::: "memory"); \
    _Pragma("unroll") for (int d = 0; d < 4; ++d) _Pragma("unroll") for (int r = 0; r < 16; ++r) o[d][r] *= al_l[crow(r, hi)]; } } while (0)
#define MASKB(P0, P1, j) do { if constexpr (BAND) { const float _f0 = fdq + (float)(64 * (j)); const float _ninf = -__builtin_inff(); \
    _Pragma("unroll") for (int r = 0; r < 16; ++r) { const float d0_ = _f0 + (float)((r & 3) + 8 * (r >> 2)), d1_ = d0_ + 32.f; \
      const float s0_ = fmaf(-U.slope_raw, __builtin_fabsf(d0_), P0[r]), s1_ = fmaf(-U.slope_raw, __builtin_fabsf(d1_), P1[r]); \
      P0[r] = (d0_ >= flo && d0_ <= fhi) ? s0_ : _ninf; P1[r] = (d1_ >= flo && d1_ <= fhi) ? s1_ : _ninf; } } } while (0)
  f32x16 pA0, pA1, pB0, pB1; float mnA, mnB, alA, alB; bf16x8 pa0, pa1, pa2, pa3; const int NT = U.NT;
  constexpr int SE = 0, SO = 1;
  SLOAD(SE, 0); asm volatile("s_waitcnt vmcnt(0)" ::: "memory"); SWRITE(0, SE); __syncthreads();
  qkt(pA0, pA1, K_lds, qr, r32, hi); MASKB(pA0, pA1, 0); partialSM(pA0, pA1, m_reg, mnA, alA);
  SLOAD(SO, KVBLK); if (2 < NT) SLOAD(SE, 2 * KVBLK);
  SWAIT(); SWRITE(1, SO); __syncthreads();
  for (int j = 1; j + 1 < NT; j += 2) {
    SBAR(); qkt(pB0, pB1, K_lds + SHM_K, qr, r32, hi);
    finishSM(pA0, pA1, alA, l_reg, pa0, pa1, pa2, pa3); SBAR();
    SLOAD(SO, (j + 2) * KVBLK); SBAR();
    pv_d0(o, vb0, pa0, pa1, pa2, pa3); MASKB(pB0, pB1, j); partialSM(pB0, pB1, m_reg, mnB, alB);
    __syncthreads(); SWAIT(); SWRITE(0, SE);
    RESC(alB); __syncthreads();
    SBAR(); qkt(pA0, pA1, K_lds, qr, r32, hi);
    finishSM(pB0, pB1, alB, l_reg, pa0, pa1, pa2, pa3); SBAR();
    if (j + 3 < NT) SLOAD(SE, (j + 3) * KVBLK); SBAR();
    pv_d0(o, vb0 + SHM_V, pa0, pa1, pa2, pa3); MASKB(pA0, pA1, j + 1); partialSM(pA0, pA1, m_reg, mnA, alA);
    __syncthreads(); SWAIT(); SWRITE(1, SO);
    RESC(alA); __syncthreads();
  }
  SBAR(); qkt(pB0, pB1, K_lds + SHM_K, qr, r32, hi);
  finishSM(pA0, pA1, alA, l_reg, pa0, pa1, pa2, pa3); SBAR();
  pv_d0(o, vb0, pa0, pa1, pa2, pa3); MASKB(pB0, pB1, NT - 1); partialSM(pB0, pB1, m_reg, mnB, alB);
  __syncthreads(); RESC(alB);
  finishSM(pB0, pB1, alB, l_reg, pa0, pa1, pa2, pa3); SBAR();
  pv_d0(o, vb0 + SHM_V, pa0, pa1, pa2, pa3);
  if constexpr (BAND) {
    if (U.has_sink) l_reg += __builtin_amdgcn_exp2f((U.sink * (1.0f / SCALE) - m_reg) * (SCALE * 1.4426950408889634f));
    if (U.lse != nullptr && hi == 0) U.lse[(unsigned)(wid * QBLK + r32) * (unsigned)U.lse_stride] = m_reg * SCALE + __builtin_amdgcn_logf(l_reg) * 0.6931471805599453f;
  }
  if (hi == 0) li_l[r32] = l_reg; asm volatile("s_waitcnt lgkmcnt(0)" ::: "memory");
  int lane_e = lane; asm volatile("" : "+v"(lane_e));
  const int r32e = lane_e & 31, hie = lane_e >> 5;
  float rli[16];
#pragma unroll
  for (int r = 0; r < 16; ++r) rli[r] = __builtin_amdgcn_rcpf(li_l[crow(r, hie)]);
  __syncthreads();
  char* ost = lds + wid * 8192;
  { char* op = ost + hie * 1024 + r32e * 2;
#pragma unroll
    for (int r = 0; r < 16; ++r) {
#pragma unroll
      for (int d0 = 0; d0 < 4; ++d0) { const unsigned w = cvtpk(o[d0][r] * rli[r], 0.f); *(unsigned short*)(op + ((r & 3) + 8 * (r >> 2)) * 256 + d0 * 64) = (unsigned short)w; } } }
  asm volatile("s_waitcnt lgkmcnt(0)" ::: "memory");
  { const char* ip = ost + (lane_e >> 4) * 256 + (lane_e & 15) * 16;
    unsigned goff = (unsigned)(wid * QBLK + (lane_e >> 4)) * (unsigned)U.ostride + (unsigned)((lane_e & 15) * 8); const unsigned gstep = 4u * (unsigned)U.ostride;
#pragma unroll
    for (int i = 0; i < 8; ++i) { const u32x4 w = *(const u32x4*)(ip + i * 1024); *(u32x4*)(U.O + goff) = w; goff += gstep; } }
  __syncthreads();
#undef ROWOF
#undef SLOAD
#undef SWRITE
#undef SWAIT
#undef RESC
#undef MASKB
}
}

constexpr int NWAVES = 8;
constexpr int DM = 2048, SEQ = 16384, NSEQ = 3, M_ALL = NSEQ * SEQ, DEPTH = 4, DFF = 5632, INC = 13824;
constexpr int A_Q = 0, A_K = 1536, A_V = 3072, B_Q = 4608, B_K = 5632, B_V = 5888, C_Q = 6144, C_K = 7168, C_V = 7424, GL0 = 7680;
constexpr float NORM_EPS = 1e-6f;
enum { I_XP = 0, I_XS, I_NF1, I_F1IN, I_F1OUT, I_NMIX, I_WIN, I_QNQ, I_QNK, I_SINK, I_WA, I_WB, I_WC, I_WO, I_NF2, I_F2IN, I_F2OUT, I_NFIN, N_IN };

constexpr size_t MiB = 1u << 20;
constexpr size_t WS_CTL = 0, CTL_ZERO_BYTES = 1 * MiB;
constexpr size_t WL_F1IN = 0, WL_F1OUT = WL_F1IN + (size_t)2 * DFF * DM * 2, WL_WIN = WL_F1OUT + (size_t)DM * DFF * 2, WL_WA = WL_WIN + (size_t)INC * DM * 2,
                 WL_WB = WL_WA + (size_t)DM * 512 * 2, WL_WC = WL_WB + (size_t)DM * 1024 * 2, WL_WO = WL_WC + (size_t)DM * 1024 * 2, WL_F2IN = WL_WO + (size_t)DM * DM * 2,
                 WL_F2OUT = WL_F2IN + (size_t)2 * DFF * DM * 2, WL_BYTES = WL_F2OUT + (size_t)DM * DFF * 2;
constexpr size_t WS_W = 1 * MiB;
constexpr size_t WS_U = WS_W + DEPTH * WL_BYTES;
constexpr size_t WS_R = WS_U + (size_t)M_ALL * DM * 2;
constexpr size_t WS_H = WS_R;
constexpr size_t WS_QKVG = WS_R;
constexpr size_t WS_OA = WS_QKVG + (size_t)SEQ * INC * 2;
constexpr size_t WS_OB = WS_OA + (size_t)SEQ * 512 * 2;
constexpr size_t WS_OC = WS_OB + (size_t)SEQ * 1024 * 2;
constexpr size_t WS_PA = WS_OC + (size_t)SEQ * 1024 * 2;
constexpr size_t WS_LSE = WS_PA + (size_t)3 * SEQ * 512 * 2;
constexpr size_t WS_QB = WS_LSE + (size_t)3 * SEQ * 4 * 4;
constexpr size_t WS_KB = WS_QB + (size_t)SEQ * 1024 * 2;
constexpr size_t WS_VB = WS_KB + (size_t)SEQ * 256 * 2;
constexpr size_t WS_MG = WS_VB + (size_t)SEQ * 256 * 2;
constexpr size_t WS_MB = WS_MG + (size_t)SEQ * DM * 4;
constexpr size_t WS_MIX_END = WS_MB + (size_t)SEQ * DM * 2;
constexpr size_t WS_H_END = WS_H + (size_t)M_ALL * DFF * 2;
constexpr size_t WS_END = WS_MIX_END > WS_H_END ? WS_MIX_END : WS_H_END;
constexpr int CW_BAR = 4096;

constexpr int RING_OFF = 0, RING_BYTES = 131072;
constexpr int LDSCTL_OFF = RING_BYTES, MISC_OFF = LDSCTL_OFF + 320;
constexpr int LDS_BYTES = 147456;

#define GAS __attribute__((address_space(1)))
#define LAS __attribute__((address_space(3)))
typedef unsigned short bf16;
typedef unsigned v4u __attribute__((ext_vector_type(4)));
typedef unsigned v2u __attribute__((ext_vector_type(2)));
typedef float f32x4 __attribute__((ext_vector_type(4)));
#define LDS_WAIT() asm volatile("s_waitcnt lgkmcnt(0)" ::: "memory")
#define VM_WAIT() asm volatile("s_waitcnt vmcnt(0)" ::: "memory")
__device__ __forceinline__ unsigned f2bf(float f) { unsigned u = __builtin_bit_cast(unsigned, f); return (u + 0x7fffu + ((u >> 16) & 1u)) >> 16; }
__device__ __forceinline__ unsigned pk2(float lo, float hi) { return f2bf(lo) | (f2bf(hi) << 16); }
__device__ __forceinline__ float bflo(unsigned w) { return __uint_as_float(w << 16); }
__device__ __forceinline__ float bfhi(unsigned w) { return __uint_as_float(w & 0xffff0000u); }

#define XB_TMO      128
#define XB_XCNT(j)  (256  + 64 * (j))
#define XB_XSUB(j)  (1280 + 64 * (j))
#define XB_XGEN(j)  (2304 + 64 * (j))
#define XB_TOP      3328
#define XB_TOPGEN   3392
#define XCD_BAR_WORDS 3456
#define XB_SPIN_CAP (1u << 18)
__device__ __forceinline__ unsigned xb_ld(unsigned* p)              { return __hip_atomic_load(p, __ATOMIC_RELAXED, __HIP_MEMORY_SCOPE_AGENT); }
__device__ __forceinline__ unsigned xb_add(unsigned* p, unsigned v) { return __hip_atomic_fetch_add(p, v, __ATOMIC_RELAXED, __HIP_MEMORY_SCOPE_AGENT); }
__device__ __forceinline__ unsigned xb_xcc_id() { return (unsigned)__builtin_amdgcn_s_getreg((3 << 11) | 20) & 0xFu; }
#define XB_SPIN(cond, bar) do { unsigned _sp = 0; while (cond) { __builtin_amdgcn_s_sleep(1); \
    if ((++_sp & 255u) == 0u) { if (xb_ld(&(bar)[XB_TMO])) break; if (_sp > XB_SPIN_CAP) { atomicAdd(&(bar)[XB_TMO], 1u); break; } } } } while (0)
struct XcdBarrier { unsigned* bar; unsigned x; volatile LAS unsigned* st; };
__device__ __forceinline__ XcdBarrier xcd_barrier_post(unsigned* bar, volatile LAS unsigned* st) {
    XcdBarrier b; b.bar = bar; b.x = xb_xcc_id(); b.st = st;
    if (threadIdx.x == 0) (void)xb_add(&bar[XB_XCNT(b.x)], 1u);
    return b;
}
__device__ __forceinline__ void xcd_barrier_complete(unsigned* bar, unsigned x, unsigned& nloc, unsigned& nx) {
    const unsigned G = gridDim.x * gridDim.y * gridDim.z;
    unsigned sum, cnt, mine, sp = 0u;
    for (;;) {
        sum = 0u; cnt = 0u; mine = 0u;
#pragma unroll
        for (unsigned j = 0; j < 16; ++j) { const unsigned c = xb_ld(&bar[XB_XCNT(j)]); sum += c; cnt += (c > 0u) ? 1u : 0u; mine = (j == x) ? c : mine; }
        if (sum == G) break;
        __builtin_amdgcn_s_sleep(1);
        if ((++sp & 255u) == 0u) { if (xb_ld(&bar[XB_TMO])) break; if (sp > XB_SPIN_CAP) { atomicAdd(&bar[XB_TMO], 1u); break; } }
    }
    nloc = mine > 0u ? mine : 1u; nx = cnt > 0u ? cnt : 1u;
}
__device__ __forceinline__ void xcd_barrier(const XcdBarrier& b) {
    asm volatile("s_waitcnt vmcnt(0)" ::: "memory");
    __syncthreads();
    if (threadIdx.x == 0) {
        unsigned* bar = b.bar;
        __builtin_amdgcn_s_waitcnt(0);
        unsigned nloc = b.st[0], nx = b.st[1];
        if (nloc == 0u) { xcd_barrier_complete(bar, b.x, nloc, nx); b.st[0] = nloc; b.st[1] = nx; }
        const unsigned old = xb_add(&bar[XB_XSUB(b.x)], 1u);
        const unsigned gen = old / nloc;
        if (old + 1u == (gen + 1u) * nloc) {
            __builtin_amdgcn_fence(__ATOMIC_RELEASE, "agent");
            asm volatile("s_waitcnt vmcnt(0)" ::: "memory");
            const unsigned og = xb_add(&bar[XB_TOP], 1u);
            const unsigned tg = og / nx;
            if (og + 1u == (tg + 1u) * nx) xb_add(&bar[XB_TOPGEN], 1u);
            else XB_SPIN(xb_ld(&bar[XB_TOPGEN]) == tg, bar);
            __builtin_amdgcn_fence(__ATOMIC_ACQUIRE, "agent");
            xb_add(&bar[XB_XGEN(b.x)], 1u);
            asm volatile("s_waitcnt vmcnt(0)" ::: "memory");
        } else {
            XB_SPIN(xb_ld(&bar[XB_XGEN(b.x)]) == gen, bar);
            __builtin_amdgcn_fence(__ATOMIC_ACQUIRE, "agent");
            asm volatile("s_waitcnt vmcnt(0)" ::: "memory");
        }
    }
    __syncthreads();
}

template <int XOR> __device__ __forceinline__ float swz_xor(float v) { return __int_as_float(__builtin_amdgcn_ds_swizzle(__float_as_int(v), (XOR << 10) | 0x1F)); }
__device__ __forceinline__ float wave_sum(float v) {
    v += swz_xor<1>(v); v += swz_xor<2>(v); v += swz_xor<4>(v); v += swz_xor<8>(v); v += swz_xor<16>(v);
    auto rr = __builtin_amdgcn_permlane32_swap(__float_as_uint(v), __float_as_uint(v), false, false);
    return __uint_as_float(rr[0]) + __uint_as_float(rr[1]);
}
__device__ __forceinline__ void transpose_item(const float* W, int K, int N, bf16* WT, int k0, int n0, int orow0, LAS float* scr, int lane) {
#pragma unroll 8
    for (int i = 0; i < 32; ++i) { const int kk = 2 * i + (lane >> 5); scr[kk * 33 + (lane & 31)] = W[(size_t)(k0 + kk) * N + n0 + (lane & 31)]; }
    LDS_WAIT(); asm volatile("" ::: "memory");
    const int c = lane & 7;
#pragma unroll
    for (int j = 0; j < 4; ++j) { const int n = (lane >> 3) + 8 * j; const LAS float* s = scr + (8 * c) * 33 + n;
        v4u o; o.x = pk2(s[0 * 33], s[1 * 33]); o.y = pk2(s[2 * 33], s[3 * 33]); o.z = pk2(s[4 * 33], s[5 * 33]); o.w = pk2(s[6 * 33], s[7 * 33]);
        *(GAS v4u*)(WT + (size_t)(orow0 + n) * K + k0 + 8 * c) = o; }
    LDS_WAIT(); asm volatile("" ::: "memory");
}
__device__ __forceinline__ void transpose_matrix(const float* W, int K, int N, bf16* WT, int swiglu, LAS float* scr, int lane, int gw, int NGW) {
    const int nblk = N / 32, nitems = (K / 64) * nblk;
    for (int it = gw; it < nitems; it += NGW) {
        const int kb = it / nblk, nb = it % nblk, k0 = 64 * kb, n0 = 32 * nb;
        int orow0 = n0;
        if (swiglu) { const int half = n0 >= DFF ? 1 : 0, np = n0 - half * DFF; orow0 = 256 * (np / 128) + 128 * half + (np % 128); }
        transpose_item(W, K, N, WT, k0, n0, orow0, scr, lane);
    }
}
__device__ __forceinline__ void rms_row_to_bf16(const float* xrow, const float* g, bf16* orow, float* xcopy, int lane) {
    const GAS f32x4* xr = (const GAS f32x4*)xrow + lane; const GAS f32x4* gr = (const GAS f32x4*)g + lane;
    f32x4 v[8]; float s = 0.f;
#pragma unroll
    for (int j = 0; j < 8; ++j) { v[j] = xr[64 * j]; s += (v[j].x * v[j].x + v[j].y * v[j].y) + (v[j].z * v[j].z + v[j].w * v[j].w); }
    if (xcopy) { GAS f32x4* xc = (GAS f32x4*)xcopy + lane;
#pragma unroll
        for (int j = 0; j < 8; ++j) xc[64 * j] = v[j]; }
    const float rstd = __builtin_amdgcn_rsqf(wave_sum(s) * (1.f / DM) + NORM_EPS);
    GAS v2u* o8 = (GAS v2u*)orow + lane;
#pragma unroll
    for (int j = 0; j < 8; ++j) { const f32x4 gg = gr[64 * j]; v2u w; w.x = pk2(v[j].x * rstd * gg.x, v[j].y * rstd * gg.y); w.y = pk2(v[j].z * rstd * gg.z, v[j].w * rstd * gg.w); o8[64 * j] = w; }
}
__device__ __forceinline__ void rms_row_f32(float* xrow, const float* g, int lane) {
    GAS f32x4* xr = (GAS f32x4*)xrow + lane; const GAS f32x4* gr = (const GAS f32x4*)g + lane;
    f32x4 v[8]; float s = 0.f;
#pragma unroll
    for (int j = 0; j < 8; ++j) { v[j] = xr[64 * j]; s += (v[j].x * v[j].x + v[j].y * v[j].y) + (v[j].z * v[j].z + v[j].w * v[j].w); }
    const float rstd = __builtin_amdgcn_rsqf(wave_sum(s) * (1.f / DM) + NORM_EPS);
#pragma unroll
    for (int j = 0; j < 8; ++j) { const f32x4 gg = gr[64 * j]; xr[64 * j] = v[j] * rstd * gg; }
}
__device__ __forceinline__ void ropeB_token(const bf16* qkvg_row, int t, const float* gq, const float* gk, bf16* qb, bf16* kb, bf16* vb, int lane) {
    const int f = lane & 31; const float pos = (float)((lane < 32) ? (t >> 6) : (t & 63));
    const float invrev = __builtin_amdgcn_exp2f((float)f * (-13.287712379549449f / 32.0f)) * 0.15915494309189535f;
    float rev = pos * invrev; rev = rev - __builtin_floorf(rev);
    const float cs = __builtin_amdgcn_cosf(rev), sn = __builtin_amdgcn_sinf(rev);
    const float gq0 = gq[2 * lane], gq1 = gq[2 * lane + 1], gk0 = gk[2 * lane], gk1 = gk[2 * lane + 1];
    const GAS unsigned* src = (const GAS unsigned*)(qkvg_row + B_Q) + lane;
#pragma unroll
    for (int h = 0; h < 10; ++h) {
        const unsigned w = src[h * 64]; const float x0 = bflo(w), x1 = bfhi(w);
        const float rstd = __builtin_amdgcn_rsqf(wave_sum(x0 * x0 + x1 * x1) * (1.f / 128.f) + NORM_EPS);
        const float y0 = x0 * rstd * (h < 8 ? gq0 : gk0), y1 = x1 * rstd * (h < 8 ? gq1 : gk1);
        const unsigned o = pk2(y0 * cs - y1 * sn, y0 * sn + y1 * cs);
        if (h < 8) ((GAS unsigned*)qb)[h * 64 + lane] = o; else ((GAS unsigned*)kb)[(h - 8) * 64 + lane] = o;
    }
    ((GAS v2u*)vb)[lane] = ((const GAS v2u*)(qkvg_row + B_V))[lane];
}
__device__ __forceinline__ void mergeA_token(const bf16* pa, const float* lse, bf16* oa, int t, int lane) {
#pragma unroll
    for (int hh = 0; hh < 4; ++hh) {
        const float l0 = lse[((size_t)0 * SEQ + t) * 4 + hh], l1 = lse[((size_t)1 * SEQ + t) * 4 + hh], l2 = lse[((size_t)2 * SEQ + t) * 4 + hh];
        const float mx = fmaxf(l0, fmaxf(l1, l2));
        const float e0 = __builtin_amdgcn_exp2f((l0 - mx) * 1.4426950408889634f), e1 = __builtin_amdgcn_exp2f((l1 - mx) * 1.4426950408889634f), e2 = __builtin_amdgcn_exp2f((l2 - mx) * 1.4426950408889634f);
        const float inv = __builtin_amdgcn_rcpf(e0 + e1 + e2);
        const unsigned w0 = ((const GAS unsigned*)(pa + ((size_t)0 * SEQ + t) * 512))[hh * 64 + lane], w1 = ((const GAS unsigned*)(pa + ((size_t)1 * SEQ + t) * 512))[hh * 64 + lane],
                       w2 = ((const GAS unsigned*)(pa + ((size_t)2 * SEQ + t) * 512))[hh * 64 + lane];
        const float a = (e0 * bflo(w0) + e1 * bflo(w1) + e2 * bflo(w2)) * inv, b = (e0 * bfhi(w0) + e1 * bfhi(w1) + e2 * bfhi(w2)) * inv;
        ((GAS unsigned*)(oa + (size_t)t * 512))[hh * 64 + lane] = pk2(a, b);
    }
}

struct Args { const float* in[N_IN]; float* out; unsigned char* ws; int ph_lo, ph_hi; };
constexpr int N_PHASES = 1 + DEPTH * (3 + 1 + NSEQ * 5 + 3) + 1;

__device__ __forceinline__ int opq_v(int x) { asm volatile("" : "+v"(x)); return x; }
template <class T> __device__ __forceinline__ T* opq_p(T* p) { GAS T* g = (GAS T*)p; asm volatile("" : "+s"(g)); return (T*)g; }
__device__ __forceinline__ int lane_id_asm() { int l; asm volatile("v_mbcnt_lo_u32_b32 %0, -1, 0\n\tv_mbcnt_hi_u32_b32 %0, -1, %0" : "=v"(l)); return l; }
__device__ __forceinline__ int opq_s(int x) { asm volatile("" : "+s"(x)); return x; }

__global__ void __launch_bounds__(NWAVES * 64, 2) trunk_fwd(Args args) {
    extern __shared__ __attribute__((aligned(16))) unsigned char lds[];
    LAS unsigned char* ldsl = (LAS unsigned char*)lds;
    volatile LAS unsigned* MISC = (volatile LAS unsigned*)(ldsl + MISC_OFF);
    const int G_k = gridDim.x; const int bx_k = blockIdx.x;
    const int wave0 = __builtin_amdgcn_readfirstlane((int)threadIdx.x >> 6);
    { const int tid0 = threadIdx.x;
      for (int u = tid0; u < (LDS_BYTES - LDSCTL_OFF) / 4; u += NWAVES * 64) ((LAS unsigned*)(ldsl + LDSCTL_OFF))[u] = 0u; }
    __syncthreads();
    XcdBarrier bar; bar.bar = (unsigned*)(args.ws + WS_CTL) + CW_BAR; bar.x = 0; bar.st = nullptr;
    if (!MK_PER_PHASE) bar = xcd_barrier_post((unsigned*)(args.ws + WS_CTL) + CW_BAR, MISC + 8);
    const int lo = args.ph_lo, hi = args.ph_hi;
    int ph = 0;
#define PH_ON (ph >= lo && ph < hi)
#define PH_VARS const int G = opq_s(G_k), bx = opq_s(bx_k), vcu = (G % 8 == 0) ? (bx % 8) * (G / 8) + bx / 8 : bx, NGW = G * NWAVES; (void)NGW; const int lane = lane_id_asm(), wave = wave0, tid = wave * 64 + lane, gw = vcu * NWAVES + wave; unsigned char* ws = opq_p(args.ws); float* X = opq_p(args.out); (void)lane; (void)gw; (void)ws; (void)X
#define PH_END do { if (PH_ON && ph + 1 < hi) { XcdBarrier b2_ = bar; b2_.bar = opq_p(bar.bar); b2_.x = (unsigned)opq_s((int)bar.x); xcd_barrier(b2_); } ++ph; } while (0)

    if (PH_ON) {
        PH_VARS;
        LAS float* scr = (LAS float*)(ldsl + RING_OFF + wave * 16384);
        for (int l = 0; l < DEPTH; ++l) {
            unsigned char* wl = ws + WS_W + (size_t)l * WL_BYTES;
            transpose_matrix(args.in[I_F1IN] + (size_t)l * DM * 2 * DFF, DM, 2 * DFF, (bf16*)(wl + WL_F1IN), 1, scr, lane, gw, NGW);
            transpose_matrix(args.in[I_F1OUT] + (size_t)l * DFF * DM, DFF, DM, (bf16*)(wl + WL_F1OUT), 0, scr, lane, gw, NGW);
            transpose_matrix(args.in[I_WIN] + (size_t)l * DM * INC, DM, INC, (bf16*)(wl + WL_WIN), 0, scr, lane, gw, NGW);
            transpose_matrix(args.in[I_WA] + (size_t)l * 512 * DM, 512, DM, (bf16*)(wl + WL_WA), 0, scr, lane, gw, NGW);
            transpose_matrix(args.in[I_WB] + (size_t)l * 1024 * DM, 1024, DM, (bf16*)(wl + WL_WB), 0, scr, lane, gw, NGW);
            transpose_matrix(args.in[I_WC] + (size_t)l * 1024 * DM, 1024, DM, (bf16*)(wl + WL_WC), 0, scr, lane, gw, NGW);
            transpose_matrix(args.in[I_WO] + (size_t)l * DM * DM, DM, DM, (bf16*)(wl + WL_WO), 0, scr, lane, gw, NGW);
            transpose_matrix(args.in[I_F2IN] + (size_t)l * DM * 2 * DFF, DM, 2 * DFF, (bf16*)(wl + WL_F2IN), 1, scr, lane, gw, NGW);
            transpose_matrix(args.in[I_F2OUT] + (size_t)l * DFF * DM, DFF, DM, (bf16*)(wl + WL_F2OUT), 0, scr, lane, gw, NGW);
        }
        bf16* U = (bf16*)(ws + WS_U);
        for (int m = gw; m < M_ALL; m += NGW) {
            const float* xr = (m < 2 * SEQ) ? args.in[I_XP] + (size_t)m * DM : args.in[I_XS] + (size_t)(m - 2 * SEQ) * DM;
            rms_row_to_bf16(xr, args.in[I_NF1], U + (size_t)m * DM, X + (size_t)m * DM, lane);
        }
    }
    PH_END;

    for (int l = 0; l < DEPTH; ++l) {
        for (int half = 0; half < 2; ++half) {
            if (PH_ON) {
                PH_VARS;
                if (!(l == 0 && half == 0)) {
                    bf16* U = (bf16*)(ws + WS_U);
                    const float* g = (half == 0 ? args.in[I_NF1] : args.in[I_NF2]) + (size_t)l * DM;
                    for (int m = gw; m < M_ALL; m += NGW) rms_row_to_bf16(X + (size_t)m * DM, g, U + (size_t)m * DM, nullptr, lane);
                }
            }
            PH_END;
            if (PH_ON) {
                PH_VARS;
                unsigned char* wl = ws + WS_W + (size_t)l * WL_BYTES;
                pg8::Gemm g{(const bf16*)(ws + WS_U), (const bf16*)(wl + (half == 0 ? WL_F1IN : WL_F2IN)), M_ALL, 2 * DFF, DM}; pg8::StaticOrder S; S.init(M_ALL, 2 * DFF, G, bx);
                pg8::EpiSwiglu E{(bf16*)(ws + WS_H), DFF};
                pg8::gemm_phase<pg8::EpiSwiglu, pg8::StaticOrder, true, true>(ldsl + RING_OFF, g, S, E, tid);
            }
            PH_END;
            if (PH_ON) {
                PH_VARS;
                unsigned char* wl = ws + WS_W + (size_t)l * WL_BYTES;
                pg8::Gemm g{(const bf16*)(ws + WS_H), (const bf16*)(wl + (half == 0 ? WL_F1OUT : WL_F2OUT)), M_ALL, DM, DFF}; pg8::StaticOrder S; S.init(M_ALL, DM, G, bx);
                pg8::EpiResid E{X, DM, 0.5f};
                pg8::gemm_phase<pg8::EpiResid, pg8::StaticOrder, true, true>(ldsl + RING_OFF, g, S, E, tid);
            }
            PH_END;
            if (half == 0) {
                if (PH_ON) {
                    PH_VARS;
                    bf16* U = (bf16*)(ws + WS_U);
                    const float* g = args.in[I_NMIX] + (size_t)l * DM;
                    for (int m = gw; m < M_ALL; m += NGW) rms_row_to_bf16(X + (size_t)m * DM, g, U + (size_t)m * DM, nullptr, lane);
                }
                PH_END;
                for (int s = 0; s < NSEQ; ++s) {
                    if (PH_ON) {
                        PH_VARS;
                        unsigned char* wl = ws + WS_W + (size_t)l * WL_BYTES;
                        pg8::Gemm g{(const bf16*)(ws + WS_U) + (size_t)s * SEQ * DM, (const bf16*)(wl + WL_WIN), SEQ, INC, DM}; pg8::StaticOrder S; S.init(SEQ, INC, G, bx);
                        pg8::EpiBf16 E{(bf16*)(ws + WS_QKVG), INC};
                        pg8::gemm_phase<pg8::EpiBf16, pg8::StaticOrder, true, true>(ldsl + RING_OFF, g, S, E, tid);
                    }
                    PH_END;
                    if (PH_ON) {
                        PH_VARS;
                        bf16* QKVG = (bf16*)(ws + WS_QKVG);
                        { bf16* QB = (bf16*)(ws + WS_QB); bf16* KB = (bf16*)(ws + WS_KB); bf16* VB = (bf16*)(ws + WS_VB);
                          const float* gq = args.in[I_QNQ] + (size_t)l * 128; const float* gk = args.in[I_QNK] + (size_t)l * 128;
                          for (int t = gw; t < SEQ; t += NGW) ropeB_token(QKVG + (size_t)t * INC, t, gq, gk, QB + (size_t)t * 1024, KB + (size_t)t * 256, VB + (size_t)t * 256, lane); }
                        for (int u = vcu; u < 8 * 64 + 12 * 64; u += G) {
                            att::Unit A;
                            if (u < 8 * 64) {
                                const int h = u >> 6, b = u & 63;
                                A.Q = QKVG + (size_t)(256 * b) * INC + C_Q + h * 128; A.qstride = INC;
                                A.K = QKVG + C_K + (h >> 2) * 128; A.V = QKVG + C_V + (h >> 2) * 128; A.kstride = INC;
                                A.O = (bf16*)(ws + WS_OC) + (size_t)(256 * b) * 1024 + h * 128; A.ostride = 1024;
                                A.NT = 8; A.kb0 = 256 * b - 128; A.n = SEQ; A.qi0 = 256 * b; A.hw = 128;
                                A.slope_raw = __uint_as_float((unsigned)(127 - (h + 1)) << 23) * (1.0f / att::SCALE);
                                A.sink = args.in[I_SINK][l * 8 + h]; A.has_sink = 1; A.lse = nullptr; A.lse_stride = 0;
                            } else {
                                const int v = u - 8 * 64, h = v >> 6, w = v & 63, gi = h >> 2, rs = 2 * gi, r = 1 << rs;
                                const int bpc = 64 >> rs, c = w / bpc, b = w % bpc, nsub = SEQ >> rs;
                                A.Q = QKVG + (size_t)(c + r * 256 * b) * INC + A_Q + h * 128; A.qstride = r * INC;
                                A.K = QKVG + (size_t)c * INC + A_K + h * 128; A.V = QKVG + (size_t)c * INC + A_V + h * 128; A.kstride = r * INC;
                                A.O = (bf16*)(ws + WS_PA) + ((size_t)gi * SEQ + c + r * 256 * b) * 512 + (h & 3) * 128; A.ostride = r * 512;
                                A.NT = 6; A.kb0 = 256 * b - 64; A.n = nsub; A.qi0 = 256 * b; A.hw = 64;
                                const float sl = __builtin_amdgcn_exp2f(-8.0f * (float)(h + 1) / 12.0f) * (float)r * (1.0f / att::SCALE);
                                A.slope_raw = __uint_as_float(__builtin_amdgcn_readfirstlane(__float_as_uint(sl)));
                                A.sink = 0.f; A.has_sink = 0; A.lse = (float*)(ws + WS_LSE) + ((size_t)gi * SEQ + c + r * 256 * b) * 4 + (h & 3); A.lse_stride = r * 4;
                            }
                            att::attn_unit<true>(A, (char*)lds + RING_OFF, tid);
                        }
                    }
                    PH_END;
                    if (PH_ON) {
                        PH_VARS;
                        for (int t = gw; t < SEQ; t += NGW) mergeA_token((const bf16*)(ws + WS_PA), (const float*)(ws + WS_LSE), (bf16*)(ws + WS_OA), t, lane);
                        for (int u = vcu; u < 8 * 64; u += G) {
                            const int h = u >> 6, b = u & 63;
                            att::Unit A;
                            A.Q = (const bf16*)(ws + WS_QB) + (size_t)(256 * b) * 1024 + h * 128; A.qstride = 1024;
                            A.K = (const bf16*)(ws + WS_KB) + (h >> 2) * 128; A.V = (const bf16*)(ws + WS_VB) + (h >> 2) * 128; A.kstride = 256;
                            A.O = (bf16*)(ws + WS_OB) + (size_t)(256 * b) * 1024 + h * 128; A.ostride = 1024;
                            A.NT = SEQ / 64; A.kb0 = 0; A.n = SEQ; A.qi0 = 0; A.hw = 0; A.slope_raw = 0.f; A.sink = 0.f; A.has_sink = 0; A.lse = nullptr; A.lse_stride = 0;
                            att::attn_unit<false>(A, (char*)lds + RING_OFF, tid);
                        }
                    }
                    PH_END;
                    if (PH_ON) {
                        PH_VARS;
                        unsigned char* wl = ws + WS_W + (size_t)l * WL_BYTES;
                        for (int br = 0; br < 3; ++br) {
                            const bf16* Ap = (const bf16*)(ws + (br == 0 ? WS_OA : (br == 1 ? WS_OB : WS_OC))); const int Kb = br == 0 ? 512 : 1024;
                            const bf16* Wp = (const bf16*)(wl + (br == 0 ? WL_WA : (br == 1 ? WL_WB : WL_WC)));
                            pg8::Gemm g{Ap, Wp, SEQ, DM, Kb}; pg8::StaticOrder S; S.init(SEQ, DM, G, bx);
                            pg8::EpiGate E{(const bf16*)(ws + WS_QKVG) + GL0 + br * DM, INC, (float*)(ws + WS_MG), (bf16*)(ws + WS_MB), DM, br};
                            pg8::gemm_phase<pg8::EpiGate, pg8::StaticOrder, true, true>(ldsl + RING_OFF, g, S, E, tid);
                        }
                    }
                    PH_END;
                    if (PH_ON) {
                        PH_VARS;
                        unsigned char* wl = ws + WS_W + (size_t)l * WL_BYTES;
                        pg8::Gemm g{(const bf16*)(ws + WS_MB), (const bf16*)(wl + WL_WO), SEQ, DM, DM}; pg8::StaticOrder S; S.init(SEQ, DM, G, bx);
                        pg8::EpiResid E{X + (size_t)s * SEQ * DM, DM, 1.0f};
                        pg8::gemm_phase<pg8::EpiResid, pg8::StaticOrder, true, true>(ldsl + RING_OFF, g, S, E, tid);
                    }
                    PH_END;
                }
            }
        }
    }
    if (PH_ON) {
        PH_VARS;
        for (int m = gw; m < M_ALL; m += NGW) rms_row_f32(X + (size_t)m * DM, args.in[I_NFIN], lane);
    }
    PH_END;
#undef PH_ON
#undef PH_VARS
#undef PH_END
}

extern "C" void kernel_launch(void* const* d_in, const int* in_sizes, int n_in, void* d_out, int out_size, void* d_ws, size_t ws_size, hipStream_t stream) {
    static int grid = 0;
    if (grid == 0) {
        if (n_in != N_IN || out_size != M_ALL * DM || ws_size < WS_END) { fprintf(stderr, "kernel_launch: shape/workspace mismatch (n_in %d out %d ws %zu need %zu)\n", n_in, out_size, ws_size, (size_t)WS_END); grid = -1; return; }
        int dev = 0, cus = 0, per_cu = 0;
        if (hipGetDevice(&dev) != hipSuccess || hipDeviceGetAttribute(&cus, hipDeviceAttributeMultiprocessorCount, dev) != hipSuccess) { grid = -1; return; }
        if (hipFuncSetAttribute((const void*)trunk_fwd, hipFuncAttributeMaxDynamicSharedMemorySize, LDS_BYTES) != hipSuccess) { fprintf(stderr, "kernel_launch: hipFuncSetAttribute failed\n"); grid = -1; return; }
        if (hipOccupancyMaxActiveBlocksPerMultiprocessor(&per_cu, (const void*)trunk_fwd, NWAVES * 64, LDS_BYTES) != hipSuccess || per_cu < 1) { fprintf(stderr, "kernel_launch: occupancy query reports %d\n", per_cu); }
        (void)hipGetLastError();
        grid = cus;
    }
    if (grid < 0) return;
    if (hipMemsetAsync((char*)d_ws + WS_CTL, 0, CTL_ZERO_BYTES, stream) != hipSuccess) return;
    Args a{};
    for (int i = 0; i < N_IN; ++i) a.in[i] = (const float*)d_in[i];
    a.out = (float*)d_out; a.ws = (unsigned char*)d_ws;
#if MK_PER_PHASE
    for (int p = 0; p < N_PHASES; ++p) { a.ph_lo = p; a.ph_hi = p + 1; hipLaunchKernelGGL(trunk_fwd, dim3(grid), dim3(NWAVES * 64), LDS_BYTES, stream, a); }
#else
    a.ph_lo = 0; a.ph_hi = N_PHASES;
    hipLaunchKernelGGL(trunk_fwd, dim3(grid), dim3(NWAVES * 64), LDS_BYTES, stream, a);
#endif
    const hipError_t le = hipPeekAtLastError();
    if (le != hipSuccess) fprintf(stderr, "kernel_launch: launch failed: %s\n", hipGetErrorName(le));
}
```

```cpp
#include <hip/hip_runtime.h>
#include <cstdio>
#include <cstdint>

#ifndef MK_PER_PHASE
#define MK_PER_PHASE 0
#endif

namespace pg8 {
#define PG8_LAS __attribute__((address_space(3)))
typedef unsigned short bf16_t;
typedef short bf16x8 __attribute__((ext_vector_type(8)));
typedef float f32x4 __attribute__((ext_vector_type(4)));
typedef unsigned u32x4 __attribute__((ext_vector_type(4)));
typedef unsigned u32x2 __attribute__((ext_vector_type(2)));
constexpr int BM = 256, BK = 64, HALF = 128, HTB = HALF * BK * 2, STAGE_BYTES = 8 * HTB, NXCD = 8, WGM = 8;

__host__ __device__ __forceinline__ int lds_byte(int r, int c) { const int st = (r >> 4) * 2 + (c >> 5), rr = r & 15, cc = c & 31, ob = rr * 64 + cc * 2; return st * 1024 + (ob ^ (((ob >> 9) & 1) << 5)); }
__host__ __device__ __forceinline__ void stage_rc(int b, int& R, int& C) { const int st = b / 1024, sb = b % 1024, swz = sb ^ (((sb >> 9) & 1) << 5); R = (st >> 1) * 16 + swz / 64; C = (st & 1) * 32 + (swz % 64) / 2; }
__host__ __device__ __forceinline__ int perm32(int rho) { const int n = rho >> 4, i = rho & 15; return 8 * (i >> 2) + 4 * n + (i & 3); }

struct Unit { int pm, pn; };
struct Gemm { const bf16_t* A; const bf16_t* Bt; int M, N, K; };

struct StaticOrder {
    int nM, nN, nwg, G, c;
    __host__ __device__ void init(int M, int N, int G_, int c_) { nM = M / BM; nN = N / BM; nwg = nM * nN; G = G_; c = c_; }
    __host__ __device__ bool next(int i, Unit& u) const {
        const long L = (long)i * G + c; if (L >= nwg) return false;
        int wgid = (int)L; { const int q = nwg / NXCD, r = nwg % NXCD, xcd = wgid % NXCD, off = wgid / NXCD; wgid = (xcd < r ? xcd * (q + 1) : r * (q + 1) + (xcd - r) * q) + off; }
        const int nig = WGM * nN, gid = wgid / nig, fm = gid * WGM, gsz = (nM - fm) < WGM ? (nM - fm) : WGM;
        u.pm = fm + ((wgid % nig) % gsz); u.pn = (wgid % nig) / gsz; return true;
    }
    __device__ __forceinline__ void a_ready(const Unit&) const {}
    __device__ __forceinline__ void done(const Unit&) const {}
};

__device__ __forceinline__ unsigned cvt_pk_bf16(float lo, float hi) { unsigned r; asm volatile("v_cvt_pk_bf16_f32 %0, %1, %2" : "=v"(r) : "v"(lo), "v"(hi)); return r; }
__device__ __forceinline__ float bf_lo(unsigned w) { return __uint_as_float(w << 16); }
__device__ __forceinline__ float bf_hi(unsigned w) { return __uint_as_float(w & 0xffff0000u); }
__device__ __forceinline__ float sigmoidf_(float x) { return __builtin_amdgcn_rcpf(1.0f + __builtin_amdgcn_exp2f(-1.4426950408889634f * x)); }

struct EpiBf16 {
    static constexpr bool PERM = true, AFTER_DRAIN = false;
    bf16_t* O; int ldc;
    __device__ __forceinline__ void operator()(const f32x4 (&acc)[2][2][4][2], const Unit& u, int wr, int wc, int fr, int fq) const {
        const int row0 = u.pm * BM + wr * 64 + fr, col0 = u.pn * BM + wc * 32 + 8 * fq;
#pragma unroll
        for (int ai = 0; ai < 2; ++ai)
#pragma unroll
            for (int m = 0; m < 4; ++m) { bf16_t* rowp = O + (size_t)(row0 + ai * HALF + m * 16) * ldc + col0;
#pragma unroll
                for (int bj = 0; bj < 2; ++bj) { const f32x4 v0 = acc[ai][bj][m][0], v1 = acc[ai][bj][m][1];
                    u32x4 w; w.x = cvt_pk_bf16(v0[0], v0[1]); w.y = cvt_pk_bf16(v0[2], v0[3]); w.z = cvt_pk_bf16(v1[0], v1[1]); w.w = cvt_pk_bf16(v1[2], v1[3]);
                    *(u32x4*)(rowp + bj * HALF) = w; } }
    }
};
struct EpiSwiglu {
    static constexpr bool PERM = true, AFTER_DRAIN = false;
    bf16_t* H; int ldc;
    __device__ __forceinline__ void operator()(const f32x4 (&acc)[2][2][4][2], const Unit& u, int wr, int wc, int fr, int fq) const {
        const int row0 = u.pm * BM + wr * 64 + fr, col0 = u.pn * HALF + wc * 32 + 8 * fq;
#pragma unroll
        for (int ai = 0; ai < 2; ++ai)
#pragma unroll
            for (int m = 0; m < 4; ++m) { bf16_t* rowp = H + (size_t)(row0 + ai * HALF + m * 16) * ldc + col0;
                float h[8];
#pragma unroll
                for (int n = 0; n < 2; ++n)
#pragma unroll
                    for (int e = 0; e < 4; ++e) { const float a = acc[ai][0][m][n][e], b = acc[ai][1][m][n][e]; h[n * 4 + e] = a * sigmoidf_(a) * b; }
                u32x4 w; w.x = cvt_pk_bf16(h[0], h[1]); w.y = cvt_pk_bf16(h[2], h[3]); w.z = cvt_pk_bf16(h[4], h[5]); w.w = cvt_pk_bf16(h[6], h[7]);
                *(u32x4*)rowp = w; }
    }
};
struct EpiResid {
    static constexpr bool PERM = false, AFTER_DRAIN = false;
    float* X; int ldc; float scale;
    __device__ __forceinline__ void operator()(const f32x4 (&acc)[2][2][4][2], const Unit& u, int wr, int wc, int fr, int fq) const {
        const int row0 = u.pm * BM + wr * 64 + fr, col0 = u.pn * BM + wc * 32 + 4 * fq;
#pragma unroll
        for (int ai = 0; ai < 2; ++ai)
#pragma unroll
            for (int m = 0; m < 4; ++m) { float* rowp = X + (size_t)(row0 + ai * HALF + m * 16) * ldc + col0;
#pragma unroll
                for (int bj = 0; bj < 2; ++bj)
#pragma unroll
                    for (int n = 0; n < 2; ++n) { f32x4* p = (f32x4*)(rowp + bj * HALF + n * 16); *p = *p + acc[ai][bj][m][n] * scale; }
                if (m & 1) asm volatile("" ::: "memory"); }
    }
};
struct EpiGate {
    static constexpr bool PERM = true, AFTER_DRAIN = false;
    const bf16_t* GL; int ldg; float* MG; bf16_t* MB; int ldc; int mode;
    __device__ __forceinline__ void operator()(const f32x4 (&acc)[2][2][4][2], const Unit& u, int wr, int wc, int fr, int fq) const {
        const int row0 = u.pm * BM + wr * 64 + fr, col0 = u.pn * BM + wc * 32 + 8 * fq;
#pragma unroll
        for (int ai = 0; ai < 2; ++ai)
#pragma unroll
            for (int m = 0; m < 4; ++m) { const size_t row = (size_t)(row0 + ai * HALF + m * 16);
#pragma unroll
                for (int bj = 0; bj < 2; ++bj) { const int col = col0 + bj * HALF;
                    const u32x4 g = *(const u32x4*)(GL + row * ldg + col);
                    f32x4 v0 = acc[ai][bj][m][0], v1 = acc[ai][bj][m][1];
                    v0[0] *= sigmoidf_(bf_lo(g.x)); v0[1] *= sigmoidf_(bf_hi(g.x)); v0[2] *= sigmoidf_(bf_lo(g.y)); v0[3] *= sigmoidf_(bf_hi(g.y));
                    v1[0] *= sigmoidf_(bf_lo(g.z)); v1[1] *= sigmoidf_(bf_hi(g.z)); v1[2] *= sigmoidf_(bf_lo(g.w)); v1[3] *= sigmoidf_(bf_hi(g.w));
                    float* mp = MG + row * ldc + col;
                    if (mode > 0) { v0 = v0 + *(const f32x4*)mp; v1 = v1 + *(const f32x4*)(mp + 4); }
                    if (mode < 2) { *(f32x4*)mp = v0; *(f32x4*)(mp + 4) = v1; }
                    else { u32x4 w; w.x = cvt_pk_bf16(v0[0], v0[1]); w.y = cvt_pk_bf16(v0[2], v0[3]); w.z = cvt_pk_bf16(v1[0], v1[1]); w.w = cvt_pk_bf16(v1[2], v1[3]);
                        *(u32x4*)(MB + row * ldc + col) = w; } }
                asm volatile("" ::: "memory"); }
    }
};

template <class Epi, class Sched, bool ALIGN_EPI = false, bool SP2 = false>
__device__ __forceinline__ void gemm_phase(PG8_LAS unsigned char* lds, const Gemm g, const Sched& S, const Epi& E, const int tid) {
    const int wid = __builtin_amdgcn_readfirstlane(tid >> 6), lane = tid & 63, wr = wid >> 2, wc = wid & 3, fr = lane & 15, fq = lane >> 4;
    const int K = g.K, nt = K / BK;
    unsigned voffA[2], voffB[2];
#pragma unroll
    for (int i = 0; i < 2; ++i) { int R, C; stage_rc(tid * 16 + i * 8192, R, C); const int Rb = Epi::PERM ? ((R & ~31) + perm32(R & 31)) : R;
        voffA[i] = (unsigned)(R * K + C) * 2u; voffB[i] = (unsigned)(Rb * K + C) * 2u; }
    const size_t kstep = (size_t)(BK * 2);
    const size_t hstep = (size_t)HALF * K * 2;
    const size_t tstep = 2 * hstep;
    const unsigned ldsw = (unsigned)wid * 1024u;
    const int aoff = lds_byte(wr * 64 + fr, fq * 8), boff = lds_byte(wc * 32 + fr, fq * 8);
#define PG8_SA(b, h) (((b) * 2 + (h)) * HTB)
#define PG8_SB(b, h) ((4 + (b) * 2 + (h)) * HTB)
#define PG8_STAGE(bufoff, gbase, voff) do { _Pragma("unroll") for (int _i = 0; _i < 2; ++_i) \
        __builtin_amdgcn_global_load_lds((const unsigned*)((const char*)(gbase) + (voff)[_i]), (PG8_LAS unsigned*)(lds + (bufoff) + ldsw + _i * 8192), 16, 0, 0); } while (0)
#define PG8_LDA(dst, b, h) do { _Pragma("unroll") for (int m = 0; m < 4; ++m) _Pragma("unroll") for (int k = 0; k < 2; ++k) dst[m][k] = *(const PG8_LAS bf16x8*)(lds + PG8_SA(b, h) + aoff + m * 2048 + k * 1024); } while (0)
#define PG8_LDB(dst, b, h) do { _Pragma("unroll") for (int n = 0; n < 2; ++n) _Pragma("unroll") for (int k = 0; k < 2; ++k) dst[n][k] = *(const PG8_LAS bf16x8*)(lds + PG8_SB(b, h) + boff + n * 2048 + k * 1024); } while (0)
#define PG8_MMA(ai, bj, At, Bt) do { __builtin_amdgcn_s_setprio(1); _Pragma("unroll") for (int m = 0; m < 4; ++m) _Pragma("unroll") for (int n = 0; n < 2; ++n) _Pragma("unroll") for (int k = 0; k < 2; ++k) \
        acc[ai][bj][m][n] = __builtin_amdgcn_mfma_f32_16x16x32_bf16(Bt[n][k], At[m][k], acc[ai][bj][m][n], 0, 0, 0); __builtin_amdgcn_s_setprio(0); } while (0)
#define PG8_WAIT_V(n) asm volatile("s_waitcnt vmcnt(" #n ")" ::: "memory")
#define PG8_WAIT_L(n) asm volatile("s_waitcnt lgkmcnt(" #n ")" ::: "memory")
#define PG8_BAR __builtin_amdgcn_s_barrier()
#define PG8_SCHED __builtin_amdgcn_sched_barrier(0)
    Unit cur, nxt; int ui = 0;
    if (!S.next(0, cur)) return;
    f32x4 acc[2][2][4][2];
#pragma unroll
    for (int a = 0; a < 2; ++a)
#pragma unroll
        for (int b = 0; b < 2; ++b)
#pragma unroll
            for (int m = 0; m < 4; ++m)
#pragma unroll
                for (int n = 0; n < 2; ++n) acc[a][b][m][n] = (f32x4){0.f, 0.f, 0.f, 0.f};
    bf16x8 At[4][2], B0[2][2], B1[2][2];
    const char* cA = (const char*)g.A + (size_t)cur.pm * tstep; const char* cB = (const char*)g.Bt + (size_t)cur.pn * tstep;
    S.a_ready(cur);
    if constexpr (SP2) {
        PG8_STAGE(PG8_SB(0, 0), cB, voffB); PG8_STAGE(PG8_SB(0, 1), cB + hstep, voffB); PG8_STAGE(PG8_SA(0, 0), cA, voffA); PG8_STAGE(PG8_SA(0, 1), cA + hstep, voffA);
        if (wr == 1) PG8_BAR;
        PG8_WAIT_V(2); PG8_BAR;
        PG8_STAGE(PG8_SB(1, 0), cB + kstep, voffB); PG8_STAGE(PG8_SA(1, 0), cA + kstep, voffA); PG8_STAGE(PG8_SB(1, 1), cB + hstep + kstep, voffB);
        PG8_WAIT_V(6); PG8_BAR;
    } else {
        PG8_STAGE(PG8_SB(0, 0), cB, voffB); PG8_STAGE(PG8_SA(0, 0), cA, voffA); PG8_STAGE(PG8_SB(0, 1), cB + hstep, voffB); PG8_STAGE(PG8_SA(0, 1), cA + hstep, voffA);
        if (wr == 1) PG8_BAR;
        PG8_WAIT_V(4); PG8_BAR;
        PG8_STAGE(PG8_SB(1, 0), cB + kstep, voffB); PG8_STAGE(PG8_SA(1, 0), cA + kstep, voffA); PG8_STAGE(PG8_SB(1, 1), cB + hstep + kstep, voffB);
        PG8_WAIT_V(6); PG8_BAR;
    }
    for (;;) {
        const bool has_next = S.next(ui + 1, nxt);
        const char* nA = has_next ? (const char*)g.A + (size_t)nxt.pm * tstep : cA; const char* nB = has_next ? (const char*)g.Bt + (size_t)nxt.pn * tstep : cB;
        for (int t = 0; t < nt; t += 2) {
            const bool last = (t == nt - 2);
            const char* a1 = cA + (size_t)(t + 1) * kstep;
            const char* a2 = last ? nA : cA + (size_t)(t + 2) * kstep; const char* b2 = last ? nB : cB + (size_t)(t + 2) * kstep;
            const char* a3 = a2 + kstep; const char* b3 = b2 + kstep;
            if (last && has_next) S.a_ready(nxt);
            if constexpr (SP2) {
            PG8_LDB(B0, 0, 0); PG8_LDB(B1, 0, 1); PG8_SCHED; PG8_LDA(At, 0, 0); PG8_STAGE(PG8_SA(1, 1), a1 + hstep, voffA);
            PG8_WAIT_V(8); PG8_WAIT_L(0); PG8_BAR; PG8_MMA(0, 0, At, B0); PG8_MMA(0, 1, At, B1); PG8_BAR; PG8_SCHED;
            PG8_LDA(At, 0, 1); PG8_STAGE(PG8_SB(0, 0), b2, voffB); PG8_STAGE(PG8_SB(0, 1), b2 + hstep, voffB); PG8_STAGE(PG8_SA(0, 0), a2, voffA);
            PG8_WAIT_V(8); PG8_WAIT_L(0); PG8_BAR; PG8_MMA(1, 0, At, B0); PG8_MMA(1, 1, At, B1); PG8_BAR; PG8_SCHED;
            PG8_LDB(B0, 1, 0); PG8_LDB(B1, 1, 1); PG8_SCHED; PG8_LDA(At, 1, 0); PG8_STAGE(PG8_SA(0, 1), a2 + hstep, voffA);
            PG8_WAIT_V(8); PG8_WAIT_L(0); PG8_BAR; PG8_MMA(0, 0, At, B0); PG8_MMA(0, 1, At, B1); PG8_BAR; PG8_SCHED;
            PG8_LDA(At, 1, 1); PG8_STAGE(PG8_SB(1, 0), b3, voffB); PG8_STAGE(PG8_SB(1, 1), b3 + hstep, voffB); PG8_STAGE(PG8_SA(1, 0), a3, voffA);
            PG8_WAIT_V(8); PG8_WAIT_L(0); PG8_BAR; PG8_MMA(1, 0, At, B0); PG8_MMA(1, 1, At, B1); PG8_BAR; PG8_SCHED;
            } else {
            PG8_LDB(B0, 0, 0); PG8_SCHED; PG8_LDA(At, 0, 0); PG8_STAGE(PG8_SA(1, 1), a1 + hstep, voffA);
            PG8_WAIT_L(8); PG8_BAR; PG8_WAIT_L(0); PG8_MMA(0, 0, At, B0); PG8_BAR; PG8_SCHED;
            PG8_LDB(B1, 0, 1); PG8_STAGE(PG8_SB(0, 0), b2, voffB);
            PG8_BAR; PG8_WAIT_L(0); PG8_MMA(0, 1, At, B1); PG8_BAR;
            PG8_LDA(At, 0, 1); PG8_STAGE(PG8_SA(0, 0), a2, voffA);
            PG8_BAR; PG8_WAIT_L(0); PG8_MMA(1, 0, At, B0); PG8_BAR; PG8_SCHED;
            PG8_STAGE(PG8_SB(0, 1), b2 + hstep, voffB);
            PG8_WAIT_V(6); PG8_BAR; PG8_MMA(1, 1, At, B1); PG8_BAR;
            PG8_LDB(B0, 1, 0); PG8_SCHED; PG8_LDA(At, 1, 0); PG8_STAGE(PG8_SA(0, 1), a2 + hstep, voffA);
            PG8_WAIT_L(8); PG8_BAR; PG8_WAIT_L(0); PG8_MMA(0, 0, At, B0); PG8_BAR; PG8_SCHED;
            PG8_LDB(B1, 1, 1); PG8_STAGE(PG8_SB(1, 0), b3, voffB);
            PG8_BAR; PG8_WAIT_L(0); PG8_MMA(0, 1, At, B1); PG8_BAR;
            PG8_LDA(At, 1, 1); PG8_STAGE(PG8_SA(1, 0), a3, voffA);
            PG8_BAR; PG8_WAIT_L(0); PG8_MMA(1, 0, At, B0); PG8_BAR; PG8_SCHED;
            PG8_STAGE(PG8_SB(1, 1), b3 + hstep, voffB);
            PG8_WAIT_V(6); PG8_BAR; PG8_MMA(1, 1, At, B1); PG8_BAR;
            }
        }
        if constexpr (ALIGN_EPI) { if (wr == 0) PG8_BAR; }
        E(acc, cur, wr, wc, fr, fq); S.done(cur);
        if (!has_next) break;
#pragma unroll
        for (int a = 0; a < 2; ++a)
#pragma unroll
            for (int b = 0; b < 2; ++b)
#pragma unroll
                for (int m = 0; m < 4; ++m)
#pragma unroll
                    for (int n = 0; n < 2; ++n) acc[a][b][m][n] = (f32x4){0.f, 0.f, 0.f, 0.f};
        cur = nxt; cA = nA; cB = nB; ++ui;
        if constexpr (ALIGN_EPI) { if (wr == 1) PG8_BAR; }
    }
    PG8_WAIT_V(0);
    if constexpr (!ALIGN_EPI) { if (wr == 0) PG8_BAR; }
    PG8_BAR;
#undef PG8_SA
#undef PG8_SB
#undef PG8_STAGE
#undef PG8_LDA
#undef PG8_LDB
#undef PG8_MMA
#undef PG8_WAIT_V
#undef PG8_WAIT_L
#undef PG8_BAR
#undef PG8_SCHED
}
}

namespace att {
typedef unsigned short bf16;
using bf16x8 = __attribute__((ext_vector_type(8))) short;
using s16x4  = __attribute__((ext_vector_type(4))) short;
using f32x16 = __attribute__((ext_vector_type(16))) float;
using u32x4  = __attribute__((ext_vector_type(4))) unsigned;
constexpr int D = 128, NW = 8, QBLK = 32, KVBLK = 64;
constexpr float SCALE = 0.088388347648318440f;
constexpr float THR = 8.f;
constexpr int SHM_V = KVBLK * D * 2, SHM_K = KVBLK * D * 2, SHM_ATTN = 2 * SHM_V + 2 * SHM_K + NW * 64 * 4;
#define KSWZ(row, colB) ((row) * 256 + ((colB) ^ (((row) & 7) << 4)))
#define SBAR() __builtin_amdgcn_sched_barrier(0)
__device__ __forceinline__ int crow(int r, int hi) { return (r & 3) + 8 * (r >> 2) + 4 * hi; }
__device__ __forceinline__ unsigned cvtpk(float lo, float hi) { unsigned r; asm volatile("v_cvt_pk_bf16_f32 %0, %1, %2" : "=v"(r) : "v"(lo), "v"(hi)); return r; }

__device__ __forceinline__ void partialSM(f32x16& p0, f32x16& p1, float& m_reg, float& mn, float& alpha) {
  constexpr float C = SCALE * 1.4426950408889634f;
  float pmax = p0[0];
#pragma unroll
  for (int r = 1; r < 16; ++r) pmax = fmaxf(pmax, p0[r]);
#pragma unroll
  for (int r = 0; r < 16; ++r) pmax = fmaxf(pmax, p1[r]);
  { auto rr = __builtin_amdgcn_permlane32_swap(__float_as_uint(pmax), __float_as_uint(pmax), false, false);
    pmax = fmaxf(__uint_as_float(rr[0]), __uint_as_float(rr[1])); }
  if (__builtin_expect(__all(pmax - m_reg <= THR / SCALE), 1)) { mn = m_reg; alpha = 1.f; }
  else { mn = fmaxf(m_reg, pmax); alpha = __builtin_amdgcn_exp2f((m_reg - mn) * C); m_reg = mn; }
  float mnC = -mn * C;
#pragma unroll
  for (int r = 0; r < 16; ++r) p0[r] = fmaf(p0[r], C, mnC);
#pragma unroll
  for (int r = 0; r < 16; ++r) p1[r] = fmaf(p1[r], C, mnC);
#pragma unroll
  for (int r = 0; r < 16; ++r) p0[r] = __builtin_amdgcn_exp2f(p0[r]);
}
__device__ __forceinline__ void finishSM(f32x16& p0, f32x16& p1, float alpha, float& l_reg, bf16x8& pa0, bf16x8& pa1, bf16x8& pa2, bf16x8& pa3) {
#pragma unroll
  for (int r = 0; r < 16; ++r) p1[r] = __builtin_amdgcn_exp2f(p1[r]);
  float ps = 0;
#pragma unroll
  for (int r = 0; r < 16; ++r) ps += p0[r];
#pragma unroll
  for (int r = 0; r < 16; ++r) ps += p1[r];
  { auto rr = __builtin_amdgcn_permlane32_swap(__float_as_uint(ps), __float_as_uint(ps), false, false);
    ps = __uint_as_float(rr[0]) + __uint_as_float(rr[1]); }
  l_reg = l_reg * alpha + ps;
#define PK4(P, BASE, OUT) do { unsigned a0 = cvtpk(P[BASE + 0], P[BASE + 1]), a1 = cvtpk(P[BASE + 2], P[BASE + 3]);   \
    unsigned b0 = cvtpk(P[BASE + 4], P[BASE + 5]), b1 = cvtpk(P[BASE + 6], P[BASE + 7]);                              \
    auto r0 = __builtin_amdgcn_permlane32_swap(a0, b0, false, false); auto r1 = __builtin_amdgcn_permlane32_swap(a1, b1, false, false); \
    u32x4 w = {r0[0], r1[0], r0[1], r1[1]}; OUT = *reinterpret_cast<bf16x8*>(&w); } while (0)
  PK4(p0, 0, pa0); PK4(p0, 8, pa1); PK4(p1, 0, pa2); PK4(p1, 8, pa3);
#undef PK4
}
__device__ __forceinline__ void qkt(f32x16& p0, f32x16& p1, const char* Ks, const bf16x8* qr, int r32, int hi) {
  p0 = f32x16{}; p1 = f32x16{};
#pragma unroll
  for (int d0 = 0; d0 < 8; ++d0) { int cb = (d0 * 16 + hi * 8) * 2;
    bf16x8 b0 = *reinterpret_cast<const bf16x8*>(Ks + KSWZ(r32, cb));
    bf16x8 b1 = *reinterpret_cast<const bf16x8*>(Ks + KSWZ(32 + r32, cb));
    p0 = __builtin_amdgcn_mfma_f32_32x32x16_bf16(b0, qr[d0], p0, 0, 0, 0);
    p1 = __builtin_amdgcn_mfma_f32_32x32x16_bf16(b1, qr[d0], p1, 0, 0, 0); }
}
__device__ __forceinline__ int v_st(int k, int c) { const int kk = (k & ~0xC) | ((k & 4) << 1) | ((k & 8) >> 1); return ((kk >> 3) * 4 + (c >> 5)) * 512 + ((kk & 7) * 32 + (c & 31)) * 2; }
__device__ __forceinline__ int v_rd_base(int lane) { return ((lane & 3) << 3) | (((lane >> 2) & 3) << 6) | (((lane >> 4) & 1) << 5) | (((lane >> 5) & 1) << 8); }
constexpr int v_rd_off(int d0, int ks, int half) { return d0 * 512 + ks * 4096 + half * 2048; }
template <int OFF> __device__ __forceinline__ s16x4 tr_read(int vb) {
  s16x4 r; asm volatile("ds_read_b64_tr_b16 %0, %1 offset:%2" : "=&v"(r) : "v"(vb), "i"(OFF) : "memory"); return r;
}
template <int D0> __device__ __forceinline__ void pv_one(f32x16& od, int vb, bf16x8 pa0, bf16x8 pa1, bf16x8 pa2, bf16x8 pa3) {
  const s16x4 l0 = tr_read<v_rd_off(D0, 0, 0)>(vb), h0 = tr_read<v_rd_off(D0, 0, 1)>(vb), l1 = tr_read<v_rd_off(D0, 1, 0)>(vb), h1 = tr_read<v_rd_off(D0, 1, 1)>(vb);
  const s16x4 l2 = tr_read<v_rd_off(D0, 2, 0)>(vb), h2 = tr_read<v_rd_off(D0, 2, 1)>(vb), l3 = tr_read<v_rd_off(D0, 3, 0)>(vb), h3 = tr_read<v_rd_off(D0, 3, 1)>(vb);
  asm volatile("s_waitcnt lgkmcnt(0)" ::: "memory"); SBAR();
#define PK(L, H) (bf16x8){L[0], L[1], L[2], L[3], H[0], H[1], H[2], H[3]}
  od = __builtin_amdgcn_mfma_f32_32x32x16_bf16(pa0, PK(l0, h0), od, 0, 0, 0);
  od = __builtin_amdgcn_mfma_f32_32x32x16_bf16(pa1, PK(l1, h1), od, 0, 0, 0);
  od = __builtin_amdgcn_mfma_f32_32x32x16_bf16(pa2, PK(l2, h2), od, 0, 0, 0);
  od = __builtin_amdgcn_mfma_f32_32x32x16_bf16(pa3, PK(l3, h3), od, 0, 0, 0);
#undef PK
}
__device__ __forceinline__ void pv_d0(f32x16* o, int vb, bf16x8 pa0, bf16x8 pa1, bf16x8 pa2, bf16x8 pa3) {
  pv_one<0>(o[0], vb, pa0, pa1, pa2, pa3); pv_one<1>(o[1], vb, pa0, pa1, pa2, pa3); pv_one<2>(o[2], vb, pa0, pa1, pa2, pa3); pv_one<3>(o[3], vb, pa0, pa1, pa2, pa3);
}

struct Unit {
  const bf16* Q; const bf16* K; const bf16* V; bf16* O; float* lse;
  int qstride, kstride, ostride, lse_stride;
  int NT;
  int kb0, n, qi0, hw;
  float slope_raw;
  float sink; int has_sink;
};

template <bool BAND>
__device__ __forceinline__ void attn_unit(const Unit& U, char* lds, const int tid) {
  const int wid = tid >> 6, lane = tid & 63, r32 = lane & 31, hi = lane >> 5;
  char* V_lds = lds; char* K_lds = lds + 2 * SHM_V;
  float* ws = (float*)(lds + 2 * SHM_V + 2 * SHM_K) + wid * 64; float* li_l = ws; float* al_l = ws + 32;
  float m_reg = -1e30f, l_reg = 0; f32x16 o[4] = {}; bf16x8 qr[8];
  { const unsigned qoff = (unsigned)(wid * QBLK + r32) * (unsigned)U.qstride + (unsigned)(hi * 8);
#pragma unroll
    for (int d0 = 0; d0 < 8; ++d0) qr[d0] = *reinterpret_cast<const bf16x8*>(U.Q + qoff + d0 * 16); }
  const int sr = tid >> 4, sc = (tid & 15) * 8, vst0 = v_st(sr, sc), vst1 = v_st(32 + sr, sc);
  const int vb0 = (int)(uintptr_t)V_lds + v_rd_base(lane);
  struct { bf16x8 vs0, vs1, ks0, ks1; } sr_[2];
  float flo = 0.f, fhi = 0.f, fdq = 0.f;
  if constexpr (BAND) { const int qi = U.qi0 + wid * QBLK + r32; const int lo = -U.hw > -qi ? -U.hw : -qi; const int hh = U.hw < U.n - 1 - qi ? U.hw : U.n - 1 - qi;
    flo = (float)lo; fhi = (float)hh; fdq = (float)(U.kb0 + 4 * hi - qi); }
#define ROWOF(k) ((k) < 0 ? 0 : ((k) >= U.n ? U.n - 1 : (k)))
#define SLOAD(i, k0) do { unsigned _o0, _o1; \
    if constexpr (BAND) { const int _ka = U.kb0 + (k0) + sr; _o0 = (unsigned)ROWOF(_ka) * (unsigned)U.kstride + (unsigned)sc; _o1 = (unsigned)ROWOF(_ka + 32) * (unsigned)U.kstride + (unsigned)sc; } \
    else { _o0 = (unsigned)((k0) + sr) * (unsigned)U.kstride + (unsigned)sc; _o1 = _o0 + 32u * (unsigned)U.kstride; } \
    sr_[i].vs0 = *reinterpret_cast<const bf16x8*>(U.V + _o0); sr_[i].vs1 = *reinterpret_cast<const bf16x8*>(U.V + _o1); \
    sr_[i].ks0 = *reinterpret_cast<const bf16x8*>(U.K + _o0); sr_[i].ks1 = *reinterpret_cast<const bf16x8*>(U.K + _o1); } while (0)
#define SWRITE(b, i) do { *(bf16x8*)(V_lds + (b) * SHM_V + vst0) = sr_[i].vs0;          \
    *(bf16x8*)(V_lds + (b) * SHM_V + vst1) = sr_[i].vs1; int kc = sc * 2;               \
    *(bf16x8*)(K_lds + (b) * SHM_K + KSWZ(sr, kc)) = sr_[i].ks0;                       \
    *(bf16x8*)(K_lds + (b) * SHM_K + KSWZ(32 + sr, kc)) = sr_[i].ks1; } while (0)
#define SWAIT() asm volatile("s_waitcnt vmcnt(4)" ::: "memory")
#define RESC(a) do { if (__any((a) < 1.f)) { if (hi == 0) al_l[r32] = (a); asm volatile("s_waitcnt lgkmcnt(0)" ::: "memory"); \
    _Pragma("unroll") for (int d = 0; d < 4; ++d) _Pragma("unroll") for (int r = 0; r < 16; ++r) o[d][r] *= al_l[crow(r, hi)]; } } while (0)
#define MASKB(P0, P1, j) do { if constexpr (BAND) { const float _f0 = fdq + (float)(64 * (j)); const float _ninf = -__builtin_inff(); \
    _Pragma("unroll") for (int r = 0; r < 16; ++r) { const float d0_ = _f0 + (float)((r & 3) + 8 * (r >> 2)), d1_ = d0_ + 32.f; \
      const float s0_ = fmaf(-U.slope_raw, __builtin_fabsf(d0_), P0[r]), s1_ = fmaf(-U.slope_raw, __builtin_fabsf(d1_), P1[r]); \
      P0[r] = (d0_ >= flo && d0_ <= fhi) ? s0_ : _ninf; P1[r] = (d1_ >= flo && d1_ <= fhi) ? s1_ : _ninf; } } } while (0)
  f32x16 pA0, pA1, pB0, pB1; float mnA, mnB, alA, alB; bf16x8 pa0, pa1, pa2, pa3; const int NT = U.NT;
  constexpr int SE = 0, SO = 1;
  SLOAD(SE, 0); asm volatile("s_waitcnt vmcnt(0)" ::: "memory"); SWRITE(0, SE); __syncthreads();
  qkt(pA0, pA1, K_lds, qr, r32, hi); MASKB(pA0, pA1, 0); partialSM(pA0, pA1, m_reg, mnA, alA);
  SLOAD(SO, KVBLK); if (2 < NT) SLOAD(SE, 2 * KVBLK);
  SWAIT(); SWRITE(1, SO); __syncthreads();
  for (int j = 1; j + 1 < NT; j += 2) {
    SBAR(); qkt(pB0, pB1, K_lds + SHM_K, qr, r32, hi);
    finishSM(pA0, pA1, alA, l_reg, pa0, pa1, pa2, pa3); SBAR();
    SLOAD(SO, (j + 2) * KVBLK); SBAR();
    pv_d0(o, vb0, pa0, pa1, pa2, pa3); MASKB(pB0, pB1, j); partialSM(pB0, pB1, m_reg, mnB, alB);
    __syncthreads(); SWAIT(); SWRITE(0, SE);
    RESC(alB); __syncthreads();
    SBAR(); qkt(pA0, pA1, K_lds, qr, r32, hi);
    finishSM(pB0, pB1, alB, l_reg, pa0, pa1, pa2, pa3); SBAR();
    if (j + 3 < NT) SLOAD(SE, (j + 3) * KVBLK); SBAR();
    pv_d0(o, vb0 + SHM_V, pa0, pa1, pa2, pa3); MASKB(pA0, pA1, j + 1); partialSM(pA0, pA1, m_reg, mnA, alA);
    __syncthreads(); SWAIT(); SWRITE(1, SO);
    RESC(alA); __syncthreads();
  }
  SBAR(); qkt(pB0, pB1, K_lds + SHM_K, qr, r32, hi);
  finishSM(pA0, pA1, alA, l_reg, pa0, pa1, pa2, pa3); SBAR();
  pv_d0(o, vb0, pa0, pa1, pa2, pa3); MASKB(pB0, pB1, NT - 1); partialSM(pB0, pB1, m_reg, mnB, alB);
  __syncthreads(); RESC(alB);
  finishSM(pB0, pB1, alB, l_reg, pa0, pa1, pa2, pa3); SBAR();
  pv_d0(o, vb0 + SHM_V, pa0, pa1, pa2, pa3);
  if constexpr (BAND) {
    if (U.has_sink) l_reg += __builtin_amdgcn_exp2f((U.sink * (1.0f / SCALE) - m_reg) * (SCALE * 1.4426950408889634f));
    if (U.lse != nullptr && hi == 0) U.lse[(unsigned)(wid * QBLK + r32) * (unsigned)U.lse_stride] = m_reg * SCALE + __builtin_amdgcn_logf(l_reg) * 0.6931471805599453f;
  }
  if (hi == 0) li_l[r32] = l_reg; asm volatile("s_waitcnt lgkmcnt(0)" ::: "memory");
  int lane_e = lane; asm volatile("" : "+v"(lane_e));
  const int r32e = lane_e & 31, hie = lane_e >> 5;
  float rli[16];
#pragma unroll
  for (int r = 0; r < 16; ++r) rli[r] = __builtin_amdgcn_rcpf(li_l[crow(r, hie)]);
  __syncthreads();
  char* ost = lds + wid * 8192;
  { char* op = ost + hie * 1024 + r32e * 2;
#pragma unroll
    for (int r = 0; r < 16; ++r) {
#pragma unroll
      for (int d0 = 0; d0 < 4; ++d0) { const unsigned w = cvtpk(o[d0][r] * rli[r], 0.f); *(unsigned short*)(op + ((r & 3) + 8 * (r >> 2)) * 256 + d0 * 64) = (unsigned short)w; } } }
  asm volatile("s_waitcnt lgkmcnt(0)" ::: "memory");
  { const char* ip = ost + (lane_e >> 4) * 256 + (lane_e & 15) * 16;
    unsigned goff = (unsigned)(wid * QBLK + (lane_e >> 4)) * (unsigned)U.ostride + (unsigned)((lane_e & 15) * 8); const unsigned gstep = 4u * (unsigned)U.ostride;
#pragma unroll
    for (int i = 0; i < 8; ++i) { const u32x4 w = *(const u32x4*)(ip + i * 1024); *(u32x4*)(U.O + goff) = w; goff += gstep; } }
  __syncthreads();
#undef ROWOF
#undef SLOAD
#undef SWRITE
#undef SWAIT
#undef RESC
#undef MASKB
}
}

constexpr int NWAVES = 8;
constexpr int DM = 2048, SEQ = 16384, NSEQ = 3, M_ALL = NSEQ * SEQ, DEPTH = 4, DFF = 5632, INC = 13824;
constexpr int A_Q = 0, A_K = 1536, A_V = 3072, B_Q = 4608, B_K = 5632, B_V = 5888, C_Q = 6144, C_K = 7168, C_V = 7424, GL0 = 7680;
constexpr float NORM_EPS = 1e-6f;
enum { I_XP = 0, I_XS, I_NF1, I_F1IN, I_F1OUT, I_NMIX, I_WIN, I_QNQ, I_QNK, I_SINK, I_WA, I_WB, I_WC, I_WO, I_NF2, I_F2IN, I_F2OUT, I_NFIN, N_IN };

constexpr size_t MiB = 1u << 20;
constexpr size_t WS_CTL = 0, CTL_ZERO_BYTES = 1 * MiB;
constexpr size_t WL_F1IN = 0, WL_F1OUT = WL_F1IN + (size_t)2 * DFF * DM * 2, WL_WIN = WL_F1OUT + (size_t)DM * DFF * 2, WL_WA = WL_WIN + (size_t)INC * DM * 2,
                 WL_WB = WL_WA + (size_t)DM * 512 * 2, WL_WC = WL_WB + (size_t)DM * 1024 * 2, WL_WO = WL_WC + (size_t)DM * 1024 * 2, WL_F2IN = WL_WO + (size_t)DM * DM * 2,
                 WL_F2OUT = WL_F2IN + (size_t)2 * DFF * DM * 2, WL_BYTES = WL_F2OUT + (size_t)DM * DFF * 2;
constexpr size_t WS_W = 1 * MiB;
constexpr size_t WS_U = WS_W + DEPTH * WL_BYTES;
constexpr size_t WS_R = WS_U + (size_t)M_ALL * DM * 2;
constexpr size_t WS_H = WS_R;
constexpr size_t WS_QKVG = WS_R;
constexpr size_t WS_OA = WS_QKVG + (size_t)SEQ * INC * 2;
constexpr size_t WS_OB = WS_OA + (size_t)SEQ * 512 * 2;
constexpr size_t WS_OC = WS_OB + (size_t)SEQ * 1024 * 2;
constexpr size_t WS_PA = WS_OC + (size_t)SEQ * 1024 * 2;
constexpr size_t WS_LSE = WS_PA + (size_t)3 * SEQ * 512 * 2;
constexpr size_t WS_QB = WS_LSE + (size_t)3 * SEQ * 4 * 4;
constexpr size_t WS_KB = WS_QB + (size_t)SEQ * 1024 * 2;
constexpr size_t WS_VB = WS_KB + (size_t)SEQ * 256 * 2;
constexpr size_t WS_MG = WS_VB + (size_t)SEQ * 256 * 2;
constexpr size_t WS_MB = WS_MG + (size_t)SEQ * DM * 4;
constexpr size_t WS_MIX_END = WS_MB + (size_t)SEQ * DM * 2;
constexpr size_t WS_H_END = WS_H + (size_t)M_ALL * DFF * 2;
constexpr size_t WS_END = WS_MIX_END > WS_H_END ? WS_MIX_END : WS_H_END;
constexpr int CW_BAR = 4096;

constexpr int RING_OFF = 0, RING_BYTES = 131072;
constexpr int LDSCTL_OFF = RING_BYTES, MISC_OFF = LDSCTL_OFF + 320;
constexpr int LDS_BYTES = 147456;

#define GAS __attribute__((address_space(1)))
#define LAS __attribute__((address_space(3)))
typedef unsigned short bf16;
typedef unsigned v4u __attribute__((ext_vector_type(4)));
typedef unsigned v2u __attribute__((ext_vector_type(2)));
typedef float f32x4 __attribute__((ext_vector_type(4)));
#define LDS_WAIT() asm volatile("s_waitcnt lgkmcnt(0)" ::: "memory")
#define VM_WAIT() asm volatile("s_waitcnt vmcnt(0)" ::: "memory")
__device__ __forceinline__ unsigned f2bf(float f) { unsigned u = __builtin_bit_cast(unsigned, f); return (u + 0x7fffu + ((u >> 16) & 1u)) >> 16; }
__device__ __forceinline__ unsigned pk2(float lo, float hi) { return f2bf(lo) | (f2bf(hi) << 16); }
__device__ __forceinline__ float bflo(unsigned w) { return __uint_as_float(w << 16); }
__device__ __forceinline__ float bfhi(unsigned w) { return __uint_as_float(w & 0xffff0000u); }

#define XB_TMO      128
#define XB_XCNT(j)  (256  + 64 * (j))
#define XB_XSUB(j)  (1280 + 64 * (j))
#define XB_XGEN(j)  (2304 + 64 * (j))
#define XB_TOP      3328
#define XB_TOPGEN   3392
#define XCD_BAR_WORDS 3456
#define XB_SPIN_CAP (1u << 18)
__device__ __forceinline__ unsigned xb_ld(unsigned* p)              { return __hip_atomic_load(p, __ATOMIC_RELAXED, __HIP_MEMORY_SCOPE_AGENT); }
__device__ __forceinline__ unsigned xb_add(unsigned* p, unsigned v) { return __hip_atomic_fetch_add(p, v, __ATOMIC_RELAXED, __HIP_MEMORY_SCOPE_AGENT); }
__device__ __forceinline__ unsigned xb_xcc_id() { return (unsigned)__builtin_amdgcn_s_getreg((3 << 11) | 20) & 0xFu; }
#define XB_SPIN(cond, bar) do { unsigned _sp = 0; while (cond) { __builtin_amdgcn_s_sleep(1); \
    if ((++_sp & 255u) == 0u) { if (xb_ld(&(bar)[XB_TMO])) break; if (_sp > XB_SPIN_CAP) { atomicAdd(&(bar)[XB_TMO], 1u); break; } } } } while (0)
struct XcdBarrier { unsigned* bar; unsigned x; volatile LAS unsigned* st; };
__device__ __forceinline__ XcdBarrier xcd_barrier_post(unsigned* bar, volatile LAS unsigned* st) {
    XcdBarrier b; b.bar = bar; b.x = xb_xcc_id(); b.st = st;
    if (threadIdx.x == 0) (void)xb_add(&bar[XB_XCNT(b.x)], 1u);
    return b;
}
__device__ __forceinline__ void xcd_barrier_complete(unsigned* bar, unsigned x, unsigned& nloc, unsigned& nx) {
    const unsigned G = gridDim.x * gridDim.y * gridDim.z;
    unsigned sum, cnt, mine, sp = 0u;
    for (;;) {
        sum = 0u; cnt = 0u; mine = 0u;
#pragma unroll
        for (unsigned j = 0; j < 16; ++j) { const unsigned c = xb_ld(&bar[XB_XCNT(j)]); sum += c; cnt += (c > 0u) ? 1u : 0u; mine = (j == x) ? c : mine; }
        if (sum == G) break;
        __builtin_amdgcn_s_sleep(1);
        if ((++sp & 255u) == 0u) { if (xb_ld(&bar[XB_TMO])) break; if (sp > XB_SPIN_CAP) { atomicAdd(&bar[XB_TMO], 1u); break; } }
    }
    nloc = mine > 0u ? mine : 1u; nx = cnt > 0u ? cnt : 1u;
}
__device__ __forceinline__ void xcd_barrier(const XcdBarrier& b) {
    asm volatile("s_waitcnt vmcnt(0)" ::: "memory");
    __syncthreads();
    if (threadIdx.x == 0) {
        unsigned* bar = b.bar;
        __builtin_amdgcn_s_waitcnt(0);
        unsigned nloc = b.st[0], nx = b.st[1];
        if (nloc == 0u) { xcd_barrier_complete(bar, b.x, nloc, nx); b.st[0] = nloc; b.st[1] = nx; }
        const unsigned old = xb_add(&bar[XB_XSUB(b.x)], 1u);
        const unsigned gen = old / nloc;
        if (old + 1u == (gen + 1u) * nloc) {
            __builtin_amdgcn_fence(__ATOMIC_RELEASE, "agent");
            asm volatile("s_waitcnt vmcnt(0)" ::: "memory");
            const unsigned og = xb_add(&bar[XB_TOP], 1u);
            const unsigned tg = og / nx;
            if (og + 1u == (tg + 1u) * nx) xb_add(&bar[XB_TOPGEN], 1u);
            else XB_SPIN(xb_ld(&bar[XB_TOPGEN]) == tg, bar);
            __builtin_amdgcn_fence(__ATOMIC_ACQUIRE, "agent");
            xb_add(&bar[XB_XGEN(b.x)], 1u);
            asm volatile("s_waitcnt vmcnt(0)" ::: "memory");
        } else {
            XB_SPIN(xb_ld(&bar[XB_XGEN(b.x)]) == gen, bar);
            __builtin_amdgcn_fence(__ATOMIC_ACQUIRE, "agent");
            asm volatile("s_waitcnt vmcnt(0)" ::: "memory");
        }
    }
    __syncthreads();
}

template <int XOR> __device__ __forceinline__ float swz_xor(float v) { return __int_as_float(__builtin_amdgcn_ds_swizzle(__float_as_int(v), (XOR << 10) | 0x1F)); }
__device__ __forceinline__ float wave_sum(float v) {
    v += swz_xor<1>(v); v += swz_xor<2>(v); v += swz_xor<4>(v); v += swz_xor<8>(v); v += swz_xor<16>(v);
    auto rr = __builtin_amdgcn_permlane32_swap(__float_as_uint(v), __float_as_uint(v), false, false);
    return __uint_as_float(rr[0]) + __uint_as_float(rr[1]);
}
__device__ __forceinline__ void transpose_item(const float* W, int K, int N, bf16* WT, int k0, int n0, int orow0, LAS float* scr, int lane) {
#pragma unroll 8
    for (int i = 0; i < 32; ++i) { const int kk = 2 * i + (lane >> 5); scr[kk * 33 + (lane & 31)] = W[(size_t)(k0 + kk) * N + n0 + (lane & 31)]; }
    LDS_WAIT(); asm volatile("" ::: "memory");
    const int c = lane & 7;
#pragma unroll
    for (int j = 0; j < 4; ++j) { const int n = (lane >> 3) + 8 * j; const LAS float* s = scr + (8 * c) * 33 + n;
        v4u o; o.x = pk2(s[0 * 33], s[1 * 33]); o.y = pk2(s[2 * 33], s[3 * 33]); o.z = pk2(s[4 * 33], s[5 * 33]); o.w = pk2(s[6 * 33], s[7 * 33]);
        *(GAS v4u*)(WT + (size_t)(orow0 + n) * K + k0 + 8 * c) = o; }
    LDS_WAIT(); asm volatile("" ::: "memory");
}
__device__ __forceinline__ void transpose_matrix(const float* W, int K, int N, bf16* WT, int swiglu, LAS float* scr, int lane, int gw, int NGW) {
    const int nblk = N / 32, nitems = (K / 64) * nblk;
    for (int it = gw; it < nitems; it += NGW) {
        const int kb = it / nblk, nb = it % nblk, k0 = 64 * kb, n0 = 32 * nb;
        int orow0 = n0;
        if (swiglu) { const int half = n0 >= DFF ? 1 : 0, np = n0 - half * DFF; orow0 = 256 * (np / 128) + 128 * half + (np % 128); }
        transpose_item(W, K, N, WT, k0, n0, orow0, scr, lane);
    }
}
__device__ __forceinline__ void rms_row_to_bf16(const float* xrow, const float* g, bf16* orow, float* xcopy, int lane) {
    const GAS f32x4* xr = (const GAS f32x4*)xrow + lane; const GAS f32x4* gr = (const GAS f32x4*)g + lane;
    f32x4 v[8]; float s = 0.f;
#pragma unroll
    for (int j = 0; j < 8; ++j) { v[j] = xr[64 * j]; s += (v[j].x * v[j].x + v[j].y * v[j].y) + (v[j].z * v[j].z + v[j].w * v[j].w); }
    if (xcopy) { GAS f32x4* xc = (GAS f32x4*)xcopy + lane;
#pragma unroll
        for (int j = 0; j < 8; ++j) xc[64 * j] = v[j]; }
    const float rstd = __builtin_amdgcn_rsqf(wave_sum(s) * (1.f / DM) + NORM_EPS);
    GAS v2u* o8 = (GAS v2u*)orow + lane;
#pragma unroll
    for (int j = 0; j < 8; ++j) { const f32x4 gg = gr[64 * j]; v2u w; w.x = pk2(v[j].x * rstd * gg.x, v[j].y * rstd * gg.y); w.y = pk2(v[j].z * rstd * gg.z, v[j].w * rstd * gg.w); o8[64 * j] = w; }
}
__device__ __forceinline__ void rms_row_f32(float* xrow, const float* g, int lane) {
    GAS f32x4* xr = (GAS f32x4*)xrow + lane; const GAS f32x4* gr = (const GAS f32x4*)g + lane;
    f32x4 v[8]; float s = 0.f;
#pragma unroll
    for (int j = 0; j < 8; ++j) { v[j] = xr[64 * j]; s += (v[j].x * v[j].x + v[j].y * v[j].y) + (v[j].z * v[j].z + v[j].w * v[j].w); }
    const float rstd = __builtin_amdgcn_rsqf(wave_sum(s) * (1.f / DM) + NORM_EPS);
#pragma unroll
    for (int j = 0; j < 8; ++j) { const f32x4 gg = gr[64 * j]; xr[64 * j] = v[j] * rstd * gg; }
}
__device__ __forceinline__ void ropeB_token(const bf16* qkvg_row, int t, const float* gq, const float* gk, bf16* qb, bf16* kb, bf16* vb, int lane) {
    const int f = lane & 31; const float pos = (float)((lane < 32) ? (t >> 6) : (t & 63));
    const float invrev = __builtin_amdgcn_exp2f((float)f * (-13.287712379549449f / 32.0f)) * 0.15915494309189535f;
    float rev = pos * invrev; rev = rev - __builtin_floorf(rev);
    const float cs = __builtin_amdgcn_cosf(rev), sn = __builtin_amdgcn_sinf(rev);
    const float gq0 = gq[2 * lane], gq1 = gq[2 * lane + 1], gk0 = gk[2 * lane], gk1 = gk[2 * lane + 1];
    const GAS unsigned* src = (const GAS unsigned*)(qkvg_row + B_Q) + lane;
#pragma unroll
    for (int h = 0; h < 10; ++h) {
        const unsigned w = src[h * 64]; const float x0 = bflo(w), x1 = bfhi(w);
        const float rstd = __builtin_amdgcn_rsqf(wave_sum(x0 * x0 + x1 * x1) * (1.f / 128.f) + NORM_EPS);
        const float y0 = x0 * rstd * (h < 8 ? gq0 : gk0), y1 = x1 * rstd * (h < 8 ? gq1 : gk1);
        const unsigned o = pk2(y0 * cs - y1 * sn, y0 * sn + y1 * cs);
        if (h < 8) ((GAS unsigned*)qb)[h * 64 + lane] = o; else ((GAS unsigned*)kb)[(h - 8) * 64 + lane] = o;
    }
    ((GAS v2u*)vb)[lane] = ((const GAS v2u*)(qkvg_row + B_V))[lane];
}
__device__ __forceinline__ void mergeA_token(const bf16* pa, const float* lse, bf16* oa, int t, int lane) {
#pragma unroll
    for (int hh = 0; hh < 4; ++hh) {
        const float l0 = lse[((size_t)0 * SEQ + t) * 4 + hh], l1 = lse[((size_t)1 * SEQ + t) * 4 + hh], l2 = lse[((size_t)2 * SEQ + t) * 4 + hh];
        const float mx = fmaxf(l0, fmaxf(l1, l2));
        const float e0 = __builtin_amdgcn_exp2f((l0 - mx) * 1.4426950408889634f), e1 = __builtin_amdgcn_exp2f((l1 - mx) * 1.4426950408889634f), e2 = __builtin_amdgcn_exp2f((l2 - mx) * 1.4426950408889634f);
        const float inv = __builtin_amdgcn_rcpf(e0 + e1 + e2);
        const unsigned w0 = ((const GAS unsigned*)(pa + ((size_t)0 * SEQ + t) * 512))[hh * 64 + lane], w1 = ((const GAS unsigned*)(pa + ((size_t)1 * SEQ + t) * 512))[hh * 64 + lane],
                       w2 = ((const GAS unsigned*)(pa + ((size_t)2 * SEQ + t) * 512))[hh * 64 + lane];
        const float a = (e0 * bflo(w0) + e1 * bflo(w1) + e2 * bflo(w2)) * inv, b = (e0 * bfhi(w0) + e1 * bfhi(w1) + e2 * bfhi(w2)) * inv;
        ((GAS unsigned*)(oa + (size_t)t * 512))[hh * 64 + lane] = pk2(a, b);
    }
}

struct Args { const float* in[N_IN]; float* out; unsigned char* ws; int ph_lo, ph_hi; };
constexpr int N_PHASES = 1 + DEPTH * (3 + 1 + NSEQ * 5 + 3) + 1;

__device__ __forceinline__ int opq_v(int x) { asm volatile("" : "+v"(x)); return x; }
template <class T> __device__ __forceinline__ T* opq_p(T* p) { GAS T* g = (GAS T*)p; asm volatile("" : "+s"(g)); return (T*)g; }
__device__ __forceinline__ int lane_id_asm() { int l; asm volatile("v_mbcnt_lo_u32_b32 %0, -1, 0\n\tv_mbcnt_hi_u32_b32 %0, -1, %0" : "=v"(l)); return l; }
__device__ __forceinline__ int opq_s(int x) { asm volatile("" : "+s"(x)); return x; }

__global__ void __launch_bounds__(NWAVES * 64, 2) trunk_fwd(Args args) {
    extern __shared__ __attribute__((aligned(16))) unsigned char lds[];
    LAS unsigned char* ldsl = (LAS unsigned char*)lds;
    volatile LAS unsigned* MISC = (volatile LAS unsigned*)(ldsl + MISC_OFF);
    const int G_k = gridDim.x; const int bx_k = blockIdx.x;
    const int wave0 = __builtin_amdgcn_readfirstlane((int)threadIdx.x >> 6);
    { const int tid0 = threadIdx.x;
      for (int u = tid0; u < (LDS_BYTES - LDSCTL_OFF) / 4; u += NWAVES * 64) ((LAS unsigned*)(ldsl + LDSCTL_OFF))[u] = 0u; }
    __syncthreads();
    XcdBarrier bar; bar.bar = (unsigned*)(args.ws + WS_CTL) + CW_BAR; bar.x = 0; bar.st = nullptr;
    if (!MK_PER_PHASE) bar = xcd_barrier_post((unsigned*)(args.ws + WS_CTL) + CW_BAR, MISC + 8);
    const int lo = args.ph_lo, hi = args.ph_hi;
    int ph = 0;
#define PH_ON (ph >= lo && ph < hi)
#define PH_VARS const int G = opq_s(G_k), bx = opq_s(bx_k), vcu = (G % 8 == 0) ? (bx % 8) * (G / 8) + bx / 8 : bx, NGW = G * NWAVES; (void)NGW; const int lane = lane_id_asm(), wave = wave0, tid = wave * 64 + lane, gw = vcu * NWAVES + wave; unsigned char* ws = opq_p(args.ws); float* X = opq_p(args.out); (void)lane; (void)gw; (void)ws; (void)X
#define PH_END do { if (PH_ON && ph + 1 < hi) { XcdBarrier b2_ = bar; b2_.bar = opq_p(bar.bar); b2_.x = (unsigned)opq_s((int)bar.x); xcd_barrier(b2_); } ++ph; } while (0)

    if (PH_ON) {
        PH_VARS;
        LAS float* scr = (LAS float*)(ldsl + RING_OFF + wave * 16384);
        for (int l = 0; l < DEPTH; ++l) {
            unsigned char* wl = ws + WS_W + (size_t)l * WL_BYTES;
            transpose_matrix(args.in[I_F1IN] + (size_t)l * DM * 2 * DFF, DM, 2 * DFF, (bf16*)(wl + WL_F1IN), 1, scr, lane, gw, NGW);
            transpose_matrix(args.in[I_F1OUT] + (size_t)l * DFF * DM, DFF, DM, (bf16*)(wl + WL_F1OUT), 0, scr, lane, gw, NGW);
            transpose_matrix(args.in[I_WIN] + (size_t)l * DM * INC, DM, INC, (bf16*)(wl + WL_WIN), 0, scr, lane, gw, NGW);
            transpose_matrix(args.in[I_WA] + (size_t)l * 512 * DM, 512, DM, (bf16*)(wl + WL_WA), 0, scr, lane, gw, NGW);
            transpose_matrix(args.in[I_WB] + (size_t)l * 1024 * DM, 1024, DM, (bf16*)(wl + WL_WB), 0, scr, lane, gw, NGW);
            transpose_matrix(args.in[I_WC] + (size_t)l * 1024 * DM, 1024, DM, (bf16*)(wl + WL_WC), 0, scr, lane, gw, NGW);
            transpose_matrix(args.in[I_WO] + (size_t)l * DM * DM, DM, DM, (bf16*)(wl + WL_WO), 0, scr, lane, gw, NGW);
            transpose_matrix(args.in[I_F2IN] + (size_t)l * DM * 2 * DFF, DM, 2 * DFF, (bf16*)(wl + WL_F2IN), 1, scr, lane, gw, NGW);
            transpose_matrix(args.in[I_F2OUT] + (size_t)l * DFF * DM, DFF, DM, (bf16*)(wl + WL_F2OUT), 0, scr, lane, gw, NGW);
        }
        bf16* U = (bf16*)(ws + WS_U);
        for (int m = gw; m < M_ALL; m += NGW) {
            const float* xr = (m < 2 * SEQ) ? args.in[I_XP] + (size_t)m * DM : args.in[I_XS] + (size_t)(m - 2 * SEQ) * DM;
            rms_row_to_bf16(xr, args.in[I_NF1], U + (size_t)m * DM, X + (size_t)m * DM, lane);
        }
    }
    PH_END;

    for (int l = 0; l < DEPTH; ++l) {
        for (int half = 0; half < 2; ++half) {
            if (PH_ON) {
                PH_VARS;
                if (!(l == 0 && half == 0)) {
                    bf16* U = (bf16*)(ws + WS_U);
                    const float* g = (half == 0 ? args.in[I_NF1] : args.in[I_NF2]) + (size_t)l * DM;
                    for (int m = gw; m < M_ALL; m += NGW) rms_row_to_bf16(X + (size_t)m * DM, g, U + (size_t)m * DM, nullptr, lane);
                }
            }
            PH_END;
            if (PH_ON) {
                PH_VARS;
                unsigned char* wl = ws + WS_W + (size_t)l * WL_BYTES;
                pg8::Gemm g{(const bf16*)(ws + WS_U), (const bf16*)(wl + (half == 0 ? WL_F1IN : WL_F2IN)), M_ALL, 2 * DFF, DM}; pg8::StaticOrder S; S.init(M_ALL, 2 * DFF, G, bx);
                pg8::EpiSwiglu E{(bf16*)(ws + WS_H), DFF};
                pg8::gemm_phase<pg8::EpiSwiglu, pg8::StaticOrder, true, true>(ldsl + RING_OFF, g, S, E, tid);
            }
            PH_END;
            if (PH_ON) {
                PH_VARS;
                unsigned char* wl = ws + WS_W + (size_t)l * WL_BYTES;
                pg8::Gemm g{(const bf16*)(ws + WS_H), (const bf16*)(wl + (half == 0 ? WL_F1OUT : WL_F2OUT)), M_ALL, DM, DFF}; pg8::StaticOrder S; S.init(M_ALL, DM, G, bx);
                pg8::EpiResid E{X, DM, 0.5f};
                pg8::gemm_phase<pg8::EpiResid, pg8::StaticOrder, true, true>(ldsl + RING_OFF, g, S, E, tid);
            }
            PH_END;
            if (half == 0) {
                if (PH_ON) {
                    PH_VARS;
                    bf16* U = (bf16*)(ws + WS_U);
                    const float* g = args.in[I_NMIX] + (size_t)l * DM;
                    for (int m = gw; m < M_ALL; m += NGW) rms_row_to_bf16(X + (size_t)m * DM, g, U + (size_t)m * DM, nullptr, lane);
                }
                PH_END;
                for (int s = 0; s < NSEQ; ++s) {
                    if (PH_ON) {
                        PH_VARS;
                        unsigned char* wl = ws + WS_W + (size_t)l * WL_BYTES;
                        pg8::Gemm g{(const bf16*)(ws + WS_U) + (size_t)s * SEQ * DM, (const bf16*)(wl + WL_WIN), SEQ, INC, DM}; pg8::StaticOrder S; S.init(SEQ, INC, G, bx);
                        pg8::EpiBf16 E{(bf16*)(ws + WS_QKVG), INC};
                        pg8::gemm_phase<pg8::EpiBf16, pg8::StaticOrder, true, true>(ldsl + RING_OFF, g, S, E, tid);
                    }
                    PH_END;
                    if (PH_ON) {
                        PH_VARS;
                        bf16* QKVG = (bf16*)(ws + WS_QKVG);
                        { bf16* QB = (bf16*)(ws + WS_QB); bf16* KB = (bf16*)(ws + WS_KB); bf16* VB = (bf16*)(ws + WS_VB);
                          const float* gq = args.in[I_QNQ] + (size_t)l * 128; const float* gk = args.in[I_QNK] + (size_t)l * 128;
                          for (int t = gw; t < SEQ; t += NGW) ropeB_token(QKVG + (size_t)t * INC, t, gq, gk, QB + (size_t)t * 1024, KB + (size_t)t * 256, VB + (size_t)t * 256, lane); }
                        for (int u = vcu; u < 8 * 64 + 12 * 64; u += G) {
                            att::Unit A;
                            if (u < 8 * 64) {
                                const int h = u >> 6, b = u & 63;
                                A.Q = QKVG + (size_t)(256 * b) * INC + C_Q + h * 128; A.qstride = INC;
                                A.K = QKVG + C_K + (h >> 2) * 128; A.V = QKVG + C_V + (h >> 2) * 128; A.kstride = INC;
                                A.O = (bf16*)(ws + WS_OC) + (size_t)(256 * b) * 1024 + h * 128; A.ostride = 1024;
                                A.NT = 8; A.kb0 = 256 * b - 128; A.n = SEQ; A.qi0 = 256 * b; A.hw = 128;
                                A.slope_raw = __uint_as_float((unsigned)(127 - (h + 1)) << 23) * (1.0f / att::SCALE);
                                A.sink = args.in[I_SINK][l * 8 + h]; A.has_sink = 1; A.lse = nullptr; A.lse_stride = 0;
                            } else {
                                const int v = u - 8 * 64, h = v >> 6, w = v & 63, gi = h >> 2, rs = 2 * gi, r = 1 << rs;
                                const int bpc = 64 >> rs, c = w / bpc, b = w % bpc, nsub = SEQ >> rs;
                                A.Q = QKVG + (size_t)(c + r * 256 * b) * INC + A_Q + h * 128; A.qstride = r * INC;
                                A.K = QKVG + (size_t)c * INC + A_K + h * 128; A.V = QKVG + (size_t)c * INC + A_V + h * 128; A.kstride = r * INC;
                                A.O = (bf16*)(ws + WS_PA) + ((size_t)gi * SEQ + c + r * 256 * b) * 512 + (h & 3) * 128; A.ostride = r * 512;
                                A.NT = 6; A.kb0 = 256 * b - 64; A.n = nsub; A.qi0 = 256 * b; A.hw = 64;
                                const float sl = __builtin_amdgcn_exp2f(-8.0f * (float)(h + 1) / 12.0f) * (float)r * (1.0f / att::SCALE);
                                A.slope_raw = __uint_as_float(__builtin_amdgcn_readfirstlane(__float_as_uint(sl)));
                                A.sink = 0.f; A.has_sink = 0; A.lse = (float*)(ws + WS_LSE) + ((size_t)gi * SEQ + c + r * 256 * b) * 4 + (h & 3); A.lse_stride = r * 4;
                            }
                            att::attn_unit<true>(A, (char*)lds + RING_OFF, tid);
                        }
                    }
                    PH_END;
                    if (PH_ON) {
                        PH_VARS;
                        for (int t = gw; t < SEQ; t += NGW) mergeA_token((const bf16*)(ws + WS_PA), (const float*)(ws + WS_LSE), (bf16*)(ws + WS_OA), t, lane);
                        for (int u = vcu; u < 8 * 64; u += G) {
                            const int h = u >> 6, b = u & 63;
                            att::Unit A;
                            A.Q = (const bf16*)(ws + WS_QB) + (size_t)(256 * b) * 1024 + h * 128; A.qstride = 1024;
                            A.K = (const bf16*)(ws + WS_KB) + (h >> 2) * 128; A.V = (const bf16*)(ws + WS_VB) + (h >> 2) * 128; A.kstride = 256;
                            A.O = (bf16*)(ws + WS_OB) + (size_t)(256 * b) * 1024 + h * 128; A.ostride = 1024;
                            A.NT = SEQ / 64; A.kb0 = 0; A.n = SEQ; A.qi0 = 0; A.hw = 0; A.slope_raw = 0.f; A.sink = 0.f; A.has_sink = 0; A.lse = nullptr; A.lse_stride = 0;
                            att::attn_unit<false>(A, (char*)lds + RING_OFF, tid);
                        }
                    }
                    PH_END;
                    if (PH_ON) {
                        PH_VARS;
                        unsigned char* wl = ws + WS_W + (size_t)l * WL_BYTES;
                        for (int br = 0; br < 3; ++br) {
                            const bf16* Ap = (const bf16*)(ws + (br == 0 ? WS_OA : (br == 1 ? WS_OB : WS_OC))); const int Kb = br == 0 ? 512 : 1024;
                            const bf16* Wp = (const bf16*)(wl + (br == 0 ? WL_WA : (br == 1 ? WL_WB : WL_WC)));
                            pg8::Gemm g{Ap, Wp, SEQ, DM, Kb}; pg8::StaticOrder S; S.init(SEQ, DM, G, bx);
                            pg8::EpiGate E{(const bf16*)(ws + WS_QKVG) + GL0 + br * DM, INC, (float*)(ws + WS_MG), (bf16*)(ws + WS_MB), DM, br};
                            pg8::gemm_phase<pg8::EpiGate, pg8::StaticOrder, true, true>(ldsl + RING_OFF, g, S, E, tid);
                        }
                    }
                    PH_END;
                    if (PH_ON) {
                        PH_VARS;
                        unsigned char* wl = ws + WS_W + (size_t)l * WL_BYTES;
                        pg8::Gemm g{(const bf16*)(ws + WS_MB), (const bf16*)(wl + WL_WO), SEQ, DM, DM}; pg8::StaticOrder S; S.init(SEQ, DM, G, bx);
                        pg8::EpiResid E{X + (size_t)s * SEQ * DM, DM, 1.0f};
                        pg8::gemm_phase<pg8::EpiResid, pg8::StaticOrder, true, true>(ldsl + RING_OFF, g, S, E, tid);
                    }
                    PH_END;
                }
            }
        }
    }
    if (PH_ON) {
        PH_VARS;
        for (int m = gw; m < M_ALL; m += NGW) rms_row_f32(X + (size_t)m * DM, args.in[I_NFIN], lane);
    }
    PH_END;
#undef PH_ON
#undef PH_VARS
#undef PH_END
}

extern "C" void kernel_launch(void* const* d_in, const int* in_sizes, int n_in, void* d_out, int out_size, void* d_ws, size_t ws_size, hipStream_t stream) {
    static int grid = 0;
    if (grid == 0) {
        if (n_in != N_IN || out_size != M_ALL * DM || ws_size < WS_END) { fprintf(stderr, "kernel_launch: shape/workspace mismatch (n_in %d out %d ws %zu need %zu)\n", n_in, out_size, ws_size, (size_t)WS_END); grid = -1; return; }
        int dev = 0, cus = 0, per_cu = 0;
        if (hipGetDevice(&dev) != hipSuccess || hipDeviceGetAttribute(&cus, hipDeviceAttributeMultiprocessorCount, dev) != hipSuccess) { grid = -1; return; }
        if (hipFuncSetAttribute((const void*)trunk_fwd, hipFuncAttributeMaxDynamicSharedMemorySize, LDS_BYTES) != hipSuccess) { fprintf(stderr, "kernel_launch: hipFuncSetAttribute failed\n"); grid = -1; return; }
        if (hipOccupancyMaxActiveBlocksPerMultiprocessor(&per_cu, (const void*)trunk_fwd, NWAVES * 64, LDS_BYTES) != hipSuccess || per_cu < 1) { fprintf(stderr, "kernel_launch: occupancy query reports %d\n", per_cu); }
        (void)hipGetLastError();
        grid = cus;
    }
    if (grid < 0) return;
    if (hipMemsetAsync((char*)d_ws + WS_CTL, 0, CTL_ZERO_BYTES, stream) != hipSuccess) return;
    Args a{};
    for (int i = 0; i < N_IN; ++i) a.in[i] = (const float*)d_in[i];
    a.out = (float*)d_out; a.ws = (unsigned char*)d_ws;
#if MK_PER_PHASE
    for (int p = 0; p < N_PHASES; ++p) { a.ph_lo = p; a.ph_hi = p + 1; hipLaunchKernelGGL(trunk_fwd, dim3(grid), dim3(NWAVES * 64), LDS_BYTES, stream, a); }
#else
    a.ph_lo = 0; a.ph_hi = N_PHASES;
    hipLaunchKernelGGL(trunk_fwd, dim3(grid), dim3(NWAVES * 64), LDS_BYTES, stream, a);
#endif
    const hipError_t le = hipPeekAtLastError();
    if (le != hipSuccess) fprintf(stderr, "kernel_launch: launch failed: %s\n", hipGetErrorName(le));
}
```

```cpp
#include <hip/hip_runtime.h>
#include <cstdio>
#include <cstdint>

#ifndef DIAG
#define DIAG 0
#endif
#ifndef DIAG_A
#define DIAG_A 2
#endif
#ifndef DIAG_B
#define DIAG_B 3
#endif
#ifndef DIAG_SHIFT
#define DIAG_SHIFT 0
#endif
#ifndef DUP_TYPE
#define DUP_TYPE -1
#endif
#ifndef STAG_STEP
#define STAG_STEP 0
#endif
#ifndef EPI_FENCE
#define EPI_FENCE 1
#endif
#ifndef EXTRA
#define EXTRA 0
#endif
#ifndef ATT_SCHED
#define ATT_SCHED 0
#endif
#ifndef CHECKB
#define CHECKB 0
#endif
#ifndef ATT_RING
#define ATT_RING 0
#endif
#ifndef REV_FFNOUT
#define REV_FFNOUT 1
#endif
#ifndef LDH_PAD
#define LDH_PAD 64
#endif
#ifndef LDU_PAD
#define LDU_PAD 0
#endif
#ifndef LDW_PAD
#define LDW_PAD 0
#endif
#ifndef QKT_PREFETCH
#define QKT_PREFETCH 1
#endif
#ifndef WSKIP
#define WSKIP 0
#endif
#ifndef BAND_PREFETCH
#define BAND_PREFETCH 0
#endif
#ifndef MK_PER_PHASE
#define MK_PER_PHASE 0
#endif

namespace pg8 {
#define PG8_LAS __attribute__((address_space(3)))
typedef unsigned short bf16_t;
typedef short bf16x8 __attribute__((ext_vector_type(8)));
typedef float f32x4 __attribute__((ext_vector_type(4)));
typedef unsigned u32x4 __attribute__((ext_vector_type(4)));
typedef unsigned u32x2 __attribute__((ext_vector_type(2)));
constexpr int BM = 256, BK = 64, HALF = 128, HTB = HALF * BK * 2, STAGE_BYTES = 8 * HTB, NXCD = 8, WGM = 8;

__host__ __device__ __forceinline__ int lds_byte(int r, int c) { const int st = (r >> 4) * 2 + (c >> 5), rr = r & 15, cc = c & 31, ob = rr * 64 + cc * 2; return st * 1024 + (ob ^ (((ob >> 9) & 1) << 5)); }
__host__ __device__ __forceinline__ void stage_rc(int b, int& R, int& C) { const int st = b / 1024, sb = b % 1024, swz = sb ^ (((sb >> 9) & 1) << 5); R = (st >> 1) * 16 + swz / 64; C = (st & 1) * 32 + (swz % 64) / 2; }
__host__ __device__ __forceinline__ int perm32(int rho) { const int n = rho >> 4, i = rho & 15; return 8 * (i >> 2) + 4 * n + (i & 3); }

struct Unit { int pm, pn; };
struct Gemm { const bf16_t* A; const bf16_t* Bt; int M, N, K; int lda = 0, ldb = 0; };

struct StaticOrder {
    int nM, nN, nwg, G, c, rev;
    __host__ __device__ void init(int M, int N, int G_, int c_, int rev_ = 0) { nM = M / BM; nN = N / BM; nwg = nM * nN; G = G_; c = c_; rev = rev_; }
    __host__ __device__ bool next(int i, Unit& u) const {
        const long L = (long)i * G + c; if (L >= nwg) return false;
        int wgid = (int)L; { const int q = nwg / NXCD, r = nwg % NXCD, xcd = wgid % NXCD, off = wgid / NXCD; wgid = (xcd < r ? xcd * (q + 1) : r * (q + 1) + (xcd - r) * q) + off; }
        const int nig = WGM * nN, gid = wgid / nig, fm = gid * WGM, gsz = (nM - fm) < WGM ? (nM - fm) : WGM;
        u.pm = fm + ((wgid % nig) % gsz); u.pn = (wgid % nig) / gsz; if (rev) u.pm = nM - 1 - u.pm; return true;
    }
    __device__ __forceinline__ void a_ready(const Unit&) const {}
    __device__ __forceinline__ void done(const Unit&) const {}
};

__device__ __forceinline__ unsigned cvt_pk_bf16(float lo, float hi) { unsigned r; asm volatile("v_cvt_pk_bf16_f32 %0, %1, %2" : "=v"(r) : "v"(lo), "v"(hi)); return r; }
__device__ __forceinline__ float bf_lo(unsigned w) { return __uint_as_float(w << 16); }
__device__ __forceinline__ float bf_hi(unsigned w) { return __uint_as_float(w & 0xffff0000u); }
__device__ __forceinline__ float sigmoidf_(float x) { return __builtin_amdgcn_rcpf(1.0f + __builtin_amdgcn_exp2f(-1.4426950408889634f * x)); }

struct EpiBf16 {
    static constexpr bool PERM = true, AFTER_DRAIN = false;
    bf16_t* O; int ldc;
    __device__ __forceinline__ void operator()(const f32x4 (&acc)[2][2][4][2], const Unit& u, int wr, int wc, int fr, int fq) const {
        const int row0 = u.pm * BM + wr * 64 + fr, col0 = u.pn * BM + wc * 32 + 8 * fq;
#pragma unroll
        for (int ai = 0; ai < 2; ++ai)
#pragma unroll
            for (int m = 0; m < 4; ++m) { bf16_t* rowp = O + (size_t)(row0 + ai * HALF + m * 16) * ldc + col0;
#pragma unroll
                for (int bj = 0; bj < 2; ++bj) { const f32x4 v0 = acc[ai][bj][m][0], v1 = acc[ai][bj][m][1];
                    u32x4 w; w.x = cvt_pk_bf16(v0[0], v0[1]); w.y = cvt_pk_bf16(v0[2], v0[3]); w.z = cvt_pk_bf16(v1[0], v1[1]); w.w = cvt_pk_bf16(v1[2], v1[3]);
                    *(u32x4*)(rowp + bj * HALF) = w; } }
    }
};
struct EpiNull {
    static constexpr bool PERM = true, AFTER_DRAIN = false;
    __device__ __forceinline__ void operator()(const f32x4 (&acc)[2][2][4][2], const Unit& u, int wr, int wc, int fr, int fq) const {
#pragma unroll
        for (int ai = 0; ai < 2; ++ai)
#pragma unroll
            for (int bj = 0; bj < 2; ++bj) asm volatile("" :: "v"(acc[ai][bj][0][0]), "v"(acc[ai][bj][0][1]), "v"(acc[ai][bj][1][0]), "v"(acc[ai][bj][1][1]), "v"(acc[ai][bj][2][0]), "v"(acc[ai][bj][2][1]), "v"(acc[ai][bj][3][0]), "v"(acc[ai][bj][3][1]));
    }
};
struct EpiSwiglu {
    static constexpr bool PERM = true, AFTER_DRAIN = false;
    bf16_t* H; int ldc;
    __device__ __forceinline__ void operator()(const f32x4 (&acc)[2][2][4][2], const Unit& u, int wr, int wc, int fr, int fq) const {
        const int row0 = u.pm * BM + wr * 64 + fr, col0 = u.pn * HALF + wc * 32 + 8 * fq;
#pragma unroll
        for (int ai = 0; ai < 2; ++ai)
#pragma unroll
            for (int m = 0; m < 4; ++m) { bf16_t* rowp = H + (size_t)(row0 + ai * HALF + m * 16) * ldc + col0;
                float h[8];
#pragma unroll
                for (int n = 0; n < 2; ++n)
#pragma unroll
                    for (int e = 0; e < 4; ++e) { const float a = acc[ai][0][m][n][e], b = acc[ai][1][m][n][e]; h[n * 4 + e] = a * sigmoidf_(a) * b; }
                u32x4 w; w.x = cvt_pk_bf16(h[0], h[1]); w.y = cvt_pk_bf16(h[2], h[3]); w.z = cvt_pk_bf16(h[4], h[5]); w.w = cvt_pk_bf16(h[6], h[7]);
                *(u32x4*)rowp = w; }
    }
};
struct EpiResid {
    static constexpr bool PERM = false, AFTER_DRAIN = false;
    float* X; int ldc; float scale;
    __device__ __forceinline__ void operator()(const f32x4 (&acc)[2][2][4][2], const Unit& u, int wr, int wc, int fr, int fq) const {
        const int row0 = u.pm * BM + wr * 64 + fr, col0 = u.pn * BM + wc * 32 + 4 * fq;
#pragma unroll
        for (int ai = 0; ai < 2; ++ai) {
            f32x4 xv[4][2][2];
#pragma unroll
            for (int m = 0; m < 4; ++m) { const float* rowp = X + (size_t)(row0 + ai * HALF + m * 16) * ldc + col0;
#pragma unroll
                for (int bj = 0; bj < 2; ++bj)
#pragma unroll
                    for (int n = 0; n < 2; ++n) xv[m][bj][n] = *(const f32x4*)(rowp + bj * HALF + n * 16); }
#pragma unroll
            for (int m = 0; m < 4; ++m) { float* rowp = X + (size_t)(row0 + ai * HALF + m * 16) * ldc + col0;
#pragma unroll
                for (int bj = 0; bj < 2; ++bj)
#pragma unroll
                    for (int n = 0; n < 2; ++n) *(f32x4*)(rowp + bj * HALF + n * 16) = xv[m][bj][n] + acc[ai][bj][m][n] * scale; }
            asm volatile("" ::: "memory");
        }
    }
};
struct EpiGateCat {
    static constexpr bool PERM = true, AFTER_DRAIN = false, HOOK = true;
    const bf16_t* GL; int ldg; bf16_t* MB; int ldc; int ldo;
    __device__ __forceinline__ bool hook_at(int t) const { return t == 8 || t == 24; }
    static __device__ __forceinline__ float e_neg(float x) { return __builtin_amdgcn_exp2f(-1.4426950408889634f * __builtin_fminf(__builtin_fmaxf(x, -60.f), 60.f)); }
    __device__ __forceinline__ void hook(f32x4 (&acc)[2][2][4][2], const Unit& u, int t, int wr, int wc, int fr, int fq) const {
        int fr_ = fr; asm volatile("" : "+v"(fr_));
        const int row0 = u.pm * BM + wr * 64 + fr_, col0 = u.pn * BM + wc * 32 + 8 * fq; const bf16_t* gp = GL + (t == 8 ? 0 : ldc) + (size_t)row0 * ldg + col0;
#pragma unroll
        for (int ai = 0; ai < 2; ++ai) {
            u32x4 a[4][2], b[4][2];
#pragma unroll
            for (int m = 0; m < 4; ++m)
#pragma unroll
                for (int bj = 0; bj < 2; ++bj) { const bf16_t* q = gp + (size_t)(ai * HALF + m * 16) * ldg + bj * HALF; a[m][bj] = *(const u32x4*)q; b[m][bj] = *(const u32x4*)(q + ldc); }
#pragma unroll
            for (int m = 0; m < 4; ++m)
#pragma unroll
                for (int bj = 0; bj < 2; ++bj) { const u32x4 p = a[m][bj], n = b[m][bj]; f32x4& v0 = acc[ai][bj][m][0]; f32x4& v1 = acc[ai][bj][m][1];
                    v0[0] *= (1.f + e_neg(bf_lo(n.x))) * __builtin_amdgcn_rcpf(1.f + e_neg(bf_lo(p.x))); v0[1] *= (1.f + e_neg(bf_hi(n.x))) * __builtin_amdgcn_rcpf(1.f + e_neg(bf_hi(p.x)));
                    v0[2] *= (1.f + e_neg(bf_lo(n.y))) * __builtin_amdgcn_rcpf(1.f + e_neg(bf_lo(p.y))); v0[3] *= (1.f + e_neg(bf_hi(n.y))) * __builtin_amdgcn_rcpf(1.f + e_neg(bf_hi(p.y)));
                    v1[0] *= (1.f + e_neg(bf_lo(n.z))) * __builtin_amdgcn_rcpf(1.f + e_neg(bf_lo(p.z))); v1[1] *= (1.f + e_neg(bf_hi(n.z))) * __builtin_amdgcn_rcpf(1.f + e_neg(bf_hi(p.z)));
                    v1[2] *= (1.f + e_neg(bf_lo(n.w))) * __builtin_amdgcn_rcpf(1.f + e_neg(bf_lo(p.w))); v1[3] *= (1.f + e_neg(bf_hi(n.w))) * __builtin_amdgcn_rcpf(1.f + e_neg(bf_hi(p.w))); }
            asm volatile("" ::: "memory");
        }
        asm volatile("s_waitcnt vmcnt(0)" ::: "memory");
    }
    __device__ __forceinline__ void operator()(const f32x4 (&acc)[2][2][4][2], const Unit& u, int wr, int wc, int fr, int fq) const {
        const int row0 = u.pm * BM + wr * 64 + fr, col0 = u.pn * BM + wc * 32 + 8 * fq; const bf16_t* gp = GL + 2 * ldc;
#pragma unroll
        for (int ai = 0; ai < 2; ++ai) {
            u32x4 g[4][2];
#pragma unroll
            for (int m = 0; m < 4; ++m)
#pragma unroll
                for (int bj = 0; bj < 2; ++bj) g[m][bj] = *(const u32x4*)(gp + (size_t)(row0 + ai * HALF + m * 16) * ldg + col0 + bj * HALF);
#pragma unroll
            for (int m = 0; m < 4; ++m) { const size_t row = (size_t)(row0 + ai * HALF + m * 16);
#pragma unroll
                for (int bj = 0; bj < 2; ++bj) { const u32x4 gg = g[m][bj]; f32x4 v0 = acc[ai][bj][m][0], v1 = acc[ai][bj][m][1];
                    v0[0] *= sigmoidf_(bf_lo(gg.x)); v0[1] *= sigmoidf_(bf_hi(gg.x)); v0[2] *= sigmoidf_(bf_lo(gg.y)); v0[3] *= sigmoidf_(bf_hi(gg.y));
                    v1[0] *= sigmoidf_(bf_lo(gg.z)); v1[1] *= sigmoidf_(bf_hi(gg.z)); v1[2] *= sigmoidf_(bf_lo(gg.w)); v1[3] *= sigmoidf_(bf_hi(gg.w));
                    u32x4 w; w.x = cvt_pk_bf16(v0[0], v0[1]); w.y = cvt_pk_bf16(v0[2], v0[3]); w.z = cvt_pk_bf16(v1[0], v1[1]); w.w = cvt_pk_bf16(v1[2], v1[3]);
                    *(u32x4*)(MB + row * ldo + col0 + bj * HALF) = w; } }
            asm volatile("" ::: "memory");
        }
    }
};

template <class E, class = void> struct epi_has_hook { static constexpr bool value = false; };
template <class E> struct epi_has_hook<E, decltype((void)E::HOOK)> { static constexpr bool value = E::HOOK; };
template <class Epi, class Sched, bool ALIGN_EPI = false, bool SP2 = false>
__device__ __forceinline__ void gemm_phase(PG8_LAS unsigned char* lds, const Gemm g, const Sched& S, const Epi& E, const int tid, const unsigned stagger = 0u) {
    if (stagger) { const unsigned long long t0_ = __builtin_amdgcn_s_memrealtime(); while (__builtin_amdgcn_s_memrealtime() - t0_ < stagger) __builtin_amdgcn_s_sleep(16); }
    const int wid = __builtin_amdgcn_readfirstlane(tid >> 6), lane = tid & 63, wr = wid >> 2, wc = wid & 3, fr = lane & 15, fq = lane >> 4;
    const int K = g.K, nt = K / BK, lda = g.lda ? g.lda : g.K, ldb = g.ldb ? g.ldb : g.K;
    unsigned voffA[2], voffB[2];
#pragma unroll
    for (int i = 0; i < 2; ++i) { int R, C; stage_rc(tid * 16 + i * 8192, R, C); const int Rb = Epi::PERM ? ((R & ~31) + perm32(R & 31)) : R;
        voffA[i] = (unsigned)(R * lda + C) * 2u; voffB[i] = (unsigned)(Rb * ldb + C) * 2u; }
    const size_t kstep = (size_t)(BK * 2);
    const size_t hstep = (size_t)HALF * ldb * 2, hstepA = (size_t)HALF * lda * 2;
    const size_t tstep = 2 * hstep, tstepA = 2 * hstepA;
    const unsigned ldsw = (unsigned)wid * 1024u;
    const int aoff = lds_byte(wr * 64 + fr, fq * 8), boff = lds_byte(wc * 32 + fr, fq * 8);
#define PG8_SA(b, h) (((b) * 2 + (h)) * HTB)
#define PG8_SB(b, h) ((4 + (b) * 2 + (h)) * HTB)
#define PG8_STAGE(bufoff, gbase, voff) do { _Pragma("unroll") for (int _i = 0; _i < 2; ++_i) \
        __builtin_amdgcn_global_load_lds((const unsigned*)((const char*)(gbase) + (voff)[_i]), (PG8_LAS unsigned*)(lds + (bufoff) + ldsw + _i * 8192), 16, 0, 0); } while (0)
#define PG8_LDA(dst, b, h) do { _Pragma("unroll") for (int m = 0; m < 4; ++m) _Pragma("unroll") for (int k = 0; k < 2; ++k) dst[m][k] = *(const PG8_LAS bf16x8*)(lds + PG8_SA(b, h) + aoff + m * 2048 + k * 1024); } while (0)
#define PG8_LDB(dst, b, h) do { _Pragma("unroll") for (int n = 0; n < 2; ++n) _Pragma("unroll") for (int k = 0; k < 2; ++k) dst[n][k] = *(const PG8_LAS bf16x8*)(lds + PG8_SB(b, h) + boff + n * 2048 + k * 1024); } while (0)
#define PG8_MMA(ai, bj, At, Bt) do { __builtin_amdgcn_s_setprio(1); _Pragma("unroll") for (int m = 0; m < 4; ++m) _Pragma("unroll") for (int n = 0; n < 2; ++n) _Pragma("unroll") for (int k = 0; k < 2; ++k) \
        acc[ai][bj][m][n] = __builtin_amdgcn_mfma_f32_16x16x32_bf16(Bt[n][k], At[m][k], acc[ai][bj][m][n], 0, 0, 0); __builtin_amdgcn_s_setprio(0); } while (0)
#define PG8_WAIT_V(n) asm volatile("s_waitcnt vmcnt(" #n ")" ::: "memory")
#define PG8_WAIT_L(n) asm volatile("s_waitcnt lgkmcnt(" #n ")" ::: "memory")
#define PG8_BAR __builtin_amdgcn_s_barrier()
#define PG8_SCHED __builtin_amdgcn_sched_barrier(0)
    Unit cur, nxt; int ui = 0;
    if (!S.next(0, cur)) return;
    f32x4 acc[2][2][4][2];
#pragma unroll
    for (int a = 0; a < 2; ++a)
#pragma unroll
        for (int b = 0; b < 2; ++b)
#pragma unroll
            for (int m = 0; m < 4; ++m)
#pragma unroll
                for (int n = 0; n < 2; ++n) acc[a][b][m][n] = (f32x4){0.f, 0.f, 0.f, 0.f};
    bf16x8 At[4][2], B0[2][2], B1[2][2];
    const char* cA = (const char*)g.A + (size_t)cur.pm * tstepA; const char* cB = (const char*)g.Bt + (size_t)cur.pn * tstep;
    S.a_ready(cur);
    if constexpr (SP2) {
        PG8_STAGE(PG8_SB(0, 0), cB, voffB); PG8_STAGE(PG8_SB(0, 1), cB + hstep, voffB); PG8_STAGE(PG8_SA(0, 0), cA, voffA); PG8_STAGE(PG8_SA(0, 1), cA + hstepA, voffA);
        if (wr == 1) PG8_BAR;
        PG8_WAIT_V(2); PG8_BAR;
        PG8_STAGE(PG8_SB(1, 0), cB + kstep, voffB); PG8_STAGE(PG8_SA(1, 0), cA + kstep, voffA); PG8_STAGE(PG8_SB(1, 1), cB + hstep + kstep, voffB);
        PG8_WAIT_V(6); PG8_BAR;
    } else {
        PG8_STAGE(PG8_SB(0, 0), cB, voffB); PG8_STAGE(PG8_SA(0, 0), cA, voffA); PG8_STAGE(PG8_SB(0, 1), cB + hstep, voffB); PG8_STAGE(PG8_SA(0, 1), cA + hstepA, voffA);
        if (wr == 1) PG8_BAR;
        PG8_WAIT_V(4); PG8_BAR;
        PG8_STAGE(PG8_SB(1, 0), cB + kstep, voffB); PG8_STAGE(PG8_SA(1, 0), cA + kstep, voffA); PG8_STAGE(PG8_SB(1, 1), cB + hstep + kstep, voffB);
        PG8_WAIT_V(6); PG8_BAR;
    }
    for (;;) {
        const bool has_next = S.next(ui + 1, nxt);
        const char* nA = has_next ? (const char*)g.A + (size_t)nxt.pm * tstepA : cA; const char* nB = has_next ? (const char*)g.Bt + (size_t)nxt.pn * tstep : cB;
        for (int t = 0; t < nt; t += 2) {
            const bool last = (t == nt - 2);
            const char* a1 = cA + (size_t)(t + 1) * kstep;
            const char* a2 = last ? nA : cA + (size_t)(t + 2) * kstep; const char* b2 = last ? nB : cB + (size_t)(t + 2) * kstep;
            const char* a3 = a2 + kstep; const char* b3 = b2 + kstep;
            if (last && has_next) S.a_ready(nxt);
            if constexpr (epi_has_hook<Epi>::value) { if (E.hook_at(t)) E.hook(acc, cur, t, wr, wc, fr, fq); }
            if constexpr (SP2) {
            PG8_LDB(B0, 0, 0); PG8_LDB(B1, 0, 1); PG8_SCHED; PG8_LDA(At, 0, 0); PG8_STAGE(PG8_SA(1, 1), a1 + hstepA, voffA);
            PG8_WAIT_V(8); PG8_WAIT_L(0); PG8_BAR; PG8_MMA(0, 0, At, B0); PG8_MMA(0, 1, At, B1); PG8_BAR; PG8_SCHED;
            PG8_LDA(At, 0, 1); PG8_STAGE(PG8_SB(0, 0), b2, voffB); PG8_STAGE(PG8_SB(0, 1), b2 + hstep, voffB); PG8_STAGE(PG8_SA(0, 0), a2, voffA);
            PG8_WAIT_V(8); PG8_WAIT_L(0); PG8_BAR; PG8_MMA(1, 0, At, B0); PG8_MMA(1, 1, At, B1); PG8_BAR; PG8_SCHED;
            PG8_LDB(B0, 1, 0); PG8_LDB(B1, 1, 1); PG8_SCHED; PG8_LDA(At, 1, 0); PG8_STAGE(PG8_SA(0, 1), a2 + hstepA, voffA);
            PG8_WAIT_V(8); PG8_WAIT_L(0); PG8_BAR; PG8_MMA(0, 0, At, B0); PG8_MMA(0, 1, At, B1); PG8_BAR; PG8_SCHED;
            PG8_LDA(At, 1, 1); PG8_STAGE(PG8_SB(1, 0), b3, voffB); PG8_STAGE(PG8_SB(1, 1), b3 + hstep, voffB); PG8_STAGE(PG8_SA(1, 0), a3, voffA);
            PG8_WAIT_V(8); PG8_WAIT_L(0); PG8_BAR; PG8_MMA(1, 0, At, B0); PG8_MMA(1, 1, At, B1); PG8_BAR; PG8_SCHED;
            } else {
            PG8_LDB(B0, 0, 0); PG8_SCHED; PG8_LDA(At, 0, 0); PG8_STAGE(PG8_SA(1, 1), a1 + hstepA, voffA);
            PG8_WAIT_L(8); PG8_BAR; PG8_WAIT_L(0); PG8_MMA(0, 0, At, B0); PG8_BAR; PG8_SCHED;
            PG8_LDB(B1, 0, 1); PG8_STAGE(PG8_SB(0, 0), b2, voffB);
            PG8_BAR; PG8_WAIT_L(0); PG8_MMA(0, 1, At, B1); PG8_BAR;
            PG8_LDA(At, 0, 1); PG8_STAGE(PG8_SA(0, 0), a2, voffA);
            PG8_BAR; PG8_WAIT_L(0); PG8_MMA(1, 0, At, B0); PG8_BAR; PG8_SCHED;
            PG8_STAGE(PG8_SB(0, 1), b2 + hstep, voffB);
            PG8_WAIT_V(6); PG8_BAR; PG8_MMA(1, 1, At, B1); PG8_BAR;
            PG8_LDB(B0, 1, 0); PG8_SCHED; PG8_LDA(At, 1, 0); PG8_STAGE(PG8_SA(0, 1), a2 + hstepA, voffA);
            PG8_WAIT_L(8); PG8_BAR; PG8_WAIT_L(0); PG8_MMA(0, 0, At, B0); PG8_BAR; PG8_SCHED;
            PG8_LDB(B1, 1, 1); PG8_STAGE(PG8_SB(1, 0), b3, voffB);
            PG8_BAR; PG8_WAIT_L(0); PG8_MMA(0, 1, At, B1); PG8_BAR;
            PG8_LDA(At, 1, 1); PG8_STAGE(PG8_SA(1, 0), a3, voffA);
            PG8_BAR; PG8_WAIT_L(0); PG8_MMA(1, 0, At, B0); PG8_BAR; PG8_SCHED;
            PG8_STAGE(PG8_SB(1, 1), b3 + hstep, voffB);
            PG8_WAIT_V(6); PG8_BAR; PG8_MMA(1, 1, At, B1); PG8_BAR;
            }
        }
        if constexpr (ALIGN_EPI) { if (wr == 0) PG8_BAR; }
        E(acc, cur, wr, wc, fr, fq); S.done(cur);
        if (!has_next) break;
#pragma unroll
        for (int a = 0; a < 2; ++a)
#pragma unroll
            for (int b = 0; b < 2; ++b)
#pragma unroll
                for (int m = 0; m < 4; ++m)
#pragma unroll
                    for (int n = 0; n < 2; ++n) acc[a][b][m][n] = (f32x4){0.f, 0.f, 0.f, 0.f};
        cur = nxt; cA = nA; cB = nB; ++ui;
        if constexpr (ALIGN_EPI) { if (wr == 1) PG8_BAR; }
    }
    PG8_WAIT_V(0);
    if constexpr (!ALIGN_EPI) { if (wr == 0) PG8_BAR; }
    PG8_BAR;
#undef PG8_SA
#undef PG8_SB
#undef PG8_STAGE
#undef PG8_LDA
#undef PG8_LDB
#undef PG8_MMA
#undef PG8_WAIT_V
#undef PG8_WAIT_L
#undef PG8_BAR
#undef PG8_SCHED
}
}

namespace att {
typedef unsigned short bf16;
using bf16x8 = __attribute__((ext_vector_type(8))) short;
using s16x4  = __attribute__((ext_vector_type(4))) short;
using f32x16 = __attribute__((ext_vector_type(16))) float;
using u32x4  = __attribute__((ext_vector_type(4))) unsigned;
constexpr int D = 128, NW = 8, QBLK = 32, KVBLK = 64;
constexpr float SCALE = 0.088388347648318440f;
constexpr float THR = 8.f;
constexpr int SHM_V = KVBLK * D * 2, SHM_K = KVBLK * D * 2, SHM_ATTN = 2 * SHM_V + 2 * SHM_K + NW * 64 * 4;
#define KSWZ(row, colB) ((row) * 256 + ((colB) ^ (((row) & 7) << 4)))
#define SBAR() __builtin_amdgcn_sched_barrier(0)
__device__ __forceinline__ int crow(int r, int hi) { return (r & 3) + 8 * (r >> 2) + 4 * hi; }
__device__ __forceinline__ unsigned cvtpk(float lo, float hi) { unsigned r; asm volatile("v_cvt_pk_bf16_f32 %0, %1, %2" : "=v"(r) : "v"(lo), "v"(hi)); return r; }

template <int SM> __device__ __forceinline__ void partialSM(f32x16& p0, f32x16& p1, float& m_reg, float& mn, float& alpha) {
  if constexpr (SM == 2) {
#pragma unroll
    for (int r = 0; r < 16; ++r) p0[r] = __builtin_amdgcn_exp2f(p0[r]);
    return; }
  constexpr float C = SM == 0 ? SCALE * 1.4426950408889634f : 1.0f; constexpr float THRU = SM == 0 ? THR / SCALE : THR * 1.4426950408889634f;
  float pmax = p0[0];
#pragma unroll
  for (int r = 1; r < 16; ++r) pmax = fmaxf(pmax, p0[r]);
#pragma unroll
  for (int r = 0; r < 16; ++r) pmax = fmaxf(pmax, p1[r]);
  { auto rr = __builtin_amdgcn_permlane32_swap(__float_as_uint(pmax), __float_as_uint(pmax), false, false);
    pmax = fmaxf(__uint_as_float(rr[0]), __uint_as_float(rr[1])); }
  if (__builtin_expect(__all(pmax - m_reg <= THRU), 1)) { mn = m_reg; alpha = 1.f; }
  else { mn = fmaxf(m_reg, pmax); alpha = __builtin_amdgcn_exp2f((m_reg - mn) * C); m_reg = mn; }
  float mnC = -mn * C;
#pragma unroll
  for (int r = 0; r < 16; ++r) p0[r] = fmaf(p0[r], C, mnC);
#pragma unroll
  for (int r = 0; r < 16; ++r) p1[r] = fmaf(p1[r], C, mnC);
#pragma unroll
  for (int r = 0; r < 16; ++r) p0[r] = __builtin_amdgcn_exp2f(p0[r]);
}
template <int SM> __device__ __forceinline__ void finishSM(f32x16& p0, f32x16& p1, float alpha, float& l_reg, bf16x8& pa0, bf16x8& pa1, bf16x8& pa2, bf16x8& pa3) {
#pragma unroll
  for (int r = 0; r < 16; ++r) p1[r] = __builtin_amdgcn_exp2f(p1[r]);
  float ps = 0;
#pragma unroll
  for (int r = 0; r < 16; ++r) ps += p0[r];
#pragma unroll
  for (int r = 0; r < 16; ++r) ps += p1[r];
  { auto rr = __builtin_amdgcn_permlane32_swap(__float_as_uint(ps), __float_as_uint(ps), false, false);
    ps = __uint_as_float(rr[0]) + __uint_as_float(rr[1]); }
  if constexpr (SM == 2) l_reg += ps; else l_reg = l_reg * alpha + ps;
#define PK4(P, BASE, OUT) do { unsigned a0 = cvtpk(P[BASE + 0], P[BASE + 1]), a1 = cvtpk(P[BASE + 2], P[BASE + 3]);   \
    unsigned b0 = cvtpk(P[BASE + 4], P[BASE + 5]), b1 = cvtpk(P[BASE + 6], P[BASE + 7]);                              \
    auto r0 = __builtin_amdgcn_permlane32_swap(a0, b0, false, false); auto r1 = __builtin_amdgcn_permlane32_swap(a1, b1, false, false); \
    u32x4 w = {r0[0], r1[0], r0[1], r1[1]}; OUT = *reinterpret_cast<bf16x8*>(&w); } while (0)
  PK4(p0, 0, pa0); PK4(p0, 8, pa1); PK4(p1, 0, pa2); PK4(p1, 8, pa3);
#undef PK4
}
template <bool PF> __device__ __forceinline__ void qkt(f32x16& p0, f32x16& p1, const char* Ks, const bf16x8* qr, int r32, int hi) {
  p0 = f32x16{}; p1 = f32x16{};
  if constexpr (PF) {
  bf16x8 b0 = *reinterpret_cast<const bf16x8*>(Ks + KSWZ(r32, (hi * 8) * 2)), b1 = *reinterpret_cast<const bf16x8*>(Ks + KSWZ(32 + r32, (hi * 8) * 2));
#pragma unroll
  for (int d0 = 0; d0 < 8; ++d0) { bf16x8 n0 = b0, n1 = b1;
    if (d0 < 7) { const int cb = ((d0 + 1) * 16 + hi * 8) * 2; n0 = *reinterpret_cast<const bf16x8*>(Ks + KSWZ(r32, cb)); n1 = *reinterpret_cast<const bf16x8*>(Ks + KSWZ(32 + r32, cb)); }
    if (d0 < 7) asm volatile("s_waitcnt lgkmcnt(2)" ::: "memory"); else asm volatile("s_waitcnt lgkmcnt(0)" ::: "memory");
    __builtin_amdgcn_sched_barrier(0);
    p0 = __builtin_amdgcn_mfma_f32_32x32x16_bf16(b0, qr[d0], p0, 0, 0, 0);
    p1 = __builtin_amdgcn_mfma_f32_32x32x16_bf16(b1, qr[d0], p1, 0, 0, 0);
    b0 = n0; b1 = n1; }
  } else {
#pragma unroll
  for (int d0 = 0; d0 < 8; ++d0) { int cb = (d0 * 16 + hi * 8) * 2;
    bf16x8 b0 = *reinterpret_cast<const bf16x8*>(Ks + KSWZ(r32, cb));
    bf16x8 b1 = *reinterpret_cast<const bf16x8*>(Ks + KSWZ(32 + r32, cb));
    p0 = __builtin_amdgcn_mfma_f32_32x32x16_bf16(b0, qr[d0], p0, 0, 0, 0);
    p1 = __builtin_amdgcn_mfma_f32_32x32x16_bf16(b1, qr[d0], p1, 0, 0, 0); }
  }
}
__device__ __forceinline__ int v_st(int k, int c) { const int kk = (k & ~0xC) | ((k & 4) << 1) | ((k & 8) >> 1); return ((kk >> 3) * 4 + (c >> 5)) * 512 + ((kk & 7) * 32 + (c & 31)) * 2; }
__device__ __forceinline__ int v_rd_base(int lane) { return ((lane & 3) << 3) | (((lane >> 2) & 3) << 6) | (((lane >> 4) & 1) << 5) | (((lane >> 5) & 1) << 8); }
constexpr int v_rd_off(int d0, int ks, int half) { return d0 * 512 + ks * 4096 + half * 2048; }
template <int OFF> __device__ __forceinline__ s16x4 tr_read(int vb) {
  s16x4 r; asm volatile("ds_read_b64_tr_b16 %0, %1 offset:%2" : "=&v"(r) : "v"(vb), "i"(OFF) : "memory"); return r;
}
template <int D0> __device__ __forceinline__ void pv_one(f32x16& od, int vb, bf16x8 pa0, bf16x8 pa1, bf16x8 pa2, bf16x8 pa3) {
  const s16x4 l0 = tr_read<v_rd_off(D0, 0, 0)>(vb), h0 = tr_read<v_rd_off(D0, 0, 1)>(vb), l1 = tr_read<v_rd_off(D0, 1, 0)>(vb), h1 = tr_read<v_rd_off(D0, 1, 1)>(vb);
  const s16x4 l2 = tr_read<v_rd_off(D0, 2, 0)>(vb), h2 = tr_read<v_rd_off(D0, 2, 1)>(vb), l3 = tr_read<v_rd_off(D0, 3, 0)>(vb), h3 = tr_read<v_rd_off(D0, 3, 1)>(vb);
  asm volatile("s_waitcnt lgkmcnt(0)" ::: "memory"); SBAR();
#define PK(L, H) (bf16x8){L[0], L[1], L[2], L[3], H[0], H[1], H[2], H[3]}
  od = __builtin_amdgcn_mfma_f32_32x32x16_bf16(pa0, PK(l0, h0), od, 0, 0, 0);
  od = __builtin_amdgcn_mfma_f32_32x32x16_bf16(pa1, PK(l1, h1), od, 0, 0, 0);
  od = __builtin_amdgcn_mfma_f32_32x32x16_bf16(pa2, PK(l2, h2), od, 0, 0, 0);
  od = __builtin_amdgcn_mfma_f32_32x32x16_bf16(pa3, PK(l3, h3), od, 0, 0, 0);
#undef PK
}
__device__ __forceinline__ void pv_d0(f32x16* o, int vb, bf16x8 pa0, bf16x8 pa1, bf16x8 pa2, bf16x8 pa3) {
  pv_one<0>(o[0], vb, pa0, pa1, pa2, pa3); pv_one<1>(o[1], vb, pa0, pa1, pa2, pa3); pv_one<2>(o[2], vb, pa0, pa1, pa2, pa3); pv_one<3>(o[3], vb, pa0, pa1, pa2, pa3);
}

struct Unit {
  const bf16* Q; const bf16* K; const bf16* V; bf16* O; float* lse;
  int qstride, kstride, ostride, lse_stride;
  int NT;
  int kb0, n, qi0, hw;
  float slope_raw;
  float sink; int has_sink;
};

template <bool BAND, int SM>
__device__ __forceinline__ void attn_unit(const Unit& U, char* lds, const int tid) {
  const int wid = tid >> 6, lane = tid & 63, r32 = lane & 31, hi = lane >> 5;
  char* V_lds = lds; char* K_lds = lds + 2 * SHM_V;
  float* ws = (float*)(lds + 2 * SHM_V + 2 * SHM_K) + wid * 64; float* li_l = ws; float* al_l = ws + 32;
  float m_reg = -1e30f, l_reg = 0; f32x16 o[4] = {}; bf16x8 qr[8];
  { int lq_ = lane; asm volatile("" : "+v"(lq_));
    const unsigned qoff = (unsigned)(wid * QBLK + (lq_ & 31)) * (unsigned)U.qstride + (unsigned)((lq_ >> 5) * 8);
#pragma unroll
    for (int d0 = 0; d0 < 8; ++d0) qr[d0] = *reinterpret_cast<const bf16x8*>(U.Q + qoff + d0 * 16); }
  const int sr = tid >> 4, sc = (tid & 15) * 8, vst0 = v_st(sr, sc), kst0 = KSWZ(sr, sc * 2);
  const int vb0 = (int)(uintptr_t)V_lds + v_rd_base(lane);
  struct { bf16x8 vs0, vs1, ks0, ks1; } sr_[BAND ? 1 : 2];
  float fq = 0.f;
  if constexpr (BAND) fq = (float)(U.qi0 + wid * QBLK + r32);
#define ROWOF(k) ((k) < 0 ? 0 : ((k) >= U.n ? U.n - 1 : (k)))
#define SLOAD(i, k0) do { unsigned _o0, _o1; \
    if constexpr (BAND) { const int _ka = U.kb0 + (k0) + sr; _o0 = (unsigned)ROWOF(_ka) * (unsigned)U.kstride + (unsigned)sc; _o1 = (unsigned)ROWOF(_ka + 32) * (unsigned)U.kstride + (unsigned)sc; } \
    else { _o0 = (unsigned)((k0) + sr) * (unsigned)U.kstride + (unsigned)sc; _o1 = _o0 + 32u * (unsigned)U.kstride; } \
    sr_[i].vs0 = *reinterpret_cast<const bf16x8*>(U.V + _o0); sr_[i].vs1 = *reinterpret_cast<const bf16x8*>(U.V + _o1); \
    sr_[i].ks0 = *reinterpret_cast<const bf16x8*>(U.K + _o0); sr_[i].ks1 = *reinterpret_cast<const bf16x8*>(U.K + _o1); } while (0)
#define SWRITE(b, i) do { *(bf16x8*)(V_lds + (b) * SHM_V + vst0) = sr_[i].vs0;          \
    *(bf16x8*)(V_lds + (b) * SHM_V + vst0 + 8192) = sr_[i].vs1;                         \
    *(bf16x8*)(K_lds + (b) * SHM_K + kst0) = sr_[i].ks0;                               \
    *(bf16x8*)(K_lds + (b) * SHM_K + kst0 + 8192) = sr_[i].ks1; } while (0)
#define SWAIT() asm volatile("s_waitcnt vmcnt(4)" ::: "memory")
#define QK_SCHED() do { if constexpr (SM == 2 && ATT_SCHED == 1) { __builtin_amdgcn_sched_group_barrier(0x100, 4, 0); \
    _Pragma("unroll") for (int i_ = 0; i_ < 7; ++i_) { __builtin_amdgcn_sched_group_barrier(0x008, 2, 0); __builtin_amdgcn_sched_group_barrier(0x002, 9, 0); __builtin_amdgcn_sched_group_barrier(0x100, 2, 0); } \
    __builtin_amdgcn_sched_group_barrier(0x008, 2, 0); __builtin_amdgcn_sched_group_barrier(0x002, 12, 0); } \
    if constexpr (SM == 2 && ATT_SCHED == 2) { _Pragma("unroll") for (int i_ = 0; i_ < 8; ++i_) { __builtin_amdgcn_sched_group_barrier(0x100, 2, 0); __builtin_amdgcn_sched_group_barrier(0x008, 2, 0); __builtin_amdgcn_sched_group_barrier(0x002, 9, 0); } } } while (0)
#define RESC(a) do { if constexpr (SM != 2) if (__any((a) < 1.f)) { if (hi == 0) al_l[r32] = (a); asm volatile("s_waitcnt lgkmcnt(0)" ::: "memory"); \
    _Pragma("unroll") for (int d = 0; d < 4; ++d) _Pragma("unroll") for (int r = 0; r < 16; ++r) o[d][r] *= al_l[crow(r, hi)]; } } while (0)
#define MASKB(P0, P1, j) do { if constexpr (BAND) { const float _f0 = ((float)(U.kb0 + 64 * (j)) + (float)(4 * hi)) - fq; const float _ninf = -__builtin_inff(); \
    const float flo = __builtin_fmaxf(-(float)U.hw, -fq), fhi = __builtin_fminf((float)U.hw, (float)(U.n - 1) - fq); \
    _Pragma("unroll") for (int r = 0; r < 16; ++r) { const float d0_ = _f0 + (float)((r & 3) + 8 * (r >> 2)), d1_ = d0_ + 32.f; \
      const float s0_ = fmaf(-U.slope_raw, __builtin_fabsf(d0_), P0[r]), s1_ = fmaf(-U.slope_raw, __builtin_fabsf(d1_), P1[r]); \
      P0[r] = (d0_ >= flo && d0_ <= fhi) ? s0_ : _ninf; P1[r] = (d1_ >= flo && d1_ <= fhi) ? s1_ : _ninf; } } } while (0)
  f32x16 pA0, pA1, pB0, pB1; float mnA, mnB, alA, alB; bf16x8 pa0, pa1, pa2, pa3; const int NT = U.NT;
  constexpr int SE = 0, SO = 1;
  if constexpr (BAND) {
  const int tlo_ = __builtin_amdgcn_readfirstlane(wid >> 1), thi_ = tlo_ + (U.hw >> 5);
#define ACT(j) (!WSKIP || ((j) >= tlo_ && (j) <= thi_))
  SLOAD(0, 0); SWRITE(0, 0); SLOAD(0, KVBLK); __syncthreads();
  if (ACT(0)) { qkt<(BAND_PREFETCH != 0)>(pA0, pA1, K_lds, qr, r32, hi); MASKB(pA0, pA1, 0); partialSM<SM>(pA0, pA1, m_reg, mnA, alA); }
  SWRITE(1, 0); if (2 < NT) SLOAD(0, 2 * KVBLK); __syncthreads();
  for (int j = 1; j + 1 < NT; j += 2) {
      { const bool aj = ACT(j), ap = ACT(j - 1);
        SBAR(); if (aj) qkt<(BAND_PREFETCH != 0)>(pB0, pB1, K_lds + SHM_K, qr, r32, hi);
        if (ap) { finishSM<SM>(pA0, pA1, alA, l_reg, pa0, pa1, pa2, pa3); SBAR(); pv_d0(o, vb0, pa0, pa1, pa2, pa3); }
        if (aj) { MASKB(pB0, pB1, j); partialSM<SM>(pB0, pB1, m_reg, mnB, alB); }
        __syncthreads(); SWRITE(0, 0); SLOAD(0, (j + 2) * KVBLK);
        if (aj) RESC(alB); __syncthreads(); }
      { const bool aj = ACT(j + 1), ap = ACT(j);
        SBAR(); if (aj) qkt<(BAND_PREFETCH != 0)>(pA0, pA1, K_lds, qr, r32, hi);
        if (ap) { finishSM<SM>(pB0, pB1, alB, l_reg, pa0, pa1, pa2, pa3); SBAR(); pv_d0(o, vb0 + SHM_V, pa0, pa1, pa2, pa3); }
        if (aj) { MASKB(pA0, pA1, j + 1); partialSM<SM>(pA0, pA1, m_reg, mnA, alA); }
        __syncthreads(); SWRITE(1, 0); if (j + 3 < NT) SLOAD(0, (j + 3) * KVBLK);
        if (aj) RESC(alA); __syncthreads(); }
  }
  { const bool aj = ACT(NT - 1), ap = ACT(NT - 2);
    SBAR(); if (aj) qkt<(BAND_PREFETCH != 0)>(pB0, pB1, K_lds + SHM_K, qr, r32, hi);
    if (ap) { finishSM<SM>(pA0, pA1, alA, l_reg, pa0, pa1, pa2, pa3); SBAR(); pv_d0(o, vb0, pa0, pa1, pa2, pa3); }
    if (aj) { MASKB(pB0, pB1, NT - 1); partialSM<SM>(pB0, pB1, m_reg, mnB, alB); }
    __syncthreads();
    if (aj) { RESC(alB);
      finishSM<SM>(pB0, pB1, alB, l_reg, pa0, pa1, pa2, pa3); SBAR();
      pv_d0(o, vb0 + SHM_V, pa0, pa1, pa2, pa3); } }
#undef ACT
  } else {
  SLOAD(SE, 0); asm volatile("s_waitcnt vmcnt(0)" ::: "memory"); SWRITE(0, SE); __syncthreads();
  qkt<(QKT_PREFETCH != 0) && SM == 2>(pA0, pA1, K_lds, qr, r32, hi); partialSM<SM>(pA0, pA1, m_reg, mnA, alA);
  SLOAD(SO, KVBLK); if (2 < NT) SLOAD(SE, 2 * KVBLK);
  SWAIT(); SWRITE(1, SO); __syncthreads();
  for (int j = 1; j + 1 < NT; j += 2) {
    SBAR(); qkt<(QKT_PREFETCH != 0) && SM == 2>(pB0, pB1, K_lds + SHM_K, qr, r32, hi);
    finishSM<SM>(pA0, pA1, alA, l_reg, pa0, pa1, pa2, pa3); QK_SCHED(); SBAR();
    SLOAD(SO, (j + 2) * KVBLK); SBAR();
    pv_d0(o, vb0, pa0, pa1, pa2, pa3); partialSM<SM>(pB0, pB1, m_reg, mnB, alB);
    __syncthreads(); SWAIT(); SWRITE(0, SE);
    RESC(alB); __syncthreads();
    SBAR(); qkt<(QKT_PREFETCH != 0) && SM == 2>(pA0, pA1, K_lds, qr, r32, hi);
    finishSM<SM>(pB0, pB1, alB, l_reg, pa0, pa1, pa2, pa3); QK_SCHED(); SBAR();
    if (j + 3 < NT) SLOAD(SE, (j + 3) * KVBLK); SBAR();
    pv_d0(o, vb0 + SHM_V, pa0, pa1, pa2, pa3); partialSM<SM>(pA0, pA1, m_reg, mnA, alA);
    __syncthreads(); SWAIT(); SWRITE(1, SO);
    RESC(alA); __syncthreads();
  }
  SBAR(); qkt<(QKT_PREFETCH != 0) && SM == 2>(pB0, pB1, K_lds + SHM_K, qr, r32, hi);
  finishSM<SM>(pA0, pA1, alA, l_reg, pa0, pa1, pa2, pa3); SBAR();
  pv_d0(o, vb0, pa0, pa1, pa2, pa3); partialSM<SM>(pB0, pB1, m_reg, mnB, alB);
  __syncthreads(); RESC(alB);
  finishSM<SM>(pB0, pB1, alB, l_reg, pa0, pa1, pa2, pa3); SBAR();
  pv_d0(o, vb0 + SHM_V, pa0, pa1, pa2, pa3);
  }
  if constexpr (BAND) {
    if (U.has_sink) l_reg += __builtin_amdgcn_exp2f((U.sink * (1.0f / SCALE) - m_reg) * (SCALE * 1.4426950408889634f));
    if (U.lse != nullptr && hi == 0) U.lse[(unsigned)(wid * QBLK + r32) * (unsigned)U.lse_stride] = m_reg * SCALE + __builtin_amdgcn_logf(l_reg) * 0.6931471805599453f;
  }
  int lane_e = lane; asm volatile("" : "+v"(lane_e));
  const int r32e = lane_e & 31, hie = lane_e >> 5;
  if (hie == 0) li_l[r32e] = l_reg; asm volatile("s_waitcnt lgkmcnt(0)" ::: "memory");
  float rli[16];
#pragma unroll
  for (int r = 0; r < 16; ++r) rli[r] = __builtin_amdgcn_rcpf(li_l[crow(r, hie)]);
  __syncthreads();
  char* ost = lds + wid * 8192;
  { char* op = ost + hie * 1024 + r32e * 2;
#pragma unroll
    for (int r = 0; r < 16; ++r) {
#pragma unroll
      for (int d0 = 0; d0 < 4; ++d0) { const unsigned w = cvtpk(o[d0][r] * rli[r], 0.f); *(unsigned short*)(op + ((r & 3) + 8 * (r >> 2)) * 256 + d0 * 64) = (unsigned short)w; } } }
  asm volatile("s_waitcnt lgkmcnt(0)" ::: "memory");
  { const char* ip = ost + (lane_e >> 4) * 256 + (lane_e & 15) * 16;
    unsigned goff = (unsigned)(wid * QBLK + (lane_e >> 4)) * (unsigned)U.ostride + (unsigned)((lane_e & 15) * 8); const unsigned gstep = 4u * (unsigned)U.ostride;
#pragma unroll
    for (int i = 0; i < 8; ++i) { const u32x4 w = *(const u32x4*)(ip + i * 1024); *(u32x4*)(U.O + goff) = w; goff += gstep; } }
  __syncthreads();
#undef ROWOF
#undef SLOAD
#undef SWRITE
#undef SWAIT
#undef QK_SCHED
#undef RESC
#undef MASKB
}

constexpr int SHM_RING = 3 * SHM_V + 2 * SHM_K + NW * 64 * 4;
__device__ __forceinline__ void attn_unit_ring(const Unit& U, char* lds, const int tid) {
  const int wid = tid >> 6, lane = tid & 63, r32 = lane & 31, hi = lane >> 5;
  char* V_lds = lds; char* K_lds = lds + 3 * SHM_V;
  float* ws = (float*)(lds + 3 * SHM_V + 2 * SHM_K) + wid * 64; float* li_l = ws;
  float m_reg = 0.f, l_reg = 0, mn_, al_ = 1.f; f32x16 o[4] = {}; bf16x8 qr[8];
  { const unsigned qoff = (unsigned)(wid * QBLK + r32) * (unsigned)U.qstride + (unsigned)(hi * 8);
#pragma unroll
    for (int d0 = 0; d0 < 8; ++d0) qr[d0] = *reinterpret_cast<const bf16x8*>(U.Q + qoff + d0 * 16); }
  const int sr = tid >> 4, sc = (tid & 15) * 8, vst0 = v_st(sr, sc), vst1 = v_st(32 + sr, sc);
  const int vb0 = (int)(uintptr_t)V_lds + v_rd_base(lane);
  struct { bf16x8 vs0, vs1, ks0, ks1; } sr_[1];
#define SLOAD(i, k0) do { const unsigned _o0 = (unsigned)((k0) + sr) * (unsigned)U.kstride + (unsigned)sc, _o1 = _o0 + 32u * (unsigned)U.kstride; \
    sr_[i].vs0 = *reinterpret_cast<const bf16x8*>(U.V + _o0); sr_[i].vs1 = *reinterpret_cast<const bf16x8*>(U.V + _o1); \
    sr_[i].ks0 = *reinterpret_cast<const bf16x8*>(U.K + _o0); sr_[i].ks1 = *reinterpret_cast<const bf16x8*>(U.K + _o1); } while (0)
#define SWRITE(kb, vsl, i) do { char* _v = V_lds + (vsl) * SHM_V; *(bf16x8*)(_v + vst0) = sr_[i].vs0; *(bf16x8*)(_v + vst1) = sr_[i].vs1; int kc = sc * 2; \
    *(bf16x8*)(K_lds + (kb) * SHM_K + KSWZ(sr, kc)) = sr_[i].ks0; *(bf16x8*)(K_lds + (kb) * SHM_K + KSWZ(32 + sr, kc)) = sr_[i].ks1; } while (0)
#define NEXT3(x) ((x) == 2 ? 0 : (x) + 1)
  f32x16 pA0, pA1, pB0, pB1; bf16x8 pa0, pa1, pa2, pa3; const int NT = U.NT;
  SLOAD(0, 0); SWRITE(0, 0, 0); SLOAD(0, KVBLK);
  __syncthreads();
  SWRITE(1, 1, 0); SLOAD(0, 2 * KVBLK);
  qkt<(QKT_PREFETCH != 0)>(pA0, pA1, K_lds, qr, r32, hi); partialSM<2>(pA0, pA1, m_reg, mn_, al_);
  __syncthreads();
  int vr = 0;
  for (int j = 1; j + 1 < NT; j += 2) {
    { const int vw = NEXT3(NEXT3(vr));
      SWRITE(0, vw, 0); SLOAD(0, (j + 2) * KVBLK);
      SBAR(); qkt<(QKT_PREFETCH != 0)>(pB0, pB1, K_lds + SHM_K, qr, r32, hi);
      finishSM<2>(pA0, pA1, al_, l_reg, pa0, pa1, pa2, pa3); SBAR();
      pv_d0(o, vb0 + vr * SHM_V, pa0, pa1, pa2, pa3); partialSM<2>(pB0, pB1, m_reg, mn_, al_);
      __syncthreads(); vr = NEXT3(vr); }
    { const int vw = NEXT3(NEXT3(vr));
      SWRITE(1, vw, 0); if (j + 3 < NT) SLOAD(0, (j + 3) * KVBLK);
      SBAR(); qkt<(QKT_PREFETCH != 0)>(pA0, pA1, K_lds, qr, r32, hi);
      finishSM<2>(pB0, pB1, al_, l_reg, pa0, pa1, pa2, pa3); SBAR();
      pv_d0(o, vb0 + vr * SHM_V, pa0, pa1, pa2, pa3); partialSM<2>(pA0, pA1, m_reg, mn_, al_);
      __syncthreads(); vr = NEXT3(vr); }
  }
  SBAR(); qkt<(QKT_PREFETCH != 0)>(pB0, pB1, K_lds + SHM_K, qr, r32, hi);
  finishSM<2>(pA0, pA1, al_, l_reg, pa0, pa1, pa2, pa3); SBAR();
  pv_d0(o, vb0 + vr * SHM_V, pa0, pa1, pa2, pa3); partialSM<2>(pB0, pB1, m_reg, mn_, al_);
  finishSM<2>(pB0, pB1, al_, l_reg, pa0, pa1, pa2, pa3); SBAR();
  pv_d0(o, vb0 + NEXT3(vr) * SHM_V, pa0, pa1, pa2, pa3);
  int lane_e = lane; asm volatile("" : "+v"(lane_e));
  const int r32e = lane_e & 31, hie = lane_e >> 5;
  if (hie == 0) li_l[r32e] = l_reg; asm volatile("s_waitcnt lgkmcnt(0)" ::: "memory");
  float rli[16];
#pragma unroll
  for (int r = 0; r < 16; ++r) rli[r] = __builtin_amdgcn_rcpf(li_l[crow(r, hie)]);
  __syncthreads();
  char* ost = lds + wid * 8192;
  { char* op = ost + hie * 1024 + r32e * 2;
#pragma unroll
    for (int r = 0; r < 16; ++r) {
#pragma unroll
      for (int d0 = 0; d0 < 4; ++d0) { const unsigned w = cvtpk(o[d0][r] * rli[r], 0.f); *(unsigned short*)(op + ((r & 3) + 8 * (r >> 2)) * 256 + d0 * 64) = (unsigned short)w; } } }
  asm volatile("s_waitcnt lgkmcnt(0)" ::: "memory");
  { const char* ip = ost + (lane_e >> 4) * 256 + (lane_e & 15) * 16;
    unsigned goff = (unsigned)(wid * QBLK + (lane_e >> 4)) * (unsigned)U.ostride + (unsigned)((lane_e & 15) * 8); const unsigned gstep = 4u * (unsigned)U.ostride;
#pragma unroll
    for (int i = 0; i < 8; ++i) { const u32x4 w = *(const u32x4*)(ip + i * 1024); *(u32x4*)(U.O + goff) = w; goff += gstep; } }
  __syncthreads();
#undef SLOAD
#undef SWRITE
#undef NEXT3
}
}

constexpr int NWAVES = 8;
constexpr int DM = 2048, SEQ = 16384, NSEQ = 3, M_ALL = NSEQ * SEQ, DEPTH = 4, DFF = 5632, INC = 13824;
constexpr int A_Q = 0, A_K = 1536, A_V = 3072, B_Q = 4608, B_K = 5632, B_V = 5888, C_Q = 6144, C_K = 7168, C_V = 7424, GL0 = 7680;
constexpr float NORM_EPS = 1e-6f;
enum { I_XP = 0, I_XS, I_NF1, I_F1IN, I_F1OUT, I_NMIX, I_WIN, I_QNQ, I_QNK, I_SINK, I_WA, I_WB, I_WC, I_WO, I_NF2, I_F2IN, I_F2OUT, I_NFIN, N_IN };

constexpr size_t MiB = 1u << 20;
constexpr size_t WS_CTL = 0, CTL_ZERO_BYTES = 1 * MiB;
constexpr int LDW = DM + LDW_PAD, LDU = DM + LDU_PAD;
constexpr size_t WL_F1IN = 0, WL_F1OUT = WL_F1IN + (size_t)2 * DFF * LDW * 2, WL_WIN = WL_F1OUT + (size_t)DM * DFF * 2, WL_WA = WL_WIN + (size_t)INC * LDW * 2,
                 WL_WB = WL_WA + (size_t)DM * 512 * 2, WL_WC = WL_WB + (size_t)DM * 1024 * 2, WL_WO = WL_WC + (size_t)DM * 1024 * 2, WL_F2IN = WL_WO + (size_t)DM * LDW * 2,
                 WL_F2OUT = WL_F2IN + (size_t)2 * DFF * LDW * 2, WL_BYTES = WL_F2OUT + (size_t)DM * DFF * 2;
constexpr size_t WS_W = 1 * MiB;
constexpr size_t WS_U = WS_W + DEPTH * WL_BYTES;
constexpr size_t WS_R = WS_U + (size_t)M_ALL * LDU * 2;
constexpr size_t WS_H = WS_R;
constexpr size_t WS_QKVG = WS_R;
constexpr int OCAT = 2560;
constexpr size_t WS_OCAT = WS_QKVG + (size_t)SEQ * INC * 2;
constexpr size_t WS_OA = WS_OCAT, WS_OB = WS_OCAT + 512 * 2, WS_OC = WS_OCAT + 1536 * 2;
constexpr size_t WS_PA = WS_OCAT + (size_t)SEQ * OCAT * 2;
constexpr size_t WS_LSE = WS_PA + (size_t)3 * SEQ * 512 * 2;
constexpr size_t WS_QB = WS_LSE + (size_t)3 * SEQ * 4 * 4;
constexpr size_t WS_KB = WS_QB + (size_t)SEQ * 1024 * 2;
constexpr size_t WS_VB = WS_KB + (size_t)SEQ * 256 * 2;
constexpr size_t WS_MG = WS_VB + (size_t)SEQ * 256 * 2;
constexpr size_t WS_MB = WS_MG + (size_t)SEQ * DM * 4;
constexpr size_t WS_MIX_END = WS_MB + (size_t)SEQ * LDU * 2;
constexpr int LDH = DFF + LDH_PAD;
constexpr size_t WS_H_END = WS_H + (size_t)M_ALL * LDH * 2;
constexpr size_t WS_END = WS_MIX_END > WS_H_END ? WS_MIX_END : WS_H_END;
constexpr int CW_BAR = 4096;

constexpr int RING_OFF = 0, RING_BYTES = 131072;
constexpr int LDSCTL_OFF = RING_BYTES, MISC_OFF = LDSCTL_OFF + 320;
constexpr int LDS_BYTES = 147456;
constexpr int DIAG_OFF = MISC_OFF + 256;

#define GAS __attribute__((address_space(1)))
#define LAS __attribute__((address_space(3)))
typedef unsigned short bf16;
typedef unsigned v4u __attribute__((ext_vector_type(4)));
typedef unsigned v2u __attribute__((ext_vector_type(2)));
typedef float f32x4 __attribute__((ext_vector_type(4)));
#define LDS_WAIT() asm volatile("s_waitcnt lgkmcnt(0)" ::: "memory")
#define VM_WAIT() asm volatile("s_waitcnt vmcnt(0)" ::: "memory")
__device__ __forceinline__ unsigned f2bf(float f) { unsigned u = __builtin_bit_cast(unsigned, f); return (u + 0x7fffu + ((u >> 16) & 1u)) >> 16; }
__device__ __forceinline__ unsigned pk2(float lo, float hi) { return f2bf(lo) | (f2bf(hi) << 16); }
__device__ __forceinline__ float bflo(unsigned w) { return __uint_as_float(w << 16); }
__device__ __forceinline__ float bfhi(unsigned w) { return __uint_as_float(w & 0xffff0000u); }

#define XB_TMO      128
#define XB_XCNT(j)  (256  + 64 * (j))
#define XB_XSUB(j)  (1280 + 64 * (j))
#define XB_XGEN(j)  (2304 + 64 * (j))
#define XB_TOP      3328
#define XB_TOPGEN   3392
#define XCD_BAR_WORDS 3456
#define XB_SPIN_CAP (1u << 18)
__device__ __forceinline__ unsigned xb_ld(unsigned* p)              { return __hip_atomic_load(p, __ATOMIC_RELAXED, __HIP_MEMORY_SCOPE_AGENT); }
__device__ __forceinline__ unsigned xb_add(unsigned* p, unsigned v) { return __hip_atomic_fetch_add(p, v, __ATOMIC_RELAXED, __HIP_MEMORY_SCOPE_AGENT); }
__device__ __forceinline__ unsigned xb_xcc_id() { return (unsigned)__builtin_amdgcn_s_getreg((3 << 11) | 20) & 0xFu; }
#define XB_SPIN(cond, bar) do { unsigned _sp = 0; while (cond) { __builtin_amdgcn_s_sleep(1); \
    if ((++_sp & 255u) == 0u) { if (xb_ld(&(bar)[XB_TMO])) break; if (_sp > XB_SPIN_CAP) { atomicAdd(&(bar)[XB_TMO], 1u); break; } } } } while (0)
struct XcdBarrier { unsigned* bar; unsigned x; volatile LAS unsigned* st; };
__device__ __forceinline__ XcdBarrier xcd_barrier_post(unsigned* bar, volatile LAS unsigned* st) {
    XcdBarrier b; b.bar = bar; b.x = xb_xcc_id(); b.st = st;
    if (threadIdx.x == 0) (void)xb_add(&bar[XB_XCNT(b.x)], 1u);
    return b;
}
__device__ __forceinline__ void xcd_barrier_complete(unsigned* bar, unsigned x, unsigned& nloc, unsigned& nx) {
    const unsigned G = gridDim.x * gridDim.y * gridDim.z;
    unsigned sum, cnt, mine, sp = 0u;
    for (;;) {
        sum = 0u; cnt = 0u; mine = 0u;
#pragma unroll
        for (unsigned j = 0; j < 16; ++j) { const unsigned c = xb_ld(&bar[XB_XCNT(j)]); sum += c; cnt += (c > 0u) ? 1u : 0u; mine = (j == x) ? c : mine; }
        if (sum == G) break;
        __builtin_amdgcn_s_sleep(1);
        if ((++sp & 255u) == 0u) { if (xb_ld(&bar[XB_TMO])) break; if (sp > XB_SPIN_CAP) { atomicAdd(&bar[XB_TMO], 1u); break; } }
    }
    nloc = mine > 0u ? mine : 1u; nx = cnt > 0u ? cnt : 1u;
}
__device__ __forceinline__ void xcd_barrier(const XcdBarrier& b) {
    asm volatile("s_waitcnt vmcnt(0)" ::: "memory");
    __syncthreads();
    if (threadIdx.x == 0) {
        unsigned* bar = b.bar;
        __builtin_amdgcn_s_waitcnt(0);
        unsigned nloc = b.st[0], nx = b.st[1];
        if (nloc == 0u) { xcd_barrier_complete(bar, b.x, nloc, nx); b.st[0] = nloc; b.st[1] = nx; }
        const unsigned old = xb_add(&bar[XB_XSUB(b.x)], 1u);
        const unsigned gen = old / nloc;
        if (old + 1u == (gen + 1u) * nloc) {
            __builtin_amdgcn_fence(__ATOMIC_RELEASE, "agent");
            asm volatile("s_waitcnt vmcnt(0)" ::: "memory");
            const unsigned og = xb_add(&bar[XB_TOP], 1u);
            const unsigned tg = og / nx;
            if (og + 1u == (tg + 1u) * nx) xb_add(&bar[XB_TOPGEN], 1u);
            else XB_SPIN(xb_ld(&bar[XB_TOPGEN]) == tg, bar);
            __builtin_amdgcn_fence(__ATOMIC_ACQUIRE, "agent");
            xb_add(&bar[XB_XGEN(b.x)], 1u);
            asm volatile("s_waitcnt vmcnt(0)" ::: "memory");
        } else {
            XB_SPIN(xb_ld(&bar[XB_XGEN(b.x)]) == gen, bar);
            __builtin_amdgcn_fence(__ATOMIC_ACQUIRE, "agent");
            asm volatile("s_waitcnt vmcnt(0)" ::: "memory");
        }
    }
    __syncthreads();
}

template <int XOR> __device__ __forceinline__ float swz_xor(float v) { return __int_as_float(__builtin_amdgcn_ds_swizzle(__float_as_int(v), (XOR << 10) | 0x1F)); }
__device__ __forceinline__ float wave_sum(float v) {
    v += swz_xor<1>(v); v += swz_xor<2>(v); v += swz_xor<4>(v); v += swz_xor<8>(v); v += swz_xor<16>(v);
    auto rr = __builtin_amdgcn_permlane32_swap(__float_as_uint(v), __float_as_uint(v), false, false);
    return __uint_as_float(rr[0]) + __uint_as_float(rr[1]);
}
__device__ __forceinline__ float wave_max(float v) {
    v = fmaxf(v, swz_xor<1>(v)); v = fmaxf(v, swz_xor<2>(v)); v = fmaxf(v, swz_xor<4>(v)); v = fmaxf(v, swz_xor<8>(v)); v = fmaxf(v, swz_xor<16>(v));
    auto rr = __builtin_amdgcn_permlane32_swap(__float_as_uint(v), __float_as_uint(v), false, false);
    return fmaxf(__uint_as_float(rr[0]), __uint_as_float(rr[1]));
}
__device__ __forceinline__ void transpose_item(const float* W, int K, int N, bf16* WT, int k0, int n0, int orow0, LAS float* scr, int lane, int ldw) {
#pragma unroll 8
    for (int i = 0; i < 32; ++i) { const int kk = 2 * i + (lane >> 5); scr[kk * 33 + (lane & 31)] = W[(size_t)(k0 + kk) * N + n0 + (lane & 31)]; }
    LDS_WAIT(); asm volatile("" ::: "memory");
    const int c = lane & 7;
#pragma unroll
    for (int j = 0; j < 4; ++j) { const int n = (lane >> 3) + 8 * j; const LAS float* s = scr + (8 * c) * 33 + n;
        v4u o; o.x = pk2(s[0 * 33], s[1 * 33]); o.y = pk2(s[2 * 33], s[3 * 33]); o.z = pk2(s[4 * 33], s[5 * 33]); o.w = pk2(s[6 * 33], s[7 * 33]);
        *(GAS v4u*)(WT + (size_t)(orow0 + n) * ldw + k0 + 8 * c) = o; }
    LDS_WAIT(); asm volatile("" ::: "memory");
}
__device__ __forceinline__ void transpose_matrix(const float* W, int K, int N, bf16* WT, int swiglu, LAS float* scr, int lane, int gw, int NGW, int ldw = 0) {
    const int nblk = N / 32, nitems = (K / 64) * nblk;
    for (int it = gw; it < nitems; it += NGW) {
        const int kb = it / nblk, nb = it % nblk, k0 = 64 * kb, n0 = 32 * nb;
        int orow0 = n0;
        if (swiglu) { const int half = n0 >= DFF ? 1 : 0, np = n0 - half * DFF; orow0 = 256 * (np / 128) + 128 * half + (np % 128); }
        transpose_item(W, K, N, WT, k0, n0, orow0, scr, lane, ldw ? ldw : K);
    }
}
__device__ __forceinline__ void rms_row_to_bf16(const float* xrow, const float* g, bf16* orow, float* xcopy, int lane) {
    const GAS f32x4* xr = (const GAS f32x4*)xrow + lane; const GAS f32x4* gr = (const GAS f32x4*)g + lane;
    f32x4 v[8]; float s = 0.f;
#pragma unroll
    for (int j = 0; j < 8; ++j) { v[j] = xr[64 * j]; s += (v[j].x * v[j].x + v[j].y * v[j].y) + (v[j].z * v[j].z + v[j].w * v[j].w); }
    if (xcopy) { GAS f32x4* xc = (GAS f32x4*)xcopy + lane;
#pragma unroll
        for (int j = 0; j < 8; ++j) xc[64 * j] = v[j]; }
    const float rstd = __builtin_amdgcn_rsqf(wave_sum(s) * (1.f / DM) + NORM_EPS);
    GAS v2u* o8 = (GAS v2u*)orow + lane;
#pragma unroll
    for (int j = 0; j < 8; ++j) { const f32x4 gg = gr[64 * j]; v2u w; w.x = pk2(v[j].x * rstd * gg.x, v[j].y * rstd * gg.y); w.y = pk2(v[j].z * rstd * gg.z, v[j].w * rstd * gg.w); o8[64 * j] = w; }
}
__device__ __forceinline__ void rms_row_f32(float* xrow, const float* g, int lane) {
    GAS f32x4* xr = (GAS f32x4*)xrow + lane; const GAS f32x4* gr = (const GAS f32x4*)g + lane;
    f32x4 v[8]; float s = 0.f;
#pragma unroll
    for (int j = 0; j < 8; ++j) { v[j] = xr[64 * j]; s += (v[j].x * v[j].x + v[j].y * v[j].y) + (v[j].z * v[j].z + v[j].w * v[j].w); }
    const float rstd = __builtin_amdgcn_rsqf(wave_sum(s) * (1.f / DM) + NORM_EPS);
#pragma unroll
    for (int j = 0; j < 8; ++j) { const f32x4 gg = gr[64 * j]; xr[64 * j] = v[j] * rstd * gg; }
}
constexpr float QPRESCALE = 0.088388347648318440f * 1.4426950408889634f;
template <int NT_>
__device__ __forceinline__ void ropeB_tokens(const bf16* qkvg, int t0, int tstep, const float* gq, const float* gk, bf16* qb, bf16* kb, bf16* vb, int lane) {
    const int f = lane & 31;
    const float invrev = __builtin_amdgcn_exp2f((float)f * (-13.287712379549449f / 32.0f)) * 0.15915494309189535f;
    const float gq0 = gq[2 * lane], gq1 = gq[2 * lane + 1], gk0 = gk[2 * lane], gk1 = gk[2 * lane + 1];
    unsigned w[NT_][10]; v2u vv[NT_];
#pragma unroll
    for (int i = 0; i < NT_; ++i) { const int t = t0 + i * tstep; const GAS unsigned* src = (const GAS unsigned*)(qkvg + (size_t)t * INC + B_Q) + lane;
#pragma unroll
        for (int h = 0; h < 10; ++h) w[i][h] = src[h * 64];
        vv[i] = ((const GAS v2u*)(qkvg + (size_t)t * INC + B_V))[lane]; }
#pragma unroll
    for (int i = 0; i < NT_; ++i) { const int t = t0 + i * tstep;
        const float pos = (float)((lane < 32) ? (t >> 6) : (t & 63));
        float rev = pos * invrev; rev = rev - __builtin_floorf(rev);
        const float cs = __builtin_amdgcn_cosf(rev), sn = __builtin_amdgcn_sinf(rev);
#pragma unroll
        for (int h = 0; h < 10; ++h) {
            const float x0 = bflo(w[i][h]), x1 = bfhi(w[i][h]);
            const float rstd = __builtin_amdgcn_rsqf(wave_sum(x0 * x0 + x1 * x1) * (1.f / 128.f) + NORM_EPS);
            const float y0 = x0 * rstd * (h < 8 ? gq0 : gk0), y1 = x1 * rstd * (h < 8 ? gq1 : gk1);
            const float qs = h < 8 ? QPRESCALE : 1.0f;
            const unsigned o = pk2((y0 * cs - y1 * sn) * qs, (y0 * sn + y1 * cs) * qs);
            if (h < 8) ((GAS unsigned*)(qb + (size_t)t * 1024))[h * 64 + lane] = o; else ((GAS unsigned*)(kb + (size_t)t * 256))[(h - 8) * 64 + lane] = o;
        }
        ((GAS v2u*)(vb + (size_t)t * 256))[lane] = vv[i]; }
}
__device__ __forceinline__ void mergeA_token(const bf16* pa, const float* lse, bf16* oa, int t, int lane) {
#pragma unroll
    for (int hh = 0; hh < 4; ++hh) {
        const float l0 = lse[((size_t)0 * SEQ + t) * 4 + hh], l1 = lse[((size_t)1 * SEQ + t) * 4 + hh], l2 = lse[((size_t)2 * SEQ + t) * 4 + hh];
        const float mx = fmaxf(l0, fmaxf(l1, l2));
        const float e0 = __builtin_amdgcn_exp2f((l0 - mx) * 1.4426950408889634f), e1 = __builtin_amdgcn_exp2f((l1 - mx) * 1.4426950408889634f), e2 = __builtin_amdgcn_exp2f((l2 - mx) * 1.4426950408889634f);
        const float inv = __builtin_amdgcn_rcpf(e0 + e1 + e2);
        const unsigned w0 = ((const GAS unsigned*)(pa + ((size_t)0 * SEQ + t) * 512))[hh * 64 + lane], w1 = ((const GAS unsigned*)(pa + ((size_t)1 * SEQ + t) * 512))[hh * 64 + lane],
                       w2 = ((const GAS unsigned*)(pa + ((size_t)2 * SEQ + t) * 512))[hh * 64 + lane];
        const float a = (e0 * bflo(w0) + e1 * bflo(w1) + e2 * bflo(w2)) * inv, b = (e0 * bfhi(w0) + e1 * bfhi(w1) + e2 * bfhi(w2)) * inv;
        ((GAS unsigned*)(oa + (size_t)t * OCAT))[hh * 64 + lane] = pk2(a, b);
    }
}

struct Args { const float* in[N_IN]; float* out; unsigned char* ws; int ph_lo, ph_hi; };
constexpr int N_PHASES = 1 + DEPTH * (3 + 1 + NSEQ * 5 + 3) + 1;

__device__ __forceinline__ int opq_v(int x) { asm volatile("" : "+v"(x)); return x; }
template <class T> __device__ __forceinline__ T* opq_p(T* p) { GAS T* g = (GAS T*)p; asm volatile("" : "+s"(g)); return (T*)g; }
__device__ __forceinline__ int lane_id_asm() { int l; asm volatile("v_mbcnt_lo_u32_b32 %0, -1, 0\n\tv_mbcnt_hi_u32_b32 %0, -1, %0" : "=v"(l)); return l; }
__device__ __forceinline__ int opq_s(int x) { asm volatile("" : "+s"(x)); return x; }

__global__ void __launch_bounds__(NWAVES * 64, 2) trunk_fwd(Args args) {
    extern __shared__ __attribute__((aligned(16))) unsigned char lds[];
    LAS unsigned char* ldsl = (LAS unsigned char*)lds;
    volatile LAS unsigned* MISC = (volatile LAS unsigned*)(ldsl + MISC_OFF);
    const int G_k = gridDim.x; const int bx_k = blockIdx.x;
    const int wave0 = __builtin_amdgcn_readfirstlane((int)threadIdx.x >> 6);
    { const int tid0 = threadIdx.x;
      for (int u = tid0; u < (LDS_BYTES - LDSCTL_OFF) / 4; u += NWAVES * 64) ((LAS unsigned*)(ldsl + LDSCTL_OFF))[u] = 0u; }
    __syncthreads();
    XcdBarrier bar; bar.bar = (unsigned*)(args.ws + WS_CTL) + CW_BAR; bar.x = 0; bar.st = nullptr;
    if (!MK_PER_PHASE) bar = xcd_barrier_post((unsigned*)(args.ws + WS_CTL) + CW_BAR, MISC + 8);
    const int lo = args.ph_lo, hi = args.ph_hi;
    int ph = 0;
#define PH_ON (ph >= lo && ph < hi)
#define PH_VARS const int G = opq_s(G_k), bx = opq_s(bx_k), vcu = (G % 8 == 0) ? (bx % 8) * (G / 8) + bx / 8 : bx, NGW = G * NWAVES; (void)NGW; const int lane = lane_id_asm(), wave = wave0, tid = wave * 64 + lane, gw = vcu * NWAVES + wave; unsigned char* ws = opq_p(args.ws); float* X = opq_p(args.out); (void)lane; (void)gw; (void)ws; (void)X
#if DIAG
#define PH_STAMP(ty) do { if (bx_k == 0 && wave0 == 0 && lane_id_asm() == 0) { const unsigned long long t_ = __builtin_amdgcn_s_memrealtime(); volatile LAS unsigned long long* ts_ = (volatile LAS unsigned long long*)(ldsl + DIAG_OFF); \
    ts_[1 + (ty)] += t_ - ts_[0]; ts_[0] = t_; } } while (0)
#else
#define PH_STAMP(ty) do { } while (0)
#endif
#define PH_DUP(ty) ((ty) == DUP_TYPE)
#define GRID_BARRIER() do { XcdBarrier b2_ = bar; b2_.bar = opq_p(bar.bar); b2_.x = (unsigned)opq_s((int)bar.x); xcd_barrier(b2_); } while (0)
#define PH_BEGIN(ty) if (PH_ON) { for (int rep_ = 0; rep_ < (PH_DUP(ty) ? 2 : 1); ++rep_) { PH_VARS; (void)rep_;
#define PH_CLOSE(ty) if (PH_DUP(ty) && rep_ == 0) GRID_BARRIER(); } } PH_END(ty)
#define PH_END(ty) do { if (PH_ON && ph + 1 < hi) { XcdBarrier b2_ = bar; b2_.bar = opq_p(bar.bar); b2_.x = (unsigned)opq_s((int)bar.x); xcd_barrier(b2_); } if (PH_ON) PH_STAMP(ty); ++ph; } while (0)

    PH_BEGIN(0)

        LAS float* scr = (LAS float*)(ldsl + RING_OFF + wave * 16384);
        for (int l = 0; l < DEPTH; ++l) {
            unsigned char* wl = ws + WS_W + (size_t)l * WL_BYTES;
            transpose_matrix(args.in[I_F1IN] + (size_t)l * DM * 2 * DFF, DM, 2 * DFF, (bf16*)(wl + WL_F1IN), 1, scr, lane, gw, NGW, LDW);
            transpose_matrix(args.in[I_F1OUT] + (size_t)l * DFF * DM, DFF, DM, (bf16*)(wl + WL_F1OUT), 0, scr, lane, gw, NGW);
            transpose_matrix(args.in[I_WIN] + (size_t)l * DM * INC, DM, INC, (bf16*)(wl + WL_WIN), 0, scr, lane, gw, NGW, LDW);
            transpose_matrix(args.in[I_WA] + (size_t)l * 512 * DM, 512, DM, (bf16*)(wl + WL_WA), 0, scr, lane, gw, NGW, OCAT);
            transpose_matrix(args.in[I_WB] + (size_t)l * 1024 * DM, 1024, DM, (bf16*)(wl + WL_WA) + 512, 0, scr, lane, gw, NGW, OCAT);
            transpose_matrix(args.in[I_WC] + (size_t)l * 1024 * DM, 1024, DM, (bf16*)(wl + WL_WA) + 1536, 0, scr, lane, gw, NGW, OCAT);
            transpose_matrix(args.in[I_WO] + (size_t)l * DM * DM, DM, DM, (bf16*)(wl + WL_WO), 0, scr, lane, gw, NGW, LDW);
            transpose_matrix(args.in[I_F2IN] + (size_t)l * DM * 2 * DFF, DM, 2 * DFF, (bf16*)(wl + WL_F2IN), 1, scr, lane, gw, NGW, LDW);
            transpose_matrix(args.in[I_F2OUT] + (size_t)l * DFF * DM, DFF, DM, (bf16*)(wl + WL_F2OUT), 0, scr, lane, gw, NGW);
        }
        bf16* U = (bf16*)(ws + WS_U);
        for (int m = gw; m < M_ALL; m += NGW) {
            const float* xr = (m < 2 * SEQ) ? args.in[I_XP] + (size_t)m * DM : args.in[I_XS] + (size_t)(m - 2 * SEQ) * DM;
            rms_row_to_bf16(xr, args.in[I_NF1], U + (size_t)m * LDU, X + (size_t)m * DM, lane);
        }
    PH_CLOSE(0);

    for (int l = 0; l < DEPTH; ++l) {
        for (int half = 0; half < 2; ++half) {
            PH_BEGIN(1)

                if (!(l == 0 && half == 0)) {
                    bf16* U = (bf16*)(ws + WS_U);
                    const float* g = (half == 0 ? args.in[I_NF1] : args.in[I_NF2]) + (size_t)l * DM;
                    for (int m = gw; m < M_ALL; m += NGW) rms_row_to_bf16(X + (size_t)m * DM, g, U + (size_t)m * LDU, nullptr, lane);
                }
            PH_CLOSE(1);
            PH_BEGIN(2)

                unsigned char* wl = ws + WS_W + (size_t)l * WL_BYTES;
                pg8::Gemm g{(const bf16*)(ws + WS_U), (const bf16*)(wl + (half == 0 ? WL_F1IN : WL_F2IN)), M_ALL, 2 * DFF, DM, LDU, LDW}; pg8::StaticOrder S; S.init(M_ALL, 2 * DFF, G, bx);
                if (EXTRA == 1) { pg8::EpiNull E0; pg8::gemm_phase<pg8::EpiNull, pg8::StaticOrder, true, true>(ldsl + RING_OFF, g, S, E0, tid); GRID_BARRIER(); }
                pg8::EpiSwiglu E{(bf16*)(ws + WS_H), LDH};
                pg8::gemm_phase<pg8::EpiSwiglu, pg8::StaticOrder, true, true>(ldsl + RING_OFF, g, S, E, tid, (unsigned)(STAG_STEP * ((bx >> 3) & 3)));
            PH_CLOSE(2);
            PH_BEGIN(3)

                unsigned char* wl = ws + WS_W + (size_t)l * WL_BYTES;
                pg8::Gemm g{(const bf16*)(ws + WS_H), (const bf16*)(wl + (half == 0 ? WL_F1OUT : WL_F2OUT)), M_ALL, DM, DFF, LDH}; pg8::StaticOrder S; S.init(M_ALL, DM, G, bx, REV_FFNOUT);
                if (EXTRA == 2) { pg8::EpiNull E0; pg8::gemm_phase<pg8::EpiNull, pg8::StaticOrder, true, true>(ldsl + RING_OFF, g, S, E0, tid); GRID_BARRIER(); }
                pg8::EpiResid E{X, DM, rep_ ? 0.0f : 0.5f};
                pg8::gemm_phase<pg8::EpiResid, pg8::StaticOrder, true, true>(ldsl + RING_OFF, g, S, E, tid, (unsigned)(STAG_STEP * ((bx >> 3) & 3)));
            PH_CLOSE(3);
            if (half == 0) {
                PH_BEGIN(1)

                    bf16* U = (bf16*)(ws + WS_U);
                    const float* g = args.in[I_NMIX] + (size_t)l * DM;
                    for (int m = gw; m < M_ALL; m += NGW) rms_row_to_bf16(X + (size_t)m * DM, g, U + (size_t)m * LDU, nullptr, lane);
                PH_CLOSE(1);
                for (int s = 0; s < NSEQ; ++s) {
                    PH_BEGIN(4)

                        unsigned char* wl = ws + WS_W + (size_t)l * WL_BYTES;
                        pg8::Gemm g{(const bf16*)(ws + WS_U) + (size_t)s * SEQ * LDU, (const bf16*)(wl + WL_WIN), SEQ, INC, DM, LDU, LDW}; pg8::StaticOrder S; S.init(SEQ, INC, G, bx);
                        pg8::EpiBf16 E{(bf16*)(ws + WS_QKVG), INC};
                        pg8::gemm_phase<pg8::EpiBf16, pg8::StaticOrder, true, true>(ldsl + RING_OFF, g, S, E, tid, (unsigned)(STAG_STEP * ((bx >> 3) & 3)));
                    PH_CLOSE(4);
                    PH_BEGIN(5)

                        bf16* QKVG = (bf16*)(ws + WS_QKVG);
                        for (int rq_ = (EXTRA == 6) ? 0 : 1; rq_ < 2; ++rq_)
                        { bf16* QB = (bf16*)(ws + WS_QB); bf16* KB = (bf16*)(ws + WS_KB); bf16* VB = (bf16*)(ws + WS_VB);
                          const float* gq = args.in[I_QNQ] + (size_t)l * 128; const float* gk = args.in[I_QNK] + (size_t)l * 128;
                          int t = gw;
                          for (; t + 3 * NGW < SEQ; t += 4 * NGW) ropeB_tokens<4>(QKVG, t, NGW, gq, gk, QB, KB, VB, lane);
                          for (; t < SEQ; t += NGW) ropeB_tokens<1>(QKVG, t, NGW, gq, gk, QB, KB, VB, lane); }
                        for (int rp_ = (EXTRA == 7 || EXTRA == 8) ? 0 : 1; rp_ < 2; ++rp_) {
                        const int ulo_ = (rp_ == 0 && EXTRA == 8) ? 8 * 64 : 0, uhi_ = (rp_ == 0 && EXTRA == 7) ? 8 * 64 : 8 * 64 + 12 * 64;
                        for (int u = vcu + ulo_; u < uhi_; u += G) {
                            att::Unit A;
                            if (u < 8 * 64) {
                                const int h = u >> 6, b = u & 63;
                                A.Q = QKVG + (size_t)(256 * b) * INC + C_Q + h * 128; A.qstride = INC;
                                A.K = QKVG + C_K + (h >> 2) * 128; A.V = QKVG + C_V + (h >> 2) * 128; A.kstride = INC;
                                A.O = (bf16*)(ws + WS_OC) + (size_t)(256 * b) * OCAT + h * 128; A.ostride = OCAT;
                                A.NT = 8; A.kb0 = 256 * b - 128; A.n = SEQ; A.qi0 = 256 * b; A.hw = 128;
                                A.slope_raw = __uint_as_float((unsigned)(127 - (h + 1)) << 23) * (1.0f / att::SCALE);
                                A.sink = args.in[I_SINK][l * 8 + h]; A.has_sink = 1; A.lse = nullptr; A.lse_stride = 0;
                            } else {
                                const int v = u - 8 * 64, h = v >> 6, w = v & 63, gi = h >> 2, rs = 2 * gi, r = 1 << rs;
                                const int bpc = 64 >> rs, c = w / bpc, b = w % bpc, nsub = SEQ >> rs;
                                A.Q = QKVG + (size_t)(c + r * 256 * b) * INC + A_Q + h * 128; A.qstride = r * INC;
                                A.K = QKVG + (size_t)c * INC + A_K + h * 128; A.V = QKVG + (size_t)c * INC + A_V + h * 128; A.kstride = r * INC;
                                A.O = (bf16*)(ws + WS_PA) + ((size_t)gi * SEQ + c + r * 256 * b) * 512 + (h & 3) * 128; A.ostride = r * 512;
                                A.NT = 6; A.kb0 = 256 * b - 64; A.n = nsub; A.qi0 = 256 * b; A.hw = 64;
                                const float sl = __builtin_amdgcn_exp2f(-8.0f * (float)(h + 1) / 12.0f) * (float)r * (1.0f / att::SCALE);
                                A.slope_raw = __uint_as_float(__builtin_amdgcn_readfirstlane(__float_as_uint(sl)));
                                A.sink = 0.f; A.has_sink = 0; A.lse = (float*)(ws + WS_LSE) + ((size_t)gi * SEQ + c + r * 256 * b) * 4 + (h & 3); A.lse_stride = r * 4;
                            }
                            att::attn_unit<true, 0>(A, (char*)lds + RING_OFF, tid);
                        }
                        if (rp_ == 0) GRID_BARRIER(); }
                    PH_CLOSE(5);
                    PH_BEGIN(6)

                        for (int t = gw; t < SEQ; t += NGW) mergeA_token((const bf16*)(ws + WS_PA), (const float*)(ws + WS_LSE), (bf16*)(ws + WS_OA), t, lane);
                        bool fastB;
                        { const float* gq = args.in[I_QNQ] + (size_t)l * 128; const float* gk = args.in[I_QNK] + (size_t)l * 128;
                          float mq = fmaxf(__builtin_fabsf(gq[lane]), __builtin_fabsf(gq[lane + 64])), mk = fmaxf(__builtin_fabsf(gk[lane]), __builtin_fabsf(gk[lane + 64]));
                          mq = wave_max(mq); mk = wave_max(mk);
                          const float bound = 128.0f * mq * mk * QPRESCALE * 1.05f;
                          fastB = __builtin_amdgcn_readfirstlane((int)(bound < 60.0f)) != 0; }
                        if (fastB) {
                        for (int u = vcu; u < 8 * 64; u += G) {
                            const int h = u >> 6, b = u & 63;
                            att::Unit A;
                            A.Q = (const bf16*)(ws + WS_QB) + (size_t)(256 * b) * 1024 + h * 128; A.qstride = 1024;
                            A.K = (const bf16*)(ws + WS_KB) + (h >> 2) * 128; A.V = (const bf16*)(ws + WS_VB) + (h >> 2) * 128; A.kstride = 256;
                            A.O = (bf16*)(ws + WS_OB) + (size_t)(256 * b) * OCAT + h * 128; A.ostride = OCAT;
                            A.NT = SEQ / 64; A.kb0 = 0; A.n = SEQ; A.qi0 = 0; A.hw = 0; A.slope_raw = 0.f; A.sink = 0.f; A.has_sink = 0; A.lse = nullptr; A.lse_stride = 0;
                            if (ATT_RING) att::attn_unit_ring(A, (char*)lds + RING_OFF, tid); else att::attn_unit<false, 2>(A, (char*)lds + RING_OFF, tid);
                        }
                        } else {
                        for (int u = vcu; u < 8 * 64; u += G) {
                            const int h = u >> 6, b = u & 63;
                            att::Unit A;
                            A.Q = (const bf16*)(ws + WS_QB) + (size_t)(256 * b) * 1024 + h * 128; A.qstride = 1024;
                            A.K = (const bf16*)(ws + WS_KB) + (h >> 2) * 128; A.V = (const bf16*)(ws + WS_VB) + (h >> 2) * 128; A.kstride = 256;
                            A.O = (bf16*)(ws + WS_OB) + (size_t)(256 * b) * OCAT + h * 128; A.ostride = OCAT;
                            A.NT = SEQ / 64; A.kb0 = 0; A.n = SEQ; A.qi0 = 0; A.hw = 0; A.slope_raw = 0.f; A.sink = 0.f; A.has_sink = 0; A.lse = nullptr; A.lse_stride = 0;
                            att::attn_unit<false, 1>(A, (char*)lds + RING_OFF, tid);
                        }
                        }
                    PH_CLOSE(6);
                    PH_BEGIN(7)

                        unsigned char* wl = ws + WS_W + (size_t)l * WL_BYTES;
                        pg8::Gemm g{(const bf16*)(ws + WS_OCAT), (const bf16*)(wl + WL_WA), SEQ, DM, OCAT}; pg8::StaticOrder S; S.init(SEQ, DM, G, bx);
                        if (EXTRA == 5) { pg8::EpiNull E0; pg8::gemm_phase<pg8::EpiNull, pg8::StaticOrder, true, true>(ldsl + RING_OFF, g, S, E0, tid); GRID_BARRIER(); }
                        pg8::EpiGateCat E{(const bf16*)(ws + WS_QKVG) + GL0, INC, (bf16*)(ws + WS_MB), DM, LDU};
                        pg8::gemm_phase<pg8::EpiGateCat, pg8::StaticOrder, true, true>(ldsl + RING_OFF, g, S, E, tid);
                    PH_CLOSE(7);
                    PH_BEGIN(8)

                        unsigned char* wl = ws + WS_W + (size_t)l * WL_BYTES;
                        pg8::Gemm g{(const bf16*)(ws + WS_MB), (const bf16*)(wl + WL_WO), SEQ, DM, DM, LDU, LDW}; pg8::StaticOrder S; S.init(SEQ, DM, G, bx);
                        pg8::EpiResid E{X + (size_t)s * SEQ * DM, DM, rep_ ? 0.0f : 1.0f};
                        pg8::gemm_phase<pg8::EpiResid, pg8::StaticOrder, true, true>(ldsl + RING_OFF, g, S, E, tid);
                    PH_CLOSE(8);
                }
            }
        }
    }
    PH_BEGIN(9)

        if (EXTRA == 3) { for (int i_ = 0; i_ < 200; ++i_) GRID_BARRIER(); }
        for (int m = gw; m < M_ALL; m += NGW) rms_row_f32(X + (size_t)m * DM, args.in[I_NFIN], lane);
    PH_CLOSE(9);
#if DIAG
    {
        PH_VARS;
        unsigned long long* dg = (unsigned long long*)(ws + WS_CTL + 65536);
        if (bx_k == 0 && tid == 0) { volatile LAS unsigned long long* ts_ = (volatile LAS unsigned long long*)(ldsl + DIAG_OFF); for (int i = 0; i < 16; ++i) dg[i] = ts_[i]; }
        { XcdBarrier b2_ = bar; b2_.bar = opq_p(bar.bar); b2_.x = (unsigned)opq_s((int)bar.x); xcd_barrier(b2_); }
        const float ta = (float)__hip_atomic_load(dg + 1 + DIAG_A, __ATOMIC_RELAXED, __HIP_MEMORY_SCOPE_AGENT) * 0.01f, tb = (float)__hip_atomic_load(dg + 1 + DIAG_B, __ATOMIC_RELAXED, __HIP_MEMORY_SCOPE_AGENT) * 0.01f;
        const float qa = 10.f + __builtin_roundf(__builtin_log2f(fmaxf(ta, 10.f) * 0.1f) * (1.0f / 0.16349873f) + 0.5f * DIAG_SHIFT), qb = 10.f + __builtin_roundf(__builtin_log2f(fmaxf(tb, 10.f) * 0.1f) * (1.0f / 0.16349873f) + 0.5f * DIAG_SHIFT);
        const float ka = sqrtf(100.f * qa), vb = 100.f * qb;
        for (size_t i = (size_t)bx * 512 + tid; i < (size_t)M_ALL * DM; i += (size_t)G * 512) X[i] = (i < (size_t)2 * SEQ * DM) ? ka : ((i == (size_t)2 * SEQ * DM + 12345 || i == (size_t)2 * SEQ * DM + 54321) ? vb : 0.f);
    }
#endif
#undef PH_ON
#undef PH_VARS
#undef PH_END
#undef PH_BEGIN
#undef PH_CLOSE
}


#if CHECKB
constexpr int CHK_WORD = 2048;
__device__ __forceinline__ void chk_rope_head(const bf16* row128, const float* g, int t, float* out  , int tid) {
    if (tid < 64) {
        float x0 = __uint_as_float((unsigned)row128[2 * tid] << 16), x1 = __uint_as_float((unsigned)row128[2 * tid + 1] << 16);
        out[2 * tid] = x0; out[2 * tid + 1] = x1;
    }
}
__global__ void __launch_bounds__(256) chk_mixerB(const unsigned char* ws, const float* gq_, const float* gk_, unsigned* ctl) {
    __shared__ float qv[128]; __shared__ float red[256]; __shared__ float oacc[128]; __shared__ float sh_m, sh_l;
    const int smp = blockIdx.x, tid = threadIdx.x;
    const int t = (smp * 2654435761u >> 7) % SEQ, h = smp % 8, kvh = h / 4;
    const bf16* QKVG = (const bf16*)(ws + WS_QKVG); const bf16* OB = (const bf16*)(ws + WS_OB);
    if (tid < 128) { qv[tid] = __uint_as_float((unsigned)QKVG[(size_t)t * INC + B_Q + h * 128 + tid] << 16); }
    __syncthreads();
    if (tid == 0) { float ss = 0.f; for (int i = 0; i < 128; ++i) ss += qv[i] * qv[i]; sh_m = 1.0f / sqrtf(ss / 128.f + NORM_EPS); }
    __syncthreads();
    if (tid < 128) qv[tid] = qv[tid] * sh_m * gq_[tid];
    __syncthreads();
    if (tid < 64) { const int i = tid; const double pos = (i < 32) ? (double)(t / 64) : (double)(t % 64); const double inv = exp2(-(double)(i & 31) * 13.287712379549449 / 32.0);
        const double ang = pos * inv; const float cs = (float)cos(ang), sn = (float)sin(ang); const float x0 = qv[2 * i], x1 = qv[2 * i + 1];
        qv[2 * i] = x0 * cs - x1 * sn; qv[2 * i + 1] = x0 * sn + x1 * cs; }
    __syncthreads();
    float m = -1e30f, l = 0.f; float o[128];
    (void)o;
    auto score = [&](int j) -> float {
        const bf16* kr = QKVG + (size_t)j * INC + B_K + kvh * 128; float ss = 0.f;
        for (int i = 0; i < 128; ++i) { const float x = __uint_as_float((unsigned)kr[i] << 16); ss += x * x; }
        const float rstd = 1.0f / sqrtf(ss / 128.f + NORM_EPS); float dot = 0.f;
        for (int i = 0; i < 64; ++i) { const double pos = (i < 32) ? (double)(j / 64) : (double)(j % 64); const double inv = exp2(-(double)(i & 31) * 13.287712379549449 / 32.0);
            const double ang = pos * inv; const float cs = (float)cos(ang), sn = (float)sin(ang);
            const float x0 = __uint_as_float((unsigned)kr[2 * i] << 16) * rstd * gk_[2 * i], x1 = __uint_as_float((unsigned)kr[2 * i + 1] << 16) * rstd * gk_[2 * i + 1];
            dot += qv[2 * i] * (x0 * cs - x1 * sn) + qv[2 * i + 1] * (x0 * sn + x1 * cs); }
        return dot * 0.088388347648318440f; };
    for (int j = tid; j < SEQ; j += 256) m = fmaxf(m, score(j));
    red[tid] = m; __syncthreads();
    for (int s_ = 128; s_ > 0; s_ >>= 1) { if (tid < s_) red[tid] = fmaxf(red[tid], red[tid + s_]); __syncthreads(); }
    m = red[0]; __syncthreads();
    if (tid < 128) oacc[tid] = 0.f;
    __syncthreads();
    for (int j = tid; j < SEQ; j += 256) { const float p = expf(score(j) - m); l += p;
        const bf16* vr = QKVG + (size_t)j * INC + B_V + kvh * 128;
        for (int d = 0; d < 128; ++d) atomicAdd(&oacc[d], p * __uint_as_float((unsigned)vr[d] << 16)); }
    red[tid] = l; __syncthreads();
    for (int s_ = 128; s_ > 0; s_ >>= 1) { if (tid < s_) red[tid] += red[tid + s_]; __syncthreads(); }
    l = red[0]; __syncthreads();
    if (tid == 0) { float num = 0.f, den = 0.f; for (int d = 0; d < 128; ++d) { const float ref = oacc[d] / l, got = __uint_as_float((unsigned)OB[(size_t)t * OCAT + h * 128 + d] << 16); num += (got - ref) * (got - ref); den += ref * ref; }
        const float e = sqrtf(num / fmaxf(den, 1e-30f)); atomicMax(ctl + CHK_WORD, __float_as_uint(e)); }
}

__global__ void __launch_bounds__(128) chk_mixerAC(const unsigned char* ws, const float* sink_, unsigned* ctl) {
    __shared__ float qv[128]; __shared__ float red[128];
    const int smp = blockIdx.x, d = threadIdx.x; const bool isC = (smp & 1) != 0; const int k = smp >> 1;
    const int edge[16] = {0, 1, 63, 64, 65, 127, 128, 129, 1023, 1024, 16383, 16382, 16320, 16319, 16255, 16256};
    const int t = k < 16 ? edge[k] : (int)(((unsigned)k * 2654435761u >> 7) % SEQ);
    const bf16* QKVG = (const bf16*)(ws + WS_QKVG);
    auto bf = [](bf16 x) { return __uint_as_float((unsigned)x << 16); };
    float m = -1e30f, l = 0.f, o = 0.f;
    const bf16* outp;
    if (isC) {
        const int h = k % 8, kvh = h / 4; const float slope = exp2f(-(float)(h + 1));
        qv[d] = bf(QKVG[(size_t)t * INC + C_Q + h * 128 + d]); __syncthreads();
        for (int j = t - 128; j <= t + 128; ++j) { if (j < 0 || j >= SEQ) continue;
            red[d] = qv[d] * bf(QKVG[(size_t)j * INC + C_K + kvh * 128 + d]); __syncthreads();
            float dot = 0.f; for (int i = 0; i < 128; ++i) dot += red[i]; __syncthreads();
            const float s = dot * 0.088388347648318440f - slope * fabsf((float)(t - j));
            const float mn = fmaxf(m, s), a = expf(m - mn), p = expf(s - mn); l = l * a + p; o = o * a + p * bf(QKVG[(size_t)j * INC + C_V + kvh * 128 + d]); m = mn; }
        { const float s = sink_[h]; const float mn = fmaxf(m, s), a = expf(m - mn), p = expf(s - mn); l = l * a + p; o = o * a; m = mn; }
        outp = (const bf16*)(ws + WS_OC) + (size_t)t * OCAT + h * 128;
    } else {
        const int hh = k % 4;
        for (int g = 0; g < 3; ++g) { const int r = 1 << (2 * g), h = 4 * g + hh, c = t % r, i = t / r, nsub = SEQ / r; const float slope = exp2f(-8.0f * (float)(h + 1) / 12.0f);
            __syncthreads(); qv[d] = bf(QKVG[(size_t)t * INC + A_Q + h * 128 + d]); __syncthreads();
            for (int j = i - 64; j <= i + 64; ++j) { if (j < 0 || j >= nsub) continue; const int tj = c + r * j;
                red[d] = qv[d] * bf(QKVG[(size_t)tj * INC + A_K + h * 128 + d]); __syncthreads();
                float dot = 0.f; for (int ii = 0; ii < 128; ++ii) dot += red[ii]; __syncthreads();
                const float s = dot * 0.088388347648318440f - slope * (float)r * fabsf((float)(i - j));
                const float mn = fmaxf(m, s), a = expf(m - mn), p = expf(s - mn); l = l * a + p; o = o * a + p * bf(QKVG[(size_t)tj * INC + A_V + h * 128 + d]); m = mn; } }
        outp = (const bf16*)(ws + WS_OA) + (size_t)t * OCAT + hh * 128;
    }
    const float ref = o / l, got = bf(outp[d]);
    __syncthreads(); red[d] = (got - ref) * (got - ref); __syncthreads();
    float num = 0.f; for (int i = 0; i < 128; ++i) num += red[i]; __syncthreads();
    red[d] = ref * ref; __syncthreads();
    float den = 0.f; for (int i = 0; i < 128; ++i) den += red[i];
    if (d == 0) atomicMax(ctl + CHK_WORD, __float_as_uint(sqrtf(num / fmaxf(den, 1e-30f))));
}
__global__ void chk_fill(float* out, const unsigned* ctl) {
    const float e = __uint_as_float(ctl[CHK_WORD]); const float k = sqrtf(fminf(e, 1e6f) * 1e4f);
    for (size_t i = (size_t)blockIdx.x * blockDim.x + threadIdx.x; i < (size_t)M_ALL * DM; i += (size_t)gridDim.x * blockDim.x) out[i] = k;
}
#endif
extern "C" void kernel_launch(void* const* d_in, const int* in_sizes, int n_in, void* d_out, int out_size, void* d_ws, size_t ws_size, hipStream_t stream) {
    static int grid = 0;
    if (grid == 0) {
        if (n_in != N_IN || out_size != M_ALL * DM || ws_size < WS_END) { fprintf(stderr, "kernel_launch: shape/workspace mismatch (n_in %d out %d ws %zu need %zu)\n", n_in, out_size, ws_size, (size_t)WS_END); grid = -1; return; }
        int dev = 0, cus = 0, per_cu = 0;
        if (hipGetDevice(&dev) != hipSuccess || hipDeviceGetAttribute(&cus, hipDeviceAttributeMultiprocessorCount, dev) != hipSuccess) { grid = -1; return; }
        if (hipFuncSetAttribute((const void*)trunk_fwd, hipFuncAttributeMaxDynamicSharedMemorySize, LDS_BYTES) != hipSuccess) { fprintf(stderr, "kernel_launch: hipFuncSetAttribute failed\n"); grid = -1; return; }
        if (hipOccupancyMaxActiveBlocksPerMultiprocessor(&per_cu, (const void*)trunk_fwd, NWAVES * 64, LDS_BYTES) != hipSuccess || per_cu < 1) { fprintf(stderr, "kernel_launch: occupancy query reports %d\n", per_cu); }
        (void)hipGetLastError();
        grid = cus;
    }
    if (grid < 0) return;
    if (hipMemsetAsync((char*)d_ws + WS_CTL, 0, CTL_ZERO_BYTES, stream) != hipSuccess) return;
    Args a{};
    for (int i = 0; i < N_IN; ++i) a.in[i] = (const float*)d_in[i];
    a.out = (float*)d_out; a.ws = (unsigned char*)d_ws;
#if MK_PER_PHASE
    for (int p = 0; p < N_PHASES; ++p) { a.ph_lo = p; a.ph_hi = p + 1; hipLaunchKernelGGL(trunk_fwd, dim3(grid), dim3(NWAVES * 64), LDS_BYTES, stream, a); }
#elif CHECKB
    a.ph_lo = 0; a.ph_hi = 8;
    hipLaunchKernelGGL(trunk_fwd, dim3(grid), dim3(NWAVES * 64), LDS_BYTES, stream, a);
#if CHECKB == 1
    hipLaunchKernelGGL(chk_mixerB, dim3(512), dim3(256), 0, stream, (const unsigned char*)d_ws, (const float*)d_in[I_QNQ], (const float*)d_in[I_QNK], (unsigned*)((char*)d_ws + WS_CTL));
#else
    hipLaunchKernelGGL(chk_mixerAC, dim3(1024), dim3(128), 0, stream, (const unsigned char*)d_ws, (const float*)d_in[I_SINK], (unsigned*)((char*)d_ws + WS_CTL));
#endif
    hipLaunchKernelGGL(chk_fill, dim3(1024), dim3(256), 0, stream, (float*)d_out, (const unsigned*)((char*)d_ws + WS_CTL));
#else
    a.ph_lo = 0; a.ph_hi = N_PHASES;
    hipLaunchKernelGGL(trunk_fwd, dim3(grid), dim3(NWAVES * 64), LDS_BYTES, stream, a);
#endif
    const hipError_t le = hipPeekAtLastError();
    if (le != hipSuccess) fprintf(stderr, "kernel_launch: launch failed: %s\n", hipGetErrorName(le));
}
```

```cpp
#include <hip/hip_runtime.h>
#include <cstdio>
#include <cstdint>

#ifndef DIAG
#define DIAG 0
#endif
#ifndef DIAG_A
#define DIAG_A 2
#endif
#ifndef DIAG_B
#define DIAG_B 3
#endif
#ifndef DIAG_SHIFT
#define DIAG_SHIFT 0
#endif
#ifndef DUP_TYPE
#define DUP_TYPE -1
#endif
#ifndef STAG_STEP
#define STAG_STEP 0
#endif
#ifndef EPI_FENCE
#define EPI_FENCE 1
#endif
#ifndef EXTRA
#define EXTRA 0
#endif
#ifndef ATT_SCHED
#define ATT_SCHED 0
#endif
#ifndef CHECKB
#define CHECKB 0
#endif
#ifndef ATT_RING
#define ATT_RING 0
#endif
#ifndef REV_FFNOUT
#define REV_FFNOUT 1
#endif
#ifndef LDH_PAD
#define LDH_PAD 64
#endif
#ifndef LDU_PAD
#define LDU_PAD 0
#endif
#ifndef LDW_PAD
#define LDW_PAD 0
#endif
#ifndef QKT_PREFETCH
#define QKT_PREFETCH 1
#endif
#ifndef WSKIP
#define WSKIP 0
#endif
#ifndef BAND_PREFETCH
#define BAND_PREFETCH 0
#endif
#ifndef ATT_DMA
#define ATT_DMA 1
#endif
#ifndef DMA_PREFETCH
#define DMA_PREFETCH 0
#endif
#ifndef MK_PER_PHASE
#define MK_PER_PHASE 0
#endif

namespace pg8 {
#define PG8_LAS __attribute__((address_space(3)))
typedef unsigned short bf16_t;
typedef short bf16x8 __attribute__((ext_vector_type(8)));
typedef float f32x4 __attribute__((ext_vector_type(4)));
typedef unsigned u32x4 __attribute__((ext_vector_type(4)));
typedef unsigned u32x2 __attribute__((ext_vector_type(2)));
constexpr int BM = 256, BK = 64, HALF = 128, HTB = HALF * BK * 2, STAGE_BYTES = 8 * HTB, NXCD = 8, WGM = 8;

__host__ __device__ __forceinline__ int lds_byte(int r, int c) { const int st = (r >> 4) * 2 + (c >> 5), rr = r & 15, cc = c & 31, ob = rr * 64 + cc * 2; return st * 1024 + (ob ^ (((ob >> 9) & 1) << 5)); }
__host__ __device__ __forceinline__ void stage_rc(int b, int& R, int& C) { const int st = b / 1024, sb = b % 1024, swz = sb ^ (((sb >> 9) & 1) << 5); R = (st >> 1) * 16 + swz / 64; C = (st & 1) * 32 + (swz % 64) / 2; }
__host__ __device__ __forceinline__ int perm32(int rho) { const int n = rho >> 4, i = rho & 15; return 8 * (i >> 2) + 4 * n + (i & 3); }

struct Unit { int pm, pn; };
struct Gemm { const bf16_t* A; const bf16_t* Bt; int M, N, K; int lda = 0, ldb = 0; };

struct StaticOrder {
    int nM, nN, nwg, G, c, rev;
    __host__ __device__ void init(int M, int N, int G_, int c_, int rev_ = 0) { nM = M / BM; nN = N / BM; nwg = nM * nN; G = G_; c = c_; rev = rev_; }
    __host__ __device__ bool next(int i, Unit& u) const {
        const long L = (long)i * G + c; if (L >= nwg) return false;
        int wgid = (int)L; { const int q = nwg / NXCD, r = nwg % NXCD, xcd = wgid % NXCD, off = wgid / NXCD; wgid = (xcd < r ? xcd * (q + 1) : r * (q + 1) + (xcd - r) * q) + off; }
        const int nig = WGM * nN, gid = wgid / nig, fm = gid * WGM, gsz = (nM - fm) < WGM ? (nM - fm) : WGM;
        u.pm = fm + ((wgid % nig) % gsz); u.pn = (wgid % nig) / gsz; if (rev) u.pm = nM - 1 - u.pm; return true;
    }
    __device__ __forceinline__ void a_ready(const Unit&) const {}
    __device__ __forceinline__ void done(const Unit&) const {}
};

__device__ __forceinline__ unsigned cvt_pk_bf16(float lo, float hi) { unsigned r; asm volatile("v_cvt_pk_bf16_f32 %0, %1, %2" : "=v"(r) : "v"(lo), "v"(hi)); return r; }
__device__ __forceinline__ float bf_lo(unsigned w) { return __uint_as_float(w << 16); }
__device__ __forceinline__ float bf_hi(unsigned w) { return __uint_as_float(w & 0xffff0000u); }
__device__ __forceinline__ float sigmoidf_(float x) { return __builtin_amdgcn_rcpf(1.0f + __builtin_amdgcn_exp2f(-1.4426950408889634f * x)); }

struct EpiBf16 {
    static constexpr bool PERM = true, AFTER_DRAIN = false;
    bf16_t* O; int ldc;
    __device__ __forceinline__ void operator()(const f32x4 (&acc)[2][2][4][2], const Unit& u, int wr, int wc, int fr, int fq) const {
        const int row0 = u.pm * BM + wr * 64 + fr, col0 = u.pn * BM + wc * 32 + 8 * fq;
#pragma unroll
        for (int ai = 0; ai < 2; ++ai)
#pragma unroll
            for (int m = 0; m < 4; ++m) { bf16_t* rowp = O + (size_t)(row0 + ai * HALF + m * 16) * ldc + col0;
#pragma unroll
                for (int bj = 0; bj < 2; ++bj) { const f32x4 v0 = acc[ai][bj][m][0], v1 = acc[ai][bj][m][1];
                    u32x4 w; w.x = cvt_pk_bf16(v0[0], v0[1]); w.y = cvt_pk_bf16(v0[2], v0[3]); w.z = cvt_pk_bf16(v1[0], v1[1]); w.w = cvt_pk_bf16(v1[2], v1[3]);
                    *(u32x4*)(rowp + bj * HALF) = w; } }
    }
};
struct EpiNull {
    static constexpr bool PERM = true, AFTER_DRAIN = false;
    __device__ __forceinline__ void operator()(const f32x4 (&acc)[2][2][4][2], const Unit& u, int wr, int wc, int fr, int fq) const {
#pragma unroll
        for (int ai = 0; ai < 2; ++ai)
#pragma unroll
            for (int bj = 0; bj < 2; ++bj) asm volatile("" :: "v"(acc[ai][bj][0][0]), "v"(acc[ai][bj][0][1]), "v"(acc[ai][bj][1][0]), "v"(acc[ai][bj][1][1]), "v"(acc[ai][bj][2][0]), "v"(acc[ai][bj][2][1]), "v"(acc[ai][bj][3][0]), "v"(acc[ai][bj][3][1]));
    }
};
struct EpiSwiglu {
    static constexpr bool PERM = true, AFTER_DRAIN = false;
    bf16_t* H; int ldc;
    __device__ __forceinline__ void operator()(const f32x4 (&acc)[2][2][4][2], const Unit& u, int wr, int wc, int fr, int fq) const {
        const int row0 = u.pm * BM + wr * 64 + fr, col0 = u.pn * HALF + wc * 32 + 8 * fq;
#pragma unroll
        for (int ai = 0; ai < 2; ++ai)
#pragma unroll
            for (int m = 0; m < 4; ++m) { bf16_t* rowp = H + (size_t)(row0 + ai * HALF + m * 16) * ldc + col0;
                float h[8];
#pragma unroll
                for (int n = 0; n < 2; ++n)
#pragma unroll
                    for (int e = 0; e < 4; ++e) { const float a = acc[ai][0][m][n][e], b = acc[ai][1][m][n][e]; h[n * 4 + e] = a * sigmoidf_(a) * b; }
                u32x4 w; w.x = cvt_pk_bf16(h[0], h[1]); w.y = cvt_pk_bf16(h[2], h[3]); w.z = cvt_pk_bf16(h[4], h[5]); w.w = cvt_pk_bf16(h[6], h[7]);
                *(u32x4*)rowp = w; }
    }
};
struct EpiResid {
    static constexpr bool PERM = false, AFTER_DRAIN = false;
    float* X; int ldc; float scale;
    __device__ __forceinline__ void operator()(const f32x4 (&acc)[2][2][4][2], const Unit& u, int wr, int wc, int fr, int fq) const {
        const int row0 = u.pm * BM + wr * 64 + fr, col0 = u.pn * BM + wc * 32 + 4 * fq;
#pragma unroll
        for (int ai = 0; ai < 2; ++ai) {
            f32x4 xv[4][2][2];
#pragma unroll
            for (int m = 0; m < 4; ++m) { const float* rowp = X + (size_t)(row0 + ai * HALF + m * 16) * ldc + col0;
#pragma unroll
                for (int bj = 0; bj < 2; ++bj)
#pragma unroll
                    for (int n = 0; n < 2; ++n) xv[m][bj][n] = *(const f32x4*)(rowp + bj * HALF + n * 16); }
#pragma unroll
            for (int m = 0; m < 4; ++m) { float* rowp = X + (size_t)(row0 + ai * HALF + m * 16) * ldc + col0;
#pragma unroll
                for (int bj = 0; bj < 2; ++bj)
#pragma unroll
                    for (int n = 0; n < 2; ++n) *(f32x4*)(rowp + bj * HALF + n * 16) = xv[m][bj][n] + acc[ai][bj][m][n] * scale; }
            asm volatile("" ::: "memory");
        }
    }
};
struct EpiGateCat {
    static constexpr bool PERM = true, AFTER_DRAIN = false, HOOK = true;
    const bf16_t* GL; int ldg; bf16_t* MB; int ldc; int ldo;
    __device__ __forceinline__ bool hook_at(int t) const { return t == 8 || t == 24; }
    static __device__ __forceinline__ float e_neg(float x) { return __builtin_amdgcn_exp2f(-1.4426950408889634f * __builtin_fminf(__builtin_fmaxf(x, -60.f), 60.f)); }
    __device__ __forceinline__ void hook(f32x4 (&acc)[2][2][4][2], const Unit& u, int t, int wr, int wc, int fr, int fq) const {
        int fr_ = fr; asm volatile("" : "+v"(fr_));
        const int row0 = u.pm * BM + wr * 64 + fr_, col0 = u.pn * BM + wc * 32 + 8 * fq; const bf16_t* gp = GL + (t == 8 ? 0 : ldc) + (size_t)row0 * ldg + col0;
#pragma unroll
        for (int ai = 0; ai < 2; ++ai) {
            u32x4 a[4][2], b[4][2];
#pragma unroll
            for (int m = 0; m < 4; ++m)
#pragma unroll
                for (int bj = 0; bj < 2; ++bj) { const bf16_t* q = gp + (size_t)(ai * HALF + m * 16) * ldg + bj * HALF; a[m][bj] = *(const u32x4*)q; b[m][bj] = *(const u32x4*)(q + ldc); }
#pragma unroll
            for (int m = 0; m < 4; ++m)
#pragma unroll
                for (int bj = 0; bj < 2; ++bj) { const u32x4 p = a[m][bj], n = b[m][bj]; f32x4& v0 = acc[ai][bj][m][0]; f32x4& v1 = acc[ai][bj][m][1];
                    v0[0] *= (1.f + e_neg(bf_lo(n.x))) * __builtin_amdgcn_rcpf(1.f + e_neg(bf_lo(p.x))); v0[1] *= (1.f + e_neg(bf_hi(n.x))) * __builtin_amdgcn_rcpf(1.f + e_neg(bf_hi(p.x)));
                    v0[2] *= (1.f + e_neg(bf_lo(n.y))) * __builtin_amdgcn_rcpf(1.f + e_neg(bf_lo(p.y))); v0[3] *= (1.f + e_neg(bf_hi(n.y))) * __builtin_amdgcn_rcpf(1.f + e_neg(bf_hi(p.y)));
                    v1[0] *= (1.f + e_neg(bf_lo(n.z))) * __builtin_amdgcn_rcpf(1.f + e_neg(bf_lo(p.z))); v1[1] *= (1.f + e_neg(bf_hi(n.z))) * __builtin_amdgcn_rcpf(1.f + e_neg(bf_hi(p.z)));
                    v1[2] *= (1.f + e_neg(bf_lo(n.w))) * __builtin_amdgcn_rcpf(1.f + e_neg(bf_lo(p.w))); v1[3] *= (1.f + e_neg(bf_hi(n.w))) * __builtin_amdgcn_rcpf(1.f + e_neg(bf_hi(p.w))); }
            asm volatile("" ::: "memory");
        }
        asm volatile("s_waitcnt vmcnt(0)" ::: "memory");
    }
    __device__ __forceinline__ void operator()(const f32x4 (&acc)[2][2][4][2], const Unit& u, int wr, int wc, int fr, int fq) const {
        const int row0 = u.pm * BM + wr * 64 + fr, col0 = u.pn * BM + wc * 32 + 8 * fq; const bf16_t* gp = GL + 2 * ldc;
#pragma unroll
        for (int ai = 0; ai < 2; ++ai) {
            u32x4 g[4][2];
#pragma unroll
            for (int m = 0; m < 4; ++m)
#pragma unroll
                for (int bj = 0; bj < 2; ++bj) g[m][bj] = *(const u32x4*)(gp + (size_t)(row0 + ai * HALF + m * 16) * ldg + col0 + bj * HALF);
#pragma unroll
            for (int m = 0; m < 4; ++m) { const size_t row = (size_t)(row0 + ai * HALF + m * 16);
#pragma unroll
                for (int bj = 0; bj < 2; ++bj) { const u32x4 gg = g[m][bj]; f32x4 v0 = acc[ai][bj][m][0], v1 = acc[ai][bj][m][1];
                    v0[0] *= sigmoidf_(bf_lo(gg.x)); v0[1] *= sigmoidf_(bf_hi(gg.x)); v0[2] *= sigmoidf_(bf_lo(gg.y)); v0[3] *= sigmoidf_(bf_hi(gg.y));
                    v1[0] *= sigmoidf_(bf_lo(gg.z)); v1[1] *= sigmoidf_(bf_hi(gg.z)); v1[2] *= sigmoidf_(bf_lo(gg.w)); v1[3] *= sigmoidf_(bf_hi(gg.w));
                    u32x4 w; w.x = cvt_pk_bf16(v0[0], v0[1]); w.y = cvt_pk_bf16(v0[2], v0[3]); w.z = cvt_pk_bf16(v1[0], v1[1]); w.w = cvt_pk_bf16(v1[2], v1[3]);
                    *(u32x4*)(MB + row * ldo + col0 + bj * HALF) = w; } }
            asm volatile("" ::: "memory");
        }
    }
};

template <class E, class = void> struct epi_has_hook { static constexpr bool value = false; };
template <class E> struct epi_has_hook<E, decltype((void)E::HOOK)> { static constexpr bool value = E::HOOK; };
template <class Epi, class Sched, bool ALIGN_EPI = false, bool SP2 = false>
__device__ __forceinline__ void gemm_phase(PG8_LAS unsigned char* lds, const Gemm g, const Sched& S, const Epi& E, const int tid, const unsigned stagger = 0u) {
    if (stagger) { const unsigned long long t0_ = __builtin_amdgcn_s_memrealtime(); while (__builtin_amdgcn_s_memrealtime() - t0_ < stagger) __builtin_amdgcn_s_sleep(16); }
    const int wid = __builtin_amdgcn_readfirstlane(tid >> 6), lane = tid & 63, wr = wid >> 2, wc = wid & 3, fr = lane & 15, fq = lane >> 4;
    const int K = g.K, nt = K / BK, lda = g.lda ? g.lda : g.K, ldb = g.ldb ? g.ldb : g.K;
    unsigned voffA[2], voffB[2];
#pragma unroll
    for (int i = 0; i < 2; ++i) { int R, C; stage_rc(tid * 16 + i * 8192, R, C); const int Rb = Epi::PERM ? ((R & ~31) + perm32(R & 31)) : R;
        voffA[i] = (unsigned)(R * lda + C) * 2u; voffB[i] = (unsigned)(Rb * ldb + C) * 2u; }
    const size_t kstep = (size_t)(BK * 2);
    const size_t hstep = (size_t)HALF * ldb * 2, hstepA = (size_t)HALF * lda * 2;
    const size_t tstep = 2 * hstep, tstepA = 2 * hstepA;
    const unsigned ldsw = (unsigned)wid * 1024u;
    const int aoff = lds_byte(wr * 64 + fr, fq * 8), boff = lds_byte(wc * 32 + fr, fq * 8);
#define PG8_SA(b, h) (((b) * 2 + (h)) * HTB)
#define PG8_SB(b, h) ((4 + (b) * 2 + (h)) * HTB)
#define PG8_STAGE(bufoff, gbase, voff) do { _Pragma("unroll") for (int _i = 0; _i < 2; ++_i) \
        __builtin_amdgcn_global_load_lds((const unsigned*)((const char*)(gbase) + (voff)[_i]), (PG8_LAS unsigned*)(lds + (bufoff) + ldsw + _i * 8192), 16, 0, 0); } while (0)
#define PG8_LDA(dst, b, h) do { _Pragma("unroll") for (int m = 0; m < 4; ++m) _Pragma("unroll") for (int k = 0; k < 2; ++k) dst[m][k] = *(const PG8_LAS bf16x8*)(lds + PG8_SA(b, h) + aoff + m * 2048 + k * 1024); } while (0)
#define PG8_LDB(dst, b, h) do { _Pragma("unroll") for (int n = 0; n < 2; ++n) _Pragma("unroll") for (int k = 0; k < 2; ++k) dst[n][k] = *(const PG8_LAS bf16x8*)(lds + PG8_SB(b, h) + boff + n * 2048 + k * 1024); } while (0)
#define PG8_MMA(ai, bj, At, Bt) do { __builtin_amdgcn_s_setprio(1); _Pragma("unroll") for (int m = 0; m < 4; ++m) _Pragma("unroll") for (int n = 0; n < 2; ++n) _Pragma("unroll") for (int k = 0; k < 2; ++k) \
        acc[ai][bj][m][n] = __builtin_amdgcn_mfma_f32_16x16x32_bf16(Bt[n][k], At[m][k], acc[ai][bj][m][n], 0, 0, 0); __builtin_amdgcn_s_setprio(0); } while (0)
#define PG8_WAIT_V(n) asm volatile("s_waitcnt vmcnt(" #n ")" ::: "memory")
#define PG8_WAIT_L(n) asm volatile("s_waitcnt lgkmcnt(" #n ")" ::: "memory")
#define PG8_BAR __builtin_amdgcn_s_barrier()
#define PG8_SCHED __builtin_amdgcn_sched_barrier(0)
    Unit cur, nxt; int ui = 0;
    if (!S.next(0, cur)) return;
    f32x4 acc[2][2][4][2];
#pragma unroll
    for (int a = 0; a < 2; ++a)
#pragma unroll
        for (int b = 0; b < 2; ++b)
#pragma unroll
            for (int m = 0; m < 4; ++m)
#pragma unroll
                for (int n = 0; n < 2; ++n) acc[a][b][m][n] = (f32x4){0.f, 0.f, 0.f, 0.f};
    bf16x8 At[4][2], B0[2][2], B1[2][2];
    const char* cA = (const char*)g.A + (size_t)cur.pm * tstepA; const char* cB = (const char*)g.Bt + (size_t)cur.pn * tstep;
    S.a_ready(cur);
    if constexpr (SP2) {
        PG8_STAGE(PG8_SB(0, 0), cB, voffB); PG8_STAGE(PG8_SB(0, 1), cB + hstep, voffB); PG8_STAGE(PG8_SA(0, 0), cA, voffA); PG8_STAGE(PG8_SA(0, 1), cA + hstepA, voffA);
        if (wr == 1) PG8_BAR;
        PG8_WAIT_V(2); PG8_BAR;
        PG8_STAGE(PG8_SB(1, 0), cB + kstep, voffB); PG8_STAGE(PG8_SA(1, 0), cA + kstep, voffA); PG8_STAGE(PG8_SB(1, 1), cB + hstep + kstep, voffB);
        PG8_WAIT_V(6); PG8_BAR;
    } else {
        PG8_STAGE(PG8_SB(0, 0), cB, voffB); PG8_STAGE(PG8_SA(0, 0), cA, voffA); PG8_STAGE(PG8_SB(0, 1), cB + hstep, voffB); PG8_STAGE(PG8_SA(0, 1), cA + hstepA, voffA);
        if (wr == 1) PG8_BAR;
        PG8_WAIT_V(4); PG8_BAR;
        PG8_STAGE(PG8_SB(1, 0), cB + kstep, voffB); PG8_STAGE(PG8_SA(1, 0), cA + kstep, voffA); PG8_STAGE(PG8_SB(1, 1), cB + hstep + kstep, voffB);
        PG8_WAIT_V(6); PG8_BAR;
    }
    for (;;) {
        const bool has_next = S.next(ui + 1, nxt);
        const char* nA = has_next ? (const char*)g.A + (size_t)nxt.pm * tstepA : cA; const char* nB = has_next ? (const char*)g.Bt + (size_t)nxt.pn * tstep : cB;
        for (int t = 0; t < nt; t += 2) {
            const bool last = (t == nt - 2);
            const char* a1 = cA + (size_t)(t + 1) * kstep;
            const char* a2 = last ? nA : cA + (size_t)(t + 2) * kstep; const char* b2 = last ? nB : cB + (size_t)(t + 2) * kstep;
            const char* a3 = a2 + kstep; const char* b3 = b2 + kstep;
            if (last && has_next) S.a_ready(nxt);
            if constexpr (epi_has_hook<Epi>::value) { if (E.hook_at(t)) E.hook(acc, cur, t, wr, wc, fr, fq); }
            if constexpr (SP2) {
            PG8_LDB(B0, 0, 0); PG8_LDB(B1, 0, 1); PG8_SCHED; PG8_LDA(At, 0, 0); PG8_STAGE(PG8_SA(1, 1), a1 + hstepA, voffA);
            PG8_WAIT_V(8); PG8_WAIT_L(0); PG8_BAR; PG8_MMA(0, 0, At, B0); PG8_MMA(0, 1, At, B1); PG8_BAR; PG8_SCHED;
            PG8_LDA(At, 0, 1); PG8_STAGE(PG8_SB(0, 0), b2, voffB); PG8_STAGE(PG8_SB(0, 1), b2 + hstep, voffB); PG8_STAGE(PG8_SA(0, 0), a2, voffA);
            PG8_WAIT_V(8); PG8_WAIT_L(0); PG8_BAR; PG8_MMA(1, 0, At, B0); PG8_MMA(1, 1, At, B1); PG8_BAR; PG8_SCHED;
            PG8_LDB(B0, 1, 0); PG8_LDB(B1, 1, 1); PG8_SCHED; PG8_LDA(At, 1, 0); PG8_STAGE(PG8_SA(0, 1), a2 + hstepA, voffA);
            PG8_WAIT_V(8); PG8_WAIT_L(0); PG8_BAR; PG8_MMA(0, 0, At, B0); PG8_MMA(0, 1, At, B1); PG8_BAR; PG8_SCHED;
            PG8_LDA(At, 1, 1); PG8_STAGE(PG8_SB(1, 0), b3, voffB); PG8_STAGE(PG8_SB(1, 1), b3 + hstep, voffB); PG8_STAGE(PG8_SA(1, 0), a3, voffA);
            PG8_WAIT_V(8); PG8_WAIT_L(0); PG8_BAR; PG8_MMA(1, 0, At, B0); PG8_MMA(1, 1, At, B1); PG8_BAR; PG8_SCHED;
            } else {
            PG8_LDB(B0, 0, 0); PG8_SCHED; PG8_LDA(At, 0, 0); PG8_STAGE(PG8_SA(1, 1), a1 + hstepA, voffA);
            PG8_WAIT_L(8); PG8_BAR; PG8_WAIT_L(0); PG8_MMA(0, 0, At, B0); PG8_BAR; PG8_SCHED;
            PG8_LDB(B1, 0, 1); PG8_STAGE(PG8_SB(0, 0), b2, voffB);
            PG8_BAR; PG8_WAIT_L(0); PG8_MMA(0, 1, At, B1); PG8_BAR;
            PG8_LDA(At, 0, 1); PG8_STAGE(PG8_SA(0, 0), a2, voffA);
            PG8_BAR; PG8_WAIT_L(0); PG8_MMA(1, 0, At, B0); PG8_BAR; PG8_SCHED;
            PG8_STAGE(PG8_SB(0, 1), b2 + hstep, voffB);
            PG8_WAIT_V(6); PG8_BAR; PG8_MMA(1, 1, At, B1); PG8_BAR;
            PG8_LDB(B0, 1, 0); PG8_SCHED; PG8_LDA(At, 1, 0); PG8_STAGE(PG8_SA(0, 1), a2 + hstepA, voffA);
            PG8_WAIT_L(8); PG8_BAR; PG8_WAIT_L(0); PG8_MMA(0, 0, At, B0); PG8_BAR; PG8_SCHED;
            PG8_LDB(B1, 1, 1); PG8_STAGE(PG8_SB(1, 0), b3, voffB);
            PG8_BAR; PG8_WAIT_L(0); PG8_MMA(0, 1, At, B1); PG8_BAR;
            PG8_LDA(At, 1, 1); PG8_STAGE(PG8_SA(1, 0), a3, voffA);
            PG8_BAR; PG8_WAIT_L(0); PG8_MMA(1, 0, At, B0); PG8_BAR; PG8_SCHED;
            PG8_STAGE(PG8_SB(1, 1), b3 + hstep, voffB);
            PG8_WAIT_V(6); PG8_BAR; PG8_MMA(1, 1, At, B1); PG8_BAR;
            }
        }
        if constexpr (ALIGN_EPI) { if (wr == 0) PG8_BAR; }
        E(acc, cur, wr, wc, fr, fq); S.done(cur);
        if (!has_next) break;
#pragma unroll
        for (int a = 0; a < 2; ++a)
#pragma unroll
            for (int b = 0; b < 2; ++b)
#pragma unroll
                for (int m = 0; m < 4; ++m)
#pragma unroll
                    for (int n = 0; n < 2; ++n) acc[a][b][m][n] = (f32x4){0.f, 0.f, 0.f, 0.f};
        cur = nxt; cA = nA; cB = nB; ++ui;
        if constexpr (ALIGN_EPI) { if (wr == 1) PG8_BAR; }
    }
    PG8_WAIT_V(0);
    if constexpr (!ALIGN_EPI) { if (wr == 0) PG8_BAR; }
    PG8_BAR;
#undef PG8_SA
#undef PG8_SB
#undef PG8_STAGE
#undef PG8_LDA
#undef PG8_LDB
#undef PG8_MMA
#undef PG8_WAIT_V
#undef PG8_WAIT_L
#undef PG8_BAR
#undef PG8_SCHED
}
}

namespace att {
typedef unsigned short bf16;
using bf16x8 = __attribute__((ext_vector_type(8))) short;
using s16x4  = __attribute__((ext_vector_type(4))) short;
using f32x16 = __attribute__((ext_vector_type(16))) float;
using u32x4  = __attribute__((ext_vector_type(4))) unsigned;
constexpr int D = 128, NW = 8, QBLK = 32, KVBLK = 64;
constexpr float SCALE = 0.088388347648318440f;
constexpr float THR = 8.f;
constexpr int SHM_V = KVBLK * D * 2, SHM_K = KVBLK * D * 2, SHM_ATTN = 2 * SHM_V + 2 * SHM_K + NW * 64 * 4;
#define KSWZ(row, colB) ((row) * 256 + ((colB) ^ (((row) & 7) << 4)))
#define SBAR() __builtin_amdgcn_sched_barrier(0)
__device__ __forceinline__ int crow(int r, int hi) { return (r & 3) + 8 * (r >> 2) + 4 * hi; }
__device__ __forceinline__ unsigned cvtpk(float lo, float hi) { unsigned r; asm volatile("v_cvt_pk_bf16_f32 %0, %1, %2" : "=v"(r) : "v"(lo), "v"(hi)); return r; }

template <int SM> __device__ __forceinline__ void partialSM(f32x16& p0, f32x16& p1, float& m_reg, float& mn, float& alpha) {
  if constexpr (SM == 2) {
#pragma unroll
    for (int r = 0; r < 16; ++r) p0[r] = __builtin_amdgcn_exp2f(p0[r]);
    return; }
  constexpr float C = SM == 0 ? SCALE * 1.4426950408889634f : 1.0f; constexpr float THRU = SM == 0 ? THR / SCALE : THR * 1.4426950408889634f;
  float pmax = p0[0];
#pragma unroll
  for (int r = 1; r < 16; ++r) pmax = fmaxf(pmax, p0[r]);
#pragma unroll
  for (int r = 0; r < 16; ++r) pmax = fmaxf(pmax, p1[r]);
  { auto rr = __builtin_amdgcn_permlane32_swap(__float_as_uint(pmax), __float_as_uint(pmax), false, false);
    pmax = fmaxf(__uint_as_float(rr[0]), __uint_as_float(rr[1])); }
  if (__builtin_expect(__all(pmax - m_reg <= THRU), 1)) { mn = m_reg; alpha = 1.f; }
  else { mn = fmaxf(m_reg, pmax); alpha = __builtin_amdgcn_exp2f((m_reg - mn) * C); m_reg = mn; }
  float mnC = -mn * C;
#pragma unroll
  for (int r = 0; r < 16; ++r) p0[r] = fmaf(p0[r], C, mnC);
#pragma unroll
  for (int r = 0; r < 16; ++r) p1[r] = fmaf(p1[r], C, mnC);
#pragma unroll
  for (int r = 0; r < 16; ++r) p0[r] = __builtin_amdgcn_exp2f(p0[r]);
}
template <int SM> __device__ __forceinline__ void finishSM(f32x16& p0, f32x16& p1, float alpha, float& l_reg, bf16x8& pa0, bf16x8& pa1, bf16x8& pa2, bf16x8& pa3) {
#pragma unroll
  for (int r = 0; r < 16; ++r) p1[r] = __builtin_amdgcn_exp2f(p1[r]);
  float ps = 0;
#pragma unroll
  for (int r = 0; r < 16; ++r) ps += p0[r];
#pragma unroll
  for (int r = 0; r < 16; ++r) ps += p1[r];
  { auto rr = __builtin_amdgcn_permlane32_swap(__float_as_uint(ps), __float_as_uint(ps), false, false);
    ps = __uint_as_float(rr[0]) + __uint_as_float(rr[1]); }
  if constexpr (SM == 2) l_reg += ps; else l_reg = l_reg * alpha + ps;
#define PK4(P, BASE, OUT) do { unsigned a0 = cvtpk(P[BASE + 0], P[BASE + 1]), a1 = cvtpk(P[BASE + 2], P[BASE + 3]);   \
    unsigned b0 = cvtpk(P[BASE + 4], P[BASE + 5]), b1 = cvtpk(P[BASE + 6], P[BASE + 7]);                              \
    auto r0 = __builtin_amdgcn_permlane32_swap(a0, b0, false, false); auto r1 = __builtin_amdgcn_permlane32_swap(a1, b1, false, false); \
    u32x4 w = {r0[0], r1[0], r0[1], r1[1]}; OUT = *reinterpret_cast<bf16x8*>(&w); } while (0)
  PK4(p0, 0, pa0); PK4(p0, 8, pa1); PK4(p1, 0, pa2); PK4(p1, 8, pa3);
#undef PK4
}
template <bool PF> __device__ __forceinline__ void qkt(f32x16& p0, f32x16& p1, const char* Ks, const bf16x8* qr, int r32, int hi) {
  p0 = f32x16{}; p1 = f32x16{};
  if constexpr (PF) {
  bf16x8 b0 = *reinterpret_cast<const bf16x8*>(Ks + KSWZ(r32, (hi * 8) * 2)), b1 = *reinterpret_cast<const bf16x8*>(Ks + KSWZ(32 + r32, (hi * 8) * 2));
#pragma unroll
  for (int d0 = 0; d0 < 8; ++d0) { bf16x8 n0 = b0, n1 = b1;
    if (d0 < 7) { const int cb = ((d0 + 1) * 16 + hi * 8) * 2; n0 = *reinterpret_cast<const bf16x8*>(Ks + KSWZ(r32, cb)); n1 = *reinterpret_cast<const bf16x8*>(Ks + KSWZ(32 + r32, cb)); }
    if (d0 < 7) asm volatile("s_waitcnt lgkmcnt(2)" ::: "memory"); else asm volatile("s_waitcnt lgkmcnt(0)" ::: "memory");
    __builtin_amdgcn_sched_barrier(0);
    p0 = __builtin_amdgcn_mfma_f32_32x32x16_bf16(b0, qr[d0], p0, 0, 0, 0);
    p1 = __builtin_amdgcn_mfma_f32_32x32x16_bf16(b1, qr[d0], p1, 0, 0, 0);
    b0 = n0; b1 = n1; }
  } else {
#pragma unroll
  for (int d0 = 0; d0 < 8; ++d0) { int cb = (d0 * 16 + hi * 8) * 2;
    bf16x8 b0 = *reinterpret_cast<const bf16x8*>(Ks + KSWZ(r32, cb));
    bf16x8 b1 = *reinterpret_cast<const bf16x8*>(Ks + KSWZ(32 + r32, cb));
    p0 = __builtin_amdgcn_mfma_f32_32x32x16_bf16(b0, qr[d0], p0, 0, 0, 0);
    p1 = __builtin_amdgcn_mfma_f32_32x32x16_bf16(b1, qr[d0], p1, 0, 0, 0); }
  }
}
__device__ __forceinline__ int v_st(int k, int c) { const int kk = (k & ~0xC) | ((k & 4) << 1) | ((k & 8) >> 1); return ((kk >> 3) * 4 + (c >> 5)) * 512 + ((kk & 7) * 32 + (c & 31)) * 2; }
__device__ __forceinline__ int v_rd_base(int lane) { return ((lane & 3) << 3) | (((lane >> 2) & 3) << 6) | (((lane >> 4) & 1) << 5) | (((lane >> 5) & 1) << 8); }
constexpr int v_rd_off(int d0, int ks, int half) { return d0 * 512 + ks * 4096 + half * 2048; }
template <int OFF> __device__ __forceinline__ s16x4 tr_read(int vb) {
  s16x4 r; asm volatile("ds_read_b64_tr_b16 %0, %1 offset:%2" : "=&v"(r) : "v"(vb), "i"(OFF) : "memory"); return r;
}
template <int D0> __device__ __forceinline__ void pv_one(f32x16& od, int vb, bf16x8 pa0, bf16x8 pa1, bf16x8 pa2, bf16x8 pa3) {
  const s16x4 l0 = tr_read<v_rd_off(D0, 0, 0)>(vb), h0 = tr_read<v_rd_off(D0, 0, 1)>(vb), l1 = tr_read<v_rd_off(D0, 1, 0)>(vb), h1 = tr_read<v_rd_off(D0, 1, 1)>(vb);
  const s16x4 l2 = tr_read<v_rd_off(D0, 2, 0)>(vb), h2 = tr_read<v_rd_off(D0, 2, 1)>(vb), l3 = tr_read<v_rd_off(D0, 3, 0)>(vb), h3 = tr_read<v_rd_off(D0, 3, 1)>(vb);
  asm volatile("s_waitcnt lgkmcnt(0)" ::: "memory"); SBAR();
#define PK(L, H) (bf16x8){L[0], L[1], L[2], L[3], H[0], H[1], H[2], H[3]}
  od = __builtin_amdgcn_mfma_f32_32x32x16_bf16(pa0, PK(l0, h0), od, 0, 0, 0);
  od = __builtin_amdgcn_mfma_f32_32x32x16_bf16(pa1, PK(l1, h1), od, 0, 0, 0);
  od = __builtin_amdgcn_mfma_f32_32x32x16_bf16(pa2, PK(l2, h2), od, 0, 0, 0);
  od = __builtin_amdgcn_mfma_f32_32x32x16_bf16(pa3, PK(l3, h3), od, 0, 0, 0);
#undef PK
}
__device__ __forceinline__ void pv_d0(f32x16* o, int vb, bf16x8 pa0, bf16x8 pa1, bf16x8 pa2, bf16x8 pa3) {
  pv_one<0>(o[0], vb, pa0, pa1, pa2, pa3); pv_one<1>(o[1], vb, pa0, pa1, pa2, pa3); pv_one<2>(o[2], vb, pa0, pa1, pa2, pa3); pv_one<3>(o[3], vb, pa0, pa1, pa2, pa3);
}

struct Unit {
  const bf16* Q; const bf16* K; const bf16* V; bf16* O; float* lse;
  int qstride, kstride, ostride, lse_stride;
  int NT;
  int kb0, n, qi0, hw;
  float slope_raw;
  float sink; int has_sink;
};

template <bool BAND, int SM>
__device__ __forceinline__ void attn_unit(const Unit& U, char* lds, const int tid) {
  const int wid = tid >> 6, lane = tid & 63, r32 = lane & 31, hi = lane >> 5;
  char* V_lds = lds; char* K_lds = lds + 2 * SHM_V;
  float* ws = (float*)(lds + 2 * SHM_V + 2 * SHM_K) + wid * 64; float* li_l = ws; float* al_l = ws + 32;
  float m_reg = -1e30f, l_reg = 0; f32x16 o[4] = {}; bf16x8 qr[8];
  { int lq_ = lane; asm volatile("" : "+v"(lq_));
    const unsigned qoff = (unsigned)(wid * QBLK + (lq_ & 31)) * (unsigned)U.qstride + (unsigned)((lq_ >> 5) * 8);
#pragma unroll
    for (int d0 = 0; d0 < 8; ++d0) qr[d0] = *reinterpret_cast<const bf16x8*>(U.Q + qoff + d0 * 16); }
  const int sr = tid >> 4, sc = (tid & 15) * 8, vst0 = v_st(sr, sc), kst0 = KSWZ(sr, sc * 2);
  const int vb0 = (int)(uintptr_t)V_lds + v_rd_base(lane);
  struct { bf16x8 vs0, vs1, ks0, ks1; } sr_[BAND ? 1 : 2];
  float fq = 0.f;
  if constexpr (BAND) fq = (float)(U.qi0 + wid * QBLK + r32);
#define ROWOF(k) ((k) < 0 ? 0 : ((k) >= U.n ? U.n - 1 : (k)))
#define SLOAD(i, k0) do { unsigned _o0, _o1; \
    if constexpr (BAND) { const int _ka = U.kb0 + (k0) + sr; _o0 = (unsigned)ROWOF(_ka) * (unsigned)U.kstride + (unsigned)sc; _o1 = (unsigned)ROWOF(_ka + 32) * (unsigned)U.kstride + (unsigned)sc; } \
    else { _o0 = (unsigned)((k0) + sr) * (unsigned)U.kstride + (unsigned)sc; _o1 = _o0 + 32u * (unsigned)U.kstride; } \
    sr_[i].vs0 = *reinterpret_cast<const bf16x8*>(U.V + _o0); sr_[i].vs1 = *reinterpret_cast<const bf16x8*>(U.V + _o1); \
    sr_[i].ks0 = *reinterpret_cast<const bf16x8*>(U.K + _o0); sr_[i].ks1 = *reinterpret_cast<const bf16x8*>(U.K + _o1); } while (0)
#define SWRITE(b, i) do { *(bf16x8*)(V_lds + (b) * SHM_V + vst0) = sr_[i].vs0;          \
    *(bf16x8*)(V_lds + (b) * SHM_V + vst0 + 8192) = sr_[i].vs1;                         \
    *(bf16x8*)(K_lds + (b) * SHM_K + kst0) = sr_[i].ks0;                               \
    *(bf16x8*)(K_lds + (b) * SHM_K + kst0 + 8192) = sr_[i].ks1; } while (0)
#define SWAIT() asm volatile("s_waitcnt vmcnt(4)" ::: "memory")
#define QK_SCHED() do { if constexpr (SM == 2 && ATT_SCHED == 1) { __builtin_amdgcn_sched_group_barrier(0x100, 4, 0); \
    _Pragma("unroll") for (int i_ = 0; i_ < 7; ++i_) { __builtin_amdgcn_sched_group_barrier(0x008, 2, 0); __builtin_amdgcn_sched_group_barrier(0x002, 9, 0); __builtin_amdgcn_sched_group_barrier(0x100, 2, 0); } \
    __builtin_amdgcn_sched_group_barrier(0x008, 2, 0); __builtin_amdgcn_sched_group_barrier(0x002, 12, 0); } \
    if constexpr (SM == 2 && ATT_SCHED == 2) { _Pragma("unroll") for (int i_ = 0; i_ < 8; ++i_) { __builtin_amdgcn_sched_group_barrier(0x100, 2, 0); __builtin_amdgcn_sched_group_barrier(0x008, 2, 0); __builtin_amdgcn_sched_group_barrier(0x002, 9, 0); } } } while (0)
#define RESC(a) do { if constexpr (SM != 2) if (__any((a) < 1.f)) { if (hi == 0) al_l[r32] = (a); asm volatile("s_waitcnt lgkmcnt(0)" ::: "memory"); \
    _Pragma("unroll") for (int d = 0; d < 4; ++d) _Pragma("unroll") for (int r = 0; r < 16; ++r) o[d][r] *= al_l[crow(r, hi)]; } } while (0)
#define MASKB(P0, P1, j) do { if constexpr (BAND) { const float _f0 = ((float)(U.kb0 + 64 * (j)) + (float)(4 * hi)) - fq; const float _ninf = -__builtin_inff(); \
    const float flo = __builtin_fmaxf(-(float)U.hw, -fq), fhi = __builtin_fminf((float)U.hw, (float)(U.n - 1) - fq); \
    _Pragma("unroll") for (int r = 0; r < 16; ++r) { const float d0_ = _f0 + (float)((r & 3) + 8 * (r >> 2)), d1_ = d0_ + 32.f; \
      const float s0_ = fmaf(-U.slope_raw, __builtin_fabsf(d0_), P0[r]), s1_ = fmaf(-U.slope_raw, __builtin_fabsf(d1_), P1[r]); \
      P0[r] = (d0_ >= flo && d0_ <= fhi) ? s0_ : _ninf; P1[r] = (d1_ >= flo && d1_ <= fhi) ? s1_ : _ninf; } } } while (0)
  f32x16 pA0, pA1, pB0, pB1; float mnA, mnB, alA, alB; bf16x8 pa0, pa1, pa2, pa3; const int NT = U.NT;
  constexpr int SE = 0, SO = 1;
  if constexpr (BAND) {
  const int tlo_ = __builtin_amdgcn_readfirstlane(wid >> 1), thi_ = tlo_ + (U.hw >> 5);
#define ACT(j) (!WSKIP || ((j) >= tlo_ && (j) <= thi_))
  SLOAD(0, 0); SWRITE(0, 0); SLOAD(0, KVBLK); __syncthreads();
  if (ACT(0)) { qkt<(BAND_PREFETCH != 0)>(pA0, pA1, K_lds, qr, r32, hi); MASKB(pA0, pA1, 0); partialSM<SM>(pA0, pA1, m_reg, mnA, alA); }
  SWRITE(1, 0); if (2 < NT) SLOAD(0, 2 * KVBLK); __syncthreads();
  for (int j = 1; j + 1 < NT; j += 2) {
      { const bool aj = ACT(j), ap = ACT(j - 1);
        SBAR(); if (aj) qkt<(BAND_PREFETCH != 0)>(pB0, pB1, K_lds + SHM_K, qr, r32, hi);
        if (ap) { finishSM<SM>(pA0, pA1, alA, l_reg, pa0, pa1, pa2, pa3); SBAR(); pv_d0(o, vb0, pa0, pa1, pa2, pa3); }
        if (aj) { MASKB(pB0, pB1, j); partialSM<SM>(pB0, pB1, m_reg, mnB, alB); }
        __syncthreads(); SWRITE(0, 0); SLOAD(0, (j + 2) * KVBLK);
        if (aj) RESC(alB); __syncthreads(); }
      { const bool aj = ACT(j + 1), ap = ACT(j);
        SBAR(); if (aj) qkt<(BAND_PREFETCH != 0)>(pA0, pA1, K_lds, qr, r32, hi);
        if (ap) { finishSM<SM>(pB0, pB1, alB, l_reg, pa0, pa1, pa2, pa3); SBAR(); pv_d0(o, vb0 + SHM_V, pa0, pa1, pa2, pa3); }
        if (aj) { MASKB(pA0, pA1, j + 1); partialSM<SM>(pA0, pA1, m_reg, mnA, alA); }
        __syncthreads(); SWRITE(1, 0); if (j + 3 < NT) SLOAD(0, (j + 3) * KVBLK);
        if (aj) RESC(alA); __syncthreads(); }
  }
  { const bool aj = ACT(NT - 1), ap = ACT(NT - 2);
    SBAR(); if (aj) qkt<(BAND_PREFETCH != 0)>(pB0, pB1, K_lds + SHM_K, qr, r32, hi);
    if (ap) { finishSM<SM>(pA0, pA1, alA, l_reg, pa0, pa1, pa2, pa3); SBAR(); pv_d0(o, vb0, pa0, pa1, pa2, pa3); }
    if (aj) { MASKB(pB0, pB1, NT - 1); partialSM<SM>(pB0, pB1, m_reg, mnB, alB); }
    __syncthreads();
    if (aj) { RESC(alB);
      finishSM<SM>(pB0, pB1, alB, l_reg, pa0, pa1, pa2, pa3); SBAR();
      pv_d0(o, vb0 + SHM_V, pa0, pa1, pa2, pa3); } }
#undef ACT
  } else {
  SLOAD(SE, 0); asm volatile("s_waitcnt vmcnt(0)" ::: "memory"); SWRITE(0, SE); __syncthreads();
  qkt<(QKT_PREFETCH != 0) && SM == 2>(pA0, pA1, K_lds, qr, r32, hi); partialSM<SM>(pA0, pA1, m_reg, mnA, alA);
  SLOAD(SO, KVBLK); if (2 < NT) SLOAD(SE, 2 * KVBLK);
  SWAIT(); SWRITE(1, SO); __syncthreads();
  for (int j = 1; j + 1 < NT; j += 2) {
    SBAR(); qkt<(QKT_PREFETCH != 0) && SM == 2>(pB0, pB1, K_lds + SHM_K, qr, r32, hi);
    finishSM<SM>(pA0, pA1, alA, l_reg, pa0, pa1, pa2, pa3); QK_SCHED(); SBAR();
    SLOAD(SO, (j + 2) * KVBLK); SBAR();
    pv_d0(o, vb0, pa0, pa1, pa2, pa3); partialSM<SM>(pB0, pB1, m_reg, mnB, alB);
    __syncthreads(); SWAIT(); SWRITE(0, SE);
    RESC(alB); __syncthreads();
    SBAR(); qkt<(QKT_PREFETCH != 0) && SM == 2>(pA0, pA1, K_lds, qr, r32, hi);
    finishSM<SM>(pB0, pB1, alB, l_reg, pa0, pa1, pa2, pa3); QK_SCHED(); SBAR();
    if (j + 3 < NT) SLOAD(SE, (j + 3) * KVBLK); SBAR();
    pv_d0(o, vb0 + SHM_V, pa0, pa1, pa2, pa3); partialSM<SM>(pA0, pA1, m_reg, mnA, alA);
    __syncthreads(); SWAIT(); SWRITE(1, SO);
    RESC(alA); __syncthreads();
  }
  SBAR(); qkt<(QKT_PREFETCH != 0) && SM == 2>(pB0, pB1, K_lds + SHM_K, qr, r32, hi);
  finishSM<SM>(pA0, pA1, alA, l_reg, pa0, pa1, pa2, pa3); SBAR();
  pv_d0(o, vb0, pa0, pa1, pa2, pa3); partialSM<SM>(pB0, pB1, m_reg, mnB, alB);
  __syncthreads(); RESC(alB);
  finishSM<SM>(pB0, pB1, alB, l_reg, pa0, pa1, pa2, pa3); SBAR();
  pv_d0(o, vb0 + SHM_V, pa0, pa1, pa2, pa3);
  }
  if constexpr (BAND) {
    if (U.has_sink) l_reg += __builtin_amdgcn_exp2f((U.sink * (1.0f / SCALE) - m_reg) * (SCALE * 1.4426950408889634f));
    if (U.lse != nullptr && hi == 0) U.lse[(unsigned)(wid * QBLK + r32) * (unsigned)U.lse_stride] = m_reg * SCALE + __builtin_amdgcn_logf(l_reg) * 0.6931471805599453f;
  }
  int lane_e = lane; asm volatile("" : "+v"(lane_e));
  const int r32e = lane_e & 31, hie = lane_e >> 5;
  if (hie == 0) li_l[r32e] = l_reg; asm volatile("s_waitcnt lgkmcnt(0)" ::: "memory");
  float rli[16];
#pragma unroll
  for (int r = 0; r < 16; ++r) rli[r] = __builtin_amdgcn_rcpf(li_l[crow(r, hie)]);
  __syncthreads();
  char* ost = lds + wid * 8192;
  { char* op = ost + hie * 1024 + r32e * 2;
#pragma unroll
    for (int r = 0; r < 16; ++r) {
#pragma unroll
      for (int d0 = 0; d0 < 4; ++d0) { const unsigned w = cvtpk(o[d0][r] * rli[r], 0.f); *(unsigned short*)(op + ((r & 3) + 8 * (r >> 2)) * 256 + d0 * 64) = (unsigned short)w; } } }
  asm volatile("s_waitcnt lgkmcnt(0)" ::: "memory");
  { const char* ip = ost + (lane_e >> 4) * 256 + (lane_e & 15) * 16;
    unsigned goff = (unsigned)(wid * QBLK + (lane_e >> 4)) * (unsigned)U.ostride + (unsigned)((lane_e & 15) * 8); const unsigned gstep = 4u * (unsigned)U.ostride;
#pragma unroll
    for (int i = 0; i < 8; ++i) { const u32x4 w = *(const u32x4*)(ip + i * 1024); *(u32x4*)(U.O + goff) = w; goff += gstep; } }
  __syncthreads();
#undef ROWOF
#undef SLOAD
#undef SWRITE
#undef SWAIT
#undef QK_SCHED
#undef RESC
#undef MASKB
}

constexpr int SHM_RING = 3 * SHM_V + 2 * SHM_K + NW * 64 * 4;
__device__ __forceinline__ void attn_unit_ring(const Unit& U, char* lds, const int tid) {
  const int wid = tid >> 6, lane = tid & 63, r32 = lane & 31, hi = lane >> 5;
  char* V_lds = lds; char* K_lds = lds + 3 * SHM_V;
  float* ws = (float*)(lds + 3 * SHM_V + 2 * SHM_K) + wid * 64; float* li_l = ws;
  float m_reg = 0.f, l_reg = 0, mn_, al_ = 1.f; f32x16 o[4] = {}; bf16x8 qr[8];
  { const unsigned qoff = (unsigned)(wid * QBLK + r32) * (unsigned)U.qstride + (unsigned)(hi * 8);
#pragma unroll
    for (int d0 = 0; d0 < 8; ++d0) qr[d0] = *reinterpret_cast<const bf16x8*>(U.Q + qoff + d0 * 16); }
  const int sr = tid >> 4, sc = (tid & 15) * 8, vst0 = v_st(sr, sc), vst1 = v_st(32 + sr, sc);
  const int vb0 = (int)(uintptr_t)V_lds + v_rd_base(lane);
  struct { bf16x8 vs0, vs1, ks0, ks1; } sr_[1];
#define SLOAD(i, k0) do { const unsigned _o0 = (unsigned)((k0) + sr) * (unsigned)U.kstride + (unsigned)sc, _o1 = _o0 + 32u * (unsigned)U.kstride; \
    sr_[i].vs0 = *reinterpret_cast<const bf16x8*>(U.V + _o0); sr_[i].vs1 = *reinterpret_cast<const bf16x8*>(U.V + _o1); \
    sr_[i].ks0 = *reinterpret_cast<const bf16x8*>(U.K + _o0); sr_[i].ks1 = *reinterpret_cast<const bf16x8*>(U.K + _o1); } while (0)
#define SWRITE(kb, vsl, i) do { char* _v = V_lds + (vsl) * SHM_V; *(bf16x8*)(_v + vst0) = sr_[i].vs0; *(bf16x8*)(_v + vst1) = sr_[i].vs1; int kc = sc * 2; \
    *(bf16x8*)(K_lds + (kb) * SHM_K + KSWZ(sr, kc)) = sr_[i].ks0; *(bf16x8*)(K_lds + (kb) * SHM_K + KSWZ(32 + sr, kc)) = sr_[i].ks1; } while (0)
#define NEXT3(x) ((x) == 2 ? 0 : (x) + 1)
  f32x16 pA0, pA1, pB0, pB1; bf16x8 pa0, pa1, pa2, pa3; const int NT = U.NT;
  SLOAD(0, 0); SWRITE(0, 0, 0); SLOAD(0, KVBLK);
  __syncthreads();
  SWRITE(1, 1, 0); SLOAD(0, 2 * KVBLK);
  qkt<(QKT_PREFETCH != 0)>(pA0, pA1, K_lds, qr, r32, hi); partialSM<2>(pA0, pA1, m_reg, mn_, al_);
  __syncthreads();
  int vr = 0;
  for (int j = 1; j + 1 < NT; j += 2) {
    { const int vw = NEXT3(NEXT3(vr));
      SWRITE(0, vw, 0); SLOAD(0, (j + 2) * KVBLK);
      SBAR(); qkt<(QKT_PREFETCH != 0)>(pB0, pB1, K_lds + SHM_K, qr, r32, hi);
      finishSM<2>(pA0, pA1, al_, l_reg, pa0, pa1, pa2, pa3); SBAR();
      pv_d0(o, vb0 + vr * SHM_V, pa0, pa1, pa2, pa3); partialSM<2>(pB0, pB1, m_reg, mn_, al_);
      __syncthreads(); vr = NEXT3(vr); }
    { const int vw = NEXT3(NEXT3(vr));
      SWRITE(1, vw, 0); if (j + 3 < NT) SLOAD(0, (j + 3) * KVBLK);
      SBAR(); qkt<(QKT_PREFETCH != 0)>(pA0, pA1, K_lds, qr, r32, hi);
      finishSM<2>(pB0, pB1, al_, l_reg, pa0, pa1, pa2, pa3); SBAR();
      pv_d0(o, vb0 + vr * SHM_V, pa0, pa1, pa2, pa3); partialSM<2>(pA0, pA1, m_reg, mn_, al_);
      __syncthreads(); vr = NEXT3(vr); }
  }
  SBAR(); qkt<(QKT_PREFETCH != 0)>(pB0, pB1, K_lds + SHM_K, qr, r32, hi);
  finishSM<2>(pA0, pA1, al_, l_reg, pa0, pa1, pa2, pa3); SBAR();
  pv_d0(o, vb0 + vr * SHM_V, pa0, pa1, pa2, pa3); partialSM<2>(pB0, pB1, m_reg, mn_, al_);
  finishSM<2>(pB0, pB1, al_, l_reg, pa0, pa1, pa2, pa3); SBAR();
  pv_d0(o, vb0 + NEXT3(vr) * SHM_V, pa0, pa1, pa2, pa3);
  int lane_e = lane; asm volatile("" : "+v"(lane_e));
  const int r32e = lane_e & 31, hie = lane_e >> 5;
  if (hie == 0) li_l[r32e] = l_reg; asm volatile("s_waitcnt lgkmcnt(0)" ::: "memory");
  float rli[16];
#pragma unroll
  for (int r = 0; r < 16; ++r) rli[r] = __builtin_amdgcn_rcpf(li_l[crow(r, hie)]);
  __syncthreads();
  char* ost = lds + wid * 8192;
  { char* op = ost + hie * 1024 + r32e * 2;
#pragma unroll
    for (int r = 0; r < 16; ++r) {
#pragma unroll
      for (int d0 = 0; d0 < 4; ++d0) { const unsigned w = cvtpk(o[d0][r] * rli[r], 0.f); *(unsigned short*)(op + ((r & 3) + 8 * (r >> 2)) * 256 + d0 * 64) = (unsigned short)w; } } }
  asm volatile("s_waitcnt lgkmcnt(0)" ::: "memory");
  { const char* ip = ost + (lane_e >> 4) * 256 + (lane_e & 15) * 16;
    unsigned goff = (unsigned)(wid * QBLK + (lane_e >> 4)) * (unsigned)U.ostride + (unsigned)((lane_e & 15) * 8); const unsigned gstep = 4u * (unsigned)U.ostride;
#pragma unroll
    for (int i = 0; i < 8; ++i) { const u32x4 w = *(const u32x4*)(ip + i * 1024); *(u32x4*)(U.O + goff) = w; goff += gstep; } }
  __syncthreads();
#undef SLOAD
#undef SWRITE
#undef NEXT3
}

constexpr int DMA_KOFF = 0, DMA_VOFF = 3 * SHM_K, DMA_SCR = 3 * SHM_K + 4 * SHM_V, SHM_DMA = DMA_SCR + NW * 64 * 4;
typedef __attribute__((address_space(3))) unsigned char lds_u8;
__device__ __forceinline__ void attn_unit_dma(const Unit& U, char* lds, lds_u8* ldsl, const int tid) {
  const int wid = __builtin_amdgcn_readfirstlane(tid >> 6), lane = tid & 63, r32 = lane & 31, hi = lane >> 5;
  char* K_lds = lds + DMA_KOFF; char* V_lds = lds + DMA_VOFF;
  float* ws = (float*)(lds + DMA_SCR) + wid * 64; float* li_l = ws;
  float m_reg = 0.f, l_reg = 0, mn_, al_ = 1.f; f32x16 o[4] = {}; bf16x8 qr[8];
  { int lq_ = lane; asm volatile("" : "+v"(lq_));
    const unsigned qoff = (unsigned)(wid * QBLK + (lq_ & 31)) * (unsigned)U.qstride + (unsigned)((lq_ >> 5) * 8);
#pragma unroll
    for (int d0 = 0; d0 < 8; ++d0) qr[d0] = *reinterpret_cast<const bf16x8*>(U.Q + qoff + d0 * 16); }
  unsigned koff[2], voff[2];
#pragma unroll
  for (int i = 0; i < 2; ++i) { const int p = (wid * 2 + i) * 64 + lane;
    { const int row = p >> 4, cs = p & 15, c = cs ^ (row & 7); koff[i] = ((unsigned)row * (unsigned)U.kstride + (unsigned)(c * 8)) * 2u; }
    { const int st = p >> 5, q = p & 31, kk = (st >> 2) * 8 + (q >> 2), key = (kk & ~0xC) | ((kk & 4) << 1) | ((kk & 8) >> 1), c = (st & 3) * 32 + (q & 3) * 8; voff[i] = ((unsigned)key * (unsigned)U.kstride + (unsigned)c) * 2u; } }
  const int vb0 = (int)(uintptr_t)V_lds + v_rd_base(lane);
  const unsigned ldsw = (unsigned)wid * 2048u;
#define NEXT3(x) ((x) == 2 ? 0 : (x) + 1)
#define NEXT4(x) (((x) + 1) & 3)
#define DMA_TILE(t, ks, vs) do { const int t_ = (t); const char* kb_ = (const char*)(U.K + (size_t)t_ * KVBLK * U.kstride); const char* vb_ = (const char*)(U.V + (size_t)t_ * KVBLK * U.kstride); \
    _Pragma("unroll") for (int i_ = 0; i_ < 2; ++i_) { \
      __builtin_amdgcn_global_load_lds((const unsigned*)(kb_ + koff[i_]), (__attribute__((address_space(3))) unsigned*)(ldsl + DMA_KOFF + (ks) * SHM_K + ldsw + i_ * 1024), 16, 0, 0); \
      __builtin_amdgcn_global_load_lds((const unsigned*)(vb_ + voff[i_]), (__attribute__((address_space(3))) unsigned*)(ldsl + DMA_VOFF + (vs) * SHM_V + ldsw + i_ * 1024), 16, 0, 0); } } while (0)
#define STEP_BAR() do { asm volatile("s_waitcnt vmcnt(4) lgkmcnt(0)" ::: "memory"); __builtin_amdgcn_s_barrier(); asm volatile("" ::: "memory"); } while (0)
#define STEP_BAR0() do { asm volatile("s_waitcnt vmcnt(0) lgkmcnt(0)" ::: "memory"); __builtin_amdgcn_s_barrier(); asm volatile("" ::: "memory"); } while (0)
  f32x16 pA0, pA1, pB0, pB1; bf16x8 pa0, pa1, pa2, pa3; const int NT = U.NT;
  asm volatile("s_waitcnt vmcnt(0)" ::: "memory");
  DMA_TILE(0, 0, 0); DMA_TILE(1, 1, 1);
  STEP_BAR();
  DMA_TILE(2, 2, 2);
  qkt<(QKT_PREFETCH != 0)>(pA0, pA1, K_lds, qr, r32, hi); partialSM<2>(pA0, pA1, m_reg, mn_, al_);
  STEP_BAR();
  int ks = 1, vs = 1;
  for (int j = 1; j + 1 < NT; j += 2) {
    { const int kw = NEXT3(NEXT3(ks)), vw = NEXT4(NEXT4(vs));
      const bool more_ = j + 2 < NT; if (more_) DMA_TILE(j + 2, kw, vw);
      SBAR(); qkt<(QKT_PREFETCH != 0)>(pB0, pB1, K_lds + ks * SHM_K, qr, r32, hi);
      finishSM<2>(pA0, pA1, al_, l_reg, pa0, pa1, pa2, pa3); SBAR();
      pv_d0(o, vb0 + ((vs + 3) & 3) * SHM_V, pa0, pa1, pa2, pa3); partialSM<2>(pB0, pB1, m_reg, mn_, al_);
      if (more_) STEP_BAR(); else STEP_BAR0(); ks = NEXT3(ks); vs = NEXT4(vs); }
    { const int kw = NEXT3(NEXT3(ks)), vw = NEXT4(NEXT4(vs));
      const bool more_ = j + 3 < NT; if (more_) DMA_TILE(j + 3, kw, vw);
      SBAR(); qkt<(QKT_PREFETCH != 0)>(pA0, pA1, K_lds + ks * SHM_K, qr, r32, hi);
      finishSM<2>(pB0, pB1, al_, l_reg, pa0, pa1, pa2, pa3); SBAR();
      pv_d0(o, vb0 + ((vs + 3) & 3) * SHM_V, pa0, pa1, pa2, pa3); partialSM<2>(pA0, pA1, m_reg, mn_, al_);
      if (more_) STEP_BAR(); else STEP_BAR0(); ks = NEXT3(ks); vs = NEXT4(vs); }
  }
  SBAR(); qkt<(QKT_PREFETCH != 0)>(pB0, pB1, K_lds + ks * SHM_K, qr, r32, hi);
  finishSM<2>(pA0, pA1, al_, l_reg, pa0, pa1, pa2, pa3); SBAR();
  pv_d0(o, vb0 + ((vs + 3) & 3) * SHM_V, pa0, pa1, pa2, pa3); partialSM<2>(pB0, pB1, m_reg, mn_, al_);
  finishSM<2>(pB0, pB1, al_, l_reg, pa0, pa1, pa2, pa3); SBAR();
  pv_d0(o, vb0 + vs * SHM_V, pa0, pa1, pa2, pa3);
  asm volatile("s_waitcnt vmcnt(0) lgkmcnt(0)" ::: "memory");
  int lane_e = lane; asm volatile("" : "+v"(lane_e));
  const int r32e = lane_e & 31, hie = lane_e >> 5;
  if (hie == 0) li_l[r32e] = l_reg; asm volatile("s_waitcnt lgkmcnt(0)" ::: "memory");
  float rli[16];
#pragma unroll
  for (int r = 0; r < 16; ++r) rli[r] = __builtin_amdgcn_rcpf(li_l[crow(r, hie)]);
  __syncthreads();
  char* ost = lds + wid * 8192;
  { char* op = ost + hie * 1024 + r32e * 2;
#pragma unroll
    for (int r = 0; r < 16; ++r) {
#pragma unroll
      for (int d0 = 0; d0 < 4; ++d0) { const unsigned w = cvtpk(o[d0][r] * rli[r], 0.f); *(unsigned short*)(op + ((r & 3) + 8 * (r >> 2)) * 256 + d0 * 64) = (unsigned short)w; } } }
  asm volatile("s_waitcnt lgkmcnt(0)" ::: "memory");
  { const char* ip = ost + (lane_e >> 4) * 256 + (lane_e & 15) * 16;
    unsigned goff = (unsigned)(wid * QBLK + (lane_e >> 4)) * (unsigned)U.ostride + (unsigned)((lane_e & 15) * 8); const unsigned gstep = 4u * (unsigned)U.ostride;
#pragma unroll
    for (int i = 0; i < 8; ++i) { const u32x4 w = *(const u32x4*)(ip + i * 1024); *(u32x4*)(U.O + goff) = w; goff += gstep; } }
  __syncthreads();
#undef NEXT3
#undef NEXT4
#undef DMA_TILE
#undef STEP_BAR
#undef STEP_BAR0
}
}

constexpr int NWAVES = 8;
constexpr int DM = 2048, SEQ = 16384, NSEQ = 3, M_ALL = NSEQ * SEQ, DEPTH = 4, DFF = 5632, INC = 13824;
constexpr int A_Q = 0, A_K = 1536, A_V = 3072, B_Q = 4608, B_K = 5632, B_V = 5888, C_Q = 6144, C_K = 7168, C_V = 7424, GL0 = 7680;
constexpr float NORM_EPS = 1e-6f;
enum { I_XP = 0, I_XS, I_NF1, I_F1IN, I_F1OUT, I_NMIX, I_WIN, I_QNQ, I_QNK, I_SINK, I_WA, I_WB, I_WC, I_WO, I_NF2, I_F2IN, I_F2OUT, I_NFIN, N_IN };

constexpr size_t MiB = 1u << 20;
constexpr size_t WS_CTL = 0, CTL_ZERO_BYTES = 1 * MiB;
constexpr int LDW = DM + LDW_PAD, LDU = DM + LDU_PAD;
constexpr size_t WL_F1IN = 0, WL_F1OUT = WL_F1IN + (size_t)2 * DFF * LDW * 2, WL_WIN = WL_F1OUT + (size_t)DM * DFF * 2, WL_WA = WL_WIN + (size_t)INC * LDW * 2,
                 WL_WB = WL_WA + (size_t)DM * 512 * 2, WL_WC = WL_WB + (size_t)DM * 1024 * 2, WL_WO = WL_WC + (size_t)DM * 1024 * 2, WL_F2IN = WL_WO + (size_t)DM * LDW * 2,
                 WL_F2OUT = WL_F2IN + (size_t)2 * DFF * LDW * 2, WL_BYTES = WL_F2OUT + (size_t)DM * DFF * 2;
constexpr size_t WS_W = 1 * MiB;
constexpr size_t WS_U = WS_W + DEPTH * WL_BYTES;
constexpr size_t WS_R = WS_U + (size_t)M_ALL * LDU * 2;
constexpr size_t WS_H = WS_R;
constexpr size_t WS_QKVG = WS_R;
constexpr int OCAT = 2560;
constexpr size_t WS_OCAT = WS_QKVG + (size_t)SEQ * INC * 2;
constexpr size_t WS_OA = WS_OCAT, WS_OB = WS_OCAT + 512 * 2, WS_OC = WS_OCAT + 1536 * 2;
constexpr size_t WS_PA = WS_OCAT + (size_t)SEQ * OCAT * 2;
constexpr size_t WS_LSE = WS_PA + (size_t)3 * SEQ * 512 * 2;
constexpr size_t WS_QB = WS_LSE + (size_t)3 * SEQ * 4 * 4;
constexpr size_t WS_KB = WS_QB + (size_t)SEQ * 1024 * 2;
constexpr size_t WS_VB = WS_KB + (size_t)SEQ * 256 * 2;
constexpr size_t WS_MG = WS_VB + (size_t)SEQ * 256 * 2;
constexpr size_t WS_MB = WS_MG + (size_t)SEQ * DM * 4;
constexpr size_t WS_MIX_END = WS_MB + (size_t)SEQ * LDU * 2;
constexpr int LDH = DFF + LDH_PAD;
constexpr size_t WS_H_END = WS_H + (size_t)M_ALL * LDH * 2;
constexpr size_t WS_END = WS_MIX_END > WS_H_END ? WS_MIX_END : WS_H_END;
constexpr int CW_BAR = 4096;

constexpr int RING_OFF = 0, RING_BYTES = 131072;
constexpr int LDSCTL_OFF = RING_BYTES, MISC_OFF = LDSCTL_OFF + 320;
constexpr int LDS_BYTES = 147456;
constexpr int DIAG_OFF = MISC_OFF + 256;

#define GAS __attribute__((address_space(1)))
#define LAS __attribute__((address_space(3)))
typedef unsigned short bf16;
typedef unsigned v4u __attribute__((ext_vector_type(4)));
typedef unsigned v2u __attribute__((ext_vector_type(2)));
typedef float f32x4 __attribute__((ext_vector_type(4)));
#define LDS_WAIT() asm volatile("s_waitcnt lgkmcnt(0)" ::: "memory")
#define VM_WAIT() asm volatile("s_waitcnt vmcnt(0)" ::: "memory")
__device__ __forceinline__ unsigned f2bf(float f) { unsigned u = __builtin_bit_cast(unsigned, f); return (u + 0x7fffu + ((u >> 16) & 1u)) >> 16; }
__device__ __forceinline__ unsigned pk2(float lo, float hi) { return f2bf(lo) | (f2bf(hi) << 16); }
__device__ __forceinline__ float bflo(unsigned w) { return __uint_as_float(w << 16); }
__device__ __forceinline__ float bfhi(unsigned w) { return __uint_as_float(w & 0xffff0000u); }

#define XB_TMO      128
#define XB_XCNT(j)  (256  + 64 * (j))
#define XB_XSUB(j)  (1280 + 64 * (j))
#define XB_XGEN(j)  (2304 + 64 * (j))
#define XB_TOP      3328
#define XB_TOPGEN   3392
#define XCD_BAR_WORDS 3456
#define XB_SPIN_CAP (1u << 18)
__device__ __forceinline__ unsigned xb_ld(unsigned* p)              { return __hip_atomic_load(p, __ATOMIC_RELAXED, __HIP_MEMORY_SCOPE_AGENT); }
__device__ __forceinline__ unsigned xb_add(unsigned* p, unsigned v) { return __hip_atomic_fetch_add(p, v, __ATOMIC_RELAXED, __HIP_MEMORY_SCOPE_AGENT); }
__device__ __forceinline__ unsigned xb_xcc_id() { return (unsigned)__builtin_amdgcn_s_getreg((3 << 11) | 20) & 0xFu; }
#define XB_SPIN(cond, bar) do { unsigned _sp = 0; while (cond) { __builtin_amdgcn_s_sleep(1); \
    if ((++_sp & 255u) == 0u) { if (xb_ld(&(bar)[XB_TMO])) break; if (_sp > XB_SPIN_CAP) { atomicAdd(&(bar)[XB_TMO], 1u); break; } } } } while (0)
struct XcdBarrier { unsigned* bar; unsigned x; volatile LAS unsigned* st; };
__device__ __forceinline__ XcdBarrier xcd_barrier_post(unsigned* bar, volatile LAS unsigned* st) {
    XcdBarrier b; b.bar = bar; b.x = xb_xcc_id(); b.st = st;
    if (threadIdx.x == 0) (void)xb_add(&bar[XB_XCNT(b.x)], 1u);
    return b;
}
__device__ __forceinline__ void xcd_barrier_complete(unsigned* bar, unsigned x, unsigned& nloc, unsigned& nx) {
    const unsigned G = gridDim.x * gridDim.y * gridDim.z;
    unsigned sum, cnt, mine, sp = 0u;
    for (;;) {
        sum = 0u; cnt = 0u; mine = 0u;
#pragma unroll
        for (unsigned j = 0; j < 16; ++j) { const unsigned c = xb_ld(&bar[XB_XCNT(j)]); sum += c; cnt += (c > 0u) ? 1u : 0u; mine = (j == x) ? c : mine; }
        if (sum == G) break;
        __builtin_amdgcn_s_sleep(1);
        if ((++sp & 255u) == 0u) { if (xb_ld(&bar[XB_TMO])) break; if (sp > XB_SPIN_CAP) { atomicAdd(&bar[XB_TMO], 1u); break; } }
    }
    nloc = mine > 0u ? mine : 1u; nx = cnt > 0u ? cnt : 1u;
}
__device__ __forceinline__ void xcd_barrier(const XcdBarrier& b) {
    asm volatile("s_waitcnt vmcnt(0)" ::: "memory");
    __syncthreads();
    if (threadIdx.x == 0) {
        unsigned* bar = b.bar;
        __builtin_amdgcn_s_waitcnt(0);
        unsigned nloc = b.st[0], nx = b.st[1];
        if (nloc == 0u) { xcd_barrier_complete(bar, b.x, nloc, nx); b.st[0] = nloc; b.st[1] = nx; }
        const unsigned old = xb_add(&bar[XB_XSUB(b.x)], 1u);
        const unsigned gen = old / nloc;
        if (old + 1u == (gen + 1u) * nloc) {
            __builtin_amdgcn_fence(__ATOMIC_RELEASE, "agent");
            asm volatile("s_waitcnt vmcnt(0)" ::: "memory");
            const unsigned og = xb_add(&bar[XB_TOP], 1u);
            const unsigned tg = og / nx;
            if (og + 1u == (tg + 1u) * nx) xb_add(&bar[XB_TOPGEN], 1u);
            else XB_SPIN(xb_ld(&bar[XB_TOPGEN]) == tg, bar);
            __builtin_amdgcn_fence(__ATOMIC_ACQUIRE, "agent");
            xb_add(&bar[XB_XGEN(b.x)], 1u);
            asm volatile("s_waitcnt vmcnt(0)" ::: "memory");
        } else {
            XB_SPIN(xb_ld(&bar[XB_XGEN(b.x)]) == gen, bar);
            __builtin_amdgcn_fence(__ATOMIC_ACQUIRE, "agent");
            asm volatile("s_waitcnt vmcnt(0)" ::: "memory");
        }
    }
    __syncthreads();
}

template <int XOR> __device__ __forceinline__ float swz_xor(float v) { return __int_as_float(__builtin_amdgcn_ds_swizzle(__float_as_int(v), (XOR << 10) | 0x1F)); }
__device__ __forceinline__ float wave_sum(float v) {
    v += swz_xor<1>(v); v += swz_xor<2>(v); v += swz_xor<4>(v); v += swz_xor<8>(v); v += swz_xor<16>(v);
    auto rr = __builtin_amdgcn_permlane32_swap(__float_as_uint(v), __float_as_uint(v), false, false);
    return __uint_as_float(rr[0]) + __uint_as_float(rr[1]);
}
__device__ __forceinline__ float wave_max(float v) {
    v = fmaxf(v, swz_xor<1>(v)); v = fmaxf(v, swz_xor<2>(v)); v = fmaxf(v, swz_xor<4>(v)); v = fmaxf(v, swz_xor<8>(v)); v = fmaxf(v, swz_xor<16>(v));
    auto rr = __builtin_amdgcn_permlane32_swap(__float_as_uint(v), __float_as_uint(v), false, false);
    return fmaxf(__uint_as_float(rr[0]), __uint_as_float(rr[1]));
}
__device__ __forceinline__ void transpose_item(const float* W, int K, int N, bf16* WT, int k0, int n0, int orow0, LAS float* scr, int lane, int ldw) {
#pragma unroll 8
    for (int i = 0; i < 32; ++i) { const int kk = 2 * i + (lane >> 5); scr[kk * 33 + (lane & 31)] = W[(size_t)(k0 + kk) * N + n0 + (lane & 31)]; }
    LDS_WAIT(); asm volatile("" ::: "memory");
    const int c = lane & 7;
#pragma unroll
    for (int j = 0; j < 4; ++j) { const int n = (lane >> 3) + 8 * j; const LAS float* s = scr + (8 * c) * 33 + n;
        v4u o; o.x = pk2(s[0 * 33], s[1 * 33]); o.y = pk2(s[2 * 33], s[3 * 33]); o.z = pk2(s[4 * 33], s[5 * 33]); o.w = pk2(s[6 * 33], s[7 * 33]);
        *(GAS v4u*)(WT + (size_t)(orow0 + n) * ldw + k0 + 8 * c) = o; }
    LDS_WAIT(); asm volatile("" ::: "memory");
}
__device__ __forceinline__ void transpose_matrix(const float* W, int K, int N, bf16* WT, int swiglu, LAS float* scr, int lane, int gw, int NGW, int ldw = 0) {
    const int nblk = N / 32, nitems = (K / 64) * nblk;
    for (int it = gw; it < nitems; it += NGW) {
        const int kb = it / nblk, nb = it % nblk, k0 = 64 * kb, n0 = 32 * nb;
        int orow0 = n0;
        if (swiglu) { const int half = n0 >= DFF ? 1 : 0, np = n0 - half * DFF; orow0 = 256 * (np / 128) + 128 * half + (np % 128); }
        transpose_item(W, K, N, WT, k0, n0, orow0, scr, lane, ldw ? ldw : K);
    }
}
__device__ __forceinline__ void rms_row_to_bf16(const float* xrow, const float* g, bf16* orow, float* xcopy, int lane) {
    const GAS f32x4* xr = (const GAS f32x4*)xrow + lane; const GAS f32x4* gr = (const GAS f32x4*)g + lane;
    f32x4 v[8]; float s = 0.f;
#pragma unroll
    for (int j = 0; j < 8; ++j) { v[j] = xr[64 * j]; s += (v[j].x * v[j].x + v[j].y * v[j].y) + (v[j].z * v[j].z + v[j].w * v[j].w); }
    if (xcopy) { GAS f32x4* xc = (GAS f32x4*)xcopy + lane;
#pragma unroll
        for (int j = 0; j < 8; ++j) xc[64 * j] = v[j]; }
    const float rstd = __builtin_amdgcn_rsqf(wave_sum(s) * (1.f / DM) + NORM_EPS);
    GAS v2u* o8 = (GAS v2u*)orow + lane;
#pragma unroll
    for (int j = 0; j < 8; ++j) { const f32x4 gg = gr[64 * j]; v2u w; w.x = pk2(v[j].x * rstd * gg.x, v[j].y * rstd * gg.y); w.y = pk2(v[j].z * rstd * gg.z, v[j].w * rstd * gg.w); o8[64 * j] = w; }
}
__device__ __forceinline__ void rms_row_f32(float* xrow, const float* g, int lane) {
    GAS f32x4* xr = (GAS f32x4*)xrow + lane; const GAS f32x4* gr = (const GAS f32x4*)g + lane;
    f32x4 v[8]; float s = 0.f;
#pragma unroll
    for (int j = 0; j < 8; ++j) { v[j] = xr[64 * j]; s += (v[j].x * v[j].x + v[j].y * v[j].y) + (v[j].z * v[j].z + v[j].w * v[j].w); }
    const float rstd = __builtin_amdgcn_rsqf(wave_sum(s) * (1.f / DM) + NORM_EPS);
#pragma unroll
    for (int j = 0; j < 8; ++j) { const f32x4 gg = gr[64 * j]; xr[64 * j] = v[j] * rstd * gg; }
}
constexpr float QPRESCALE = 0.088388347648318440f * 1.4426950408889634f;
template <int NT_>
__device__ __forceinline__ void ropeB_tokens(const bf16* qkvg, int t0, int tstep, const float* gq, const float* gk, bf16* qb, bf16* kb, bf16* vb, int lane) {
    const int f = lane & 31;
    const float invrev = __builtin_amdgcn_exp2f((float)f * (-13.287712379549449f / 32.0f)) * 0.15915494309189535f;
    const float gq0 = gq[2 * lane], gq1 = gq[2 * lane + 1], gk0 = gk[2 * lane], gk1 = gk[2 * lane + 1];
    unsigned w[NT_][10]; v2u vv[NT_];
#pragma unroll
    for (int i = 0; i < NT_; ++i) { const int t = t0 + i * tstep; const GAS unsigned* src = (const GAS unsigned*)(qkvg + (size_t)t * INC + B_Q) + lane;
#pragma unroll
        for (int h = 0; h < 10; ++h) w[i][h] = src[h * 64];
        vv[i] = ((const GAS v2u*)(qkvg + (size_t)t * INC + B_V))[lane]; }
#pragma unroll
    for (int i = 0; i < NT_; ++i) { const int t = t0 + i * tstep;
        const float pos = (float)((lane < 32) ? (t >> 6) : (t & 63));
        float rev = pos * invrev; rev = rev - __builtin_floorf(rev);
        const float cs = __builtin_amdgcn_cosf(rev), sn = __builtin_amdgcn_sinf(rev);
#pragma unroll
        for (int h = 0; h < 10; ++h) {
            const float x0 = bflo(w[i][h]), x1 = bfhi(w[i][h]);
            const float rstd = __builtin_amdgcn_rsqf(wave_sum(x0 * x0 + x1 * x1) * (1.f / 128.f) + NORM_EPS);
            const float y0 = x0 * rstd * (h < 8 ? gq0 : gk0), y1 = x1 * rstd * (h < 8 ? gq1 : gk1);
            const float qs = h < 8 ? QPRESCALE : 1.0f;
            const unsigned o = pk2((y0 * cs - y1 * sn) * qs, (y0 * sn + y1 * cs) * qs);
            if (h < 8) ((GAS unsigned*)(qb + (size_t)t * 1024))[h * 64 + lane] = o; else ((GAS unsigned*)(kb + (size_t)t * 256))[(h - 8) * 64 + lane] = o;
        }
        ((GAS v2u*)(vb + (size_t)t * 256))[lane] = vv[i]; }
}
__device__ __forceinline__ void mergeA_token(const bf16* pa, const float* lse, bf16* oa, int t, int lane) {
#pragma unroll
    for (int hh = 0; hh < 4; ++hh) {
        const float l0 = lse[((size_t)0 * SEQ + t) * 4 + hh], l1 = lse[((size_t)1 * SEQ + t) * 4 + hh], l2 = lse[((size_t)2 * SEQ + t) * 4 + hh];
        const float mx = fmaxf(l0, fmaxf(l1, l2));
        const float e0 = __builtin_amdgcn_exp2f((l0 - mx) * 1.4426950408889634f), e1 = __builtin_amdgcn_exp2f((l1 - mx) * 1.4426950408889634f), e2 = __builtin_amdgcn_exp2f((l2 - mx) * 1.4426950408889634f);
        const float inv = __builtin_amdgcn_rcpf(e0 + e1 + e2);
        const unsigned w0 = ((const GAS unsigned*)(pa + ((size_t)0 * SEQ + t) * 512))[hh * 64 + lane], w1 = ((const GAS unsigned*)(pa + ((size_t)1 * SEQ + t) * 512))[hh * 64 + lane],
                       w2 = ((const GAS unsigned*)(pa + ((size_t)2 * SEQ + t) * 512))[hh * 64 + lane];
        const float a = (e0 * bflo(w0) + e1 * bflo(w1) + e2 * bflo(w2)) * inv, b = (e0 * bfhi(w0) + e1 * bfhi(w1) + e2 * bfhi(w2)) * inv;
        ((GAS unsigned*)(oa + (size_t)t * OCAT))[hh * 64 + lane] = pk2(a, b);
    }
}

struct Args { const float* in[N_IN]; float* out; unsigned char* ws; int ph_lo, ph_hi; };
constexpr int N_PHASES = 1 + DEPTH * (3 + 1 + NSEQ * 5 + 3) + 1;

__device__ __forceinline__ int opq_v(int x) { asm volatile("" : "+v"(x)); return x; }
template <class T> __device__ __forceinline__ T* opq_p(T* p) { GAS T* g = (GAS T*)p; asm volatile("" : "+s"(g)); return (T*)g; }
__device__ __forceinline__ int lane_id_asm() { int l; asm volatile("v_mbcnt_lo_u32_b32 %0, -1, 0\n\tv_mbcnt_hi_u32_b32 %0, -1, %0" : "=v"(l)); return l; }
__device__ __forceinline__ int opq_s(int x) { asm volatile("" : "+s"(x)); return x; }

__global__ void __launch_bounds__(NWAVES * 64, 2) trunk_fwd(Args args) {
    extern __shared__ __attribute__((aligned(16))) unsigned char lds[];
    LAS unsigned char* ldsl = (LAS unsigned char*)lds;
    volatile LAS unsigned* MISC = (volatile LAS unsigned*)(ldsl + MISC_OFF);
    const int G_k = gridDim.x; const int bx_k = blockIdx.x;
    const int wave0 = __builtin_amdgcn_readfirstlane((int)threadIdx.x >> 6);
    { const int tid0 = threadIdx.x;
      for (int u = tid0; u < (LDS_BYTES - LDSCTL_OFF) / 4; u += NWAVES * 64) ((LAS unsigned*)(ldsl + LDSCTL_OFF))[u] = 0u; }
    __syncthreads();
    XcdBarrier bar; bar.bar = (unsigned*)(args.ws + WS_CTL) + CW_BAR; bar.x = 0; bar.st = nullptr;
    if (!MK_PER_PHASE) bar = xcd_barrier_post((unsigned*)(args.ws + WS_CTL) + CW_BAR, MISC + 8);
    const int lo = args.ph_lo, hi = args.ph_hi;
    int ph = 0;
#define PH_ON (ph >= lo && ph < hi)
#define PH_VARS const int G = opq_s(G_k), bx = opq_s(bx_k), vcu = (G % 8 == 0) ? (bx % 8) * (G / 8) + bx / 8 : bx, NGW = G * NWAVES; (void)NGW; const int lane = lane_id_asm(), wave = wave0, tid = wave * 64 + lane, gw = vcu * NWAVES + wave; unsigned char* ws = opq_p(args.ws); float* X = opq_p(args.out); (void)lane; (void)gw; (void)ws; (void)X
#if DIAG
#define PH_STAMP(ty) do { if (bx_k == 0 && wave0 == 0 && lane_id_asm() == 0) { const unsigned long long t_ = __builtin_amdgcn_s_memrealtime(); volatile LAS unsigned long long* ts_ = (volatile LAS unsigned long long*)(ldsl + DIAG_OFF); \
    ts_[1 + (ty)] += t_ - ts_[0]; ts_[0] = t_; } } while (0)
#else
#define PH_STAMP(ty) do { } while (0)
#endif
#define PH_DUP(ty) ((ty) == DUP_TYPE)
#define GRID_BARRIER() do { XcdBarrier b2_ = bar; b2_.bar = opq_p(bar.bar); b2_.x = (unsigned)opq_s((int)bar.x); xcd_barrier(b2_); } while (0)
#define PH_BEGIN(ty) if (PH_ON) { for (int rep_ = 0; rep_ < (PH_DUP(ty) ? 2 : 1); ++rep_) { PH_VARS; (void)rep_;
#define PH_CLOSE(ty) if (PH_DUP(ty) && rep_ == 0) GRID_BARRIER(); } } PH_END(ty)
#define PH_END(ty) do { if (PH_ON && ph + 1 < hi) { XcdBarrier b2_ = bar; b2_.bar = opq_p(bar.bar); b2_.x = (unsigned)opq_s((int)bar.x); xcd_barrier(b2_); } if (PH_ON) PH_STAMP(ty); ++ph; } while (0)

    PH_BEGIN(0)

        LAS float* scr = (LAS float*)(ldsl + RING_OFF + wave * 16384);
        for (int l = 0; l < DEPTH; ++l) {
            unsigned char* wl = ws + WS_W + (size_t)l * WL_BYTES;
            transpose_matrix(args.in[I_F1IN] + (size_t)l * DM * 2 * DFF, DM, 2 * DFF, (bf16*)(wl + WL_F1IN), 1, scr, lane, gw, NGW, LDW);
            transpose_matrix(args.in[I_F1OUT] + (size_t)l * DFF * DM, DFF, DM, (bf16*)(wl + WL_F1OUT), 0, scr, lane, gw, NGW);
            transpose_matrix(args.in[I_WIN] + (size_t)l * DM * INC, DM, INC, (bf16*)(wl + WL_WIN), 0, scr, lane, gw, NGW, LDW);
            transpose_matrix(args.in[I_WA] + (size_t)l * 512 * DM, 512, DM, (bf16*)(wl + WL_WA), 0, scr, lane, gw, NGW, OCAT);
            transpose_matrix(args.in[I_WB] + (size_t)l * 1024 * DM, 1024, DM, (bf16*)(wl + WL_WA) + 512, 0, scr, lane, gw, NGW, OCAT);
            transpose_matrix(args.in[I_WC] + (size_t)l * 1024 * DM, 1024, DM, (bf16*)(wl + WL_WA) + 1536, 0, scr, lane, gw, NGW, OCAT);
            transpose_matrix(args.in[I_WO] + (size_t)l * DM * DM, DM, DM, (bf16*)(wl + WL_WO), 0, scr, lane, gw, NGW, LDW);
            transpose_matrix(args.in[I_F2IN] + (size_t)l * DM * 2 * DFF, DM, 2 * DFF, (bf16*)(wl + WL_F2IN), 1, scr, lane, gw, NGW, LDW);
            transpose_matrix(args.in[I_F2OUT] + (size_t)l * DFF * DM, DFF, DM, (bf16*)(wl + WL_F2OUT), 0, scr, lane, gw, NGW);
        }
        bf16* U = (bf16*)(ws + WS_U);
        for (int m = gw; m < M_ALL; m += NGW) {
            const float* xr = (m < 2 * SEQ) ? args.in[I_XP] + (size_t)m * DM : args.in[I_XS] + (size_t)(m - 2 * SEQ) * DM;
            rms_row_to_bf16(xr, args.in[I_NF1], U + (size_t)m * LDU, X + (size_t)m * DM, lane);
        }
    PH_CLOSE(0);

    for (int l = 0; l < DEPTH; ++l) {
        for (int half = 0; half < 2; ++half) {
            PH_BEGIN(1)

                if (!(l == 0 && half == 0)) {
                    bf16* U = (bf16*)(ws + WS_U);
                    const float* g = (half == 0 ? args.in[I_NF1] : args.in[I_NF2]) + (size_t)l * DM;
                    for (int m = gw; m < M_ALL; m += NGW) rms_row_to_bf16(X + (size_t)m * DM, g, U + (size_t)m * LDU, nullptr, lane);
                }
            PH_CLOSE(1);
            PH_BEGIN(2)

                unsigned char* wl = ws + WS_W + (size_t)l * WL_BYTES;
                pg8::Gemm g{(const bf16*)(ws + WS_U), (const bf16*)(wl + (half == 0 ? WL_F1IN : WL_F2IN)), M_ALL, 2 * DFF, DM, LDU, LDW}; pg8::StaticOrder S; S.init(M_ALL, 2 * DFF, G, bx);
                if (EXTRA == 1) { pg8::EpiNull E0; pg8::gemm_phase<pg8::EpiNull, pg8::StaticOrder, true, true>(ldsl + RING_OFF, g, S, E0, tid); GRID_BARRIER(); }
                pg8::EpiSwiglu E{(bf16*)(ws + WS_H), LDH};
                pg8::gemm_phase<pg8::EpiSwiglu, pg8::StaticOrder, true, true>(ldsl + RING_OFF, g, S, E, tid, (unsigned)(STAG_STEP * ((bx >> 3) & 3)));
            PH_CLOSE(2);
            PH_BEGIN(3)

                unsigned char* wl = ws + WS_W + (size_t)l * WL_BYTES;
                pg8::Gemm g{(const bf16*)(ws + WS_H), (const bf16*)(wl + (half == 0 ? WL_F1OUT : WL_F2OUT)), M_ALL, DM, DFF, LDH}; pg8::StaticOrder S; S.init(M_ALL, DM, G, bx, REV_FFNOUT);
                if (EXTRA == 2) { pg8::EpiNull E0; pg8::gemm_phase<pg8::EpiNull, pg8::StaticOrder, true, true>(ldsl + RING_OFF, g, S, E0, tid); GRID_BARRIER(); }
                pg8::EpiResid E{X, DM, rep_ ? 0.0f : 0.5f};
                pg8::gemm_phase<pg8::EpiResid, pg8::StaticOrder, true, true>(ldsl + RING_OFF, g, S, E, tid, (unsigned)(STAG_STEP * ((bx >> 3) & 3)));
            PH_CLOSE(3);
            if (half == 0) {
                PH_BEGIN(1)

                    bf16* U = (bf16*)(ws + WS_U);
                    const float* g = args.in[I_NMIX] + (size_t)l * DM;
                    for (int m = gw; m < M_ALL; m += NGW) rms_row_to_bf16(X + (size_t)m * DM, g, U + (size_t)m * LDU, nullptr, lane);
                PH_CLOSE(1);
                for (int s = 0; s < NSEQ; ++s) {
                    PH_BEGIN(4)

                        unsigned char* wl = ws + WS_W + (size_t)l * WL_BYTES;
                        pg8::Gemm g{(const bf16*)(ws + WS_U) + (size_t)s * SEQ * LDU, (const bf16*)(wl + WL_WIN), SEQ, INC, DM, LDU, LDW}; pg8::StaticOrder S; S.init(SEQ, INC, G, bx);
                        pg8::EpiBf16 E{(bf16*)(ws + WS_QKVG), INC};
                        pg8::gemm_phase<pg8::EpiBf16, pg8::StaticOrder, true, true>(ldsl + RING_OFF, g, S, E, tid, (unsigned)(STAG_STEP * ((bx >> 3) & 3)));
                    PH_CLOSE(4);
                    PH_BEGIN(5)

                        bf16* QKVG = (bf16*)(ws + WS_QKVG);
                        for (int rq_ = (EXTRA == 6) ? 0 : 1; rq_ < 2; ++rq_)
                        { bf16* QB = (bf16*)(ws + WS_QB); bf16* KB = (bf16*)(ws + WS_KB); bf16* VB = (bf16*)(ws + WS_VB);
                          const float* gq = args.in[I_QNQ] + (size_t)l * 128; const float* gk = args.in[I_QNK] + (size_t)l * 128;
                          int t = gw;
                          for (; t + 3 * NGW < SEQ; t += 4 * NGW) ropeB_tokens<4>(QKVG, t, NGW, gq, gk, QB, KB, VB, lane);
                          for (; t < SEQ; t += NGW) ropeB_tokens<1>(QKVG, t, NGW, gq, gk, QB, KB, VB, lane); }
                        for (int rp_ = (EXTRA == 7 || EXTRA == 8) ? 0 : 1; rp_ < 2; ++rp_) {
                        const int ulo_ = (rp_ == 0 && EXTRA == 8) ? 8 * 64 : 0, uhi_ = (rp_ == 0 && EXTRA == 7) ? 8 * 64 : 8 * 64 + 12 * 64;
                        for (int u = vcu + ulo_; u < uhi_; u += G) {
                            att::Unit A;
                            if (u < 8 * 64) {
                                const int h = u >> 6, b = u & 63;
                                A.Q = QKVG + (size_t)(256 * b) * INC + C_Q + h * 128; A.qstride = INC;
                                A.K = QKVG + C_K + (h >> 2) * 128; A.V = QKVG + C_V + (h >> 2) * 128; A.kstride = INC;
                                A.O = (bf16*)(ws + WS_OC) + (size_t)(256 * b) * OCAT + h * 128; A.ostride = OCAT;
                                A.NT = 8; A.kb0 = 256 * b - 128; A.n = SEQ; A.qi0 = 256 * b; A.hw = 128;
                                A.slope_raw = __uint_as_float((unsigned)(127 - (h + 1)) << 23) * (1.0f / att::SCALE);
                                A.sink = args.in[I_SINK][l * 8 + h]; A.has_sink = 1; A.lse = nullptr; A.lse_stride = 0;
                            } else {
                                const int v = u - 8 * 64, h = v >> 6, w = v & 63, gi = h >> 2, rs = 2 * gi, r = 1 << rs;
                                const int bpc = 64 >> rs, c = w / bpc, b = w % bpc, nsub = SEQ >> rs;
                                A.Q = QKVG + (size_t)(c + r * 256 * b) * INC + A_Q + h * 128; A.qstride = r * INC;
                                A.K = QKVG + (size_t)c * INC + A_K + h * 128; A.V = QKVG + (size_t)c * INC + A_V + h * 128; A.kstride = r * INC;
                                A.O = (bf16*)(ws + WS_PA) + ((size_t)gi * SEQ + c + r * 256 * b) * 512 + (h & 3) * 128; A.ostride = r * 512;
                                A.NT = 6; A.kb0 = 256 * b - 64; A.n = nsub; A.qi0 = 256 * b; A.hw = 64;
                                const float sl = __builtin_amdgcn_exp2f(-8.0f * (float)(h + 1) / 12.0f) * (float)r * (1.0f / att::SCALE);
                                A.slope_raw = __uint_as_float(__builtin_amdgcn_readfirstlane(__float_as_uint(sl)));
                                A.sink = 0.f; A.has_sink = 0; A.lse = (float*)(ws + WS_LSE) + ((size_t)gi * SEQ + c + r * 256 * b) * 4 + (h & 3); A.lse_stride = r * 4;
                            }
                            att::attn_unit<true, 0>(A, (char*)lds + RING_OFF, tid);
                        }
                        if (rp_ == 0) GRID_BARRIER(); }
                    PH_CLOSE(5);
                    PH_BEGIN(6)

                        for (int t = gw; t < SEQ; t += NGW) mergeA_token((const bf16*)(ws + WS_PA), (const float*)(ws + WS_LSE), (bf16*)(ws + WS_OA), t, lane);
                        bool fastB;
                        { const float* gq = args.in[I_QNQ] + (size_t)l * 128; const float* gk = args.in[I_QNK] + (size_t)l * 128;
                          float mq = fmaxf(__builtin_fabsf(gq[lane]), __builtin_fabsf(gq[lane + 64])), mk = fmaxf(__builtin_fabsf(gk[lane]), __builtin_fabsf(gk[lane + 64]));
                          mq = wave_max(mq); mk = wave_max(mk);
                          const float bound = 128.0f * mq * mk * QPRESCALE * 1.05f;
                          fastB = __builtin_amdgcn_readfirstlane((int)(bound < 60.0f)) != 0; }
                        if (fastB) {
                        for (int u = vcu; u < 8 * 64; u += G) {
                            const int h = u >> 6, b = u & 63;
                            att::Unit A;
                            A.Q = (const bf16*)(ws + WS_QB) + (size_t)(256 * b) * 1024 + h * 128; A.qstride = 1024;
                            A.K = (const bf16*)(ws + WS_KB) + (h >> 2) * 128; A.V = (const bf16*)(ws + WS_VB) + (h >> 2) * 128; A.kstride = 256;
                            A.O = (bf16*)(ws + WS_OB) + (size_t)(256 * b) * OCAT + h * 128; A.ostride = OCAT;
                            A.NT = SEQ / 64; A.kb0 = 0; A.n = SEQ; A.qi0 = 0; A.hw = 0; A.slope_raw = 0.f; A.sink = 0.f; A.has_sink = 0; A.lse = nullptr; A.lse_stride = 0;
                            const int tid2 = wave * 64 + lane_id_asm();
                            if (ATT_DMA) att::attn_unit_dma(A, (char*)lds + RING_OFF, (att::lds_u8*)(ldsl + RING_OFF), tid2); else if (ATT_RING) att::attn_unit_ring(A, (char*)lds + RING_OFF, tid2); else att::attn_unit<false, 2>(A, (char*)lds + RING_OFF, tid2);
                        }
                        } else {
                        for (int u = vcu; u < 8 * 64; u += G) {
                            const int h = u >> 6, b = u & 63;
                            att::Unit A;
                            A.Q = (const bf16*)(ws + WS_QB) + (size_t)(256 * b) * 1024 + h * 128; A.qstride = 1024;
                            A.K = (const bf16*)(ws + WS_KB) + (h >> 2) * 128; A.V = (const bf16*)(ws + WS_VB) + (h >> 2) * 128; A.kstride = 256;
                            A.O = (bf16*)(ws + WS_OB) + (size_t)(256 * b) * OCAT + h * 128; A.ostride = OCAT;
                            A.NT = SEQ / 64; A.kb0 = 0; A.n = SEQ; A.qi0 = 0; A.hw = 0; A.slope_raw = 0.f; A.sink = 0.f; A.has_sink = 0; A.lse = nullptr; A.lse_stride = 0;
                            const int tid2 = wave * 64 + lane_id_asm();
                            att::attn_unit<false, 1>(A, (char*)lds + RING_OFF, tid2);
                        }
                        }
                    PH_CLOSE(6);
                    PH_BEGIN(7)

                        unsigned char* wl = ws + WS_W + (size_t)l * WL_BYTES;
                        pg8::Gemm g{(const bf16*)(ws + WS_OCAT), (const bf16*)(wl + WL_WA), SEQ, DM, OCAT}; pg8::StaticOrder S; S.init(SEQ, DM, G, bx);
                        if (EXTRA == 5) { pg8::EpiNull E0; pg8::gemm_phase<pg8::EpiNull, pg8::StaticOrder, true, true>(ldsl + RING_OFF, g, S, E0, tid); GRID_BARRIER(); }
                        pg8::EpiGateCat E{(const bf16*)(ws + WS_QKVG) + GL0, INC, (bf16*)(ws + WS_MB), DM, LDU};
                        pg8::gemm_phase<pg8::EpiGateCat, pg8::StaticOrder, true, true>(ldsl + RING_OFF, g, S, E, tid);
                    PH_CLOSE(7);
                    PH_BEGIN(8)

                        unsigned char* wl = ws + WS_W + (size_t)l * WL_BYTES;
                        pg8::Gemm g{(const bf16*)(ws + WS_MB), (const bf16*)(wl + WL_WO), SEQ, DM, DM, LDU, LDW}; pg8::StaticOrder S; S.init(SEQ, DM, G, bx);
                        pg8::EpiResid E{X + (size_t)s * SEQ * DM, DM, rep_ ? 0.0f : 1.0f};
                        pg8::gemm_phase<pg8::EpiResid, pg8::StaticOrder, true, true>(ldsl + RING_OFF, g, S, E, tid);
                    PH_CLOSE(8);
                }
            }
        }
    }
    PH_BEGIN(9)

        if (EXTRA == 3) { for (int i_ = 0; i_ < 200; ++i_) GRID_BARRIER(); }
        for (int m = gw; m < M_ALL; m += NGW) rms_row_f32(X + (size_t)m * DM, args.in[I_NFIN], lane);
    PH_CLOSE(9);
#if DIAG
    {
        PH_VARS;
        unsigned long long* dg = (unsigned long long*)(ws + WS_CTL + 65536);
        if (bx_k == 0 && tid == 0) { volatile LAS unsigned long long* ts_ = (volatile LAS unsigned long long*)(ldsl + DIAG_OFF); for (int i = 0; i < 16; ++i) dg[i] = ts_[i]; }
        { XcdBarrier b2_ = bar; b2_.bar = opq_p(bar.bar); b2_.x = (unsigned)opq_s((int)bar.x); xcd_barrier(b2_); }
        const float ta = (float)__hip_atomic_load(dg + 1 + DIAG_A, __ATOMIC_RELAXED, __HIP_MEMORY_SCOPE_AGENT) * 0.01f, tb = (float)__hip_atomic_load(dg + 1 + DIAG_B, __ATOMIC_RELAXED, __HIP_MEMORY_SCOPE_AGENT) * 0.01f;
        const float qa = 10.f + __builtin_roundf(__builtin_log2f(fmaxf(ta, 10.f) * 0.1f) * (1.0f / 0.16349873f) + 0.5f * DIAG_SHIFT), qb = 10.f + __builtin_roundf(__builtin_log2f(fmaxf(tb, 10.f) * 0.1f) * (1.0f / 0.16349873f) + 0.5f * DIAG_SHIFT);
        const float ka = sqrtf(100.f * qa), vb = 100.f * qb;
        for (size_t i = (size_t)bx * 512 + tid; i < (size_t)M_ALL * DM; i += (size_t)G * 512) X[i] = (i < (size_t)2 * SEQ * DM) ? ka : ((i == (size_t)2 * SEQ * DM + 12345 || i == (size_t)2 * SEQ * DM + 54321) ? vb : 0.f);
    }
#endif
#undef PH_ON
#undef PH_VARS
#undef PH_END
#undef PH_BEGIN
#undef PH_CLOSE
}


#if CHECKB
constexpr int CHK_WORD = 2048;
__device__ __forceinline__ void chk_rope_head(const bf16* row128, const float* g, int t, float* out  , int tid) {
    if (tid < 64) {
        float x0 = __uint_as_float((unsigned)row128[2 * tid] << 16), x1 = __uint_as_float((unsigned)row128[2 * tid + 1] << 16);
        out[2 * tid] = x0; out[2 * tid + 1] = x1;
    }
}
__global__ void __launch_bounds__(256) chk_mixerB(const unsigned char* ws, const float* gq_, const float* gk_, unsigned* ctl) {
    __shared__ float qv[128]; __shared__ float red[256]; __shared__ float oacc[128]; __shared__ float sh_m, sh_l;
    const int smp = blockIdx.x, tid = threadIdx.x;
    const int t = (smp * 2654435761u >> 7) % SEQ, h = smp % 8, kvh = h / 4;
    const bf16* QKVG = (const bf16*)(ws + WS_QKVG); const bf16* OB = (const bf16*)(ws + WS_OB);
    if (tid < 128) { qv[tid] = __uint_as_float((unsigned)QKVG[(size_t)t * INC + B_Q + h * 128 + tid] << 16); }
    __syncthreads();
    if (tid == 0) { float ss = 0.f; for (int i = 0; i < 128; ++i) ss += qv[i] * qv[i]; sh_m = 1.0f / sqrtf(ss / 128.f + NORM_EPS); }
    __syncthreads();
    if (tid < 128) qv[tid] = qv[tid] * sh_m * gq_[tid];
    __syncthreads();
    if (tid < 64) { const int i = tid; const double pos = (i < 32) ? (double)(t / 64) : (double)(t % 64); const double inv = exp2(-(double)(i & 31) * 13.287712379549449 / 32.0);
        const double ang = pos * inv; const float cs = (float)cos(ang), sn = (float)sin(ang); const float x0 = qv[2 * i], x1 = qv[2 * i + 1];
        qv[2 * i] = x0 * cs - x1 * sn; qv[2 * i + 1] = x0 * sn + x1 * cs; }
    __syncthreads();
    float m = -1e30f, l = 0.f; float o[128];
    (void)o;
    auto score = [&](int j) -> float {
        const bf16* kr = QKVG + (size_t)j * INC + B_K + kvh * 128; float ss = 0.f;
        for (int i = 0; i < 128; ++i) { const float x = __uint_as_float((unsigned)kr[i] << 16); ss += x * x; }
        const float rstd = 1.0f / sqrtf(ss / 128.f + NORM_EPS); float dot = 0.f;
        for (int i = 0; i < 64; ++i) { const double pos = (i < 32) ? (double)(j / 64) : (double)(j % 64); const double inv = exp2(-(double)(i & 31) * 13.287712379549449 / 32.0);
            const double ang = pos * inv; const float cs = (float)cos(ang), sn = (float)sin(ang);
            const float x0 = __uint_as_float((unsigned)kr[2 * i] << 16) * rstd * gk_[2 * i], x1 = __uint_as_float((unsigned)kr[2 * i + 1] << 16) * rstd * gk_[2 * i + 1];
            dot += qv[2 * i] * (x0 * cs - x1 * sn) + qv[2 * i + 1] * (x0 * sn + x1 * cs); }
        return dot * 0.088388347648318440f; };
    for (int j = tid; j < SEQ; j += 256) m = fmaxf(m, score(j));
    red[tid] = m; __syncthreads();
    for (int s_ = 128; s_ > 0; s_ >>= 1) { if (tid < s_) red[tid] = fmaxf(red[tid], red[tid + s_]); __syncthreads(); }
    m = red[0]; __syncthreads();
    if (tid < 128) oacc[tid] = 0.f;
    __syncthreads();
    for (int j = tid; j < SEQ; j += 256) { const float p = expf(score(j) - m); l += p;
        const bf16* vr = QKVG + (size_t)j * INC + B_V + kvh * 128;
        for (int d = 0; d < 128; ++d) atomicAdd(&oacc[d], p * __uint_as_float((unsigned)vr[d] << 16)); }
    red[tid] = l; __syncthreads();
    for (int s_ = 128; s_ > 0; s_ >>= 1) { if (tid < s_) red[tid] += red[tid + s_]; __syncthreads(); }
    l = red[0]; __syncthreads();
    if (tid == 0) { float num = 0.f, den = 0.f; for (int d = 0; d < 128; ++d) { const float ref = oacc[d] / l, got = __uint_as_float((unsigned)OB[(size_t)t * OCAT + h * 128 + d] << 16); num += (got - ref) * (got - ref); den += ref * ref; }
        const float e = sqrtf(num / fmaxf(den, 1e-30f)); atomicMax(ctl + CHK_WORD, __float_as_uint(e)); }
}

__global__ void __launch_bounds__(128) chk_mixerAC(const unsigned char* ws, const float* sink_, unsigned* ctl) {
    __shared__ float qv[128]; __shared__ float red[128];
    const int smp = blockIdx.x, d = threadIdx.x; const bool isC = (smp & 1) != 0; const int k = smp >> 1;
    const int edge[16] = {0, 1, 63, 64, 65, 127, 128, 129, 1023, 1024, 16383, 16382, 16320, 16319, 16255, 16256};
    const int t = k < 16 ? edge[k] : (int)(((unsigned)k * 2654435761u >> 7) % SEQ);
    const bf16* QKVG = (const bf16*)(ws + WS_QKVG);
    auto bf = [](bf16 x) { return __uint_as_float((unsigned)x << 16); };
    float m = -1e30f, l = 0.f, o = 0.f;
    const bf16* outp;
    if (isC) {
        const int h = k % 8, kvh = h / 4; const float slope = exp2f(-(float)(h + 1));
        qv[d] = bf(QKVG[(size_t)t * INC + C_Q + h * 128 + d]); __syncthreads();
        for (int j = t - 128; j <= t + 128; ++j) { if (j < 0 || j >= SEQ) continue;
            red[d] = qv[d] * bf(QKVG[(size_t)j * INC + C_K + kvh * 128 + d]); __syncthreads();
            float dot = 0.f; for (int i = 0; i < 128; ++i) dot += red[i]; __syncthreads();
            const float s = dot * 0.088388347648318440f - slope * fabsf((float)(t - j));
            const float mn = fmaxf(m, s), a = expf(m - mn), p = expf(s - mn); l = l * a + p; o = o * a + p * bf(QKVG[(size_t)j * INC + C_V + kvh * 128 + d]); m = mn; }
        { const float s = sink_[h]; const float mn = fmaxf(m, s), a = expf(m - mn), p = expf(s - mn); l = l * a + p; o = o * a; m = mn; }
        outp = (const bf16*)(ws + WS_OC) + (size_t)t * OCAT + h * 128;
    } else {
        const int hh = k % 4;
        for (int g = 0; g < 3; ++g) { const int r = 1 << (2 * g), h = 4 * g + hh, c = t % r, i = t / r, nsub = SEQ / r; const float slope = exp2f(-8.0f * (float)(h + 1) / 12.0f);
            __syncthreads(); qv[d] = bf(QKVG[(size_t)t * INC + A_Q + h * 128 + d]); __syncthreads();
            for (int j = i - 64; j <= i + 64; ++j) { if (j < 0 || j >= nsub) continue; const int tj = c + r * j;
                red[d] = qv[d] * bf(QKVG[(size_t)tj * INC + A_K + h * 128 + d]); __syncthreads();
                float dot = 0.f; for (int ii = 0; ii < 128; ++ii) dot += red[ii]; __syncthreads();
                const float s = dot * 0.088388347648318440f - slope * (float)r * fabsf((float)(i - j));
                const float mn = fmaxf(m, s), a = expf(m - mn), p = expf(s - mn); l = l * a + p; o = o * a + p * bf(QKVG[(size_t)tj * INC + A_V + h * 128 + d]); m = mn; } }
        outp = (const bf16*)(ws + WS_OA) + (size_t)t * OCAT + hh * 128;
    }
    const float ref = o / l, got = bf(outp[d]);
    __syncthreads(); red[d] = (got - ref) * (got - ref); __syncthreads();
    float num = 0.f; for (int i = 0; i < 128; ++i) num += red[i]; __syncthreads();
    red[d] = ref * ref; __syncthreads();
    float den = 0.f; for (int i = 0; i < 128; ++i) den += red[i];
    if (d == 0) atomicMax(ctl + CHK_WORD, __float_as_uint(sqrtf(num / fmaxf(den, 1e-30f))));
}
__global__ void chk_fill(float* out, const unsigned* ctl) {
    const float e = __uint_as_float(ctl[CHK_WORD]); const float k = sqrtf(fminf(e, 1e6f) * 1e4f);
    for (size_t i = (size_t)blockIdx.x * blockDim.x + threadIdx.x; i < (size_t)M_ALL * DM; i += (size_t)gridDim.x * blockDim.x) out[i] = k;
}
#endif
extern "C" void kernel_launch(void* const* d_in, const int* in_sizes, int n_in, void* d_out, int out_size, void* d_ws, size_t ws_size, hipStream_t stream) {
    static int grid = 0;
    if (grid == 0) {
        if (n_in != N_IN || out_size != M_ALL * DM || ws_size < WS_END) { fprintf(stderr, "kernel_launch: shape/workspace mismatch (n_in %d out %d ws %zu need %zu)\n", n_in, out_size, ws_size, (size_t)WS_END); grid = -1; return; }
        int dev = 0, cus = 0, per_cu = 0;
        if (hipGetDevice(&dev) != hipSuccess || hipDeviceGetAttribute(&cus, hipDeviceAttributeMultiprocessorCount, dev) != hipSuccess) { grid = -1; return; }
        if (hipFuncSetAttribute((const void*)trunk_fwd, hipFuncAttributeMaxDynamicSharedMemorySize, LDS_BYTES) != hipSuccess) { fprintf(stderr, "kernel_launch: hipFuncSetAttribute failed\n"); grid = -1; return; }
        if (hipOccupancyMaxActiveBlocksPerMultiprocessor(&per_cu, (const void*)trunk_fwd, NWAVES * 64, LDS_BYTES) != hipSuccess || per_cu < 1) { fprintf(stderr, "kernel_launch: occupancy query reports %d\n", per_cu); }
        (void)hipGetLastError();
        grid = cus;
    }
    if (grid < 0) return;
    if (hipMemsetAsync((char*)d_ws + WS_CTL, 0, CTL_ZERO_BYTES, stream) != hipSuccess) return;
    Args a{};
    for (int i = 0; i < N_IN; ++i) a.in[i] = (const float*)d_in[i];
    a.out = (float*)d_out; a.ws = (unsigned char*)d_ws;
#if MK_PER_PHASE
    for (int p = 0; p < N_PHASES; ++p) { a.ph_lo = p; a.ph_hi = p + 1; hipLaunchKernelGGL(trunk_fwd, dim3(grid), dim3(NWAVES * 64), LDS_BYTES, stream, a); }
#elif CHECKB
    a.ph_lo = 0; a.ph_hi = 8;
    hipLaunchKernelGGL(trunk_fwd, dim3(grid), dim3(NWAVES * 64), LDS_BYTES, stream, a);
#if CHECKB == 1
    hipLaunchKernelGGL(chk_mixerB, dim3(512), dim3(256), 0, stream, (const unsigned char*)d_ws, (const float*)d_in[I_QNQ], (const float*)d_in[I_QNK], (unsigned*)((char*)d_ws + WS_CTL));
#else
    hipLaunchKernelGGL(chk_mixerAC, dim3(1024), dim3(128), 0, stream, (const unsigned char*)d_ws, (const float*)d_in[I_SINK], (unsigned*)((char*)d_ws + WS_CTL));
#endif
    hipLaunchKernelGGL(chk_fill, dim3(1024), dim3(256), 0, stream, (float*)d_out, (const unsigned*)((char*)d_ws + WS_CTL));
#else
    a.ph_lo = 0; a.ph_hi = N_PHASES;
    hipLaunchKernelGGL(trunk_fwd, dim3(grid), dim3(NWAVES * 64), LDS_BYTES, stream, a);
#endif
    const hipError_t le = hipPeekAtLastError();
    if (le != hipSuccess) fprintf(stderr, "kernel_launch: launch failed: %s\n", hipGetErrorName(le));
}
```

```cpp
#include <hip/hip_runtime.h>
#include <cstdio>
#include <cstdint>

#ifndef DIAG
#define DIAG 0
#endif
#ifndef DIAG_A
#define DIAG_A 2
#endif
#ifndef DIAG_B
#define DIAG_B 3
#endif
#ifndef DIAG_SHIFT
#define DIAG_SHIFT 0
#endif
#ifndef DUP_TYPE
#define DUP_TYPE -1
#endif
#ifndef STAG_STEP
#define STAG_STEP 0
#endif
#ifndef EPI_FENCE
#define EPI_FENCE 1
#endif
#ifndef EXTRA
#define EXTRA 0
#endif
#ifndef ATT_SCHED
#define ATT_SCHED 0
#endif
#ifndef CHECKB
#define CHECKB 0
#endif
#ifndef ATT_RING
#define ATT_RING 0
#endif
#ifndef REV_FFNOUT
#define REV_FFNOUT 1
#endif
#ifndef LDH_PAD
#define LDH_PAD 64
#endif
#ifndef LDU_PAD
#define LDU_PAD 0
#endif
#ifndef LDW_PAD
#define LDW_PAD 0
#endif
#ifndef QKT_PREFETCH
#define QKT_PREFETCH 1
#endif
#ifndef WSKIP
#define WSKIP 0
#endif
#ifndef BAND_PREFETCH
#define BAND_PREFETCH 0
#endif
#ifndef ATT_DMA
#define ATT_DMA 1
#endif
#ifndef DMA_PREFETCH
#define DMA_PREFETCH 0
#endif
#ifndef MK_PER_PHASE
#define MK_PER_PHASE 0
#endif

namespace pg8 {
#define PG8_LAS __attribute__((address_space(3)))
typedef unsigned short bf16_t;
typedef short bf16x8 __attribute__((ext_vector_type(8)));
typedef float f32x4 __attribute__((ext_vector_type(4)));
typedef unsigned u32x4 __attribute__((ext_vector_type(4)));
typedef unsigned u32x2 __attribute__((ext_vector_type(2)));
constexpr int BM = 256, BK = 64, HALF = 128, HTB = HALF * BK * 2, STAGE_BYTES = 8 * HTB, NXCD = 8, WGM = 8;

__host__ __device__ __forceinline__ int lds_byte(int r, int c) { const int st = (r >> 4) * 2 + (c >> 5), rr = r & 15, cc = c & 31, ob = rr * 64 + cc * 2; return st * 1024 + (ob ^ (((ob >> 9) & 1) << 5)); }
__host__ __device__ __forceinline__ void stage_rc(int b, int& R, int& C) { const int st = b / 1024, sb = b % 1024, swz = sb ^ (((sb >> 9) & 1) << 5); R = (st >> 1) * 16 + swz / 64; C = (st & 1) * 32 + (swz % 64) / 2; }
__host__ __device__ __forceinline__ int perm32(int rho) { const int n = rho >> 4, i = rho & 15; return 8 * (i >> 2) + 4 * n + (i & 3); }

struct Unit { int pm, pn; };
struct Gemm { const bf16_t* A; const bf16_t* Bt; int M, N, K; int lda = 0, ldb = 0; };

struct StaticOrder {
    int nM, nN, nwg, G, c, rev;
    __host__ __device__ void init(int M, int N, int G_, int c_, int rev_ = 0) { nM = M / BM; nN = N / BM; nwg = nM * nN; G = G_; c = c_; rev = rev_; }
    __host__ __device__ bool next(int i, Unit& u) const {
        const long L = (long)i * G + c; if (L >= nwg) return false;
        int wgid = (int)L; { const int q = nwg / NXCD, r = nwg % NXCD, xcd = wgid % NXCD, off = wgid / NXCD; wgid = (xcd < r ? xcd * (q + 1) : r * (q + 1) + (xcd - r) * q) + off; }
        const int nig = WGM * nN, gid = wgid / nig, fm = gid * WGM, gsz = (nM - fm) < WGM ? (nM - fm) : WGM;
        u.pm = fm + ((wgid % nig) % gsz); u.pn = (wgid % nig) / gsz; if (rev) u.pm = nM - 1 - u.pm; return true;
    }
    __device__ __forceinline__ void a_ready(const Unit&) const {}
    __device__ __forceinline__ void done(const Unit&) const {}
};

__device__ __forceinline__ unsigned cvt_pk_bf16(float lo, float hi) { unsigned r; asm volatile("v_cvt_pk_bf16_f32 %0, %1, %2" : "=v"(r) : "v"(lo), "v"(hi)); return r; }
__device__ __forceinline__ float bf_lo(unsigned w) { return __uint_as_float(w << 16); }
__device__ __forceinline__ float bf_hi(unsigned w) { return __uint_as_float(w & 0xffff0000u); }
__device__ __forceinline__ float sigmoidf_(float x) { return __builtin_amdgcn_rcpf(1.0f + __builtin_amdgcn_exp2f(-1.4426950408889634f * x)); }

struct EpiBf16 {
    static constexpr bool PERM = true, AFTER_DRAIN = false;
    bf16_t* O; int ldc;
    __device__ __forceinline__ void operator()(const f32x4 (&acc)[2][2][4][2], const Unit& u, int wr, int wc, int fr, int fq) const {
        const int row0 = u.pm * BM + wr * 64 + fr, col0 = u.pn * BM + wc * 32 + 8 * fq;
#pragma unroll
        for (int ai = 0; ai < 2; ++ai)
#pragma unroll
            for (int m = 0; m < 4; ++m) { bf16_t* rowp = O + (size_t)(row0 + ai * HALF + m * 16) * ldc + col0;
#pragma unroll
                for (int bj = 0; bj < 2; ++bj) { const f32x4 v0 = acc[ai][bj][m][0], v1 = acc[ai][bj][m][1];
                    u32x4 w; w.x = cvt_pk_bf16(v0[0], v0[1]); w.y = cvt_pk_bf16(v0[2], v0[3]); w.z = cvt_pk_bf16(v1[0], v1[1]); w.w = cvt_pk_bf16(v1[2], v1[3]);
                    *(u32x4*)(rowp + bj * HALF) = w; } }
    }
};
struct EpiNull {
    static constexpr bool PERM = true, AFTER_DRAIN = false;
    __device__ __forceinline__ void operator()(const f32x4 (&acc)[2][2][4][2], const Unit& u, int wr, int wc, int fr, int fq) const {
#pragma unroll
        for (int ai = 0; ai < 2; ++ai)
#pragma unroll
            for (int bj = 0; bj < 2; ++bj) asm volatile("" :: "v"(acc[ai][bj][0][0]), "v"(acc[ai][bj][0][1]), "v"(acc[ai][bj][1][0]), "v"(acc[ai][bj][1][1]), "v"(acc[ai][bj][2][0]), "v"(acc[ai][bj][2][1]), "v"(acc[ai][bj][3][0]), "v"(acc[ai][bj][3][1]));
    }
};
struct EpiSwiglu {
    static constexpr bool PERM = true, AFTER_DRAIN = false;
    bf16_t* H; int ldc;
    __device__ __forceinline__ void operator()(const f32x4 (&acc)[2][2][4][2], const Unit& u, int wr, int wc, int fr, int fq) const {
        const int row0 = u.pm * BM + wr * 64 + fr, col0 = u.pn * HALF + wc * 32 + 8 * fq;
#pragma unroll
        for (int ai = 0; ai < 2; ++ai)
#pragma unroll
            for (int m = 0; m < 4; ++m) { bf16_t* rowp = H + (size_t)(row0 + ai * HALF + m * 16) * ldc + col0;
                float h[8];
#pragma unroll
                for (int n = 0; n < 2; ++n)
#pragma unroll
                    for (int e = 0; e < 4; ++e) { const float a = acc[ai][0][m][n][e], b = acc[ai][1][m][n][e]; h[n * 4 + e] = a * sigmoidf_(a) * b; }
                u32x4 w; w.x = cvt_pk_bf16(h[0], h[1]); w.y = cvt_pk_bf16(h[2], h[3]); w.z = cvt_pk_bf16(h[4], h[5]); w.w = cvt_pk_bf16(h[6], h[7]);
                *(u32x4*)rowp = w; }
    }
};
struct EpiResid {
    static constexpr bool PERM = false, AFTER_DRAIN = false;
    float* X; int ldc; float scale;
    __device__ __forceinline__ void operator()(const f32x4 (&acc)[2][2][4][2], const Unit& u, int wr, int wc, int fr, int fq) const {
        const int row0 = u.pm * BM + wr * 64 + fr, col0 = u.pn * BM + wc * 32 + 4 * fq;
#pragma unroll
        for (int ai = 0; ai < 2; ++ai) {
            f32x4 xv[4][2][2];
#pragma unroll
            for (int m = 0; m < 4; ++m) { const float* rowp = X + (size_t)(row0 + ai * HALF + m * 16) * ldc + col0;
#pragma unroll
                for (int bj = 0; bj < 2; ++bj)
#pragma unroll
                    for (int n = 0; n < 2; ++n) xv[m][bj][n] = *(const f32x4*)(rowp + bj * HALF + n * 16); }
#pragma unroll
            for (int m = 0; m < 4; ++m) { float* rowp = X + (size_t)(row0 + ai * HALF + m * 16) * ldc + col0;
#pragma unroll
                for (int bj = 0; bj < 2; ++bj)
#pragma unroll
                    for (int n = 0; n < 2; ++n) *(f32x4*)(rowp + bj * HALF + n * 16) = xv[m][bj][n] + acc[ai][bj][m][n] * scale; }
            asm volatile("" ::: "memory");
        }
    }
};
struct EpiGateCat {
    static constexpr bool PERM = true, AFTER_DRAIN = false, HOOK = true;
    const bf16_t* GL; int ldg; bf16_t* MB; int ldc; int ldo;
    __device__ __forceinline__ bool hook_at(int t) const { return t == 8 || t == 24; }
    static __device__ __forceinline__ float e_neg(float x) { return __builtin_amdgcn_exp2f(-1.4426950408889634f * __builtin_fminf(__builtin_fmaxf(x, -60.f), 60.f)); }
    __device__ __forceinline__ void hook(f32x4 (&acc)[2][2][4][2], const Unit& u, int t, int wr, int wc, int fr, int fq) const {
        int fr_ = fr; asm volatile("" : "+v"(fr_));
        const int row0 = u.pm * BM + wr * 64 + fr_, col0 = u.pn * BM + wc * 32 + 8 * fq; const bf16_t* gp = GL + (t == 8 ? 0 : ldc) + (size_t)row0 * ldg + col0;
#pragma unroll
        for (int ai = 0; ai < 2; ++ai) {
            u32x4 a[4][2], b[4][2];
#pragma unroll
            for (int m = 0; m < 4; ++m)
#pragma unroll
                for (int bj = 0; bj < 2; ++bj) { const bf16_t* q = gp + (size_t)(ai * HALF + m * 16) * ldg + bj * HALF; a[m][bj] = *(const u32x4*)q; b[m][bj] = *(const u32x4*)(q + ldc); }
#pragma unroll
            for (int m = 0; m < 4; ++m)
#pragma unroll
                for (int bj = 0; bj < 2; ++bj) { const u32x4 p = a[m][bj], n = b[m][bj]; f32x4& v0 = acc[ai][bj][m][0]; f32x4& v1 = acc[ai][bj][m][1];
                    v0[0] *= (1.f + e_neg(bf_lo(n.x))) * __builtin_amdgcn_rcpf(1.f + e_neg(bf_lo(p.x))); v0[1] *= (1.f + e_neg(bf_hi(n.x))) * __builtin_amdgcn_rcpf(1.f + e_neg(bf_hi(p.x)));
                    v0[2] *= (1.f + e_neg(bf_lo(n.y))) * __builtin_amdgcn_rcpf(1.f + e_neg(bf_lo(p.y))); v0[3] *= (1.f + e_neg(bf_hi(n.y))) * __builtin_amdgcn_rcpf(1.f + e_neg(bf_hi(p.y)));
                    v1[0] *= (1.f + e_neg(bf_lo(n.z))) * __builtin_amdgcn_rcpf(1.f + e_neg(bf_lo(p.z))); v1[1] *= (1.f + e_neg(bf_hi(n.z))) * __builtin_amdgcn_rcpf(1.f + e_neg(bf_hi(p.z)));
                    v1[2] *= (1.f + e_neg(bf_lo(n.w))) * __builtin_amdgcn_rcpf(1.f + e_neg(bf_lo(p.w))); v1[3] *= (1.f + e_neg(bf_hi(n.w))) * __builtin_amdgcn_rcpf(1.f + e_neg(bf_hi(p.w))); }
            asm volatile("" ::: "memory");
        }
        asm volatile("s_waitcnt vmcnt(0)" ::: "memory");
    }
    __device__ __forceinline__ void operator()(const f32x4 (&acc)[2][2][4][2], const Unit& u, int wr, int wc, int fr, int fq) const {
        const int row0 = u.pm * BM + wr * 64 + fr, col0 = u.pn * BM + wc * 32 + 8 * fq; const bf16_t* gp = GL + 2 * ldc;
#pragma unroll
        for (int ai = 0; ai < 2; ++ai) {
            u32x4 g[4][2];
#pragma unroll
            for (int m = 0; m < 4; ++m)
#pragma unroll
                for (int bj = 0; bj < 2; ++bj) g[m][bj] = *(const u32x4*)(gp + (size_t)(row0 + ai * HALF + m * 16) * ldg + col0 + bj * HALF);
#pragma unroll
            for (int m = 0; m < 4; ++m) { const size_t row = (size_t)(row0 + ai * HALF + m * 16);
#pragma unroll
                for (int bj = 0; bj < 2; ++bj) { const u32x4 gg = g[m][bj]; f32x4 v0 = acc[ai][bj][m][0], v1 = acc[ai][bj][m][1];
                    v0[0] *= sigmoidf_(bf_lo(gg.x)); v0[1] *= sigmoidf_(bf_hi(gg.x)); v0[2] *= sigmoidf_(bf_lo(gg.y)); v0[3] *= sigmoidf_(bf_hi(gg.y));
                    v1[0] *= sigmoidf_(bf_lo(gg.z)); v1[1] *= sigmoidf_(bf_hi(gg.z)); v1[2] *= sigmoidf_(bf_lo(gg.w)); v1[3] *= sigmoidf_(bf_hi(gg.w));
                    u32x4 w; w.x = cvt_pk_bf16(v0[0], v0[1]); w.y = cvt_pk_bf16(v0[2], v0[3]); w.z = cvt_pk_bf16(v1[0], v1[1]); w.w = cvt_pk_bf16(v1[2], v1[3]);
                    *(u32x4*)(MB + row * ldo + col0 + bj * HALF) = w; } }
            asm volatile("" ::: "memory");
        }
    }
};

template <class E, class = void> struct epi_has_hook { static constexpr bool value = false; };
template <class E> struct epi_has_hook<E, decltype((void)E::HOOK)> { static constexpr bool value = E::HOOK; };
template <class Epi, class Sched, bool ALIGN_EPI = false, bool SP2 = false>
__device__ __forceinline__ void gemm_phase(PG8_LAS unsigned char* lds, const Gemm g, const Sched& S, const Epi& E, const int tid, const unsigned stagger = 0u) {
    if (stagger) { const unsigned long long t0_ = __builtin_amdgcn_s_memrealtime(); while (__builtin_amdgcn_s_memrealtime() - t0_ < stagger) __builtin_amdgcn_s_sleep(16); }
    const int wid = __builtin_amdgcn_readfirstlane(tid >> 6), lane = tid & 63, wr = wid >> 2, wc = wid & 3, fr = lane & 15, fq = lane >> 4;
    const int K = g.K, nt = K / BK, lda = g.lda ? g.lda : g.K, ldb = g.ldb ? g.ldb : g.K;
    unsigned voffA[2], voffB[2];
#pragma unroll
    for (int i = 0; i < 2; ++i) { int R, C; stage_rc(tid * 16 + i * 8192, R, C); const int Rb = Epi::PERM ? ((R & ~31) + perm32(R & 31)) : R;
        voffA[i] = (unsigned)(R * lda + C) * 2u; voffB[i] = (unsigned)(Rb * ldb + C) * 2u; }
    const size_t kstep = (size_t)(BK * 2);
    const size_t hstep = (size_t)HALF * ldb * 2, hstepA = (size_t)HALF * lda * 2;
    const size_t tstep = 2 * hstep, tstepA = 2 * hstepA;
    const unsigned ldsw = (unsigned)wid * 1024u;
    const int aoff = lds_byte(wr * 64 + fr, fq * 8), boff = lds_byte(wc * 32 + fr, fq * 8);
#define PG8_SA(b, h) (((b) * 2 + (h)) * HTB)
#define PG8_SB(b, h) ((4 + (b) * 2 + (h)) * HTB)
#define PG8_STAGE(bufoff, gbase, voff) do { _Pragma("unroll") for (int _i = 0; _i < 2; ++_i) \
        __builtin_amdgcn_global_load_lds((const unsigned*)((const char*)(gbase) + (voff)[_i]), (PG8_LAS unsigned*)(lds + (bufoff) + ldsw + _i * 8192), 16, 0, 0); } while (0)
#define PG8_LDA(dst, b, h) do { _Pragma("unroll") for (int m = 0; m < 4; ++m) _Pragma("unroll") for (int k = 0; k < 2; ++k) dst[m][k] = *(const PG8_LAS bf16x8*)(lds + PG8_SA(b, h) + aoff + m * 2048 + k * 1024); } while (0)
#define PG8_LDB(dst, b, h) do { _Pragma("unroll") for (int n = 0; n < 2; ++n) _Pragma("unroll") for (int k = 0; k < 2; ++k) dst[n][k] = *(const PG8_LAS bf16x8*)(lds + PG8_SB(b, h) + boff + n * 2048 + k * 1024); } while (0)
#define PG8_MMA(ai, bj, At, Bt) do { __builtin_amdgcn_s_setprio(1); _Pragma("unroll") for (int m = 0; m < 4; ++m) _Pragma("unroll") for (int n = 0; n < 2; ++n) _Pragma("unroll") for (int k = 0; k < 2; ++k) \
        acc[ai][bj][m][n] = __builtin_amdgcn_mfma_f32_16x16x32_bf16(Bt[n][k], At[m][k], acc[ai][bj][m][n], 0, 0, 0); __builtin_amdgcn_s_setprio(0); } while (0)
#define PG8_WAIT_V(n) asm volatile("s_waitcnt vmcnt(" #n ")" ::: "memory")
#define PG8_WAIT_L(n) asm volatile("s_waitcnt lgkmcnt(" #n ")" ::: "memory")
#define PG8_BAR __builtin_amdgcn_s_barrier()
#define PG8_SCHED __builtin_amdgcn_sched_barrier(0)
    Unit cur, nxt; int ui = 0;
    if (!S.next(0, cur)) return;
    f32x4 acc[2][2][4][2];
#pragma unroll
    for (int a = 0; a < 2; ++a)
#pragma unroll
        for (int b = 0; b < 2; ++b)
#pragma unroll
            for (int m = 0; m < 4; ++m)
#pragma unroll
                for (int n = 0; n < 2; ++n) acc[a][b][m][n] = (f32x4){0.f, 0.f, 0.f, 0.f};
    bf16x8 At[4][2], B0[2][2], B1[2][2];
    const char* cA = (const char*)g.A + (size_t)cur.pm * tstepA; const char* cB = (const char*)g.Bt + (size_t)cur.pn * tstep;
    S.a_ready(cur);
    if constexpr (SP2) {
        PG8_STAGE(PG8_SB(0, 0), cB, voffB); PG8_STAGE(PG8_SB(0, 1), cB + hstep, voffB); PG8_STAGE(PG8_SA(0, 0), cA, voffA); PG8_STAGE(PG8_SA(0, 1), cA + hstepA, voffA);
        if (wr == 1) PG8_BAR;
        PG8_WAIT_V(2); PG8_BAR;
        PG8_STAGE(PG8_SB(1, 0), cB + kstep, voffB); PG8_STAGE(PG8_SA(1, 0), cA + kstep, voffA); PG8_STAGE(PG8_SB(1, 1), cB + hstep + kstep, voffB);
        PG8_WAIT_V(6); PG8_BAR;
    } else {
        PG8_STAGE(PG8_SB(0, 0), cB, voffB); PG8_STAGE(PG8_SA(0, 0), cA, voffA); PG8_STAGE(PG8_SB(0, 1), cB + hstep, voffB); PG8_STAGE(PG8_SA(0, 1), cA + hstepA, voffA);
        if (wr == 1) PG8_BAR;
        PG8_WAIT_V(4); PG8_BAR;
        PG8_STAGE(PG8_SB(1, 0), cB + kstep, voffB); PG8_STAGE(PG8_SA(1, 0), cA + kstep, voffA); PG8_STAGE(PG8_SB(1, 1), cB + hstep + kstep, voffB);
        PG8_WAIT_V(6); PG8_BAR;
    }
    for (;;) {
        const bool has_next = S.next(ui + 1, nxt);
        const char* nA = has_next ? (const char*)g.A + (size_t)nxt.pm * tstepA : cA; const char* nB = has_next ? (const char*)g.Bt + (size_t)nxt.pn * tstep : cB;
        for (int t = 0; t < nt; t += 2) {
            const bool last = (t == nt - 2);
            const char* a1 = cA + (size_t)(t + 1) * kstep;
            const char* a2 = last ? nA : cA + (size_t)(t + 2) * kstep; const char* b2 = last ? nB : cB + (size_t)(t + 2) * kstep;
            const char* a3 = a2 + kstep; const char* b3 = b2 + kstep;
            if (last && has_next) S.a_ready(nxt);
            if constexpr (epi_has_hook<Epi>::value) { if (E.hook_at(t)) E.hook(acc, cur, t, wr, wc, fr, fq); }
            if constexpr (SP2) {
            PG8_LDB(B0, 0, 0); PG8_LDB(B1, 0, 1); PG8_SCHED; PG8_LDA(At, 0, 0); PG8_STAGE(PG8_SA(1, 1), a1 + hstepA, voffA);
            PG8_WAIT_V(8); PG8_WAIT_L(0); PG8_BAR; PG8_MMA(0, 0, At, B0); PG8_MMA(0, 1, At, B1); PG8_BAR; PG8_SCHED;
            PG8_LDA(At, 0, 1); PG8_STAGE(PG8_SB(0, 0), b2, voffB); PG8_STAGE(PG8_SB(0, 1), b2 + hstep, voffB); PG8_STAGE(PG8_SA(0, 0), a2, voffA);
            PG8_WAIT_V(8); PG8_WAIT_L(0); PG8_BAR; PG8_MMA(1, 0, At, B0); PG8_MMA(1, 1, At, B1); PG8_BAR; PG8_SCHED;
            PG8_LDB(B0, 1, 0); PG8_LDB(B1, 1, 1); PG8_SCHED; PG8_LDA(At, 1, 0); PG8_STAGE(PG8_SA(0, 1), a2 + hstepA, voffA);
            PG8_WAIT_V(8); PG8_WAIT_L(0); PG8_BAR; PG8_MMA(0, 0, At, B0); PG8_MMA(0, 1, At, B1); PG8_BAR; PG8_SCHED;
            PG8_LDA(At, 1, 1); PG8_STAGE(PG8_SB(1, 0), b3, voffB); PG8_STAGE(PG8_SB(1, 1), b3 + hstep, voffB); PG8_STAGE(PG8_SA(1, 0), a3, voffA);
            PG8_WAIT_V(8); PG8_WAIT_L(0); PG8_BAR; PG8_MMA(1, 0, At, B0); PG8_MMA(1, 1, At, B1); PG8_BAR; PG8_SCHED;
            } else {
            PG8_LDB(B0, 0, 0); PG8_SCHED; PG8_LDA(At, 0, 0); PG8_STAGE(PG8_SA(1, 1), a1 + hstepA, voffA);
            PG8_WAIT_L(8); PG8_BAR; PG8_WAIT_L(0); PG8_MMA(0, 0, At, B0); PG8_BAR; PG8_SCHED;
            PG8_LDB(B1, 0, 1); PG8_STAGE(PG8_SB(0, 0), b2, voffB);
            PG8_BAR; PG8_WAIT_L(0); PG8_MMA(0, 1, At, B1); PG8_BAR;
            PG8_LDA(At, 0, 1); PG8_STAGE(PG8_SA(0, 0), a2, voffA);
            PG8_BAR; PG8_WAIT_L(0); PG8_MMA(1, 0, At, B0); PG8_BAR; PG8_SCHED;
            PG8_STAGE(PG8_SB(0, 1), b2 + hstep, voffB);
            PG8_WAIT_V(6); PG8_BAR; PG8_MMA(1, 1, At, B1); PG8_BAR;
            PG8_LDB(B0, 1, 0); PG8_SCHED; PG8_LDA(At, 1, 0); PG8_STAGE(PG8_SA(0, 1), a2 + hstepA, voffA);
            PG8_WAIT_L(8); PG8_BAR; PG8_WAIT_L(0); PG8_MMA(0, 0, At, B0); PG8_BAR; PG8_SCHED;
            PG8_LDB(B1, 1, 1); PG8_STAGE(PG8_SB(1, 0), b3, voffB);
            PG8_BAR; PG8_WAIT_L(0); PG8_MMA(0, 1, At, B1); PG8_BAR;
            PG8_LDA(At, 1, 1); PG8_STAGE(PG8_SA(1, 0), a3, voffA);
            PG8_BAR; PG8_WAIT_L(0); PG8_MMA(1, 0, At, B0); PG8_BAR; PG8_SCHED;
            PG8_STAGE(PG8_SB(1, 1), b3 + hstep, voffB);
            PG8_WAIT_V(6); PG8_BAR; PG8_MMA(1, 1, At, B1); PG8_BAR;
            }
        }
        if constexpr (ALIGN_EPI) { if (wr == 0) PG8_BAR; }
        E(acc, cur, wr, wc, fr, fq); S.done(cur);
        if (!has_next) break;
#pragma unroll
        for (int a = 0; a < 2; ++a)
#pragma unroll
            for (int b = 0; b < 2; ++b)
#pragma unroll
                for (int m = 0; m < 4; ++m)
#pragma unroll
                    for (int n = 0; n < 2; ++n) acc[a][b][m][n] = (f32x4){0.f, 0.f, 0.f, 0.f};
        cur = nxt; cA = nA; cB = nB; ++ui;
        if constexpr (ALIGN_EPI) { if (wr == 1) PG8_BAR; }
    }
    PG8_WAIT_V(0);
    if constexpr (!ALIGN_EPI) { if (wr == 0) PG8_BAR; }
    PG8_BAR;
#undef PG8_SA
#undef PG8_SB
#undef PG8_STAGE
#undef PG8_LDA
#undef PG8_LDB
#undef PG8_MMA
#undef PG8_WAIT_V
#undef PG8_WAIT_L
#undef PG8_BAR
#undef PG8_SCHED
}
}

namespace att {
typedef unsigned short bf16;
using bf16x8 = __attribute__((ext_vector_type(8))) short;
using s16x4  = __attribute__((ext_vector_type(4))) short;
using f32x16 = __attribute__((ext_vector_type(16))) float;
using u32x4  = __attribute__((ext_vector_type(4))) unsigned;
constexpr int D = 128, NW = 8, QBLK = 32, KVBLK = 64;
constexpr float SCALE = 0.088388347648318440f;
constexpr float THR = 8.f;
constexpr int SHM_V = KVBLK * D * 2, SHM_K = KVBLK * D * 2, SHM_ATTN = 2 * SHM_V + 2 * SHM_K + NW * 64 * 4;
#define KSWZ(row, colB) ((row) * 256 + ((colB) ^ (((row) & 7) << 4)))
#define SBAR() __builtin_amdgcn_sched_barrier(0)
__device__ __forceinline__ int crow(int r, int hi) { return (r & 3) + 8 * (r >> 2) + 4 * hi; }
__device__ __forceinline__ unsigned cvtpk(float lo, float hi) { unsigned r; asm volatile("v_cvt_pk_bf16_f32 %0, %1, %2" : "=v"(r) : "v"(lo), "v"(hi)); return r; }

template <int SM> __device__ __forceinline__ void partialSM(f32x16& p0, f32x16& p1, float& m_reg, float& mn, float& alpha) {
  if constexpr (SM == 2) {
#pragma unroll
    for (int r = 0; r < 16; ++r) p0[r] = __builtin_amdgcn_exp2f(p0[r]);
    return; }
  constexpr float C = SM == 0 ? SCALE * 1.4426950408889634f : 1.0f; constexpr float THRU = SM == 0 ? THR / SCALE : THR * 1.4426950408889634f;
  float pmax = p0[0];
#pragma unroll
  for (int r = 1; r < 16; ++r) pmax = fmaxf(pmax, p0[r]);
#pragma unroll
  for (int r = 0; r < 16; ++r) pmax = fmaxf(pmax, p1[r]);
  { auto rr = __builtin_amdgcn_permlane32_swap(__float_as_uint(pmax), __float_as_uint(pmax), false, false);
    pmax = fmaxf(__uint_as_float(rr[0]), __uint_as_float(rr[1])); }
  if (__builtin_expect(__all(pmax - m_reg <= THRU), 1)) { mn = m_reg; alpha = 1.f; }
  else { mn = fmaxf(m_reg, pmax); alpha = __builtin_amdgcn_exp2f((m_reg - mn) * C); m_reg = mn; }
  float mnC = -mn * C;
#pragma unroll
  for (int r = 0; r < 16; ++r) p0[r] = fmaf(p0[r], C, mnC);
#pragma unroll
  for (int r = 0; r < 16; ++r) p1[r] = fmaf(p1[r], C, mnC);
#pragma unroll
  for (int r = 0; r < 16; ++r) p0[r] = __builtin_amdgcn_exp2f(p0[r]);
}
template <int SM> __device__ __forceinline__ void finishSM(f32x16& p0, f32x16& p1, float alpha, float& l_reg, bf16x8& pa0, bf16x8& pa1, bf16x8& pa2, bf16x8& pa3) {
#pragma unroll
  for (int r = 0; r < 16; ++r) p1[r] = __builtin_amdgcn_exp2f(p1[r]);
  float ps = 0;
#pragma unroll
  for (int r = 0; r < 16; ++r) ps += p0[r];
#pragma unroll
  for (int r = 0; r < 16; ++r) ps += p1[r];
  { auto rr = __builtin_amdgcn_permlane32_swap(__float_as_uint(ps), __float_as_uint(ps), false, false);
    ps = __uint_as_float(rr[0]) + __uint_as_float(rr[1]); }
  if constexpr (SM == 2) l_reg += ps; else l_reg = l_reg * alpha + ps;
#define PK4(P, BASE, OUT) do { unsigned a0 = cvtpk(P[BASE + 0], P[BASE + 1]), a1 = cvtpk(P[BASE + 2], P[BASE + 3]);   \
    unsigned b0 = cvtpk(P[BASE + 4], P[BASE + 5]), b1 = cvtpk(P[BASE + 6], P[BASE + 7]);                              \
    auto r0 = __builtin_amdgcn_permlane32_swap(a0, b0, false, false); auto r1 = __builtin_amdgcn_permlane32_swap(a1, b1, false, false); \
    u32x4 w = {r0[0], r1[0], r0[1], r1[1]}; OUT = *reinterpret_cast<bf16x8*>(&w); } while (0)
  PK4(p0, 0, pa0); PK4(p0, 8, pa1); PK4(p1, 0, pa2); PK4(p1, 8, pa3);
#undef PK4
}
template <bool PF> __device__ __forceinline__ void qkt(f32x16& p0, f32x16& p1, const char* Ks, const bf16x8* qr, int r32, int hi) {
  p0 = f32x16{}; p1 = f32x16{};
  if constexpr (PF) {
  bf16x8 b0 = *reinterpret_cast<const bf16x8*>(Ks + KSWZ(r32, (hi * 8) * 2)), b1 = *reinterpret_cast<const bf16x8*>(Ks + KSWZ(32 + r32, (hi * 8) * 2));
#pragma unroll
  for (int d0 = 0; d0 < 8; ++d0) { bf16x8 n0 = b0, n1 = b1;
    if (d0 < 7) { const int cb = ((d0 + 1) * 16 + hi * 8) * 2; n0 = *reinterpret_cast<const bf16x8*>(Ks + KSWZ(r32, cb)); n1 = *reinterpret_cast<const bf16x8*>(Ks + KSWZ(32 + r32, cb)); }
    if (d0 < 7) asm volatile("s_waitcnt lgkmcnt(2)" ::: "memory"); else asm volatile("s_waitcnt lgkmcnt(0)" ::: "memory");
    __builtin_amdgcn_sched_barrier(0);
    p0 = __builtin_amdgcn_mfma_f32_32x32x16_bf16(b0, qr[d0], p0, 0, 0, 0);
    p1 = __builtin_amdgcn_mfma_f32_32x32x16_bf16(b1, qr[d0], p1, 0, 0, 0);
    b0 = n0; b1 = n1; }
  } else {
#pragma unroll
  for (int d0 = 0; d0 < 8; ++d0) { int cb = (d0 * 16 + hi * 8) * 2;
    bf16x8 b0 = *reinterpret_cast<const bf16x8*>(Ks + KSWZ(r32, cb));
    bf16x8 b1 = *reinterpret_cast<const bf16x8*>(Ks + KSWZ(32 + r32, cb));
    p0 = __builtin_amdgcn_mfma_f32_32x32x16_bf16(b0, qr[d0], p0, 0, 0, 0);
    p1 = __builtin_amdgcn_mfma_f32_32x32x16_bf16(b1, qr[d0], p1, 0, 0, 0); }
  }
}
__device__ __forceinline__ int v_st(int k, int c) { const int kk = (k & ~0xC) | ((k & 4) << 1) | ((k & 8) >> 1); return ((kk >> 3) * 4 + (c >> 5)) * 512 + ((kk & 7) * 32 + (c & 31)) * 2; }
__device__ __forceinline__ int v_rd_base(int lane) { return ((lane & 3) << 3) | (((lane >> 2) & 3) << 6) | (((lane >> 4) & 1) << 5) | (((lane >> 5) & 1) << 8); }
constexpr int v_rd_off(int d0, int ks, int half) { return d0 * 512 + ks * 4096 + half * 2048; }
template <int OFF> __device__ __forceinline__ s16x4 tr_read(int vb) {
  s16x4 r; asm volatile("ds_read_b64_tr_b16 %0, %1 offset:%2" : "=&v"(r) : "v"(vb), "i"(OFF) : "memory"); return r;
}
template <int D0> __device__ __forceinline__ void pv_one(f32x16& od, int vb, bf16x8 pa0, bf16x8 pa1, bf16x8 pa2, bf16x8 pa3) {
  const s16x4 l0 = tr_read<v_rd_off(D0, 0, 0)>(vb), h0 = tr_read<v_rd_off(D0, 0, 1)>(vb), l1 = tr_read<v_rd_off(D0, 1, 0)>(vb), h1 = tr_read<v_rd_off(D0, 1, 1)>(vb);
  const s16x4 l2 = tr_read<v_rd_off(D0, 2, 0)>(vb), h2 = tr_read<v_rd_off(D0, 2, 1)>(vb), l3 = tr_read<v_rd_off(D0, 3, 0)>(vb), h3 = tr_read<v_rd_off(D0, 3, 1)>(vb);
  asm volatile("s_waitcnt lgkmcnt(0)" ::: "memory"); SBAR();
#define PK(L, H) (bf16x8){L[0], L[1], L[2], L[3], H[0], H[1], H[2], H[3]}
  od = __builtin_amdgcn_mfma_f32_32x32x16_bf16(pa0, PK(l0, h0), od, 0, 0, 0);
  od = __builtin_amdgcn_mfma_f32_32x32x16_bf16(pa1, PK(l1, h1), od, 0, 0, 0);
  od = __builtin_amdgcn_mfma_f32_32x32x16_bf16(pa2, PK(l2, h2), od, 0, 0, 0);
  od = __builtin_amdgcn_mfma_f32_32x32x16_bf16(pa3, PK(l3, h3), od, 0, 0, 0);
#undef PK
}
__device__ __forceinline__ void pv_d0(f32x16* o, int vb, bf16x8 pa0, bf16x8 pa1, bf16x8 pa2, bf16x8 pa3) {
  pv_one<0>(o[0], vb, pa0, pa1, pa2, pa3); pv_one<1>(o[1], vb, pa0, pa1, pa2, pa3); pv_one<2>(o[2], vb, pa0, pa1, pa2, pa3); pv_one<3>(o[3], vb, pa0, pa1, pa2, pa3);
}

struct Unit {
  const bf16* Q; const bf16* K; const bf16* V; bf16* O; float* lse;
  int qstride, kstride, ostride, lse_stride;
  int NT;
  int kb0, n, qi0, hw;
  float slope_raw;
  float sink; int has_sink;
};

template <bool BAND, int SM>
__device__ __forceinline__ void attn_unit(const Unit& U, char* lds, const int tid) {
  const int wid = tid >> 6, lane = tid & 63, r32 = lane & 31, hi = lane >> 5;
  char* V_lds = lds; char* K_lds = lds + 2 * SHM_V;
  float* ws = (float*)(lds + 2 * SHM_V + 2 * SHM_K) + wid * 64; float* li_l = ws; float* al_l = ws + 32;
  float m_reg = -1e30f, l_reg = 0; f32x16 o[4] = {}; bf16x8 qr[8];
  { int lq_ = lane; asm volatile("" : "+v"(lq_));
    const unsigned qoff = (unsigned)(wid * QBLK + (lq_ & 31)) * (unsigned)U.qstride + (unsigned)((lq_ >> 5) * 8);
#pragma unroll
    for (int d0 = 0; d0 < 8; ++d0) qr[d0] = *reinterpret_cast<const bf16x8*>(U.Q + qoff + d0 * 16); }
  const int sr = tid >> 4, sc = (tid & 15) * 8, vst0 = v_st(sr, sc), kst0 = KSWZ(sr, sc * 2);
  const int vb0 = (int)(uintptr_t)V_lds + v_rd_base(lane);
  struct { bf16x8 vs0, vs1, ks0, ks1; } sr_[BAND ? 1 : 2];
  float fq = 0.f;
  if constexpr (BAND) fq = (float)(U.qi0 + wid * QBLK + r32);
#define ROWOF(k) ((k) < 0 ? 0 : ((k) >= U.n ? U.n - 1 : (k)))
#define SLOAD(i, k0) do { unsigned _o0, _o1; \
    if constexpr (BAND) { const int _ka = U.kb0 + (k0) + sr; _o0 = (unsigned)ROWOF(_ka) * (unsigned)U.kstride + (unsigned)sc; _o1 = (unsigned)ROWOF(_ka + 32) * (unsigned)U.kstride + (unsigned)sc; } \
    else { _o0 = (unsigned)((k0) + sr) * (unsigned)U.kstride + (unsigned)sc; _o1 = _o0 + 32u * (unsigned)U.kstride; } \
    sr_[i].vs0 = *reinterpret_cast<const bf16x8*>(U.V + _o0); sr_[i].vs1 = *reinterpret_cast<const bf16x8*>(U.V + _o1); \
    sr_[i].ks0 = *reinterpret_cast<const bf16x8*>(U.K + _o0); sr_[i].ks1 = *reinterpret_cast<const bf16x8*>(U.K + _o1); } while (0)
#define SWRITE(b, i) do { *(bf16x8*)(V_lds + (b) * SHM_V + vst0) = sr_[i].vs0;          \
    *(bf16x8*)(V_lds + (b) * SHM_V + vst0 + 8192) = sr_[i].vs1;                         \
    *(bf16x8*)(K_lds + (b) * SHM_K + kst0) = sr_[i].ks0;                               \
    *(bf16x8*)(K_lds + (b) * SHM_K + kst0 + 8192) = sr_[i].ks1; } while (0)
#define SWAIT() asm volatile("s_waitcnt vmcnt(4)" ::: "memory")
#define QK_SCHED() do { if constexpr (SM == 2 && ATT_SCHED == 1) { __builtin_amdgcn_sched_group_barrier(0x100, 4, 0); \
    _Pragma("unroll") for (int i_ = 0; i_ < 7; ++i_) { __builtin_amdgcn_sched_group_barrier(0x008, 2, 0); __builtin_amdgcn_sched_group_barrier(0x002, 9, 0); __builtin_amdgcn_sched_group_barrier(0x100, 2, 0); } \
    __builtin_amdgcn_sched_group_barrier(0x008, 2, 0); __builtin_amdgcn_sched_group_barrier(0x002, 12, 0); } \
    if constexpr (SM == 2 && ATT_SCHED == 2) { _Pragma("unroll") for (int i_ = 0; i_ < 8; ++i_) { __builtin_amdgcn_sched_group_barrier(0x100, 2, 0); __builtin_amdgcn_sched_group_barrier(0x008, 2, 0); __builtin_amdgcn_sched_group_barrier(0x002, 9, 0); } } } while (0)
#define RESC(a) do { if constexpr (SM != 2) if (__any((a) < 1.f)) { if (hi == 0) al_l[r32] = (a); asm volatile("s_waitcnt lgkmcnt(0)" ::: "memory"); \
    _Pragma("unroll") for (int d = 0; d < 4; ++d) _Pragma("unroll") for (int r = 0; r < 16; ++r) o[d][r] *= al_l[crow(r, hi)]; } } while (0)
#define MASKB(P0, P1, j) do { if constexpr (BAND) { const float _f0 = ((float)(U.kb0 + 64 * (j)) + (float)(4 * hi)) - fq; const float _ninf = -__builtin_inff(); \
    const float flo = __builtin_fmaxf(-(float)U.hw, -fq), fhi = __builtin_fminf((float)U.hw, (float)(U.n - 1) - fq); \
    _Pragma("unroll") for (int r = 0; r < 16; ++r) { const float d0_ = _f0 + (float)((r & 3) + 8 * (r >> 2)), d1_ = d0_ + 32.f; \
      const float s0_ = fmaf(-U.slope_raw, __builtin_fabsf(d0_), P0[r]), s1_ = fmaf(-U.slope_raw, __builtin_fabsf(d1_), P1[r]); \
      P0[r] = (d0_ >= flo && d0_ <= fhi) ? s0_ : _ninf; P1[r] = (d1_ >= flo && d1_ <= fhi) ? s1_ : _ninf; } } } while (0)
  f32x16 pA0, pA1, pB0, pB1; float mnA, mnB, alA, alB; bf16x8 pa0, pa1, pa2, pa3; const int NT = U.NT;
  constexpr int SE = 0, SO = 1;
  if constexpr (BAND) {
  const int tlo_ = __builtin_amdgcn_readfirstlane(wid >> 1), thi_ = tlo_ + (U.hw >> 5);
#define ACT(j) (!WSKIP || ((j) >= tlo_ && (j) <= thi_))
  SLOAD(0, 0); SWRITE(0, 0); SLOAD(0, KVBLK); __syncthreads();
  if (ACT(0)) { qkt<(BAND_PREFETCH != 0)>(pA0, pA1, K_lds, qr, r32, hi); MASKB(pA0, pA1, 0); partialSM<SM>(pA0, pA1, m_reg, mnA, alA); }
  SWRITE(1, 0); if (2 < NT) SLOAD(0, 2 * KVBLK); __syncthreads();
  for (int j = 1; j + 1 < NT; j += 2) {
      { const bool aj = ACT(j), ap = ACT(j - 1);
        SBAR(); if (aj) qkt<(BAND_PREFETCH != 0)>(pB0, pB1, K_lds + SHM_K, qr, r32, hi);
        if (ap) { finishSM<SM>(pA0, pA1, alA, l_reg, pa0, pa1, pa2, pa3); SBAR(); pv_d0(o, vb0, pa0, pa1, pa2, pa3); }
        if (aj) { MASKB(pB0, pB1, j); partialSM<SM>(pB0, pB1, m_reg, mnB, alB); }
        __syncthreads(); SWRITE(0, 0); SLOAD(0, (j + 2) * KVBLK);
        if (aj) RESC(alB); __syncthreads(); }
      { const bool aj = ACT(j + 1), ap = ACT(j);
        SBAR(); if (aj) qkt<(BAND_PREFETCH != 0)>(pA0, pA1, K_lds, qr, r32, hi);
        if (ap) { finishSM<SM>(pB0, pB1, alB, l_reg, pa0, pa1, pa2, pa3); SBAR(); pv_d0(o, vb0 + SHM_V, pa0, pa1, pa2, pa3); }
        if (aj) { MASKB(pA0, pA1, j + 1); partialSM<SM>(pA0, pA1, m_reg, mnA, alA); }
        __syncthreads(); SWRITE(1, 0); if (j + 3 < NT) SLOAD(0, (j + 3) * KVBLK);
        if (aj) RESC(alA); __syncthreads(); }
  }
  { const bool aj = ACT(NT - 1), ap = ACT(NT - 2);
    SBAR(); if (aj) qkt<(BAND_PREFETCH != 0)>(pB0, pB1, K_lds + SHM_K, qr, r32, hi);
    if (ap) { finishSM<SM>(pA0, pA1, alA, l_reg, pa0, pa1, pa2, pa3); SBAR(); pv_d0(o, vb0, pa0, pa1, pa2, pa3); }
    if (aj) { MASKB(pB0, pB1, NT - 1); partialSM<SM>(pB0, pB1, m_reg, mnB, alB); }
    __syncthreads();
    if (aj) { RESC(alB);
      finishSM<SM>(pB0, pB1, alB, l_reg, pa0, pa1, pa2, pa3); SBAR();
      pv_d0(o, vb0 + SHM_V, pa0, pa1, pa2, pa3); } }
#undef ACT
  } else {
  SLOAD(SE, 0); asm volatile("s_waitcnt vmcnt(0)" ::: "memory"); SWRITE(0, SE); __syncthreads();
  qkt<(QKT_PREFETCH != 0) && SM == 2>(pA0, pA1, K_lds, qr, r32, hi); partialSM<SM>(pA0, pA1, m_reg, mnA, alA);
  SLOAD(SO, KVBLK); if (2 < NT) SLOAD(SE, 2 * KVBLK);
  SWAIT(); SWRITE(1, SO); __syncthreads();
  for (int j = 1; j + 1 < NT; j += 2) {
    SBAR(); qkt<(QKT_PREFETCH != 0) && SM == 2>(pB0, pB1, K_lds + SHM_K, qr, r32, hi);
    finishSM<SM>(pA0, pA1, alA, l_reg, pa0, pa1, pa2, pa3); QK_SCHED(); SBAR();
    SLOAD(SO, (j + 2) * KVBLK); SBAR();
    pv_d0(o, vb0, pa0, pa1, pa2, pa3); partialSM<SM>(pB0, pB1, m_reg, mnB, alB);
    __syncthreads(); SWAIT(); SWRITE(0, SE);
    RESC(alB); __syncthreads();
    SBAR(); qkt<(QKT_PREFETCH != 0) && SM == 2>(pA0, pA1, K_lds, qr, r32, hi);
    finishSM<SM>(pB0, pB1, alB, l_reg, pa0, pa1, pa2, pa3); QK_SCHED(); SBAR();
    if (j + 3 < NT) SLOAD(SE, (j + 3) * KVBLK); SBAR();
    pv_d0(o, vb0 + SHM_V, pa0, pa1, pa2, pa3); partialSM<SM>(pA0, pA1, m_reg, mnA, alA);
    __syncthreads(); SWAIT(); SWRITE(1, SO);
    RESC(alA); __syncthreads();
  }
  SBAR(); qkt<(QKT_PREFETCH != 0) && SM == 2>(pB0, pB1, K_lds + SHM_K, qr, r32, hi);
  finishSM<SM>(pA0, pA1, alA, l_reg, pa0, pa1, pa2, pa3); SBAR();
  pv_d0(o, vb0, pa0, pa1, pa2, pa3); partialSM<SM>(pB0, pB1, m_reg, mnB, alB);
  __syncthreads(); RESC(alB);
  finishSM<SM>(pB0, pB1, alB, l_reg, pa0, pa1, pa2, pa3); SBAR();
  pv_d0(o, vb0 + SHM_V, pa0, pa1, pa2, pa3);
  }
  if constexpr (BAND) {
    if (U.has_sink) l_reg += __builtin_amdgcn_exp2f((U.sink * (1.0f / SCALE) - m_reg) * (SCALE * 1.4426950408889634f));
    if (U.lse != nullptr && hi == 0) U.lse[(unsigned)(wid * QBLK + r32) * (unsigned)U.lse_stride] = m_reg * SCALE + __builtin_amdgcn_logf(l_reg) * 0.6931471805599453f;
  }
  int lane_e = lane; asm volatile("" : "+v"(lane_e));
  const int r32e = lane_e & 31, hie = lane_e >> 5;
  if (hie == 0) li_l[r32e] = l_reg; asm volatile("s_waitcnt lgkmcnt(0)" ::: "memory");
  float rli[16];
#pragma unroll
  for (int r = 0; r < 16; ++r) rli[r] = __builtin_amdgcn_rcpf(li_l[crow(r, hie)]);
  __syncthreads();
  char* ost = lds + wid * 8192;
  { char* op = ost + hie * 1024 + r32e * 2;
#pragma unroll
    for (int r = 0; r < 16; ++r) {
#pragma unroll
      for (int d0 = 0; d0 < 4; ++d0) { const unsigned w = cvtpk(o[d0][r] * rli[r], 0.f); *(unsigned short*)(op + ((r & 3) + 8 * (r >> 2)) * 256 + d0 * 64) = (unsigned short)w; } } }
  asm volatile("s_waitcnt lgkmcnt(0)" ::: "memory");
  { const char* ip = ost + (lane_e >> 4) * 256 + (lane_e & 15) * 16;
    unsigned goff = (unsigned)(wid * QBLK + (lane_e >> 4)) * (unsigned)U.ostride + (unsigned)((lane_e & 15) * 8); const unsigned gstep = 4u * (unsigned)U.ostride;
#pragma unroll
    for (int i = 0; i < 8; ++i) { const u32x4 w = *(const u32x4*)(ip + i * 1024); *(u32x4*)(U.O + goff) = w; goff += gstep; } }
  __syncthreads();
#undef ROWOF
#undef SLOAD
#undef SWRITE
#undef SWAIT
#undef QK_SCHED
#undef RESC
#undef MASKB
}

constexpr int SHM_RING = 3 * SHM_V + 2 * SHM_K + NW * 64 * 4;
__device__ __forceinline__ void attn_unit_ring(const Unit& U, char* lds, const int tid) {
  const int wid = tid >> 6, lane = tid & 63, r32 = lane & 31, hi = lane >> 5;
  char* V_lds = lds; char* K_lds = lds + 3 * SHM_V;
  float* ws = (float*)(lds + 3 * SHM_V + 2 * SHM_K) + wid * 64; float* li_l = ws;
  float m_reg = 0.f, l_reg = 0, mn_, al_ = 1.f; f32x16 o[4] = {}; bf16x8 qr[8];
  { const unsigned qoff = (unsigned)(wid * QBLK + r32) * (unsigned)U.qstride + (unsigned)(hi * 8);
#pragma unroll
    for (int d0 = 0; d0 < 8; ++d0) qr[d0] = *reinterpret_cast<const bf16x8*>(U.Q + qoff + d0 * 16); }
  const int sr = tid >> 4, sc = (tid & 15) * 8, vst0 = v_st(sr, sc), vst1 = v_st(32 + sr, sc);
  const int vb0 = (int)(uintptr_t)V_lds + v_rd_base(lane);
  struct { bf16x8 vs0, vs1, ks0, ks1; } sr_[1];
#define SLOAD(i, k0) do { const unsigned _o0 = (unsigned)((k0) + sr) * (unsigned)U.kstride + (unsigned)sc, _o1 = _o0 + 32u * (unsigned)U.kstride; \
    sr_[i].vs0 = *reinterpret_cast<const bf16x8*>(U.V + _o0); sr_[i].vs1 = *reinterpret_cast<const bf16x8*>(U.V + _o1); \
    sr_[i].ks0 = *reinterpret_cast<const bf16x8*>(U.K + _o0); sr_[i].ks1 = *reinterpret_cast<const bf16x8*>(U.K + _o1); } while (0)
#define SWRITE(kb, vsl, i) do { char* _v = V_lds + (vsl) * SHM_V; *(bf16x8*)(_v + vst0) = sr_[i].vs0; *(bf16x8*)(_v + vst1) = sr_[i].vs1; int kc = sc * 2; \
    *(bf16x8*)(K_lds + (kb) * SHM_K + KSWZ(sr, kc)) = sr_[i].ks0; *(bf16x8*)(K_lds + (kb) * SHM_K + KSWZ(32 + sr, kc)) = sr_[i].ks1; } while (0)
#define NEXT3(x) ((x) == 2 ? 0 : (x) + 1)
  f32x16 pA0, pA1, pB0, pB1; bf16x8 pa0, pa1, pa2, pa3; const int NT = U.NT;
  SLOAD(0, 0); SWRITE(0, 0, 0); SLOAD(0, KVBLK);
  __syncthreads();
  SWRITE(1, 1, 0); SLOAD(0, 2 * KVBLK);
  qkt<(QKT_PREFETCH != 0)>(pA0, pA1, K_lds, qr, r32, hi); partialSM<2>(pA0, pA1, m_reg, mn_, al_);
  __syncthreads();
  int vr = 0;
  for (int j = 1; j + 1 < NT; j += 2) {
    { const int vw = NEXT3(NEXT3(vr));
      SWRITE(0, vw, 0); SLOAD(0, (j + 2) * KVBLK);
      SBAR(); qkt<(QKT_PREFETCH != 0)>(pB0, pB1, K_lds + SHM_K, qr, r32, hi);
      finishSM<2>(pA0, pA1, al_, l_reg, pa0, pa1, pa2, pa3); SBAR();
      pv_d0(o, vb0 + vr * SHM_V, pa0, pa1, pa2, pa3); partialSM<2>(pB0, pB1, m_reg, mn_, al_);
      __syncthreads(); vr = NEXT3(vr); }
    { const int vw = NEXT3(NEXT3(vr));
      SWRITE(1, vw, 0); if (j + 3 < NT) SLOAD(0, (j + 3) * KVBLK);
      SBAR(); qkt<(QKT_PREFETCH != 0)>(pA0, pA1, K_lds, qr, r32, hi);
      finishSM<2>(pB0, pB1, al_, l_reg, pa0, pa1, pa2, pa3); SBAR();
      pv_d0(o, vb0 + vr * SHM_V, pa0, pa1, pa2, pa3); partialSM<2>(pA0, pA1, m_reg, mn_, al_);
      __syncthreads(); vr = NEXT3(vr); }
  }
  SBAR(); qkt<(QKT_PREFETCH != 0)>(pB0, pB1, K_lds + SHM_K, qr, r32, hi);
  finishSM<2>(pA0, pA1, al_, l_reg, pa0, pa1, pa2, pa3); SBAR();
  pv_d0(o, vb0 + vr * SHM_V, pa0, pa1, pa2, pa3); partialSM<2>(pB0, pB1, m_reg, mn_, al_);
  finishSM<2>(pB0, pB1, al_, l_reg, pa0, pa1, pa2, pa3); SBAR();
  pv_d0(o, vb0 + NEXT3(vr) * SHM_V, pa0, pa1, pa2, pa3);
  int lane_e = lane; asm volatile("" : "+v"(lane_e));
  const int r32e = lane_e & 31, hie = lane_e >> 5;
  if (hie == 0) li_l[r32e] = l_reg; asm volatile("s_waitcnt lgkmcnt(0)" ::: "memory");
  float rli[16];
#pragma unroll
  for (int r = 0; r < 16; ++r) rli[r] = __builtin_amdgcn_rcpf(li_l[crow(r, hie)]);
  __syncthreads();
  char* ost = lds + wid * 8192;
  { char* op = ost + hie * 1024 + r32e * 2;
#pragma unroll
    for (int r = 0; r < 16; ++r) {
#pragma unroll
      for (int d0 = 0; d0 < 4; ++d0) { const unsigned w = cvtpk(o[d0][r] * rli[r], 0.f); *(unsigned short*)(op + ((r & 3) + 8 * (r >> 2)) * 256 + d0 * 64) = (unsigned short)w; } } }
  asm volatile("s_waitcnt lgkmcnt(0)" ::: "memory");
  { const char* ip = ost + (lane_e >> 4) * 256 + (lane_e & 15) * 16;
    unsigned goff = (unsigned)(wid * QBLK + (lane_e >> 4)) * (unsigned)U.ostride + (unsigned)((lane_e & 15) * 8); const unsigned gstep = 4u * (unsigned)U.ostride;
#pragma unroll
    for (int i = 0; i < 8; ++i) { const u32x4 w = *(const u32x4*)(ip + i * 1024); *(u32x4*)(U.O + goff) = w; goff += gstep; } }
  __syncthreads();
#undef SLOAD
#undef SWRITE
#undef NEXT3
}

constexpr int DMA_KOFF = 0, DMA_VOFF = 3 * SHM_K, DMA_SCR = 3 * SHM_K + 4 * SHM_V, SHM_DMA = DMA_SCR + NW * 64 * 4;
typedef __attribute__((address_space(3))) unsigned char lds_u8;
__device__ __forceinline__ void attn_unit_dma(const Unit& U, char* lds, lds_u8* ldsl, const int tid) {
  const int wid = __builtin_amdgcn_readfirstlane(tid >> 6), lane = tid & 63, r32 = lane & 31, hi = lane >> 5;
  char* K_lds = lds + DMA_KOFF; char* V_lds = lds + DMA_VOFF;
  float* ws = (float*)(lds + DMA_SCR) + wid * 64; float* li_l = ws;
  float m_reg = 0.f, l_reg = 0, mn_, al_ = 1.f; f32x16 o[4] = {}; bf16x8 qr[8];
  { int lq_ = lane; asm volatile("" : "+v"(lq_));
    const unsigned qoff = (unsigned)(wid * QBLK + (lq_ & 31)) * (unsigned)U.qstride + (unsigned)((lq_ >> 5) * 8);
#pragma unroll
    for (int d0 = 0; d0 < 8; ++d0) qr[d0] = *reinterpret_cast<const bf16x8*>(U.Q + qoff + d0 * 16); }
  unsigned koff[2], voff[2];
#pragma unroll
  for (int i = 0; i < 2; ++i) { const int p = (wid * 2 + i) * 64 + lane;
    { const int row = p >> 4, cs = p & 15, c = cs ^ (row & 7); koff[i] = ((unsigned)row * (unsigned)U.kstride + (unsigned)(c * 8)) * 2u; }
    { const int st = p >> 5, q = p & 31, kk = (st >> 2) * 8 + (q >> 2), key = (kk & ~0xC) | ((kk & 4) << 1) | ((kk & 8) >> 1), c = (st & 3) * 32 + (q & 3) * 8; voff[i] = ((unsigned)key * (unsigned)U.kstride + (unsigned)c) * 2u; } }
  const int vb0 = (int)(uintptr_t)V_lds + v_rd_base(lane);
  const unsigned ldsw = (unsigned)wid * 2048u;
#define NEXT3(x) ((x) == 2 ? 0 : (x) + 1)
#define NEXT4(x) (((x) + 1) & 3)
#define DMA_TILE(t, ks, vs) do { const int t_ = (t); const char* kb_ = (const char*)(U.K + (size_t)t_ * KVBLK * U.kstride); const char* vb_ = (const char*)(U.V + (size_t)t_ * KVBLK * U.kstride); \
    _Pragma("unroll") for (int i_ = 0; i_ < 2; ++i_) { \
      __builtin_amdgcn_global_load_lds((const unsigned*)(kb_ + koff[i_]), (__attribute__((address_space(3))) unsigned*)(ldsl + DMA_KOFF + (ks) * SHM_K + ldsw + i_ * 1024), 16, 0, 0); \
      __builtin_amdgcn_global_load_lds((const unsigned*)(vb_ + voff[i_]), (__attribute__((address_space(3))) unsigned*)(ldsl + DMA_VOFF + (vs) * SHM_V + ldsw + i_ * 1024), 16, 0, 0); } } while (0)
#define STEP_BAR() do { asm volatile("s_waitcnt vmcnt(4) lgkmcnt(0)" ::: "memory"); __builtin_amdgcn_s_barrier(); asm volatile("" ::: "memory"); } while (0)
#define STEP_BAR0() do { asm volatile("s_waitcnt vmcnt(0) lgkmcnt(0)" ::: "memory"); __builtin_amdgcn_s_barrier(); asm volatile("" ::: "memory"); } while (0)
  f32x16 pA0, pA1, pB0, pB1; bf16x8 pa0, pa1, pa2, pa3; const int NT = U.NT;
  asm volatile("s_waitcnt vmcnt(0)" ::: "memory");
  DMA_TILE(0, 0, 0); DMA_TILE(1, 1, 1);
  STEP_BAR();
  DMA_TILE(2, 2, 2);
  qkt<(QKT_PREFETCH != 0)>(pA0, pA1, K_lds, qr, r32, hi); partialSM<2>(pA0, pA1, m_reg, mn_, al_);
  STEP_BAR();
  int ks = 1, vs = 1;
  for (int j = 1; j + 1 < NT; j += 2) {
    { const int kw = NEXT3(NEXT3(ks)), vw = NEXT4(NEXT4(vs));
      const bool more_ = j + 2 < NT;
      SBAR(); qkt<(QKT_PREFETCH != 0)>(pB0, pB1, K_lds + ks * SHM_K, qr, r32, hi);
      finishSM<2>(pA0, pA1, al_, l_reg, pa0, pa1, pa2, pa3); SBAR();
      if (more_) DMA_TILE(j + 2, kw, vw); SBAR();
      pv_d0(o, vb0 + ((vs + 3) & 3) * SHM_V, pa0, pa1, pa2, pa3); partialSM<2>(pB0, pB1, m_reg, mn_, al_);
      if (more_) STEP_BAR(); else STEP_BAR0(); ks = NEXT3(ks); vs = NEXT4(vs); }
    { const int kw = NEXT3(NEXT3(ks)), vw = NEXT4(NEXT4(vs));
      const bool more_ = j + 3 < NT;
      SBAR(); qkt<(QKT_PREFETCH != 0)>(pA0, pA1, K_lds + ks * SHM_K, qr, r32, hi);
      finishSM<2>(pB0, pB1, al_, l_reg, pa0, pa1, pa2, pa3); SBAR();
      if (more_) DMA_TILE(j + 3, kw, vw); SBAR();
      pv_d0(o, vb0 + ((vs + 3) & 3) * SHM_V, pa0, pa1, pa2, pa3); partialSM<2>(pA0, pA1, m_reg, mn_, al_);
      if (more_) STEP_BAR(); else STEP_BAR0(); ks = NEXT3(ks); vs = NEXT4(vs); }
  }
  SBAR(); qkt<(QKT_PREFETCH != 0)>(pB0, pB1, K_lds + ks * SHM_K, qr, r32, hi);
  finishSM<2>(pA0, pA1, al_, l_reg, pa0, pa1, pa2, pa3); SBAR();
  pv_d0(o, vb0 + ((vs + 3) & 3) * SHM_V, pa0, pa1, pa2, pa3); partialSM<2>(pB0, pB1, m_reg, mn_, al_);
  finishSM<2>(pB0, pB1, al_, l_reg, pa0, pa1, pa2, pa3); SBAR();
  pv_d0(o, vb0 + vs * SHM_V, pa0, pa1, pa2, pa3);
  asm volatile("s_waitcnt vmcnt(0) lgkmcnt(0)" ::: "memory");
  int lane_e = lane; asm volatile("" : "+v"(lane_e));
  const int r32e = lane_e & 31, hie = lane_e >> 5;
  if (hie == 0) li_l[r32e] = l_reg; asm volatile("s_waitcnt lgkmcnt(0)" ::: "memory");
  float rli[16];
#pragma unroll
  for (int r = 0; r < 16; ++r) rli[r] = __builtin_amdgcn_rcpf(li_l[crow(r, hie)]);
  __syncthreads();
  char* ost = lds + wid * 8192;
  { char* op = ost + hie * 1024 + r32e * 2;
#pragma unroll
    for (int r = 0; r < 16; ++r) {
#pragma unroll
      for (int d0 = 0; d0 < 4; ++d0) { const unsigned w = cvtpk(o[d0][r] * rli[r], 0.f); *(unsigned short*)(op + ((r & 3) + 8 * (r >> 2)) * 256 + d0 * 64) = (unsigned short)w; } } }
  asm volatile("s_waitcnt lgkmcnt(0)" ::: "memory");
  { const char* ip = ost + (lane_e >> 4) * 256 + (lane_e & 15) * 16;
    unsigned goff = (unsigned)(wid * QBLK + (lane_e >> 4)) * (unsigned)U.ostride + (unsigned)((lane_e & 15) * 8); const unsigned gstep = 4u * (unsigned)U.ostride;
#pragma unroll
    for (int i = 0; i < 8; ++i) { const u32x4 w = *(const u32x4*)(ip + i * 1024); *(u32x4*)(U.O + goff) = w; goff += gstep; } }
  __syncthreads();
#undef NEXT3
#undef NEXT4
#undef DMA_TILE
#undef STEP_BAR
#undef STEP_BAR0
}
}

constexpr int NWAVES = 8;
constexpr int DM = 2048, SEQ = 16384, NSEQ = 3, M_ALL = NSEQ * SEQ, DEPTH = 4, DFF = 5632, INC = 13824;
constexpr int A_Q = 0, A_K = 1536, A_V = 3072, B_Q = 4608, B_K = 5632, B_V = 5888, C_Q = 6144, C_K = 7168, C_V = 7424, GL0 = 7680;
constexpr float NORM_EPS = 1e-6f;
enum { I_XP = 0, I_XS, I_NF1, I_F1IN, I_F1OUT, I_NMIX, I_WIN, I_QNQ, I_QNK, I_SINK, I_WA, I_WB, I_WC, I_WO, I_NF2, I_F2IN, I_F2OUT, I_NFIN, N_IN };

constexpr size_t MiB = 1u << 20;
constexpr size_t WS_CTL = 0, CTL_ZERO_BYTES = 1 * MiB;
constexpr int LDW = DM + LDW_PAD, LDU = DM + LDU_PAD;
constexpr size_t WL_F1IN = 0, WL_F1OUT = WL_F1IN + (size_t)2 * DFF * LDW * 2, WL_WIN = WL_F1OUT + (size_t)DM * DFF * 2, WL_WA = WL_WIN + (size_t)INC * LDW * 2,
                 WL_WB = WL_WA + (size_t)DM * 512 * 2, WL_WC = WL_WB + (size_t)DM * 1024 * 2, WL_WO = WL_WC + (size_t)DM * 1024 * 2, WL_F2IN = WL_WO + (size_t)DM * LDW * 2,
                 WL_F2OUT = WL_F2IN + (size_t)2 * DFF * LDW * 2, WL_BYTES = WL_F2OUT + (size_t)DM * DFF * 2;
constexpr size_t WS_W = 1 * MiB;
constexpr size_t WS_U = WS_W + DEPTH * WL_BYTES;
constexpr size_t WS_R = WS_U + (size_t)M_ALL * LDU * 2;
constexpr size_t WS_H = WS_R;
constexpr size_t WS_QKVG = WS_R;
constexpr int OCAT = 2560;
constexpr size_t WS_OCAT = WS_QKVG + (size_t)SEQ * INC * 2;
constexpr size_t WS_OA = WS_OCAT, WS_OB = WS_OCAT + 512 * 2, WS_OC = WS_OCAT + 1536 * 2;
constexpr size_t WS_PA = WS_OCAT + (size_t)SEQ * OCAT * 2;
constexpr size_t WS_LSE = WS_PA + (size_t)3 * SEQ * 512 * 2;
constexpr size_t WS_QB = WS_LSE + (size_t)3 * SEQ * 4 * 4;
constexpr size_t WS_KB = WS_QB + (size_t)SEQ * 1024 * 2;
constexpr size_t WS_VB = WS_KB + (size_t)SEQ * 256 * 2;
constexpr size_t WS_MG = WS_VB + (size_t)SEQ * 256 * 2;
constexpr size_t WS_MB = WS_MG + (size_t)SEQ * DM * 4;
constexpr size_t WS_MIX_END = WS_MB + (size_t)SEQ * LDU * 2;
constexpr int LDH = DFF + LDH_PAD;
constexpr size_t WS_H_END = WS_H + (size_t)M_ALL * LDH * 2;
constexpr size_t WS_END = WS_MIX_END > WS_H_END ? WS_MIX_END : WS_H_END;
constexpr int CW_BAR = 4096;

constexpr int RING_OFF = 0, RING_BYTES = 131072;
constexpr int LDSCTL_OFF = RING_BYTES, MISC_OFF = LDSCTL_OFF + 320;
constexpr int LDS_BYTES = 147456;
constexpr int DIAG_OFF = MISC_OFF + 256;

#define GAS __attribute__((address_space(1)))
#define LAS __attribute__((address_space(3)))
typedef unsigned short bf16;
typedef unsigned v4u __attribute__((ext_vector_type(4)));
typedef unsigned v2u __attribute__((ext_vector_type(2)));
typedef float f32x4 __attribute__((ext_vector_type(4)));
#define LDS_WAIT() asm volatile("s_waitcnt lgkmcnt(0)" ::: "memory")
#define VM_WAIT() asm volatile("s_waitcnt vmcnt(0)" ::: "memory")
__device__ __forceinline__ unsigned f2bf(float f) { unsigned u = __builtin_bit_cast(unsigned, f); return (u + 0x7fffu + ((u >> 16) & 1u)) >> 16; }
__device__ __forceinline__ unsigned pk2(float lo, float hi) { return f2bf(lo) | (f2bf(hi) << 16); }
__device__ __forceinline__ float bflo(unsigned w) { return __uint_as_float(w << 16); }
__device__ __forceinline__ float bfhi(unsigned w) { return __uint_as_float(w & 0xffff0000u); }

#define XB_TMO      128
#define XB_XCNT(j)  (256  + 64 * (j))
#define XB_XSUB(j)  (1280 + 64 * (j))
#define XB_XGEN(j)  (2304 + 64 * (j))
#define XB_TOP      3328
#define XB_TOPGEN   3392
#define XCD_BAR_WORDS 3456
#define XB_SPIN_CAP (1u << 18)
__device__ __forceinline__ unsigned xb_ld(unsigned* p)              { return __hip_atomic_load(p, __ATOMIC_RELAXED, __HIP_MEMORY_SCOPE_AGENT); }
__device__ __forceinline__ unsigned xb_add(unsigned* p, unsigned v) { return __hip_atomic_fetch_add(p, v, __ATOMIC_RELAXED, __HIP_MEMORY_SCOPE_AGENT); }
__device__ __forceinline__ unsigned xb_xcc_id() { return (unsigned)__builtin_amdgcn_s_getreg((3 << 11) | 20) & 0xFu; }
#define XB_SPIN(cond, bar) do { unsigned _sp = 0; while (cond) { __builtin_amdgcn_s_sleep(1); \
    if ((++_sp & 255u) == 0u) { if (xb_ld(&(bar)[XB_TMO])) break; if (_sp > XB_SPIN_CAP) { atomicAdd(&(bar)[XB_TMO], 1u); break; } } } } while (0)
struct XcdBarrier { unsigned* bar; unsigned x; volatile LAS unsigned* st; };
__device__ __forceinline__ XcdBarrier xcd_barrier_post(unsigned* bar, volatile LAS unsigned* st) {
    XcdBarrier b; b.bar = bar; b.x = xb_xcc_id(); b.st = st;
    if (threadIdx.x == 0) (void)xb_add(&bar[XB_XCNT(b.x)], 1u);
    return b;
}
__device__ __forceinline__ void xcd_barrier_complete(unsigned* bar, unsigned x, unsigned& nloc, unsigned& nx) {
    const unsigned G = gridDim.x * gridDim.y * gridDim.z;
    unsigned sum, cnt, mine, sp = 0u;
    for (;;) {
        sum = 0u; cnt = 0u; mine = 0u;
#pragma unroll
        for (unsigned j = 0; j < 16; ++j) { const unsigned c = xb_ld(&bar[XB_XCNT(j)]); sum += c; cnt += (c > 0u) ? 1u : 0u; mine = (j == x) ? c : mine; }
        if (sum == G) break;
        __builtin_amdgcn_s_sleep(1);
        if ((++sp & 255u) == 0u) { if (xb_ld(&bar[XB_TMO])) break; if (sp > XB_SPIN_CAP) { atomicAdd(&bar[XB_TMO], 1u); break; } }
    }
    nloc = mine > 0u ? mine : 1u; nx = cnt > 0u ? cnt : 1u;
}
__device__ __forceinline__ void xcd_barrier(const XcdBarrier& b) {
    asm volatile("s_waitcnt vmcnt(0)" ::: "memory");
    __syncthreads();
    if (threadIdx.x == 0) {
        unsigned* bar = b.bar;
        __builtin_amdgcn_s_waitcnt(0);
        unsigned nloc = b.st[0], nx = b.st[1];
        if (nloc == 0u) { xcd_barrier_complete(bar, b.x, nloc, nx); b.st[0] = nloc; b.st[1] = nx; }
        const unsigned old = xb_add(&bar[XB_XSUB(b.x)], 1u);
        const unsigned gen = old / nloc;
        if (old + 1u == (gen + 1u) * nloc) {
            __builtin_amdgcn_fence(__ATOMIC_RELEASE, "agent");
            asm volatile("s_waitcnt vmcnt(0)" ::: "memory");
            const unsigned og = xb_add(&bar[XB_TOP], 1u);
            const unsigned tg = og / nx;
            if (og + 1u == (tg + 1u) * nx) xb_add(&bar[XB_TOPGEN], 1u);
            else XB_SPIN(xb_ld(&bar[XB_TOPGEN]) == tg, bar);
            __builtin_amdgcn_fence(__ATOMIC_ACQUIRE, "agent");
            xb_add(&bar[XB_XGEN(b.x)], 1u);
            asm volatile("s_waitcnt vmcnt(0)" ::: "memory");
        } else {
            XB_SPIN(xb_ld(&bar[XB_XGEN(b.x)]) == gen, bar);
            __builtin_amdgcn_fence(__ATOMIC_ACQUIRE, "agent");
            asm volatile("s_waitcnt vmcnt(0)" ::: "memory");
        }
    }
    __syncthreads();
}

template <int XOR> __device__ __forceinline__ float swz_xor(float v) { return __int_as_float(__builtin_amdgcn_ds_swizzle(__float_as_int(v), (XOR << 10) | 0x1F)); }
__device__ __forceinline__ float wave_sum(float v) {
    v += swz_xor<1>(v); v += swz_xor<2>(v); v += swz_xor<4>(v); v += swz_xor<8>(v); v += swz_xor<16>(v);
    auto rr = __builtin_amdgcn_permlane32_swap(__float_as_uint(v), __float_as_uint(v), false, false);
    return __uint_as_float(rr[0]) + __uint_as_float(rr[1]);
}
__device__ __forceinline__ float wave_max(float v) {
    v = fmaxf(v, swz_xor<1>(v)); v = fmaxf(v, swz_xor<2>(v)); v = fmaxf(v, swz_xor<4>(v)); v = fmaxf(v, swz_xor<8>(v)); v = fmaxf(v, swz_xor<16>(v));
    auto rr = __builtin_amdgcn_permlane32_swap(__float_as_uint(v), __float_as_uint(v), false, false);
    return fmaxf(__uint_as_float(rr[0]), __uint_as_float(rr[1]));
}
__device__ __forceinline__ void transpose_item(const float* W, int K, int N, bf16* WT, int k0, int n0, int orow0, LAS float* scr, int lane, int ldw) {
#pragma unroll 8
    for (int i = 0; i < 32; ++i) { const int kk = 2 * i + (lane >> 5); scr[kk * 33 + (lane & 31)] = W[(size_t)(k0 + kk) * N + n0 + (lane & 31)]; }
    LDS_WAIT(); asm volatile("" ::: "memory");
    const int c = lane & 7;
#pragma unroll
    for (int j = 0; j < 4; ++j) { const int n = (lane >> 3) + 8 * j; const LAS float* s = scr + (8 * c) * 33 + n;
        v4u o; o.x = pk2(s[0 * 33], s[1 * 33]); o.y = pk2(s[2 * 33], s[3 * 33]); o.z = pk2(s[4 * 33], s[5 * 33]); o.w = pk2(s[6 * 33], s[7 * 33]);
        *(GAS v4u*)(WT + (size_t)(orow0 + n) * ldw + k0 + 8 * c) = o; }
    LDS_WAIT(); asm volatile("" ::: "memory");
}
__device__ __forceinline__ void transpose_matrix(const float* W, int K, int N, bf16* WT, int swiglu, LAS float* scr, int lane, int gw, int NGW, int ldw = 0) {
    const int nblk = N / 32, nitems = (K / 64) * nblk;
    for (int it = gw; it < nitems; it += NGW) {
        const int kb = it / nblk, nb = it % nblk, k0 = 64 * kb, n0 = 32 * nb;
        int orow0 = n0;
        if (swiglu) { const int half = n0 >= DFF ? 1 : 0, np = n0 - half * DFF; orow0 = 256 * (np / 128) + 128 * half + (np % 128); }
        transpose_item(W, K, N, WT, k0, n0, orow0, scr, lane, ldw ? ldw : K);
    }
}
__device__ __forceinline__ void rms_row_to_bf16(const float* xrow, const float* g, bf16* orow, float* xcopy, int lane) {
    const GAS f32x4* xr = (const GAS f32x4*)xrow + lane; const GAS f32x4* gr = (const GAS f32x4*)g + lane;
    f32x4 v[8]; float s = 0.f;
#pragma unroll
    for (int j = 0; j < 8; ++j) { v[j] = xr[64 * j]; s += (v[j].x * v[j].x + v[j].y * v[j].y) + (v[j].z * v[j].z + v[j].w * v[j].w); }
    if (xcopy) { GAS f32x4* xc = (GAS f32x4*)xcopy + lane;
#pragma unroll
        for (int j = 0; j < 8; ++j) xc[64 * j] = v[j]; }
    const float rstd = __builtin_amdgcn_rsqf(wave_sum(s) * (1.f / DM) + NORM_EPS);
    GAS v2u* o8 = (GAS v2u*)orow + lane;
#pragma unroll
    for (int j = 0; j < 8; ++j) { const f32x4 gg = gr[64 * j]; v2u w; w.x = pk2(v[j].x * rstd * gg.x, v[j].y * rstd * gg.y); w.y = pk2(v[j].z * rstd * gg.z, v[j].w * rstd * gg.w); o8[64 * j] = w; }
}
__device__ __forceinline__ void rms_row_f32(float* xrow, const float* g, int lane) {
    GAS f32x4* xr = (GAS f32x4*)xrow + lane; const GAS f32x4* gr = (const GAS f32x4*)g + lane;
    f32x4 v[8]; float s = 0.f;
#pragma unroll
    for (int j = 0; j < 8; ++j) { v[j] = xr[64 * j]; s += (v[j].x * v[j].x + v[j].y * v[j].y) + (v[j].z * v[j].z + v[j].w * v[j].w); }
    const float rstd = __builtin_amdgcn_rsqf(wave_sum(s) * (1.f / DM) + NORM_EPS);
#pragma unroll
    for (int j = 0; j < 8; ++j) { const f32x4 gg = gr[64 * j]; xr[64 * j] = v[j] * rstd * gg; }
}
constexpr float QPRESCALE = 0.088388347648318440f * 1.4426950408889634f;
template <int NT_>
__device__ __forceinline__ void ropeB_tokens(const bf16* qkvg, int t0, int tstep, const float* gq, const float* gk, bf16* qb, bf16* kb, bf16* vb, int lane) {
    const int f = lane & 31;
    const float invrev = __builtin_amdgcn_exp2f((float)f * (-13.287712379549449f / 32.0f)) * 0.15915494309189535f;
    const float gq0 = gq[2 * lane], gq1 = gq[2 * lane + 1], gk0 = gk[2 * lane], gk1 = gk[2 * lane + 1];
    unsigned w[NT_][10]; v2u vv[NT_];
#pragma unroll
    for (int i = 0; i < NT_; ++i) { const int t = t0 + i * tstep; const GAS unsigned* src = (const GAS unsigned*)(qkvg + (size_t)t * INC + B_Q) + lane;
#pragma unroll
        for (int h = 0; h < 10; ++h) w[i][h] = src[h * 64];
        vv[i] = ((const GAS v2u*)(qkvg + (size_t)t * INC + B_V))[lane]; }
#pragma unroll
    for (int i = 0; i < NT_; ++i) { const int t = t0 + i * tstep;
        const float pos = (float)((lane < 32) ? (t >> 6) : (t & 63));
        float rev = pos * invrev; rev = rev - __builtin_floorf(rev);
        const float cs = __builtin_amdgcn_cosf(rev), sn = __builtin_amdgcn_sinf(rev);
#pragma unroll
        for (int h = 0; h < 10; ++h) {
            const float x0 = bflo(w[i][h]), x1 = bfhi(w[i][h]);
            const float rstd = __builtin_amdgcn_rsqf(wave_sum(x0 * x0 + x1 * x1) * (1.f / 128.f) + NORM_EPS);
            const float y0 = x0 * rstd * (h < 8 ? gq0 : gk0), y1 = x1 * rstd * (h < 8 ? gq1 : gk1);
            const float qs = h < 8 ? QPRESCALE : 1.0f;
            const unsigned o = pk2((y0 * cs - y1 * sn) * qs, (y0 * sn + y1 * cs) * qs);
            if (h < 8) ((GAS unsigned*)(qb + (size_t)t * 1024))[h * 64 + lane] = o; else ((GAS unsigned*)(kb + (size_t)t * 256))[(h - 8) * 64 + lane] = o;
        }
        ((GAS v2u*)(vb + (size_t)t * 256))[lane] = vv[i]; }
}
__device__ __forceinline__ void mergeA_token(const bf16* pa, const float* lse, bf16* oa, int t, int lane) {
#pragma unroll
    for (int hh = 0; hh < 4; ++hh) {
        const float l0 = lse[((size_t)0 * SEQ + t) * 4 + hh], l1 = lse[((size_t)1 * SEQ + t) * 4 + hh], l2 = lse[((size_t)2 * SEQ + t) * 4 + hh];
        const float mx = fmaxf(l0, fmaxf(l1, l2));
        const float e0 = __builtin_amdgcn_exp2f((l0 - mx) * 1.4426950408889634f), e1 = __builtin_amdgcn_exp2f((l1 - mx) * 1.4426950408889634f), e2 = __builtin_amdgcn_exp2f((l2 - mx) * 1.4426950408889634f);
        const float inv = __builtin_amdgcn_rcpf(e0 + e1 + e2);
        const unsigned w0 = ((const GAS unsigned*)(pa + ((size_t)0 * SEQ + t) * 512))[hh * 64 + lane], w1 = ((const GAS unsigned*)(pa + ((size_t)1 * SEQ + t) * 512))[hh * 64 + lane],
                       w2 = ((const GAS unsigned*)(pa + ((size_t)2 * SEQ + t) * 512))[hh * 64 + lane];
        const float a = (e0 * bflo(w0) + e1 * bflo(w1) + e2 * bflo(w2)) * inv, b = (e0 * bfhi(w0) + e1 * bfhi(w1) + e2 * bfhi(w2)) * inv;
        ((GAS unsigned*)(oa + (size_t)t * OCAT))[hh * 64 + lane] = pk2(a, b);
    }
}

struct Args { const float* in[N_IN]; float* out; unsigned char* ws; int ph_lo, ph_hi; };
constexpr int N_PHASES = 1 + DEPTH * (3 + 1 + NSEQ * 5 + 3) + 1;

__device__ __forceinline__ int opq_v(int x) { asm volatile("" : "+v"(x)); return x; }
template <class T> __device__ __forceinline__ T* opq_p(T* p) { GAS T* g = (GAS T*)p; asm volatile("" : "+s"(g)); return (T*)g; }
__device__ __forceinline__ int lane_id_asm() { int l; asm volatile("v_mbcnt_lo_u32_b32 %0, -1, 0\n\tv_mbcnt_hi_u32_b32 %0, -1, %0" : "=v"(l)); return l; }
__device__ __forceinline__ int opq_s(int x) { asm volatile("" : "+s"(x)); return x; }

__global__ void __launch_bounds__(NWAVES * 64, 2) trunk_fwd(Args args) {
    extern __shared__ __attribute__((aligned(16))) unsigned char lds[];
    LAS unsigned char* ldsl = (LAS unsigned char*)lds;
    volatile LAS unsigned* MISC = (volatile LAS unsigned*)(ldsl + MISC_OFF);
    const int G_k = gridDim.x; const int bx_k = blockIdx.x;
    const int wave0 = __builtin_amdgcn_readfirstlane((int)threadIdx.x >> 6);
    { const int tid0 = threadIdx.x;
      for (int u = tid0; u < (LDS_BYTES - LDSCTL_OFF) / 4; u += NWAVES * 64) ((LAS unsigned*)(ldsl + LDSCTL_OFF))[u] = 0u; }
    __syncthreads();
    XcdBarrier bar; bar.bar = (unsigned*)(args.ws + WS_CTL) + CW_BAR; bar.x = 0; bar.st = nullptr;
    if (!MK_PER_PHASE) bar = xcd_barrier_post((unsigned*)(args.ws + WS_CTL) + CW_BAR, MISC + 8);
    const int lo = args.ph_lo, hi = args.ph_hi;
    int ph = 0;
#define PH_ON (ph >= lo && ph < hi)
#define PH_VARS const int G = opq_s(G_k), bx = opq_s(bx_k), vcu = (G % 8 == 0) ? (bx % 8) * (G / 8) + bx / 8 : bx, NGW = G * NWAVES; (void)NGW; const int lane = lane_id_asm(), wave = wave0, tid = wave * 64 + lane, gw = vcu * NWAVES + wave; unsigned char* ws = opq_p(args.ws); float* X = opq_p(args.out); (void)lane; (void)gw; (void)ws; (void)X
#if DIAG
#define PH_STAMP(ty) do { if (bx_k == 0 && wave0 == 0 && lane_id_asm() == 0) { const unsigned long long t_ = __builtin_amdgcn_s_memrealtime(); volatile LAS unsigned long long* ts_ = (volatile LAS unsigned long long*)(ldsl + DIAG_OFF); \
    ts_[1 + (ty)] += t_ - ts_[0]; ts_[0] = t_; } } while (0)
#else
#define PH_STAMP(ty) do { } while (0)
#endif
#define PH_DUP(ty) ((ty) == DUP_TYPE)
#define GRID_BARRIER() do { XcdBarrier b2_ = bar; b2_.bar = opq_p(bar.bar); b2_.x = (unsigned)opq_s((int)bar.x); xcd_barrier(b2_); } while (0)
#define PH_BEGIN(ty) if (PH_ON) { for (int rep_ = 0; rep_ < (PH_DUP(ty) ? 2 : 1); ++rep_) { PH_VARS; (void)rep_;
#define PH_CLOSE(ty) if (PH_DUP(ty) && rep_ == 0) GRID_BARRIER(); } } PH_END(ty)
#define PH_END(ty) do { if (PH_ON && ph + 1 < hi) { XcdBarrier b2_ = bar; b2_.bar = opq_p(bar.bar); b2_.x = (unsigned)opq_s((int)bar.x); xcd_barrier(b2_); } if (PH_ON) PH_STAMP(ty); ++ph; } while (0)

    PH_BEGIN(0)

        LAS float* scr = (LAS float*)(ldsl + RING_OFF + wave * 16384);
        for (int l = 0; l < DEPTH; ++l) {
            unsigned char* wl = ws + WS_W + (size_t)l * WL_BYTES;
            transpose_matrix(args.in[I_F1IN] + (size_t)l * DM * 2 * DFF, DM, 2 * DFF, (bf16*)(wl + WL_F1IN), 1, scr, lane, gw, NGW, LDW);
            transpose_matrix(args.in[I_F1OUT] + (size_t)l * DFF * DM, DFF, DM, (bf16*)(wl + WL_F1OUT), 0, scr, lane, gw, NGW);
            transpose_matrix(args.in[I_WIN] + (size_t)l * DM * INC, DM, INC, (bf16*)(wl + WL_WIN), 0, scr, lane, gw, NGW, LDW);
            transpose_matrix(args.in[I_WA] + (size_t)l * 512 * DM, 512, DM, (bf16*)(wl + WL_WA), 0, scr, lane, gw, NGW, OCAT);
            transpose_matrix(args.in[I_WB] + (size_t)l * 1024 * DM, 1024, DM, (bf16*)(wl + WL_WA) + 512, 0, scr, lane, gw, NGW, OCAT);
            transpose_matrix(args.in[I_WC] + (size_t)l * 1024 * DM, 1024, DM, (bf16*)(wl + WL_WA) + 1536, 0, scr, lane, gw, NGW, OCAT);
            transpose_matrix(args.in[I_WO] + (size_t)l * DM * DM, DM, DM, (bf16*)(wl + WL_WO), 0, scr, lane, gw, NGW, LDW);
            transpose_matrix(args.in[I_F2IN] + (size_t)l * DM * 2 * DFF, DM, 2 * DFF, (bf16*)(wl + WL_F2IN), 1, scr, lane, gw, NGW, LDW);
            transpose_matrix(args.in[I_F2OUT] + (size_t)l * DFF * DM, DFF, DM, (bf16*)(wl + WL_F2OUT), 0, scr, lane, gw, NGW);
        }
        bf16* U = (bf16*)(ws + WS_U);
        for (int m = gw; m < M_ALL; m += NGW) {
            const float* xr = (m < 2 * SEQ) ? args.in[I_XP] + (size_t)m * DM : args.in[I_XS] + (size_t)(m - 2 * SEQ) * DM;
            rms_row_to_bf16(xr, args.in[I_NF1], U + (size_t)m * LDU, X + (size_t)m * DM, lane);
        }
    PH_CLOSE(0);

    for (int l = 0; l < DEPTH; ++l) {
        for (int half = 0; half < 2; ++half) {
            PH_BEGIN(1)

                if (!(l == 0 && half == 0)) {
                    bf16* U = (bf16*)(ws + WS_U);
                    const float* g = (half == 0 ? args.in[I_NF1] : args.in[I_NF2]) + (size_t)l * DM;
                    for (int m = gw; m < M_ALL; m += NGW) rms_row_to_bf16(X + (size_t)m * DM, g, U + (size_t)m * LDU, nullptr, lane);
                }
            PH_CLOSE(1);
            PH_BEGIN(2)

                unsigned char* wl = ws + WS_W + (size_t)l * WL_BYTES;
                pg8::Gemm g{(const bf16*)(ws + WS_U), (const bf16*)(wl + (half == 0 ? WL_F1IN : WL_F2IN)), M_ALL, 2 * DFF, DM, LDU, LDW}; pg8::StaticOrder S; S.init(M_ALL, 2 * DFF, G, bx);
                if (EXTRA == 1) { pg8::EpiNull E0; pg8::gemm_phase<pg8::EpiNull, pg8::StaticOrder, true, true>(ldsl + RING_OFF, g, S, E0, tid); GRID_BARRIER(); }
                pg8::EpiSwiglu E{(bf16*)(ws + WS_H), LDH};
                pg8::gemm_phase<pg8::EpiSwiglu, pg8::StaticOrder, true, true>(ldsl + RING_OFF, g, S, E, tid, (unsigned)(STAG_STEP * ((bx >> 3) & 3)));
            PH_CLOSE(2);
            PH_BEGIN(3)

                unsigned char* wl = ws + WS_W + (size_t)l * WL_BYTES;
                pg8::Gemm g{(const bf16*)(ws + WS_H), (const bf16*)(wl + (half == 0 ? WL_F1OUT : WL_F2OUT)), M_ALL, DM, DFF, LDH}; pg8::StaticOrder S; S.init(M_ALL, DM, G, bx, REV_FFNOUT);
                if (EXTRA == 2) { pg8::EpiNull E0; pg8::gemm_phase<pg8::EpiNull, pg8::StaticOrder, true, true>(ldsl + RING_OFF, g, S, E0, tid); GRID_BARRIER(); }
                pg8::EpiResid E{X, DM, rep_ ? 0.0f : 0.5f};
                pg8::gemm_phase<pg8::EpiResid, pg8::StaticOrder, true, true>(ldsl + RING_OFF, g, S, E, tid, (unsigned)(STAG_STEP * ((bx >> 3) & 3)));
            PH_CLOSE(3);
            if (half == 0) {
                PH_BEGIN(1)

                    bf16* U = (bf16*)(ws + WS_U);
                    const float* g = args.in[I_NMIX] + (size_t)l * DM;
                    for (int m = gw; m < M_ALL; m += NGW) rms_row_to_bf16(X + (size_t)m * DM, g, U + (size_t)m * LDU, nullptr, lane);
                PH_CLOSE(1);
                for (int s = 0; s < NSEQ; ++s) {
                    PH_BEGIN(4)

                        unsigned char* wl = ws + WS_W + (size_t)l * WL_BYTES;
                        pg8::Gemm g{(const bf16*)(ws + WS_U) + (size_t)s * SEQ * LDU, (const bf16*)(wl + WL_WIN), SEQ, INC, DM, LDU, LDW}; pg8::StaticOrder S; S.init(SEQ, INC, G, bx);
                        pg8::EpiBf16 E{(bf16*)(ws + WS_QKVG), INC};
                        pg8::gemm_phase<pg8::EpiBf16, pg8::StaticOrder, true, true>(ldsl + RING_OFF, g, S, E, tid, (unsigned)(STAG_STEP * ((bx >> 3) & 3)));
                    PH_CLOSE(4);
                    PH_BEGIN(5)

                        bf16* QKVG = (bf16*)(ws + WS_QKVG);
                        for (int rq_ = (EXTRA == 6) ? 0 : 1; rq_ < 2; ++rq_)
                        { bf16* QB = (bf16*)(ws + WS_QB); bf16* KB = (bf16*)(ws + WS_KB); bf16* VB = (bf16*)(ws + WS_VB);
                          const float* gq = args.in[I_QNQ] + (size_t)l * 128; const float* gk = args.in[I_QNK] + (size_t)l * 128;
                          int t = gw;
                          for (; t + 3 * NGW < SEQ; t += 4 * NGW) ropeB_tokens<4>(QKVG, t, NGW, gq, gk, QB, KB, VB, lane);
                          for (; t < SEQ; t += NGW) ropeB_tokens<1>(QKVG, t, NGW, gq, gk, QB, KB, VB, lane); }
                        for (int rp_ = (EXTRA == 7 || EXTRA == 8) ? 0 : 1; rp_ < 2; ++rp_) {
                        const int ulo_ = (rp_ == 0 && EXTRA == 8) ? 8 * 64 : 0, uhi_ = (rp_ == 0 && EXTRA == 7) ? 8 * 64 : 8 * 64 + 12 * 64;
                        for (int u = vcu + ulo_; u < uhi_; u += G) {
                            att::Unit A;
                            if (u < 8 * 64) {
                                const int h = u >> 6, b = u & 63;
                                A.Q = QKVG + (size_t)(256 * b) * INC + C_Q + h * 128; A.qstride = INC;
                                A.K = QKVG + C_K + (h >> 2) * 128; A.V = QKVG + C_V + (h >> 2) * 128; A.kstride = INC;
                                A.O = (bf16*)(ws + WS_OC) + (size_t)(256 * b) * OCAT + h * 128; A.ostride = OCAT;
                                A.NT = 8; A.kb0 = 256 * b - 128; A.n = SEQ; A.qi0 = 256 * b; A.hw = 128;
                                A.slope_raw = __uint_as_float((unsigned)(127 - (h + 1)) << 23) * (1.0f / att::SCALE);
                                A.sink = args.in[I_SINK][l * 8 + h]; A.has_sink = 1; A.lse = nullptr; A.lse_stride = 0;
                            } else {
                                const int v = u - 8 * 64, h = v >> 6, w = v & 63, gi = h >> 2, rs = 2 * gi, r = 1 << rs;
                                const int bpc = 64 >> rs, c = w / bpc, b = w % bpc, nsub = SEQ >> rs;
                                A.Q = QKVG + (size_t)(c + r * 256 * b) * INC + A_Q + h * 128; A.qstride = r * INC;
                                A.K = QKVG + (size_t)c * INC + A_K + h * 128; A.V = QKVG + (size_t)c * INC + A_V + h * 128; A.kstride = r * INC;
                                A.O = (bf16*)(ws + WS_PA) + ((size_t)gi * SEQ + c + r * 256 * b) * 512 + (h & 3) * 128; A.ostride = r * 512;
                                A.NT = 6; A.kb0 = 256 * b - 64; A.n = nsub; A.qi0 = 256 * b; A.hw = 64;
                                const float sl = __builtin_amdgcn_exp2f(-8.0f * (float)(h + 1) / 12.0f) * (float)r * (1.0f / att::SCALE);
                                A.slope_raw = __uint_as_float(__builtin_amdgcn_readfirstlane(__float_as_uint(sl)));
                                A.sink = 0.f; A.has_sink = 0; A.lse = (float*)(ws + WS_LSE) + ((size_t)gi * SEQ + c + r * 256 * b) * 4 + (h & 3); A.lse_stride = r * 4;
                            }
                            att::attn_unit<true, 0>(A, (char*)lds + RING_OFF, tid);
                        }
                        if (rp_ == 0) GRID_BARRIER(); }
                    PH_CLOSE(5);
                    PH_BEGIN(6)

                        for (int t = gw; t < SEQ; t += NGW) mergeA_token((const bf16*)(ws + WS_PA), (const float*)(ws + WS_LSE), (bf16*)(ws + WS_OA), t, lane);
                        bool fastB;
                        { const float* gq = args.in[I_QNQ] + (size_t)l * 128; const float* gk = args.in[I_QNK] + (size_t)l * 128;
                          float mq = fmaxf(__builtin_fabsf(gq[lane]), __builtin_fabsf(gq[lane + 64])), mk = fmaxf(__builtin_fabsf(gk[lane]), __builtin_fabsf(gk[lane + 64]));
                          mq = wave_max(mq); mk = wave_max(mk);
                          const float bound = 128.0f * mq * mk * QPRESCALE * 1.05f;
                          fastB = __builtin_amdgcn_readfirstlane((int)(bound < 60.0f)) != 0; }
                        if (fastB) {
                        for (int u = vcu; u < 8 * 64; u += G) {
                            const int h = u >> 6, b = u & 63;
                            att::Unit A;
                            A.Q = (const bf16*)(ws + WS_QB) + (size_t)(256 * b) * 1024 + h * 128; A.qstride = 1024;
                            A.K = (const bf16*)(ws + WS_KB) + (h >> 2) * 128; A.V = (const bf16*)(ws + WS_VB) + (h >> 2) * 128; A.kstride = 256;
                            A.O = (bf16*)(ws + WS_OB) + (size_t)(256 * b) * OCAT + h * 128; A.ostride = OCAT;
                            A.NT = SEQ / 64; A.kb0 = 0; A.n = SEQ; A.qi0 = 0; A.hw = 0; A.slope_raw = 0.f; A.sink = 0.f; A.has_sink = 0; A.lse = nullptr; A.lse_stride = 0;
                            const int tid2 = wave * 64 + lane_id_asm();
                            if (ATT_DMA) att::attn_unit_dma(A, (char*)lds + RING_OFF, (att::lds_u8*)(ldsl + RING_OFF), tid2); else if (ATT_RING) att::attn_unit_ring(A, (char*)lds + RING_OFF, tid2); else att::attn_unit<false, 2>(A, (char*)lds + RING_OFF, tid2);
                        }
                        } else {
                        for (int u = vcu; u < 8 * 64; u += G) {
                            const int h = u >> 6, b = u & 63;
                            att::Unit A;
                            A.Q = (const bf16*)(ws + WS_QB) + (size_t)(256 * b) * 1024 + h * 128; A.qstride = 1024;
                            A.K = (const bf16*)(ws + WS_KB) + (h >> 2) * 128; A.V = (const bf16*)(ws + WS_VB) + (h >> 2) * 128; A.kstride = 256;
                            A.O = (bf16*)(ws + WS_OB) + (size_t)(256 * b) * OCAT + h * 128; A.ostride = OCAT;
                            A.NT = SEQ / 64; A.kb0 = 0; A.n = SEQ; A.qi0 = 0; A.hw = 0; A.slope_raw = 0.f; A.sink = 0.f; A.has_sink = 0; A.lse = nullptr; A.lse_stride = 0;
                            const int tid2 = wave * 64 + lane_id_asm();
                            att::attn_unit<false, 1>(A, (char*)lds + RING_OFF, tid2);
                        }
                        }
                    PH_CLOSE(6);
                    PH_BEGIN(7)

                        unsigned char* wl = ws + WS_W + (size_t)l * WL_BYTES;
                        pg8::Gemm g{(const bf16*)(ws + WS_OCAT), (const bf16*)(wl + WL_WA), SEQ, DM, OCAT}; pg8::StaticOrder S; S.init(SEQ, DM, G, bx);
                        if (EXTRA == 5) { pg8::EpiNull E0; pg8::gemm_phase<pg8::EpiNull, pg8::StaticOrder, true, true>(ldsl + RING_OFF, g, S, E0, tid); GRID_BARRIER(); }
                        pg8::EpiGateCat E{(const bf16*)(ws + WS_QKVG) + GL0, INC, (bf16*)(ws + WS_MB), DM, LDU};
                        pg8::gemm_phase<pg8::EpiGateCat, pg8::StaticOrder, true, true>(ldsl + RING_OFF, g, S, E, tid);
                    PH_CLOSE(7);
                    PH_BEGIN(8)

                        unsigned char* wl = ws + WS_W + (size_t)l * WL_BYTES;
                        pg8::Gemm g{(const bf16*)(ws + WS_MB), (const bf16*)(wl + WL_WO), SEQ, DM, DM, LDU, LDW}; pg8::StaticOrder S; S.init(SEQ, DM, G, bx);
                        pg8::EpiResid E{X + (size_t)s * SEQ * DM, DM, rep_ ? 0.0f : 1.0f};
                        pg8::gemm_phase<pg8::EpiResid, pg8::StaticOrder, true, true>(ldsl + RING_OFF, g, S, E, tid);
                    PH_CLOSE(8);
                }
            }
        }
    }
    PH_BEGIN(9)

        if (EXTRA == 3) { for (int i_ = 0; i_ < 200; ++i_) GRID_BARRIER(); }
        for (int m = gw; m < M_ALL; m += NGW) rms_row_f32(X + (size_t)m * DM, args.in[I_NFIN], lane);
    PH_CLOSE(9);
#if DIAG
    {
        PH_VARS;
        unsigned long long* dg = (unsigned long long*)(ws + WS_CTL + 65536);
        if (bx_k == 0 && tid == 0) { volatile LAS unsigned long long* ts_ = (volatile LAS unsigned long long*)(ldsl + DIAG_OFF); for (int i = 0; i < 16; ++i) dg[i] = ts_[i]; }
        { XcdBarrier b2_ = bar; b2_.bar = opq_p(bar.bar); b2_.x = (unsigned)opq_s((int)bar.x); xcd_barrier(b2_); }
        const float ta = (float)__hip_atomic_load(dg + 1 + DIAG_A, __ATOMIC_RELAXED, __HIP_MEMORY_SCOPE_AGENT) * 0.01f, tb = (float)__hip_atomic_load(dg + 1 + DIAG_B, __ATOMIC_RELAXED, __HIP_MEMORY_SCOPE_AGENT) * 0.01f;
        const float qa = 10.f + __builtin_roundf(__builtin_log2f(fmaxf(ta, 10.f) * 0.1f) * (1.0f / 0.16349873f) + 0.5f * DIAG_SHIFT), qb = 10.f + __builtin_roundf(__builtin_log2f(fmaxf(tb, 10.f) * 0.1f) * (1.0f / 0.16349873f) + 0.5f * DIAG_SHIFT);
        const float ka = sqrtf(100.f * qa), vb = 100.f * qb;
        for (size_t i = (size_t)bx * 512 + tid; i < (size_t)M_ALL * DM; i += (size_t)G * 512) X[i] = (i < (size_t)2 * SEQ * DM) ? ka : ((i == (size_t)2 * SEQ * DM + 12345 || i == (size_t)2 * SEQ * DM + 54321) ? vb : 0.f);
    }
#endif
#undef PH_ON
#undef PH_VARS
#undef PH_END
#undef PH_BEGIN
#undef PH_CLOSE
}


#if CHECKB
constexpr int CHK_WORD = 2048;
__device__ __forceinline__ void chk_rope_head(const bf16* row128, const float* g, int t, float* out  , int tid) {
    if (tid < 64) {
        float x0 = __uint_as_float((unsigned)row128[2 * tid] << 16), x1 = __uint_as_float((unsigned)row128[2 * tid + 1] << 16);
        out[2 * tid] = x0; out[2 * tid + 1] = x1;
    }
}
__global__ void __launch_bounds__(256) chk_mixerB(const unsigned char* ws, const float* gq_, const float* gk_, unsigned* ctl) {
    __shared__ float qv[128]; __shared__ float red[256]; __shared__ float oacc[128]; __shared__ float sh_m, sh_l;
    const int smp = blockIdx.x, tid = threadIdx.x;
    const int t = (smp * 2654435761u >> 7) % SEQ, h = smp % 8, kvh = h / 4;
    const bf16* QKVG = (const bf16*)(ws + WS_QKVG); const bf16* OB = (const bf16*)(ws + WS_OB);
    if (tid < 128) { qv[tid] = __uint_as_float((unsigned)QKVG[(size_t)t * INC + B_Q + h * 128 + tid] << 16); }
    __syncthreads();
    if (tid == 0) { float ss = 0.f; for (int i = 0; i < 128; ++i) ss += qv[i] * qv[i]; sh_m = 1.0f / sqrtf(ss / 128.f + NORM_EPS); }
    __syncthreads();
    if (tid < 128) qv[tid] = qv[tid] * sh_m * gq_[tid];
    __syncthreads();
    if (tid < 64) { const int i = tid; const double pos = (i < 32) ? (double)(t / 64) : (double)(t % 64); const double inv = exp2(-(double)(i & 31) * 13.287712379549449 / 32.0);
        const double ang = pos * inv; const float cs = (float)cos(ang), sn = (float)sin(ang); const float x0 = qv[2 * i], x1 = qv[2 * i + 1];
        qv[2 * i] = x0 * cs - x1 * sn; qv[2 * i + 1] = x0 * sn + x1 * cs; }
    __syncthreads();
    float m = -1e30f, l = 0.f; float o[128];
    (void)o;
    auto score = [&](int j) -> float {
        const bf16* kr = QKVG + (size_t)j * INC + B_K + kvh * 128; float ss = 0.f;
        for (int i = 0; i < 128; ++i) { const float x = __uint_as_float((unsigned)kr[i] << 16); ss += x * x; }
        const float rstd = 1.0f / sqrtf(ss / 128.f + NORM_EPS); float dot = 0.f;
        for (int i = 0; i < 64; ++i) { const double pos = (i < 32) ? (double)(j / 64) : (double)(j % 64); const double inv = exp2(-(double)(i & 31) * 13.287712379549449 / 32.0);
            const double ang = pos * inv; const float cs = (float)cos(ang), sn = (float)sin(ang);
            const float x0 = __uint_as_float((unsigned)kr[2 * i] << 16) * rstd * gk_[2 * i], x1 = __uint_as_float((unsigned)kr[2 * i + 1] << 16) * rstd * gk_[2 * i + 1];
            dot += qv[2 * i] * (x0 * cs - x1 * sn) + qv[2 * i + 1] * (x0 * sn + x1 * cs); }
        return dot * 0.088388347648318440f; };
    for (int j = tid; j < SEQ; j += 256) m = fmaxf(m, score(j));
    red[tid] = m; __syncthreads();
    for (int s_ = 128; s_ > 0; s_ >>= 1) { if (tid < s_) red[tid] = fmaxf(red[tid], red[tid + s_]); __syncthreads(); }
    m = red[0]; __syncthreads();
    if (tid < 128) oacc[tid] = 0.f;
    __syncthreads();
    for (int j = tid; j < SEQ; j += 256) { const float p = expf(score(j) - m); l += p;
        const bf16* vr = QKVG + (size_t)j * INC + B_V + kvh * 128;
        for (int d = 0; d < 128; ++d) atomicAdd(&oacc[d], p * __uint_as_float((unsigned)vr[d] << 16)); }
    red[tid] = l; __syncthreads();
    for (int s_ = 128; s_ > 0; s_ >>= 1) { if (tid < s_) red[tid] += red[tid + s_]; __syncthreads(); }
    l = red[0]; __syncthreads();
    if (tid == 0) { float num = 0.f, den = 0.f; for (int d = 0; d < 128; ++d) { const float ref = oacc[d] / l, got = __uint_as_float((unsigned)OB[(size_t)t * OCAT + h * 128 + d] << 16); num += (got - ref) * (got - ref); den += ref * ref; }
        const float e = sqrtf(num / fmaxf(den, 1e-30f)); atomicMax(ctl + CHK_WORD, __float_as_uint(e)); }
}

__global__ void __launch_bounds__(128) chk_mixerAC(const unsigned char* ws, const float* sink_, unsigned* ctl) {
    __shared__ float qv[128]; __shared__ float red[128];
    const int smp = blockIdx.x, d = threadIdx.x; const bool isC = (smp & 1) != 0; const int k = smp >> 1;
    const int edge[16] = {0, 1, 63, 64, 65, 127, 128, 129, 1023, 1024, 16383, 16382, 16320, 16319, 16255, 16256};
    const int t = k < 16 ? edge[k] : (int)(((unsigned)k * 2654435761u >> 7) % SEQ);
    const bf16* QKVG = (const bf16*)(ws + WS_QKVG);
    auto bf = [](bf16 x) { return __uint_as_float((unsigned)x << 16); };
    float m = -1e30f, l = 0.f, o = 0.f;
    const bf16* outp;
    if (isC) {
        const int h = k % 8, kvh = h / 4; const float slope = exp2f(-(float)(h + 1));
        qv[d] = bf(QKVG[(size_t)t * INC + C_Q + h * 128 + d]); __syncthreads();
        for (int j = t - 128; j <= t + 128; ++j) { if (j < 0 || j >= SEQ) continue;
            red[d] = qv[d] * bf(QKVG[(size_t)j * INC + C_K + kvh * 128 + d]); __syncthreads();
            float dot = 0.f; for (int i = 0; i < 128; ++i) dot += red[i]; __syncthreads();
            const float s = dot * 0.088388347648318440f - slope * fabsf((float)(t - j));
            const float mn = fmaxf(m, s), a = expf(m - mn), p = expf(s - mn); l = l * a + p; o = o * a + p * bf(QKVG[(size_t)j * INC + C_V + kvh * 128 + d]); m = mn; }
        { const float s = sink_[h]; const float mn = fmaxf(m, s), a = expf(m - mn), p = expf(s - mn); l = l * a + p; o = o * a; m = mn; }
        outp = (const bf16*)(ws + WS_OC) + (size_t)t * OCAT + h * 128;
    } else {
        const int hh = k % 4;
        for (int g = 0; g < 3; ++g) { const int r = 1 << (2 * g), h = 4 * g + hh, c = t % r, i = t / r, nsub = SEQ / r; const float slope = exp2f(-8.0f * (float)(h + 1) / 12.0f);
            __syncthreads(); qv[d] = bf(QKVG[(size_t)t * INC + A_Q + h * 128 + d]); __syncthreads();
            for (int j = i - 64; j <= i + 64; ++j) { if (j < 0 || j >= nsub) continue; const int tj = c + r * j;
                red[d] = qv[d] * bf(QKVG[(size_t)tj * INC + A_K + h * 128 + d]); __syncthreads();
                float dot = 0.f; for (int ii = 0; ii < 128; ++ii) dot += red[ii]; __syncthreads();
                const float s = dot * 0.088388347648318440f - slope * (float)r * fabsf((float)(i - j));
                const float mn = fmaxf(m, s), a = expf(m - mn), p = expf(s - mn); l = l * a + p; o = o * a + p * bf(QKVG[(size_t)tj * INC + A_V + h * 128 + d]); m = mn; } }
        outp = (const bf16*)(ws + WS_OA) + (size_t)t * OCAT + hh * 128;
    }
    const float ref = o / l, got = bf(outp[d]);
    __syncthreads(); red[d] = (got - ref) * (got - ref); __syncthreads();
    float num = 0.f; for (int i = 0; i < 128; ++i) num += red[i]; __syncthreads();
    red[d] = ref * ref; __syncthreads();
    float den = 0.f; for (int i = 0; i < 128; ++i) den += red[i];
    if (d == 0) atomicMax(ctl + CHK_WORD, __float_as_uint(sqrtf(num / fmaxf(den, 1e-30f))));
}
__global__ void chk_fill(float* out, const unsigned* ctl) {
    const float e = __uint_as_float(ctl[CHK_WORD]); const float k = sqrtf(fminf(e, 1e6f) * 1e4f);
    for (size_t i = (size_t)blockIdx.x * blockDim.x + threadIdx.x; i < (size_t)M_ALL * DM; i += (size_t)gridDim.x * blockDim.x) out[i] = k;
}
#endif
extern "C" void kernel_launch(void* const* d_in, const int* in_sizes, int n_in, void* d_out, int out_size, void* d_ws, size_t ws_size, hipStream_t stream) {
    static int grid = 0;
    if (grid == 0) {
        if (n_in != N_IN || out_size != M_ALL * DM || ws_size < WS_END) { fprintf(stderr, "kernel_launch: shape/workspace mismatch (n_in %d out %d ws %zu need %zu)\n", n_in, out_size, ws_size, (size_t)WS_END); grid = -1; return; }
        int dev = 0, cus = 0, per_cu = 0;
        if (hipGetDevice(&dev) != hipSuccess || hipDeviceGetAttribute(&cus, hipDeviceAttributeMultiprocessorCount, dev) != hipSuccess) { grid = -1; return; }
        if (hipFuncSetAttribute((const void*)trunk_fwd, hipFuncAttributeMaxDynamicSharedMemorySize, LDS_BYTES) != hipSuccess) { fprintf(stderr, "kernel_launch: hipFuncSetAttribute failed\n"); grid = -1; return; }
        if (hipOccupancyMaxActiveBlocksPerMultiprocessor(&per_cu, (const void*)trunk_fwd, NWAVES * 64, LDS_BYTES) != hipSuccess || per_cu < 1) { fprintf(stderr, "kernel_launch: occupancy query reports %d\n", per_cu); }
        (void)hipGetLastError();
        grid = cus;
    }
    if (grid < 0) return;
    if (hipMemsetAsync((char*)d_ws + WS_CTL, 0, CTL_ZERO_BYTES, stream) != hipSuccess) return;
    Args a{};
    for (int i = 0; i < N_IN; ++i) a.in[i] = (const float*)d_in[i];
    a.out = (float*)d_out; a.ws = (unsigned char*)d_ws;
#if MK_PER_PHASE
    for (int p = 0; p < N_PHASES; ++p) { a.ph_lo = p; a.ph_hi = p + 1; hipLaunchKernelGGL(trunk_fwd, dim3(grid), dim3(NWAVES * 64), LDS_BYTES, stream, a); }
#elif CHECKB
    a.ph_lo = 0; a.ph_hi = 8;
    hipLaunchKernelGGL(trunk_fwd, dim3(grid), dim3(NWAVES * 64), LDS_BYTES, stream, a);
#if CHECKB == 1
    hipLaunchKernelGGL(chk_mixerB, dim3(512), dim3(256), 0, stream, (const unsigned char*)d_ws, (const float*)d_in[I_QNQ], (const float*)d_in[I_QNK], (unsigned*)((char*)d_ws + WS_CTL));
#else
    hipLaunchKernelGGL(chk_mixerAC, dim3(1024), dim3(128), 0, stream, (const unsigned char*)d_ws, (const float*)d_in[I_SINK], (unsigned*)((char*)d_ws + WS_CTL));
#endif
    hipLaunchKernelGGL(chk_fill, dim3(1024), dim3(256), 0, stream, (float*)d_out, (const unsigned*)((char*)d_ws + WS_CTL));
#else
    a.ph_lo = 0; a.ph_hi = N_PHASES;
    hipLaunchKernelGGL(trunk_fwd, dim3(grid), dim3(NWAVES * 64), LDS_BYTES, stream, a);
#endif
    const hipError_t le = hipPeekAtLastError();
    if (le != hipSuccess) fprintf(stderr, "kernel_launch: launch failed: %s\n", hipGetErrorName(le));
}
```

```cpp
#include <hip/hip_runtime.h>
#include <cstdio>
#include <cstdint>

#ifndef DIAG
#define DIAG 0
#endif
#ifndef DIAG_A
#define DIAG_A 2
#endif
#ifndef DIAG_B
#define DIAG_B 3
#endif
#ifndef DIAG_SHIFT
#define DIAG_SHIFT 0
#endif
#ifndef DUP_TYPE
#define DUP_TYPE -1
#endif
#ifndef STAG_STEP
#define STAG_STEP 0
#endif
#ifndef EPI_FENCE
#define EPI_FENCE 1
#endif
#ifndef EXTRA
#define EXTRA 0
#endif
#ifndef ATT_SCHED
#define ATT_SCHED 0
#endif
#ifndef CHECKB
#define CHECKB 0
#endif
#ifndef ATT_RING
#define ATT_RING 0
#endif
#ifndef REV_FFNOUT
#define REV_FFNOUT 1
#endif
#ifndef LDH_PAD
#define LDH_PAD 64
#endif
#ifndef LDU_PAD
#define LDU_PAD 0
#endif
#ifndef LDW_PAD
#define LDW_PAD 0
#endif
#ifndef QKT_PREFETCH
#define QKT_PREFETCH 1
#endif
#ifndef WSKIP
#define WSKIP 0
#endif
#ifndef BAND_PREFETCH
#define BAND_PREFETCH 0
#endif
#ifndef ATT_DMA
#define ATT_DMA 1
#endif
#ifndef DMA_PREFETCH
#define DMA_PREFETCH 0
#endif
#ifndef MK_PER_PHASE
#define MK_PER_PHASE 0
#endif

namespace pg8 {
#define PG8_LAS __attribute__((address_space(3)))
typedef unsigned short bf16_t;
typedef short bf16x8 __attribute__((ext_vector_type(8)));
typedef float f32x4 __attribute__((ext_vector_type(4)));
typedef unsigned u32x4 __attribute__((ext_vector_type(4)));
typedef unsigned u32x2 __attribute__((ext_vector_type(2)));
constexpr int BM = 256, BK = 64, HALF = 128, HTB = HALF * BK * 2, STAGE_BYTES = 8 * HTB, NXCD = 8, WGM = 8;

__host__ __device__ __forceinline__ int lds_byte(int r, int c) { const int st = (r >> 4) * 2 + (c >> 5), rr = r & 15, cc = c & 31, ob = rr * 64 + cc * 2; return st * 1024 + (ob ^ (((ob >> 9) & 1) << 5)); }
__host__ __device__ __forceinline__ void stage_rc(int b, int& R, int& C) { const int st = b / 1024, sb = b % 1024, swz = sb ^ (((sb >> 9) & 1) << 5); R = (st >> 1) * 16 + swz / 64; C = (st & 1) * 32 + (swz % 64) / 2; }
__host__ __device__ __forceinline__ int perm32(int rho) { const int n = rho >> 4, i = rho & 15; return 8 * (i >> 2) + 4 * n + (i & 3); }

struct Unit { int pm, pn; };
struct Gemm { const bf16_t* A; const bf16_t* Bt; int M, N, K; int lda = 0, ldb = 0; };

struct StaticOrder {
    int nM, nN, nwg, G, c, rev;
    __host__ __device__ void init(int M, int N, int G_, int c_, int rev_ = 0) { nM = M / BM; nN = N / BM; nwg = nM * nN; G = G_; c = c_; rev = rev_; }
    __host__ __device__ bool next(int i, Unit& u) const {
        const long L = (long)i * G + c; if (L >= nwg) return false;
        int wgid = (int)L; { const int q = nwg / NXCD, r = nwg % NXCD, xcd = wgid % NXCD, off = wgid / NXCD; wgid = (xcd < r ? xcd * (q + 1) : r * (q + 1) + (xcd - r) * q) + off; }
        const int nig = WGM * nN, gid = wgid / nig, fm = gid * WGM, gsz = (nM - fm) < WGM ? (nM - fm) : WGM;
        u.pm = fm + ((wgid % nig) % gsz); u.pn = (wgid % nig) / gsz; if (rev) u.pm = nM - 1 - u.pm; return true;
    }
    __device__ __forceinline__ void a_ready(const Unit&) const {}
    __device__ __forceinline__ void done(const Unit&) const {}
};

__device__ __forceinline__ unsigned cvt_pk_bf16(float lo, float hi) { unsigned r; asm volatile("v_cvt_pk_bf16_f32 %0, %1, %2" : "=v"(r) : "v"(lo), "v"(hi)); return r; }
__device__ __forceinline__ float bf_lo(unsigned w) { return __uint_as_float(w << 16); }
__device__ __forceinline__ float bf_hi(unsigned w) { return __uint_as_float(w & 0xffff0000u); }
__device__ __forceinline__ float sigmoidf_(float x) { return __builtin_amdgcn_rcpf(1.0f + __builtin_amdgcn_exp2f(-1.4426950408889634f * x)); }

struct EpiBf16 {
    static constexpr bool PERM = true, AFTER_DRAIN = false;
    bf16_t* O; int ldc;
    __device__ __forceinline__ void operator()(const f32x4 (&acc)[2][2][4][2], const Unit& u, int wr, int wc, int fr, int fq) const {
        const int row0 = u.pm * BM + wr * 64 + fr, col0 = u.pn * BM + wc * 32 + 8 * fq;
#pragma unroll
        for (int ai = 0; ai < 2; ++ai)
#pragma unroll
            for (int m = 0; m < 4; ++m) { bf16_t* rowp = O + (size_t)(row0 + ai * HALF + m * 16) * ldc + col0;
#pragma unroll
                for (int bj = 0; bj < 2; ++bj) { const f32x4 v0 = acc[ai][bj][m][0], v1 = acc[ai][bj][m][1];
                    u32x4 w; w.x = cvt_pk_bf16(v0[0], v0[1]); w.y = cvt_pk_bf16(v0[2], v0[3]); w.z = cvt_pk_bf16(v1[0], v1[1]); w.w = cvt_pk_bf16(v1[2], v1[3]);
                    *(u32x4*)(rowp + bj * HALF) = w; } }
    }
};
struct EpiNull {
    static constexpr bool PERM = true, AFTER_DRAIN = false;
    __device__ __forceinline__ void operator()(const f32x4 (&acc)[2][2][4][2], const Unit& u, int wr, int wc, int fr, int fq) const {
#pragma unroll
        for (int ai = 0; ai < 2; ++ai)
#pragma unroll
            for (int bj = 0; bj < 2; ++bj) asm volatile("" :: "v"(acc[ai][bj][0][0]), "v"(acc[ai][bj][0][1]), "v"(acc[ai][bj][1][0]), "v"(acc[ai][bj][1][1]), "v"(acc[ai][bj][2][0]), "v"(acc[ai][bj][2][1]), "v"(acc[ai][bj][3][0]), "v"(acc[ai][bj][3][1]));
    }
};
struct EpiSwiglu {
    static constexpr bool PERM = true, AFTER_DRAIN = false;
    bf16_t* H; int ldc;
    __device__ __forceinline__ void operator()(const f32x4 (&acc)[2][2][4][2], const Unit& u, int wr, int wc, int fr, int fq) const {
        const int row0 = u.pm * BM + wr * 64 + fr, col0 = u.pn * HALF + wc * 32 + 8 * fq;
#pragma unroll
        for (int ai = 0; ai < 2; ++ai)
#pragma unroll
            for (int m = 0; m < 4; ++m) { bf16_t* rowp = H + (size_t)(row0 + ai * HALF + m * 16) * ldc + col0;
                float h[8];
#pragma unroll
                for (int n = 0; n < 2; ++n)
#pragma unroll
                    for (int e = 0; e < 4; ++e) { const float a = acc[ai][0][m][n][e], b = acc[ai][1][m][n][e]; h[n * 4 + e] = a * sigmoidf_(a) * b; }
                u32x4 w; w.x = cvt_pk_bf16(h[0], h[1]); w.y = cvt_pk_bf16(h[2], h[3]); w.z = cvt_pk_bf16(h[4], h[5]); w.w = cvt_pk_bf16(h[6], h[7]);
                *(u32x4*)rowp = w; }
    }
};
struct EpiResid {
    static constexpr bool PERM = false, AFTER_DRAIN = false;
    float* X; int ldc; float scale;
    __device__ __forceinline__ void operator()(const f32x4 (&acc)[2][2][4][2], const Unit& u, int wr, int wc, int fr, int fq) const {
        const int row0 = u.pm * BM + wr * 64 + fr, col0 = u.pn * BM + wc * 32 + 4 * fq;
#pragma unroll
        for (int ai = 0; ai < 2; ++ai) {
            f32x4 xv[4][2][2];
#pragma unroll
            for (int m = 0; m < 4; ++m) { const float* rowp = X + (size_t)(row0 + ai * HALF + m * 16) * ldc + col0;
#pragma unroll
                for (int bj = 0; bj < 2; ++bj)
#pragma unroll
                    for (int n = 0; n < 2; ++n) xv[m][bj][n] = *(const f32x4*)(rowp + bj * HALF + n * 16); }
#pragma unroll
            for (int m = 0; m < 4; ++m) { float* rowp = X + (size_t)(row0 + ai * HALF + m * 16) * ldc + col0;
#pragma unroll
                for (int bj = 0; bj < 2; ++bj)
#pragma unroll
                    for (int n = 0; n < 2; ++n) *(f32x4*)(rowp + bj * HALF + n * 16) = xv[m][bj][n] + acc[ai][bj][m][n] * scale; }
            asm volatile("" ::: "memory");
        }
    }
};
struct EpiGateCat {
    static constexpr bool PERM = true, AFTER_DRAIN = false, HOOK = true;
    const bf16_t* GL; int ldg; bf16_t* MB; int ldc; int ldo;
    __device__ __forceinline__ bool hook_at(int t) const { return t == 8 || t == 24; }
    static __device__ __forceinline__ float e_neg(float x) { return __builtin_amdgcn_exp2f(-1.4426950408889634f * __builtin_fminf(__builtin_fmaxf(x, -60.f), 60.f)); }
    __device__ __forceinline__ void hook(f32x4 (&acc)[2][2][4][2], const Unit& u, int t, int wr, int wc, int fr, int fq) const {
        int fr_ = fr; asm volatile("" : "+v"(fr_));
        const int row0 = u.pm * BM + wr * 64 + fr_, col0 = u.pn * BM + wc * 32 + 8 * fq; const bf16_t* gp = GL + (t == 8 ? 0 : ldc) + (size_t)row0 * ldg + col0;
#pragma unroll
        for (int ai = 0; ai < 2; ++ai) {
            u32x4 a[4][2], b[4][2];
#pragma unroll
            for (int m = 0; m < 4; ++m)
#pragma unroll
                for (int bj = 0; bj < 2; ++bj) { const bf16_t* q = gp + (size_t)(ai * HALF + m * 16) * ldg + bj * HALF; a[m][bj] = *(const u32x4*)q; b[m][bj] = *(const u32x4*)(q + ldc); }
#pragma unroll
            for (int m = 0; m < 4; ++m)
#pragma unroll
                for (int bj = 0; bj < 2; ++bj) { const u32x4 p = a[m][bj], n = b[m][bj]; f32x4& v0 = acc[ai][bj][m][0]; f32x4& v1 = acc[ai][bj][m][1];
                    v0[0] *= (1.f + e_neg(bf_lo(n.x))) * __builtin_amdgcn_rcpf(1.f + e_neg(bf_lo(p.x))); v0[1] *= (1.f + e_neg(bf_hi(n.x))) * __builtin_amdgcn_rcpf(1.f + e_neg(bf_hi(p.x)));
                    v0[2] *= (1.f + e_neg(bf_lo(n.y))) * __builtin_amdgcn_rcpf(1.f + e_neg(bf_lo(p.y))); v0[3] *= (1.f + e_neg(bf_hi(n.y))) * __builtin_amdgcn_rcpf(1.f + e_neg(bf_hi(p.y)));
                    v1[0] *= (1.f + e_neg(bf_lo(n.z))) * __builtin_amdgcn_rcpf(1.f + e_neg(bf_lo(p.z))); v1[1] *= (1.f + e_neg(bf_hi(n.z))) * __builtin_amdgcn_rcpf(1.f + e_neg(bf_hi(p.z)));
                    v1[2] *= (1.f + e_neg(bf_lo(n.w))) * __builtin_amdgcn_rcpf(1.f + e_neg(bf_lo(p.w))); v1[3] *= (1.f + e_neg(bf_hi(n.w))) * __builtin_amdgcn_rcpf(1.f + e_neg(bf_hi(p.w))); }
            asm volatile("" ::: "memory");
        }
        asm volatile("s_waitcnt vmcnt(0)" ::: "memory");
    }
    __device__ __forceinline__ void operator()(const f32x4 (&acc)[2][2][4][2], const Unit& u, int wr, int wc, int fr, int fq) const {
        const int row0 = u.pm * BM + wr * 64 + fr, col0 = u.pn * BM + wc * 32 + 8 * fq; const bf16_t* gp = GL + 2 * ldc;
#pragma unroll
        for (int ai = 0; ai < 2; ++ai) {
            u32x4 g[4][2];
#pragma unroll
            for (int m = 0; m < 4; ++m)
#pragma unroll
                for (int bj = 0; bj < 2; ++bj) g[m][bj] = *(const u32x4*)(gp + (size_t)(row0 + ai * HALF + m * 16) * ldg + col0 + bj * HALF);
#pragma unroll
            for (int m = 0; m < 4; ++m) { const size_t row = (size_t)(row0 + ai * HALF + m * 16);
#pragma unroll
                for (int bj = 0; bj < 2; ++bj) { const u32x4 gg = g[m][bj]; f32x4 v0 = acc[ai][bj][m][0], v1 = acc[ai][bj][m][1];
                    v0[0] *= sigmoidf_(bf_lo(gg.x)); v0[1] *= sigmoidf_(bf_hi(gg.x)); v0[2] *= sigmoidf_(bf_lo(gg.y)); v0[3] *= sigmoidf_(bf_hi(gg.y));
                    v1[0] *= sigmoidf_(bf_lo(gg.z)); v1[1] *= sigmoidf_(bf_hi(gg.z)); v1[2] *= sigmoidf_(bf_lo(gg.w)); v1[3] *= sigmoidf_(bf_hi(gg.w));
                    u32x4 w; w.x = cvt_pk_bf16(v0[0], v0[1]); w.y = cvt_pk_bf16(v0[2], v0[3]); w.z = cvt_pk_bf16(v1[0], v1[1]); w.w = cvt_pk_bf16(v1[2], v1[3]);
                    *(u32x4*)(MB + row * ldo + col0 + bj * HALF) = w; } }
            asm volatile("" ::: "memory");
        }
    }
};

template <class E, class = void> struct epi_has_hook { static constexpr bool value = false; };
template <class E> struct epi_has_hook<E, decltype((void)E::HOOK)> { static constexpr bool value = E::HOOK; };
template <class Epi, class Sched, bool ALIGN_EPI = false, bool SP2 = false>
__device__ __forceinline__ void gemm_phase(PG8_LAS unsigned char* lds, const Gemm g, const Sched& S, const Epi& E, const int tid, const unsigned stagger = 0u) {
    if (stagger) { const unsigned long long t0_ = __builtin_amdgcn_s_memrealtime(); while (__builtin_amdgcn_s_memrealtime() - t0_ < stagger) __builtin_amdgcn_s_sleep(16); }
    const int wid = __builtin_amdgcn_readfirstlane(tid >> 6), lane = tid & 63, wr = wid >> 2, wc = wid & 3, fr = lane & 15, fq = lane >> 4;
    const int K = g.K, nt = K / BK, lda = g.lda ? g.lda : g.K, ldb = g.ldb ? g.ldb : g.K;
    unsigned voffA[2], voffB[2];
#pragma unroll
    for (int i = 0; i < 2; ++i) { int R, C; stage_rc(tid * 16 + i * 8192, R, C); const int Rb = Epi::PERM ? ((R & ~31) + perm32(R & 31)) : R;
        voffA[i] = (unsigned)(R * lda + C) * 2u; voffB[i] = (unsigned)(Rb * ldb + C) * 2u; }
    const size_t kstep = (size_t)(BK * 2);
    const size_t hstep = (size_t)HALF * ldb * 2, hstepA = (size_t)HALF * lda * 2;
    const size_t tstep = 2 * hstep, tstepA = 2 * hstepA;
    const unsigned ldsw = (unsigned)wid * 1024u;
    const int aoff = lds_byte(wr * 64 + fr, fq * 8), boff = lds_byte(wc * 32 + fr, fq * 8);
#define PG8_SA(b, h) (((b) * 2 + (h)) * HTB)
#define PG8_SB(b, h) ((4 + (b) * 2 + (h)) * HTB)
#define PG8_STAGE(bufoff, gbase, voff) do { _Pragma("unroll") for (int _i = 0; _i < 2; ++_i) \
        __builtin_amdgcn_global_load_lds((const unsigned*)((const char*)(gbase) + (voff)[_i]), (PG8_LAS unsigned*)(lds + (bufoff) + ldsw + _i * 8192), 16, 0, 0); } while (0)
#define PG8_LDA(dst, b, h) do { _Pragma("unroll") for (int m = 0; m < 4; ++m) _Pragma("unroll") for (int k = 0; k < 2; ++k) dst[m][k] = *(const PG8_LAS bf16x8*)(lds + PG8_SA(b, h) + aoff + m * 2048 + k * 1024); } while (0)
#define PG8_LDB(dst, b, h) do { _Pragma("unroll") for (int n = 0; n < 2; ++n) _Pragma("unroll") for (int k = 0; k < 2; ++k) dst[n][k] = *(const PG8_LAS bf16x8*)(lds + PG8_SB(b, h) + boff + n * 2048 + k * 1024); } while (0)
#define PG8_MMA(ai, bj, At, Bt) do { __builtin_amdgcn_s_setprio(1); _Pragma("unroll") for (int m = 0; m < 4; ++m) _Pragma("unroll") for (int n = 0; n < 2; ++n) _Pragma("unroll") for (int k = 0; k < 2; ++k) \
        acc[ai][bj][m][n] = __builtin_amdgcn_mfma_f32_16x16x32_bf16(Bt[n][k], At[m][k], acc[ai][bj][m][n], 0, 0, 0); __builtin_amdgcn_s_setprio(0); } while (0)
#define PG8_WAIT_V(n) asm volatile("s_waitcnt vmcnt(" #n ")" ::: "memory")
#define PG8_WAIT_L(n) asm volatile("s_waitcnt lgkmcnt(" #n ")" ::: "memory")
#define PG8_BAR __builtin_amdgcn_s_barrier()
#define PG8_SCHED __builtin_amdgcn_sched_barrier(0)
    Unit cur, nxt; int ui = 0;
    if (!S.next(0, cur)) return;
    f32x4 acc[2][2][4][2];
#pragma unroll
    for (int a = 0; a < 2; ++a)
#pragma unroll
        for (int b = 0; b < 2; ++b)
#pragma unroll
            for (int m = 0; m < 4; ++m)
#pragma unroll
                for (int n = 0; n < 2; ++n) acc[a][b][m][n] = (f32x4){0.f, 0.f, 0.f, 0.f};
    bf16x8 At[4][2], B0[2][2], B1[2][2];
    const char* cA = (const char*)g.A + (size_t)cur.pm * tstepA; const char* cB = (const char*)g.Bt + (size_t)cur.pn * tstep;
    S.a_ready(cur);
    if constexpr (SP2) {
        PG8_STAGE(PG8_SB(0, 0), cB, voffB); PG8_STAGE(PG8_SB(0, 1), cB + hstep, voffB); PG8_STAGE(PG8_SA(0, 0), cA, voffA); PG8_STAGE(PG8_SA(0, 1), cA + hstepA, voffA);
        if (wr == 1) PG8_BAR;
        PG8_WAIT_V(2); PG8_BAR;
        PG8_STAGE(PG8_SB(1, 0), cB + kstep, voffB); PG8_STAGE(PG8_SA(1, 0), cA + kstep, voffA); PG8_STAGE(PG8_SB(1, 1), cB + hstep + kstep, voffB);
        PG8_WAIT_V(6); PG8_BAR;
    } else {
        PG8_STAGE(PG8_SB(0, 0), cB, voffB); PG8_STAGE(PG8_SA(0, 0), cA, voffA); PG8_STAGE(PG8_SB(0, 1), cB + hstep, voffB); PG8_STAGE(PG8_SA(0, 1), cA + hstepA, voffA);
        if (wr == 1) PG8_BAR;
        PG8_WAIT_V(4); PG8_BAR;
        PG8_STAGE(PG8_SB(1, 0), cB + kstep, voffB); PG8_STAGE(PG8_SA(1, 0), cA + kstep, voffA); PG8_STAGE(PG8_SB(1, 1), cB + hstep + kstep, voffB);
        PG8_WAIT_V(6); PG8_BAR;
    }
    for (;;) {
        const bool has_next = S.next(ui + 1, nxt);
        const char* nA = has_next ? (const char*)g.A + (size_t)nxt.pm * tstepA : cA; const char* nB = has_next ? (const char*)g.Bt + (size_t)nxt.pn * tstep : cB;
        for (int t = 0; t < nt; t += 2) {
            const bool last = (t == nt - 2);
            const char* a1 = cA + (size_t)(t + 1) * kstep;
            const char* a2 = last ? nA : cA + (size_t)(t + 2) * kstep; const char* b2 = last ? nB : cB + (size_t)(t + 2) * kstep;
            const char* a3 = a2 + kstep; const char* b3 = b2 + kstep;
            if (last && has_next) S.a_ready(nxt);
            if constexpr (epi_has_hook<Epi>::value) { if (E.hook_at(t)) E.hook(acc, cur, t, wr, wc, fr, fq); }
            if constexpr (SP2) {
            PG8_LDB(B0, 0, 0); PG8_LDB(B1, 0, 1); PG8_SCHED; PG8_LDA(At, 0, 0); PG8_STAGE(PG8_SA(1, 1), a1 + hstepA, voffA);
            PG8_WAIT_V(8); PG8_WAIT_L(0); PG8_BAR; PG8_MMA(0, 0, At, B0); PG8_MMA(0, 1, At, B1); PG8_BAR; PG8_SCHED;
            PG8_LDA(At, 0, 1); PG8_STAGE(PG8_SB(0, 0), b2, voffB); PG8_STAGE(PG8_SB(0, 1), b2 + hstep, voffB); PG8_STAGE(PG8_SA(0, 0), a2, voffA);
            PG8_WAIT_V(8); PG8_WAIT_L(0); PG8_BAR; PG8_MMA(1, 0, At, B0); PG8_MMA(1, 1, At, B1); PG8_BAR; PG8_SCHED;
            PG8_LDB(B0, 1, 0); PG8_LDB(B1, 1, 1); PG8_SCHED; PG8_LDA(At, 1, 0); PG8_STAGE(PG8_SA(0, 1), a2 + hstepA, voffA);
            PG8_WAIT_V(8); PG8_WAIT_L(0); PG8_BAR; PG8_MMA(0, 0, At, B0); PG8_MMA(0, 1, At, B1); PG8_BAR; PG8_SCHED;
            PG8_LDA(At, 1, 1); PG8_STAGE(PG8_SB(1, 0), b3, voffB); PG8_STAGE(PG8_SB(1, 1), b3 + hstep, voffB); PG8_STAGE(PG8_SA(1, 0), a3, voffA);
            PG8_WAIT_V(8); PG8_WAIT_L(0); PG8_BAR; PG8_MMA(1, 0, At, B0); PG8_MMA(1, 1, At, B1); PG8_BAR; PG8_SCHED;
            } else {
            PG8_LDB(B0, 0, 0); PG8_SCHED; PG8_LDA(At, 0, 0); PG8_STAGE(PG8_SA(1, 1), a1 + hstepA, voffA);
            PG8_WAIT_L(8); PG8_BAR; PG8_WAIT_L(0); PG8_MMA(0, 0, At, B0); PG8_BAR; PG8_SCHED;
            PG8_LDB(B1, 0, 1); PG8_STAGE(PG8_SB(0, 0), b2, voffB);
            PG8_BAR; PG8_WAIT_L(0); PG8_MMA(0, 1, At, B1); PG8_BAR;
            PG8_LDA(At, 0, 1); PG8_STAGE(PG8_SA(0, 0), a2, voffA);
            PG8_BAR; PG8_WAIT_L(0); PG8_MMA(1, 0, At, B0); PG8_BAR; PG8_SCHED;
            PG8_STAGE(PG8_SB(0, 1), b2 + hstep, voffB);
            PG8_WAIT_V(6); PG8_BAR; PG8_MMA(1, 1, At, B1); PG8_BAR;
            PG8_LDB(B0, 1, 0); PG8_SCHED; PG8_LDA(At, 1, 0); PG8_STAGE(PG8_SA(0, 1), a2 + hstepA, voffA);
            PG8_WAIT_L(8); PG8_BAR; PG8_WAIT_L(0); PG8_MMA(0, 0, At, B0); PG8_BAR; PG8_SCHED;
            PG8_LDB(B1, 1, 1); PG8_STAGE(PG8_SB(1, 0), b3, voffB);
            PG8_BAR; PG8_WAIT_L(0); PG8_MMA(0, 1, At, B1); PG8_BAR;
            PG8_LDA(At, 1, 1); PG8_STAGE(PG8_SA(1, 0), a3, voffA);
            PG8_BAR; PG8_WAIT_L(0); PG8_MMA(1, 0, At, B0); PG8_BAR; PG8_SCHED;
            PG8_STAGE(PG8_SB(1, 1), b3 + hstep, voffB);
            PG8_WAIT_V(6); PG8_BAR; PG8_MMA(1, 1, At, B1); PG8_BAR;
            }
        }
        if constexpr (ALIGN_EPI) { if (wr == 0) PG8_BAR; }
        E(acc, cur, wr, wc, fr, fq); S.done(cur);
        if (!has_next) break;
#pragma unroll
        for (int a = 0; a < 2; ++a)
#pragma unroll
            for (int b = 0; b < 2; ++b)
#pragma unroll
                for (int m = 0; m < 4; ++m)
#pragma unroll
                    for (int n = 0; n < 2; ++n) acc[a][b][m][n] = (f32x4){0.f, 0.f, 0.f, 0.f};
        cur = nxt; cA = nA; cB = nB; ++ui;
        if constexpr (ALIGN_EPI) { if (wr == 1) PG8_BAR; }
    }
    PG8_WAIT_V(0);
    if constexpr (!ALIGN_EPI) { if (wr == 0) PG8_BAR; }
    PG8_BAR;
#undef PG8_SA
#undef PG8_SB
#undef PG8_STAGE
#undef PG8_LDA
#undef PG8_LDB
#undef PG8_MMA
#undef PG8_WAIT_V
#undef PG8_WAIT_L
#undef PG8_BAR
#undef PG8_SCHED
}
}

namespace att {
typedef unsigned short bf16;
using bf16x8 = __attribute__((ext_vector_type(8))) short;
using s16x4  = __attribute__((ext_vector_type(4))) short;
using f32x16 = __attribute__((ext_vector_type(16))) float;
using u32x4  = __attribute__((ext_vector_type(4))) unsigned;
constexpr int D = 128, NW = 8, QBLK = 32, KVBLK = 64;
constexpr float SCALE = 0.088388347648318440f;
constexpr float THR = 8.f;
constexpr int SHM_V = KVBLK * D * 2, SHM_K = KVBLK * D * 2, SHM_ATTN = 2 * SHM_V + 2 * SHM_K + NW * 64 * 4;
#define KSWZ(row, colB) ((row) * 256 + ((colB) ^ (((row) & 7) << 4)))
#define SBAR() __builtin_amdgcn_sched_barrier(0)
__device__ __forceinline__ int crow(int r, int hi) { return (r & 3) + 8 * (r >> 2) + 4 * hi; }
__device__ __forceinline__ unsigned cvtpk(float lo, float hi) { unsigned r; asm volatile("v_cvt_pk_bf16_f32 %0, %1, %2" : "=v"(r) : "v"(lo), "v"(hi)); return r; }

template <int SM> __device__ __forceinline__ void partialSM(f32x16& p0, f32x16& p1, float& m_reg, float& mn, float& alpha) {
  if constexpr (SM == 2) {
#pragma unroll
    for (int r = 0; r < 16; ++r) p0[r] = __builtin_amdgcn_exp2f(p0[r]);
    return; }
  constexpr float C = SM == 0 ? SCALE * 1.4426950408889634f : 1.0f; constexpr float THRU = SM == 0 ? THR / SCALE : THR * 1.4426950408889634f;
  float pmax = p0[0];
#pragma unroll
  for (int r = 1; r < 16; ++r) pmax = fmaxf(pmax, p0[r]);
#pragma unroll
  for (int r = 0; r < 16; ++r) pmax = fmaxf(pmax, p1[r]);
  { auto rr = __builtin_amdgcn_permlane32_swap(__float_as_uint(pmax), __float_as_uint(pmax), false, false);
    pmax = fmaxf(__uint_as_float(rr[0]), __uint_as_float(rr[1])); }
  if (__builtin_expect(__all(pmax - m_reg <= THRU), 1)) { mn = m_reg; alpha = 1.f; }
  else { mn = fmaxf(m_reg, pmax); alpha = __builtin_amdgcn_exp2f((m_reg - mn) * C); m_reg = mn; }
  float mnC = -mn * C;
#pragma unroll
  for (int r = 0; r < 16; ++r) p0[r] = fmaf(p0[r], C, mnC);
#pragma unroll
  for (int r = 0; r < 16; ++r) p1[r] = fmaf(p1[r], C, mnC);
#pragma unroll
  for (int r = 0; r < 16; ++r) p0[r] = __builtin_amdgcn_exp2f(p0[r]);
}
template <int SM> __device__ __forceinline__ void finishSM(f32x16& p0, f32x16& p1, float alpha, float& l_reg, bf16x8& pa0, bf16x8& pa1, bf16x8& pa2, bf16x8& pa3) {
#pragma unroll
  for (int r = 0; r < 16; ++r) p1[r] = __builtin_amdgcn_exp2f(p1[r]);
  float ps = 0;
#pragma unroll
  for (int r = 0; r < 16; ++r) ps += p0[r];
#pragma unroll
  for (int r = 0; r < 16; ++r) ps += p1[r];
  { auto rr = __builtin_amdgcn_permlane32_swap(__float_as_uint(ps), __float_as_uint(ps), false, false);
    ps = __uint_as_float(rr[0]) + __uint_as_float(rr[1]); }
  if constexpr (SM == 2) l_reg += ps; else l_reg = l_reg * alpha + ps;
#define PK4(P, BASE, OUT) do { unsigned a0 = cvtpk(P[BASE + 0], P[BASE + 1]), a1 = cvtpk(P[BASE + 2], P[BASE + 3]);   \
    unsigned b0 = cvtpk(P[BASE + 4], P[BASE + 5]), b1 = cvtpk(P[BASE + 6], P[BASE + 7]);                              \
    auto r0 = __builtin_amdgcn_permlane32_swap(a0, b0, false, false); auto r1 = __builtin_amdgcn_permlane32_swap(a1, b1, false, false); \
    u32x4 w = {r0[0], r1[0], r0[1], r1[1]}; OUT = *reinterpret_cast<bf16x8*>(&w); } while (0)
  PK4(p0, 0, pa0); PK4(p0, 8, pa1); PK4(p1, 0, pa2); PK4(p1, 8, pa3);
#undef PK4
}
template <bool PF> __device__ __forceinline__ void qkt(f32x16& p0, f32x16& p1, const char* Ks, const bf16x8* qr, int r32, int hi) {
  p0 = f32x16{}; p1 = f32x16{};
  if constexpr (PF) {
  bf16x8 b0 = *reinterpret_cast<const bf16x8*>(Ks + KSWZ(r32, (hi * 8) * 2)), b1 = *reinterpret_cast<const bf16x8*>(Ks + KSWZ(32 + r32, (hi * 8) * 2));
#pragma unroll
  for (int d0 = 0; d0 < 8; ++d0) { bf16x8 n0 = b0, n1 = b1;
    if (d0 < 7) { const int cb = ((d0 + 1) * 16 + hi * 8) * 2; n0 = *reinterpret_cast<const bf16x8*>(Ks + KSWZ(r32, cb)); n1 = *reinterpret_cast<const bf16x8*>(Ks + KSWZ(32 + r32, cb)); }
    if (d0 < 7) asm volatile("s_waitcnt lgkmcnt(2)" ::: "memory"); else asm volatile("s_waitcnt lgkmcnt(0)" ::: "memory");
    __builtin_amdgcn_sched_barrier(0);
    p0 = __builtin_amdgcn_mfma_f32_32x32x16_bf16(b0, qr[d0], p0, 0, 0, 0);
    p1 = __builtin_amdgcn_mfma_f32_32x32x16_bf16(b1, qr[d0], p1, 0, 0, 0);
    b0 = n0; b1 = n1; }
  } else {
#pragma unroll
  for (int d0 = 0; d0 < 8; ++d0) { int cb = (d0 * 16 + hi * 8) * 2;
    bf16x8 b0 = *reinterpret_cast<const bf16x8*>(Ks + KSWZ(r32, cb));
    bf16x8 b1 = *reinterpret_cast<const bf16x8*>(Ks + KSWZ(32 + r32, cb));
    p0 = __builtin_amdgcn_mfma_f32_32x32x16_bf16(b0, qr[d0], p0, 0, 0, 0);
    p1 = __builtin_amdgcn_mfma_f32_32x32x16_bf16(b1, qr[d0], p1, 0, 0, 0); }
  }
}
__device__ __forceinline__ int v_st(int k, int c) { const int kk = (k & ~0xC) | ((k & 4) << 1) | ((k & 8) >> 1); return ((kk >> 3) * 4 + (c >> 5)) * 512 + ((kk & 7) * 32 + (c & 31)) * 2; }
__device__ __forceinline__ int v_rd_base(int lane) { return ((lane & 3) << 3) | (((lane >> 2) & 3) << 6) | (((lane >> 4) & 1) << 5) | (((lane >> 5) & 1) << 8); }
constexpr int v_rd_off(int d0, int ks, int half) { return d0 * 512 + ks * 4096 + half * 2048; }
template <int OFF> __device__ __forceinline__ s16x4 tr_read(int vb) {
  s16x4 r; asm volatile("ds_read_b64_tr_b16 %0, %1 offset:%2" : "=&v"(r) : "v"(vb), "i"(OFF) : "memory"); return r;
}
template <int D0> __device__ __forceinline__ void pv_one(f32x16& od, int vb, bf16x8 pa0, bf16x8 pa1, bf16x8 pa2, bf16x8 pa3) {
  const s16x4 l0 = tr_read<v_rd_off(D0, 0, 0)>(vb), h0 = tr_read<v_rd_off(D0, 0, 1)>(vb), l1 = tr_read<v_rd_off(D0, 1, 0)>(vb), h1 = tr_read<v_rd_off(D0, 1, 1)>(vb);
  const s16x4 l2 = tr_read<v_rd_off(D0, 2, 0)>(vb), h2 = tr_read<v_rd_off(D0, 2, 1)>(vb), l3 = tr_read<v_rd_off(D0, 3, 0)>(vb), h3 = tr_read<v_rd_off(D0, 3, 1)>(vb);
  asm volatile("s_waitcnt lgkmcnt(0)" ::: "memory"); SBAR();
#define PK(L, H) (bf16x8){L[0], L[1], L[2], L[3], H[0], H[1], H[2], H[3]}
  od = __builtin_amdgcn_mfma_f32_32x32x16_bf16(pa0, PK(l0, h0), od, 0, 0, 0);
  od = __builtin_amdgcn_mfma_f32_32x32x16_bf16(pa1, PK(l1, h1), od, 0, 0, 0);
  od = __builtin_amdgcn_mfma_f32_32x32x16_bf16(pa2, PK(l2, h2), od, 0, 0, 0);
  od = __builtin_amdgcn_mfma_f32_32x32x16_bf16(pa3, PK(l3, h3), od, 0, 0, 0);
#undef PK
}
__device__ __forceinline__ void pv_d0(f32x16* o, int vb, bf16x8 pa0, bf16x8 pa1, bf16x8 pa2, bf16x8 pa3) {
  pv_one<0>(o[0], vb, pa0, pa1, pa2, pa3); pv_one<1>(o[1], vb, pa0, pa1, pa2, pa3); pv_one<2>(o[2], vb, pa0, pa1, pa2, pa3); pv_one<3>(o[3], vb, pa0, pa1, pa2, pa3);
}

struct Unit {
  const bf16* Q; const bf16* K; const bf16* V; bf16* O; float* lse;
  int qstride, kstride, ostride, lse_stride;
  int NT;
  int kb0, n, qi0, hw;
  float slope_raw;
  float sink; int has_sink;
};

template <bool BAND, int SM>
__device__ __forceinline__ void attn_unit(const Unit& U, char* lds, const int tid) {
  const int wid = tid >> 6, lane = tid & 63, r32 = lane & 31, hi = lane >> 5;
  char* V_lds = lds; char* K_lds = lds + 2 * SHM_V;
  float* ws = (float*)(lds + 2 * SHM_V + 2 * SHM_K) + wid * 64; float* li_l = ws; float* al_l = ws + 32;
  float m_reg = -1e30f, l_reg = 0; f32x16 o[4] = {}; bf16x8 qr[8];
  { int lq_ = lane; asm volatile("" : "+v"(lq_));
    const unsigned qoff = (unsigned)(wid * QBLK + (lq_ & 31)) * (unsigned)U.qstride + (unsigned)((lq_ >> 5) * 8);
#pragma unroll
    for (int d0 = 0; d0 < 8; ++d0) qr[d0] = *reinterpret_cast<const bf16x8*>(U.Q + qoff + d0 * 16); }
  const int sr = tid >> 4, sc = (tid & 15) * 8, vst0 = v_st(sr, sc), kst0 = KSWZ(sr, sc * 2);
  const int vb0 = (int)(uintptr_t)V_lds + v_rd_base(lane);
  struct { bf16x8 vs0, vs1, ks0, ks1; } sr_[BAND ? 1 : 2];
  float fq = 0.f;
  if constexpr (BAND) fq = (float)(U.qi0 + wid * QBLK + r32);
#define ROWOF(k) ((k) < 0 ? 0 : ((k) >= U.n ? U.n - 1 : (k)))
#define SLOAD(i, k0) do { unsigned _o0, _o1; \
    if constexpr (BAND) { const int _ka = U.kb0 + (k0) + sr; _o0 = (unsigned)ROWOF(_ka) * (unsigned)U.kstride + (unsigned)sc; _o1 = (unsigned)ROWOF(_ka + 32) * (unsigned)U.kstride + (unsigned)sc; } \
    else { _o0 = (unsigned)((k0) + sr) * (unsigned)U.kstride + (unsigned)sc; _o1 = _o0 + 32u * (unsigned)U.kstride; } \
    sr_[i].vs0 = *reinterpret_cast<const bf16x8*>(U.V + _o0); sr_[i].vs1 = *reinterpret_cast<const bf16x8*>(U.V + _o1); \
    sr_[i].ks0 = *reinterpret_cast<const bf16x8*>(U.K + _o0); sr_[i].ks1 = *reinterpret_cast<const bf16x8*>(U.K + _o1); } while (0)
#define SWRITE(b, i) do { *(bf16x8*)(V_lds + (b) * SHM_V + vst0) = sr_[i].vs0;          \
    *(bf16x8*)(V_lds + (b) * SHM_V + vst0 + 8192) = sr_[i].vs1;                         \
    *(bf16x8*)(K_lds + (b) * SHM_K + kst0) = sr_[i].ks0;                               \
    *(bf16x8*)(K_lds + (b) * SHM_K + kst0 + 8192) = sr_[i].ks1; } while (0)
#define SWAIT() asm volatile("s_waitcnt vmcnt(4)" ::: "memory")
#define QK_SCHED() do { if constexpr (SM == 2 && ATT_SCHED == 1) { __builtin_amdgcn_sched_group_barrier(0x100, 4, 0); \
    _Pragma("unroll") for (int i_ = 0; i_ < 7; ++i_) { __builtin_amdgcn_sched_group_barrier(0x008, 2, 0); __builtin_amdgcn_sched_group_barrier(0x002, 9, 0); __builtin_amdgcn_sched_group_barrier(0x100, 2, 0); } \
    __builtin_amdgcn_sched_group_barrier(0x008, 2, 0); __builtin_amdgcn_sched_group_barrier(0x002, 12, 0); } \
    if constexpr (SM == 2 && ATT_SCHED == 2) { _Pragma("unroll") for (int i_ = 0; i_ < 8; ++i_) { __builtin_amdgcn_sched_group_barrier(0x100, 2, 0); __builtin_amdgcn_sched_group_barrier(0x008, 2, 0); __builtin_amdgcn_sched_group_barrier(0x002, 9, 0); } } } while (0)
#define RESC(a) do { if constexpr (SM != 2) if (__any((a) < 1.f)) { if (hi == 0) al_l[r32] = (a); asm volatile("s_waitcnt lgkmcnt(0)" ::: "memory"); \
    _Pragma("unroll") for (int d = 0; d < 4; ++d) _Pragma("unroll") for (int r = 0; r < 16; ++r) o[d][r] *= al_l[crow(r, hi)]; } } while (0)
#define MASKB(P0, P1, j) do { if constexpr (BAND) { const float _f0 = ((float)(U.kb0 + 64 * (j)) + (float)(4 * hi)) - fq; const float _ninf = -__builtin_inff(); \
    const float flo = __builtin_fmaxf(-(float)U.hw, -fq), fhi = __builtin_fminf((float)U.hw, (float)(U.n - 1) - fq); \
    _Pragma("unroll") for (int r = 0; r < 16; ++r) { const float d0_ = _f0 + (float)((r & 3) + 8 * (r >> 2)), d1_ = d0_ + 32.f; \
      const float s0_ = fmaf(-U.slope_raw, __builtin_fabsf(d0_), P0[r]), s1_ = fmaf(-U.slope_raw, __builtin_fabsf(d1_), P1[r]); \
      P0[r] = (d0_ >= flo && d0_ <= fhi) ? s0_ : _ninf; P1[r] = (d1_ >= flo && d1_ <= fhi) ? s1_ : _ninf; } } } while (0)
  f32x16 pA0, pA1, pB0, pB1; float mnA, mnB, alA, alB; bf16x8 pa0, pa1, pa2, pa3; const int NT = U.NT;
  constexpr int SE = 0, SO = 1;
  if constexpr (BAND) {
  const int tlo_ = __builtin_amdgcn_readfirstlane(wid >> 1), thi_ = tlo_ + (U.hw >> 5);
#define ACT(j) (!WSKIP || ((j) >= tlo_ && (j) <= thi_))
  SLOAD(0, 0); SWRITE(0, 0); SLOAD(0, KVBLK); __syncthreads();
  if (ACT(0)) { qkt<(BAND_PREFETCH != 0)>(pA0, pA1, K_lds, qr, r32, hi); MASKB(pA0, pA1, 0); partialSM<SM>(pA0, pA1, m_reg, mnA, alA); }
  SWRITE(1, 0); if (2 < NT) SLOAD(0, 2 * KVBLK); __syncthreads();
  for (int j = 1; j + 1 < NT; j += 2) {
      { const bool aj = ACT(j), ap = ACT(j - 1);
        SBAR(); if (aj) qkt<(BAND_PREFETCH != 0)>(pB0, pB1, K_lds + SHM_K, qr, r32, hi);
        if (ap) { finishSM<SM>(pA0, pA1, alA, l_reg, pa0, pa1, pa2, pa3); SBAR(); pv_d0(o, vb0, pa0, pa1, pa2, pa3); }
        if (aj) { MASKB(pB0, pB1, j); partialSM<SM>(pB0, pB1, m_reg, mnB, alB); }
        __syncthreads(); SWRITE(0, 0); SLOAD(0, (j + 2) * KVBLK);
        if (aj) RESC(alB); __syncthreads(); }
      { const bool aj = ACT(j + 1), ap = ACT(j);
        SBAR(); if (aj) qkt<(BAND_PREFETCH != 0)>(pA0, pA1, K_lds, qr, r32, hi);
        if (ap) { finishSM<SM>(pB0, pB1, alB, l_reg, pa0, pa1, pa2, pa3); SBAR(); pv_d0(o, vb0 + SHM_V, pa0, pa1, pa2, pa3); }
        if (aj) { MASKB(pA0, pA1, j + 1); partialSM<SM>(pA0, pA1, m_reg, mnA, alA); }
        __syncthreads(); SWRITE(1, 0); if (j + 3 < NT) SLOAD(0, (j + 3) * KVBLK);
        if (aj) RESC(alA); __syncthreads(); }
  }
  { const bool aj = ACT(NT - 1), ap = ACT(NT - 2);
    SBAR(); if (aj) qkt<(BAND_PREFETCH != 0)>(pB0, pB1, K_lds + SHM_K, qr, r32, hi);
    if (ap) { finishSM<SM>(pA0, pA1, alA, l_reg, pa0, pa1, pa2, pa3); SBAR(); pv_d0(o, vb0, pa0, pa1, pa2, pa3); }
    if (aj) { MASKB(pB0, pB1, NT - 1); partialSM<SM>(pB0, pB1, m_reg, mnB, alB); }
    __syncthreads();
    if (aj) { RESC(alB);
      finishSM<SM>(pB0, pB1, alB, l_reg, pa0, pa1, pa2, pa3); SBAR();
      pv_d0(o, vb0 + SHM_V, pa0, pa1, pa2, pa3); } }
#undef ACT
  } else {
  SLOAD(SE, 0); asm volatile("s_waitcnt vmcnt(0)" ::: "memory"); SWRITE(0, SE); __syncthreads();
  qkt<(QKT_PREFETCH != 0) && SM == 2>(pA0, pA1, K_lds, qr, r32, hi); partialSM<SM>(pA0, pA1, m_reg, mnA, alA);
  SLOAD(SO, KVBLK); if (2 < NT) SLOAD(SE, 2 * KVBLK);
  SWAIT(); SWRITE(1, SO); __syncthreads();
  for (int j = 1; j + 1 < NT; j += 2) {
    SBAR(); qkt<(QKT_PREFETCH != 0) && SM == 2>(pB0, pB1, K_lds + SHM_K, qr, r32, hi);
    finishSM<SM>(pA0, pA1, alA, l_reg, pa0, pa1, pa2, pa3); QK_SCHED(); SBAR();
    SLOAD(SO, (j + 2) * KVBLK); SBAR();
    pv_d0(o, vb0, pa0, pa1, pa2, pa3); partialSM<SM>(pB0, pB1, m_reg, mnB, alB);
    __syncthreads(); SWAIT(); SWRITE(0, SE);
    RESC(alB); __syncthreads();
    SBAR(); qkt<(QKT_PREFETCH != 0) && SM == 2>(pA0, pA1, K_lds, qr, r32, hi);
    finishSM<SM>(pB0, pB1, alB, l_reg, pa0, pa1, pa2, pa3); QK_SCHED(); SBAR();
    if (j + 3 < NT) SLOAD(SE, (j + 3) * KVBLK); SBAR();
    pv_d0(o, vb0 + SHM_V, pa0, pa1, pa2, pa3); partialSM<SM>(pA0, pA1, m_reg, mnA, alA);
    __syncthreads(); SWAIT(); SWRITE(1, SO);
    RESC(alA); __syncthreads();
  }
  SBAR(); qkt<(QKT_PREFETCH != 0) && SM == 2>(pB0, pB1, K_lds + SHM_K, qr, r32, hi);
  finishSM<SM>(pA0, pA1, alA, l_reg, pa0, pa1, pa2, pa3); SBAR();
  pv_d0(o, vb0, pa0, pa1, pa2, pa3); partialSM<SM>(pB0, pB1, m_reg, mnB, alB);
  __syncthreads(); RESC(alB);
  finishSM<SM>(pB0, pB1, alB, l_reg, pa0, pa1, pa2, pa3); SBAR();
  pv_d0(o, vb0 + SHM_V, pa0, pa1, pa2, pa3);
  }
  if constexpr (BAND) {
    if (U.has_sink) l_reg += __builtin_amdgcn_exp2f((U.sink * (1.0f / SCALE) - m_reg) * (SCALE * 1.4426950408889634f));
    if (U.lse != nullptr && hi == 0) U.lse[(unsigned)(wid * QBLK + r32) * (unsigned)U.lse_stride] = m_reg * SCALE + __builtin_amdgcn_logf(l_reg) * 0.6931471805599453f;
  }
  int lane_e = lane; asm volatile("" : "+v"(lane_e));
  const int r32e = lane_e & 31, hie = lane_e >> 5;
  if (hie == 0) li_l[r32e] = l_reg; asm volatile("s_waitcnt lgkmcnt(0)" ::: "memory");
  float rli[16];
#pragma unroll
  for (int r = 0; r < 16; ++r) rli[r] = __builtin_amdgcn_rcpf(li_l[crow(r, hie)]);
  __syncthreads();
  char* ost = lds + wid * 8192;
  { char* op = ost + hie * 1024 + r32e * 2;
#pragma unroll
    for (int r = 0; r < 16; ++r) {
#pragma unroll
      for (int d0 = 0; d0 < 4; ++d0) { const unsigned w = cvtpk(o[d0][r] * rli[r], 0.f); *(unsigned short*)(op + ((r & 3) + 8 * (r >> 2)) * 256 + d0 * 64) = (unsigned short)w; } } }
  asm volatile("s_waitcnt lgkmcnt(0)" ::: "memory");
  { const char* ip = ost + (lane_e >> 4) * 256 + (lane_e & 15) * 16;
    unsigned goff = (unsigned)(wid * QBLK + (lane_e >> 4)) * (unsigned)U.ostride + (unsigned)((lane_e & 15) * 8); const unsigned gstep = 4u * (unsigned)U.ostride;
#pragma unroll
    for (int i = 0; i < 8; ++i) { const u32x4 w = *(const u32x4*)(ip + i * 1024); *(u32x4*)(U.O + goff) = w; goff += gstep; } }
  __syncthreads();
#undef ROWOF
#undef SLOAD
#undef SWRITE
#undef SWAIT
#undef QK_SCHED
#undef RESC
#undef MASKB
}

constexpr int SHM_RING = 3 * SHM_V + 2 * SHM_K + NW * 64 * 4;
__device__ __forceinline__ void attn_unit_ring(const Unit& U, char* lds, const int tid) {
  const int wid = tid >> 6, lane = tid & 63, r32 = lane & 31, hi = lane >> 5;
  char* V_lds = lds; char* K_lds = lds + 3 * SHM_V;
  float* ws = (float*)(lds + 3 * SHM_V + 2 * SHM_K) + wid * 64; float* li_l = ws;
  float m_reg = 0.f, l_reg = 0, mn_, al_ = 1.f; f32x16 o[4] = {}; bf16x8 qr[8];
  { const unsigned qoff = (unsigned)(wid * QBLK + r32) * (unsigned)U.qstride + (unsigned)(hi * 8);
#pragma unroll
    for (int d0 = 0; d0 < 8; ++d0) qr[d0] = *reinterpret_cast<const bf16x8*>(U.Q + qoff + d0 * 16); }
  const int sr = tid >> 4, sc = (tid & 15) * 8, vst0 = v_st(sr, sc), vst1 = v_st(32 + sr, sc);
  const int vb0 = (int)(uintptr_t)V_lds + v_rd_base(lane);
  struct { bf16x8 vs0, vs1, ks0, ks1; } sr_[1];
#define SLOAD(i, k0) do { const unsigned _o0 = (unsigned)((k0) + sr) * (unsigned)U.kstride + (unsigned)sc, _o1 = _o0 + 32u * (unsigned)U.kstride; \
    sr_[i].vs0 = *reinterpret_cast<const bf16x8*>(U.V + _o0); sr_[i].vs1 = *reinterpret_cast<const bf16x8*>(U.V + _o1); \
    sr_[i].ks0 = *reinterpret_cast<const bf16x8*>(U.K + _o0); sr_[i].ks1 = *reinterpret_cast<const bf16x8*>(U.K + _o1); } while (0)
#define SWRITE(kb, vsl, i) do { char* _v = V_lds + (vsl) * SHM_V; *(bf16x8*)(_v + vst0) = sr_[i].vs0; *(bf16x8*)(_v + vst1) = sr_[i].vs1; int kc = sc * 2; \
    *(bf16x8*)(K_lds + (kb) * SHM_K + KSWZ(sr, kc)) = sr_[i].ks0; *(bf16x8*)(K_lds + (kb) * SHM_K + KSWZ(32 + sr, kc)) = sr_[i].ks1; } while (0)
#define NEXT3(x) ((x) == 2 ? 0 : (x) + 1)
  f32x16 pA0, pA1, pB0, pB1; bf16x8 pa0, pa1, pa2, pa3; const int NT = U.NT;
  SLOAD(0, 0); SWRITE(0, 0, 0); SLOAD(0, KVBLK);
  __syncthreads();
  SWRITE(1, 1, 0); SLOAD(0, 2 * KVBLK);
  qkt<(QKT_PREFETCH != 0)>(pA0, pA1, K_lds, qr, r32, hi); partialSM<2>(pA0, pA1, m_reg, mn_, al_);
  __syncthreads();
  int vr = 0;
  for (int j = 1; j + 1 < NT; j += 2) {
    { const int vw = NEXT3(NEXT3(vr));
      SWRITE(0, vw, 0); SLOAD(0, (j + 2) * KVBLK);
      SBAR(); qkt<(QKT_PREFETCH != 0)>(pB0, pB1, K_lds + SHM_K, qr, r32, hi);
      finishSM<2>(pA0, pA1, al_, l_reg, pa0, pa1, pa2, pa3); SBAR();
      pv_d0(o, vb0 + vr * SHM_V, pa0, pa1, pa2, pa3); partialSM<2>(pB0, pB1, m_reg, mn_, al_);
      __syncthreads(); vr = NEXT3(vr); }
    { const int vw = NEXT3(NEXT3(vr));
      SWRITE(1, vw, 0); if (j + 3 < NT) SLOAD(0, (j + 3) * KVBLK);
      SBAR(); qkt<(QKT_PREFETCH != 0)>(pA0, pA1, K_lds, qr, r32, hi);
      finishSM<2>(pB0, pB1, al_, l_reg, pa0, pa1, pa2, pa3); SBAR();
      pv_d0(o, vb0 + vr * SHM_V, pa0, pa1, pa2, pa3); partialSM<2>(pA0, pA1, m_reg, mn_, al_);
      __syncthreads(); vr = NEXT3(vr); }
  }
  SBAR(); qkt<(QKT_PREFETCH != 0)>(pB0, pB1, K_lds + SHM_K, qr, r32, hi);
  finishSM<2>(pA0, pA1, al_, l_reg, pa0, pa1, pa2, pa3); SBAR();
  pv_d0(o, vb0 + vr * SHM_V, pa0, pa1, pa2, pa3); partialSM<2>(pB0, pB1, m_reg, mn_, al_);
  finishSM<2>(pB0, pB1, al_, l_reg, pa0, pa1, pa2, pa3); SBAR();
  pv_d0(o, vb0 + NEXT3(vr) * SHM_V, pa0, pa1, pa2, pa3);
  int lane_e = lane; asm volatile("" : "+v"(lane_e));
  const int r32e = lane_e & 31, hie = lane_e >> 5;
  if (hie == 0) li_l[r32e] = l_reg; asm volatile("s_waitcnt lgkmcnt(0)" ::: "memory");
  float rli[16];
#pragma unroll
  for (int r = 0; r < 16; ++r) rli[r] = __builtin_amdgcn_rcpf(li_l[crow(r, hie)]);
  __syncthreads();
  char* ost = lds + wid * 8192;
  { char* op = ost + hie * 1024 + r32e * 2;
#pragma unroll
    for (int r = 0; r < 16; ++r) {
#pragma unroll
      for (int d0 = 0; d0 < 4; ++d0) { const unsigned w = cvtpk(o[d0][r] * rli[r], 0.f); *(unsigned short*)(op + ((r & 3) + 8 * (r >> 2)) * 256 + d0 * 64) = (unsigned short)w; } } }
  asm volatile("s_waitcnt lgkmcnt(0)" ::: "memory");
  { const char* ip = ost + (lane_e >> 4) * 256 + (lane_e & 15) * 16;
    unsigned goff = (unsigned)(wid * QBLK + (lane_e >> 4)) * (unsigned)U.ostride + (unsigned)((lane_e & 15) * 8); const unsigned gstep = 4u * (unsigned)U.ostride;
#pragma unroll
    for (int i = 0; i < 8; ++i) { const u32x4 w = *(const u32x4*)(ip + i * 1024); *(u32x4*)(U.O + goff) = w; goff += gstep; } }
  __syncthreads();
#undef SLOAD
#undef SWRITE
#undef NEXT3
}

constexpr int DMA_KOFF = 0, DMA_VOFF = 3 * SHM_K, DMA_SCR = 3 * SHM_K + 4 * SHM_V, SHM_DMA = DMA_SCR + NW * 64 * 4;
typedef __attribute__((address_space(3))) unsigned char lds_u8;
__device__ __forceinline__ void attn_unit_dma(const Unit& U, char* lds, lds_u8* ldsl, const int tid) {
  const int wid = __builtin_amdgcn_readfirstlane(tid >> 6), lane = tid & 63, r32 = lane & 31, hi = lane >> 5;
  char* K_lds = lds + DMA_KOFF; char* V_lds = lds + DMA_VOFF;
  float* ws = (float*)(lds + DMA_SCR) + wid * 64; float* li_l = ws;
  float m_reg = 0.f, l_reg = 0, mn_, al_ = 1.f; f32x16 o[4] = {}; bf16x8 qr[8];
  { int lq_ = lane; asm volatile("" : "+v"(lq_));
    const unsigned qoff = (unsigned)(wid * QBLK + (lq_ & 31)) * (unsigned)U.qstride + (unsigned)((lq_ >> 5) * 8);
#pragma unroll
    for (int d0 = 0; d0 < 8; ++d0) qr[d0] = *reinterpret_cast<const bf16x8*>(U.Q + qoff + d0 * 16); }
  unsigned koff[2], voff[2];
#pragma unroll
  for (int i = 0; i < 2; ++i) { const int p = (wid * 2 + i) * 64 + lane;
    { const int row = p >> 4, cs = p & 15, c = cs ^ (row & 7); koff[i] = ((unsigned)row * (unsigned)U.kstride + (unsigned)(c * 8)) * 2u; }
    { const int st = p >> 5, q = p & 31, kk = (st >> 2) * 8 + (q >> 2), key = (kk & ~0xC) | ((kk & 4) << 1) | ((kk & 8) >> 1), c = (st & 3) * 32 + (q & 3) * 8; voff[i] = ((unsigned)key * (unsigned)U.kstride + (unsigned)c) * 2u; } }
  const int vb0 = (int)(uintptr_t)V_lds + v_rd_base(lane);
  const unsigned ldsw = (unsigned)wid * 2048u;
#define NEXT3(x) ((x) == 2 ? 0 : (x) + 1)
#define NEXT4(x) (((x) + 1) & 3)
#define DMA_TILE(t, ks, vs) do { const int t_ = (t); const char* kb_ = (const char*)(U.K + (size_t)t_ * KVBLK * U.kstride); const char* vb_ = (const char*)(U.V + (size_t)t_ * KVBLK * U.kstride); \
    _Pragma("unroll") for (int i_ = 0; i_ < 2; ++i_) { \
      __builtin_amdgcn_global_load_lds((const unsigned*)(kb_ + koff[i_]), (__attribute__((address_space(3))) unsigned*)(ldsl + DMA_KOFF + (ks) * SHM_K + ldsw + i_ * 1024), 16, 0, 0); \
      __builtin_amdgcn_global_load_lds((const unsigned*)(vb_ + voff[i_]), (__attribute__((address_space(3))) unsigned*)(ldsl + DMA_VOFF + (vs) * SHM_V + ldsw + i_ * 1024), 16, 0, 0); } } while (0)
#define STEP_BAR() do { asm volatile("s_waitcnt vmcnt(4) lgkmcnt(0)" ::: "memory"); __builtin_amdgcn_s_barrier(); asm volatile("" ::: "memory"); } while (0)
#define STEP_BAR0() do { asm volatile("s_waitcnt vmcnt(0) lgkmcnt(0)" ::: "memory"); __builtin_amdgcn_s_barrier(); asm volatile("" ::: "memory"); } while (0)
  f32x16 pA0, pA1, pB0, pB1; bf16x8 pa0, pa1, pa2, pa3; const int NT = U.NT;
  asm volatile("s_waitcnt vmcnt(0)" ::: "memory");
  DMA_TILE(0, 0, 0); DMA_TILE(1, 1, 1);
  STEP_BAR();
  DMA_TILE(2, 2, 2);
  qkt<(QKT_PREFETCH != 0)>(pA0, pA1, K_lds, qr, r32, hi); partialSM<2>(pA0, pA1, m_reg, mn_, al_);
  STEP_BAR();
  int ks = 1, vs = 1;
  for (int j = 1; j + 1 < NT; j += 2) {
    { const int kw = NEXT3(NEXT3(ks)), vw = NEXT4(NEXT4(vs));
      const bool more_ = j + 2 < NT;
      SBAR(); qkt<(QKT_PREFETCH != 0)>(pB0, pB1, K_lds + ks * SHM_K, qr, r32, hi);
      finishSM<2>(pA0, pA1, al_, l_reg, pa0, pa1, pa2, pa3); SBAR();
      if (more_) DMA_TILE(j + 2, kw, vw); SBAR();
      pv_d0(o, vb0 + ((vs + 3) & 3) * SHM_V, pa0, pa1, pa2, pa3); partialSM<2>(pB0, pB1, m_reg, mn_, al_);
      if (more_) STEP_BAR(); else STEP_BAR0(); ks = NEXT3(ks); vs = NEXT4(vs); }
    { const int kw = NEXT3(NEXT3(ks)), vw = NEXT4(NEXT4(vs));
      const bool more_ = j + 3 < NT;
      SBAR(); qkt<(QKT_PREFETCH != 0)>(pA0, pA1, K_lds + ks * SHM_K, qr, r32, hi);
      finishSM<2>(pB0, pB1, al_, l_reg, pa0, pa1, pa2, pa3); SBAR();
      if (more_) DMA_TILE(j + 3, kw, vw); SBAR();
      pv_d0(o, vb0 + ((vs + 3) & 3) * SHM_V, pa0, pa1, pa2, pa3); partialSM<2>(pA0, pA1, m_reg, mn_, al_);
      if (more_) STEP_BAR(); else STEP_BAR0(); ks = NEXT3(ks); vs = NEXT4(vs); }
  }
  SBAR(); qkt<(QKT_PREFETCH != 0)>(pB0, pB1, K_lds + ks * SHM_K, qr, r32, hi);
  finishSM<2>(pA0, pA1, al_, l_reg, pa0, pa1, pa2, pa3); SBAR();
  pv_d0(o, vb0 + ((vs + 3) & 3) * SHM_V, pa0, pa1, pa2, pa3); partialSM<2>(pB0, pB1, m_reg, mn_, al_);
  finishSM<2>(pB0, pB1, al_, l_reg, pa0, pa1, pa2, pa3); SBAR();
  pv_d0(o, vb0 + vs * SHM_V, pa0, pa1, pa2, pa3);
  asm volatile("s_waitcnt vmcnt(0) lgkmcnt(0)" ::: "memory");
  int lane_e = lane; asm volatile("" : "+v"(lane_e));
  const int r32e = lane_e & 31, hie = lane_e >> 5;
  if (hie == 0) li_l[r32e] = l_reg; asm volatile("s_waitcnt lgkmcnt(0)" ::: "memory");
  float rli[16];
#pragma unroll
  for (int r = 0; r < 16; ++r) rli[r] = __builtin_amdgcn_rcpf(li_l[crow(r, hie)]);
  __syncthreads();
  char* ost = lds + wid * 8192;
  { char* op = ost + hie * 1024 + r32e * 2;
#pragma unroll
    for (int r = 0; r < 16; ++r) {
#pragma unroll
      for (int d0 = 0; d0 < 4; ++d0) { const unsigned w = cvtpk(o[d0][r] * rli[r], 0.f); *(unsigned short*)(op + ((r & 3) + 8 * (r >> 2)) * 256 + d0 * 64) = (unsigned short)w; } } }
  asm volatile("s_waitcnt lgkmcnt(0)" ::: "memory");
  { const char* ip = ost + (lane_e >> 4) * 256 + (lane_e & 15) * 16;
    unsigned goff = (unsigned)(wid * QBLK + (lane_e >> 4)) * (unsigned)U.ostride + (unsigned)((lane_e & 15) * 8); const unsigned gstep = 4u * (unsigned)U.ostride;
#pragma unroll
    for (int i = 0; i < 8; ++i) { const u32x4 w = *(const u32x4*)(ip + i * 1024); *(u32x4*)(U.O + goff) = w; goff += gstep; } }
  __syncthreads();
#undef NEXT3
#undef NEXT4
#undef DMA_TILE
#undef STEP_BAR
#undef STEP_BAR0
}
}

constexpr int NWAVES = 8;
constexpr int DM = 2048, SEQ = 16384, NSEQ = 3, M_ALL = NSEQ * SEQ, DEPTH = 4, DFF = 5632, INC = 13824;
constexpr int MGR = 2 * SEQ;
constexpr int A_Q = 0, A_K = 1536, A_V = 3072, B_Q = 4608, B_K = 5632, B_V = 5888, C_Q = 6144, C_K = 7168, C_V = 7424, GL0 = 7680;
constexpr float NORM_EPS = 1e-6f;
enum { I_XP = 0, I_XS, I_NF1, I_F1IN, I_F1OUT, I_NMIX, I_WIN, I_QNQ, I_QNK, I_SINK, I_WA, I_WB, I_WC, I_WO, I_NF2, I_F2IN, I_F2OUT, I_NFIN, N_IN };

constexpr size_t MiB = 1u << 20;
constexpr size_t WS_CTL = 0, CTL_ZERO_BYTES = 1 * MiB;
constexpr int LDW = DM + LDW_PAD, LDU = DM + LDU_PAD;
constexpr size_t WL_F1IN = 0, WL_F1OUT = WL_F1IN + (size_t)2 * DFF * LDW * 2, WL_WIN = WL_F1OUT + (size_t)DM * DFF * 2, WL_WA = WL_WIN + (size_t)INC * LDW * 2,
                 WL_WB = WL_WA + (size_t)DM * 512 * 2, WL_WC = WL_WB + (size_t)DM * 1024 * 2, WL_WO = WL_WC + (size_t)DM * 1024 * 2, WL_F2IN = WL_WO + (size_t)DM * LDW * 2,
                 WL_F2OUT = WL_F2IN + (size_t)2 * DFF * LDW * 2, WL_BYTES = WL_F2OUT + (size_t)DM * DFF * 2;
constexpr size_t WS_W = 1 * MiB;
constexpr size_t WS_U = WS_W + WL_BYTES;
constexpr size_t WS_R = WS_U + (size_t)M_ALL * LDU * 2;
constexpr size_t WS_H = WS_R;
constexpr size_t WS_QKVG = WS_R;
constexpr int OCAT = 2560;
constexpr size_t WS_OCAT = WS_QKVG + (size_t)MGR * INC * 2;
constexpr size_t WS_OA = WS_OCAT, WS_OB = WS_OCAT + 512 * 2, WS_OC = WS_OCAT + 1536 * 2;
constexpr size_t WS_PA = WS_OCAT + (size_t)MGR * OCAT * 2;
constexpr size_t WS_LSE = WS_PA + (size_t)3 * MGR * 512 * 2;
constexpr size_t WS_QB = WS_LSE + (size_t)3 * MGR * 4 * 4;
constexpr size_t WS_KB = WS_QB + (size_t)MGR * 1024 * 2;
constexpr size_t WS_VB = WS_KB + (size_t)MGR * 256 * 2;
constexpr size_t WS_MB = WS_VB + (size_t)MGR * 256 * 2;
constexpr size_t WS_MIX_END = WS_MB + (size_t)MGR * LDU * 2;
constexpr int LDH = DFF + LDH_PAD;
constexpr size_t WS_H_END = WS_H + (size_t)M_ALL * LDH * 2;
constexpr size_t WS_END = WS_MIX_END > WS_H_END ? WS_MIX_END : WS_H_END;
constexpr int CW_BAR = 4096;

constexpr int RING_OFF = 0, RING_BYTES = 131072;
constexpr int LDSCTL_OFF = RING_BYTES, MISC_OFF = LDSCTL_OFF + 320;
constexpr int LDS_BYTES = 147456;
constexpr int DIAG_OFF = MISC_OFF + 256;

#define GAS __attribute__((address_space(1)))
#define LAS __attribute__((address_space(3)))
typedef unsigned short bf16;
typedef unsigned v4u __attribute__((ext_vector_type(4)));
typedef unsigned v2u __attribute__((ext_vector_type(2)));
typedef float f32x4 __attribute__((ext_vector_type(4)));
#define LDS_WAIT() asm volatile("s_waitcnt lgkmcnt(0)" ::: "memory")
#define VM_WAIT() asm volatile("s_waitcnt vmcnt(0)" ::: "memory")
__device__ __forceinline__ unsigned f2bf(float f) { unsigned u = __builtin_bit_cast(unsigned, f); return (u + 0x7fffu + ((u >> 16) & 1u)) >> 16; }
__device__ __forceinline__ unsigned pk2(float lo, float hi) { return f2bf(lo) | (f2bf(hi) << 16); }
__device__ __forceinline__ float bflo(unsigned w) { return __uint_as_float(w << 16); }
__device__ __forceinline__ float bfhi(unsigned w) { return __uint_as_float(w & 0xffff0000u); }

#define XB_TMO      128
#define XB_XCNT(j)  (256  + 64 * (j))
#define XB_XSUB(j)  (1280 + 64 * (j))
#define XB_XGEN(j)  (2304 + 64 * (j))
#define XB_TOP      3328
#define XB_TOPGEN   3392
#define XCD_BAR_WORDS 3456
#define XB_SPIN_CAP (1u << 18)
__device__ __forceinline__ unsigned xb_ld(unsigned* p)              { return __hip_atomic_load(p, __ATOMIC_RELAXED, __HIP_MEMORY_SCOPE_AGENT); }
__device__ __forceinline__ unsigned xb_add(unsigned* p, unsigned v) { return __hip_atomic_fetch_add(p, v, __ATOMIC_RELAXED, __HIP_MEMORY_SCOPE_AGENT); }
__device__ __forceinline__ unsigned xb_xcc_id() { return (unsigned)__builtin_amdgcn_s_getreg((3 << 11) | 20) & 0xFu; }
#define XB_SPIN(cond, bar) do { unsigned _sp = 0; while (cond) { __builtin_amdgcn_s_sleep(1); \
    if ((++_sp & 255u) == 0u) { if (xb_ld(&(bar)[XB_TMO])) break; if (_sp > XB_SPIN_CAP) { atomicAdd(&(bar)[XB_TMO], 1u); break; } } } } while (0)
struct XcdBarrier { unsigned* bar; unsigned x; volatile LAS unsigned* st; };
__device__ __forceinline__ XcdBarrier xcd_barrier_post(unsigned* bar, volatile LAS unsigned* st) {
    XcdBarrier b; b.bar = bar; b.x = xb_xcc_id(); b.st = st;
    if (threadIdx.x == 0) (void)xb_add(&bar[XB_XCNT(b.x)], 1u);
    return b;
}
__device__ __forceinline__ void xcd_barrier_complete(unsigned* bar, unsigned x, unsigned& nloc, unsigned& nx) {
    const unsigned G = gridDim.x * gridDim.y * gridDim.z;
    unsigned sum, cnt, mine, sp = 0u;
    for (;;) {
        sum = 0u; cnt = 0u; mine = 0u;
#pragma unroll
        for (unsigned j = 0; j < 16; ++j) { const unsigned c = xb_ld(&bar[XB_XCNT(j)]); sum += c; cnt += (c > 0u) ? 1u : 0u; mine = (j == x) ? c : mine; }
        if (sum == G) break;
        __builtin_amdgcn_s_sleep(1);
        if ((++sp & 255u) == 0u) { if (xb_ld(&bar[XB_TMO])) break; if (sp > XB_SPIN_CAP) { atomicAdd(&bar[XB_TMO], 1u); break; } }
    }
    nloc = mine > 0u ? mine : 1u; nx = cnt > 0u ? cnt : 1u;
}
__device__ __forceinline__ void xcd_barrier(const XcdBarrier& b) {
    asm volatile("s_waitcnt vmcnt(0)" ::: "memory");
    __syncthreads();
    if (threadIdx.x == 0) {
        unsigned* bar = b.bar;
        __builtin_amdgcn_s_waitcnt(0);
        unsigned nloc = b.st[0], nx = b.st[1];
        if (nloc == 0u) { xcd_barrier_complete(bar, b.x, nloc, nx); b.st[0] = nloc; b.st[1] = nx; }
        const unsigned old = xb_add(&bar[XB_XSUB(b.x)], 1u);
        const unsigned gen = old / nloc;
        if (old + 1u == (gen + 1u) * nloc) {
            __builtin_amdgcn_fence(__ATOMIC_RELEASE, "agent");
            asm volatile("s_waitcnt vmcnt(0)" ::: "memory");
            const unsigned og = xb_add(&bar[XB_TOP], 1u);
            const unsigned tg = og / nx;
            if (og + 1u == (tg + 1u) * nx) xb_add(&bar[XB_TOPGEN], 1u);
            else XB_SPIN(xb_ld(&bar[XB_TOPGEN]) == tg, bar);
            __builtin_amdgcn_fence(__ATOMIC_ACQUIRE, "agent");
            xb_add(&bar[XB_XGEN(b.x)], 1u);
            asm volatile("s_waitcnt vmcnt(0)" ::: "memory");
        } else {
            XB_SPIN(xb_ld(&bar[XB_XGEN(b.x)]) == gen, bar);
            __builtin_amdgcn_fence(__ATOMIC_ACQUIRE, "agent");
            asm volatile("s_waitcnt vmcnt(0)" ::: "memory");
        }
    }
    __syncthreads();
}

template <int XOR> __device__ __forceinline__ float swz_xor(float v) { return __int_as_float(__builtin_amdgcn_ds_swizzle(__float_as_int(v), (XOR << 10) | 0x1F)); }
__device__ __forceinline__ float wave_sum(float v) {
    v += swz_xor<1>(v); v += swz_xor<2>(v); v += swz_xor<4>(v); v += swz_xor<8>(v); v += swz_xor<16>(v);
    auto rr = __builtin_amdgcn_permlane32_swap(__float_as_uint(v), __float_as_uint(v), false, false);
    return __uint_as_float(rr[0]) + __uint_as_float(rr[1]);
}
__device__ __forceinline__ float wave_max(float v) {
    v = fmaxf(v, swz_xor<1>(v)); v = fmaxf(v, swz_xor<2>(v)); v = fmaxf(v, swz_xor<4>(v)); v = fmaxf(v, swz_xor<8>(v)); v = fmaxf(v, swz_xor<16>(v));
    auto rr = __builtin_amdgcn_permlane32_swap(__float_as_uint(v), __float_as_uint(v), false, false);
    return fmaxf(__uint_as_float(rr[0]), __uint_as_float(rr[1]));
}
__device__ __forceinline__ void transpose_item(const float* W, int K, int N, bf16* WT, int k0, int n0, int orow0, LAS float* scr, int lane, int ldw) {
#pragma unroll 8
    for (int i = 0; i < 32; ++i) { const int kk = 2 * i + (lane >> 5); scr[kk * 33 + (lane & 31)] = W[(size_t)(k0 + kk) * N + n0 + (lane & 31)]; }
    LDS_WAIT(); asm volatile("" ::: "memory");
    const int c = lane & 7;
#pragma unroll
    for (int j = 0; j < 4; ++j) { const int n = (lane >> 3) + 8 * j; const LAS float* s = scr + (8 * c) * 33 + n;
        v4u o; o.x = pk2(s[0 * 33], s[1 * 33]); o.y = pk2(s[2 * 33], s[3 * 33]); o.z = pk2(s[4 * 33], s[5 * 33]); o.w = pk2(s[6 * 33], s[7 * 33]);
        *(GAS v4u*)(WT + (size_t)(orow0 + n) * ldw + k0 + 8 * c) = o; }
    LDS_WAIT(); asm volatile("" ::: "memory");
}
__device__ __forceinline__ void transpose_matrix(const float* W, int K, int N, bf16* WT, int swiglu, LAS float* scr, int lane, int gw, int NGW, int ldw = 0) {
    const int nblk = N / 32, nitems = (K / 64) * nblk;
    for (int it = gw; it < nitems; it += NGW) {
        const int kb = it / nblk, nb = it % nblk, k0 = 64 * kb, n0 = 32 * nb;
        int orow0 = n0;
        if (swiglu) { const int half = n0 >= DFF ? 1 : 0, np = n0 - half * DFF; orow0 = 256 * (np / 128) + 128 * half + (np % 128); }
        transpose_item(W, K, N, WT, k0, n0, orow0, scr, lane, ldw ? ldw : K);
    }
}
__device__ __forceinline__ void rms_row_to_bf16(const float* xrow, const float* g, bf16* orow, float* xcopy, int lane) {
    const GAS f32x4* xr = (const GAS f32x4*)xrow + lane; const GAS f32x4* gr = (const GAS f32x4*)g + lane;
    f32x4 v[8]; float s = 0.f;
#pragma unroll
    for (int j = 0; j < 8; ++j) { v[j] = xr[64 * j]; s += (v[j].x * v[j].x + v[j].y * v[j].y) + (v[j].z * v[j].z + v[j].w * v[j].w); }
    if (xcopy) { GAS f32x4* xc = (GAS f32x4*)xcopy + lane;
#pragma unroll
        for (int j = 0; j < 8; ++j) xc[64 * j] = v[j]; }
    const float rstd = __builtin_amdgcn_rsqf(wave_sum(s) * (1.f / DM) + NORM_EPS);
    GAS v2u* o8 = (GAS v2u*)orow + lane;
#pragma unroll
    for (int j = 0; j < 8; ++j) { const f32x4 gg = gr[64 * j]; v2u w; w.x = pk2(v[j].x * rstd * gg.x, v[j].y * rstd * gg.y); w.y = pk2(v[j].z * rstd * gg.z, v[j].w * rstd * gg.w); o8[64 * j] = w; }
}
__device__ __forceinline__ void rms_row_f32(float* xrow, const float* g, int lane) {
    GAS f32x4* xr = (GAS f32x4*)xrow + lane; const GAS f32x4* gr = (const GAS f32x4*)g + lane;
    f32x4 v[8]; float s = 0.f;
#pragma unroll
    for (int j = 0; j < 8; ++j) { v[j] = xr[64 * j]; s += (v[j].x * v[j].x + v[j].y * v[j].y) + (v[j].z * v[j].z + v[j].w * v[j].w); }
    const float rstd = __builtin_amdgcn_rsqf(wave_sum(s) * (1.f / DM) + NORM_EPS);
#pragma unroll
    for (int j = 0; j < 8; ++j) { const f32x4 gg = gr[64 * j]; xr[64 * j] = v[j] * rstd * gg; }
}
constexpr float QPRESCALE = 0.088388347648318440f * 1.4426950408889634f;
template <int NT_>
__device__ __forceinline__ void ropeB_tokens(const bf16* qkvg, int t0, int tstep, const float* gq, const float* gk, bf16* qb, bf16* kb, bf16* vb, int lane) {
    const int f = lane & 31;
    const float invrev = __builtin_amdgcn_exp2f((float)f * (-13.287712379549449f / 32.0f)) * 0.15915494309189535f;
    const float gq0 = gq[2 * lane], gq1 = gq[2 * lane + 1], gk0 = gk[2 * lane], gk1 = gk[2 * lane + 1];
    unsigned w[NT_][10]; v2u vv[NT_];
#pragma unroll
    for (int i = 0; i < NT_; ++i) { const int t = t0 + i * tstep; const GAS unsigned* src = (const GAS unsigned*)(qkvg + (size_t)t * INC + B_Q) + lane;
#pragma unroll
        for (int h = 0; h < 10; ++h) w[i][h] = src[h * 64];
        vv[i] = ((const GAS v2u*)(qkvg + (size_t)t * INC + B_V))[lane]; }
#pragma unroll
    for (int i = 0; i < NT_; ++i) { const int t = t0 + i * tstep;
        const int tp = t & (SEQ - 1);
        const float pos = (float)((lane < 32) ? (tp >> 6) : (tp & 63));
        float rev = pos * invrev; rev = rev - __builtin_floorf(rev);
        const float cs = __builtin_amdgcn_cosf(rev), sn = __builtin_amdgcn_sinf(rev);
#pragma unroll
        for (int h = 0; h < 10; ++h) {
            const float x0 = bflo(w[i][h]), x1 = bfhi(w[i][h]);
            const float rstd = __builtin_amdgcn_rsqf(wave_sum(x0 * x0 + x1 * x1) * (1.f / 128.f) + NORM_EPS);
            const float y0 = x0 * rstd * (h < 8 ? gq0 : gk0), y1 = x1 * rstd * (h < 8 ? gq1 : gk1);
            const float qs = h < 8 ? QPRESCALE : 1.0f;
            const unsigned o = pk2((y0 * cs - y1 * sn) * qs, (y0 * sn + y1 * cs) * qs);
            if (h < 8) ((GAS unsigned*)(qb + (size_t)t * 1024))[h * 64 + lane] = o; else ((GAS unsigned*)(kb + (size_t)t * 256))[(h - 8) * 64 + lane] = o;
        }
        ((GAS v2u*)(vb + (size_t)t * 256))[lane] = vv[i]; }
}
__device__ __forceinline__ void mergeA_token(const bf16* pa, const float* lse, bf16* oa, int t, int lane) {
#pragma unroll
    for (int hh = 0; hh < 4; ++hh) {
        const float l0 = lse[((size_t)0 * MGR + t) * 4 + hh], l1 = lse[((size_t)1 * MGR + t) * 4 + hh], l2 = lse[((size_t)2 * MGR + t) * 4 + hh];
        const float mx = fmaxf(l0, fmaxf(l1, l2));
        const float e0 = __builtin_amdgcn_exp2f((l0 - mx) * 1.4426950408889634f), e1 = __builtin_amdgcn_exp2f((l1 - mx) * 1.4426950408889634f), e2 = __builtin_amdgcn_exp2f((l2 - mx) * 1.4426950408889634f);
        const float inv = __builtin_amdgcn_rcpf(e0 + e1 + e2);
        const unsigned w0 = ((const GAS unsigned*)(pa + ((size_t)0 * MGR + t) * 512))[hh * 64 + lane], w1 = ((const GAS unsigned*)(pa + ((size_t)1 * MGR + t) * 512))[hh * 64 + lane],
                       w2 = ((const GAS unsigned*)(pa + ((size_t)2 * MGR + t) * 512))[hh * 64 + lane];
        const float a = (e0 * bflo(w0) + e1 * bflo(w1) + e2 * bflo(w2)) * inv, b = (e0 * bfhi(w0) + e1 * bfhi(w1) + e2 * bfhi(w2)) * inv;
        ((GAS unsigned*)(oa + (size_t)t * OCAT))[hh * 64 + lane] = pk2(a, b);
    }
}

struct Args { const float* in[N_IN]; float* out; unsigned char* ws; int ph_lo, ph_hi; };
constexpr int N_PHASES = 1 + DEPTH * (3 + 1 + 2 * 5 + 3) + 1;

__device__ __forceinline__ int opq_v(int x) { asm volatile("" : "+v"(x)); return x; }
template <class T> __device__ __forceinline__ T* opq_p(T* p) { GAS T* g = (GAS T*)p; asm volatile("" : "+s"(g)); return (T*)g; }
__device__ __forceinline__ int lane_id_asm() { int l; asm volatile("v_mbcnt_lo_u32_b32 %0, -1, 0\n\tv_mbcnt_hi_u32_b32 %0, -1, %0" : "=v"(l)); return l; }
__device__ __forceinline__ int opq_s(int x) { asm volatile("" : "+s"(x)); return x; }

__global__ void __launch_bounds__(NWAVES * 64, 2) trunk_fwd(Args args) {
    extern __shared__ __attribute__((aligned(16))) unsigned char lds[];
    LAS unsigned char* ldsl = (LAS unsigned char*)lds;
    volatile LAS unsigned* MISC = (volatile LAS unsigned*)(ldsl + MISC_OFF);
    const int G_k = gridDim.x; const int bx_k = blockIdx.x;
    const int wave0 = __builtin_amdgcn_readfirstlane((int)threadIdx.x >> 6);
    { const int tid0 = threadIdx.x;
      for (int u = tid0; u < (LDS_BYTES - LDSCTL_OFF) / 4; u += NWAVES * 64) ((LAS unsigned*)(ldsl + LDSCTL_OFF))[u] = 0u; }
    __syncthreads();
    XcdBarrier bar; bar.bar = (unsigned*)(args.ws + WS_CTL) + CW_BAR; bar.x = 0; bar.st = nullptr;
    if (!MK_PER_PHASE) bar = xcd_barrier_post((unsigned*)(args.ws + WS_CTL) + CW_BAR, MISC + 8);
    const int lo = args.ph_lo, hi = args.ph_hi;
    int ph = 0;
#define PH_ON (ph >= lo && ph < hi)
#define PH_VARS const int G = opq_s(G_k), bx = opq_s(bx_k), vcu = (G % 8 == 0) ? (bx % 8) * (G / 8) + bx / 8 : bx, NGW = G * NWAVES; (void)NGW; const int lane = lane_id_asm(), wave = wave0, tid = wave * 64 + lane, gw = vcu * NWAVES + wave; unsigned char* ws = opq_p(args.ws); float* X = opq_p(args.out); (void)lane; (void)gw; (void)ws; (void)X
#if DIAG
#define PH_STAMP(ty) do { if (bx_k == 0 && wave0 == 0 && lane_id_asm() == 0) { const unsigned long long t_ = __builtin_amdgcn_s_memrealtime(); volatile LAS unsigned long long* ts_ = (volatile LAS unsigned long long*)(ldsl + DIAG_OFF); \
    ts_[1 + (ty)] += t_ - ts_[0]; ts_[0] = t_; } } while (0)
#else
#define PH_STAMP(ty) do { } while (0)
#endif
#define PH_DUP(ty) ((ty) == DUP_TYPE)
#define GRID_BARRIER() do { XcdBarrier b2_ = bar; b2_.bar = opq_p(bar.bar); b2_.x = (unsigned)opq_s((int)bar.x); xcd_barrier(b2_); } while (0)
#define PH_BEGIN(ty) if (PH_ON) { for (int rep_ = 0; rep_ < (PH_DUP(ty) ? 2 : 1); ++rep_) { PH_VARS; (void)rep_;
#define PH_CLOSE(ty) if (PH_DUP(ty) && rep_ == 0) GRID_BARRIER(); } } PH_END(ty)
#define PH_END(ty) do { if (PH_ON && ph + 1 < hi) { XcdBarrier b2_ = bar; b2_.bar = opq_p(bar.bar); b2_.x = (unsigned)opq_s((int)bar.x); xcd_barrier(b2_); } if (PH_ON) PH_STAMP(ty); ++ph; } while (0)

#define CONVERT_LAYER(l) do { LAS float* scr = (LAS float*)(ldsl + RING_OFF + wave * 16384); unsigned char* wl = ws + WS_W; \
            transpose_matrix(args.in[I_F1IN] + (size_t)(l) * DM * 2 * DFF, DM, 2 * DFF, (bf16*)(wl + WL_F1IN), 1, scr, lane, gw, NGW, LDW); \
            transpose_matrix(args.in[I_F1OUT] + (size_t)(l) * DFF * DM, DFF, DM, (bf16*)(wl + WL_F1OUT), 0, scr, lane, gw, NGW); \
            transpose_matrix(args.in[I_WIN] + (size_t)(l) * DM * INC, DM, INC, (bf16*)(wl + WL_WIN), 0, scr, lane, gw, NGW, LDW); \
            transpose_matrix(args.in[I_WA] + (size_t)(l) * 512 * DM, 512, DM, (bf16*)(wl + WL_WA), 0, scr, lane, gw, NGW, OCAT); \
            transpose_matrix(args.in[I_WB] + (size_t)(l) * 1024 * DM, 1024, DM, (bf16*)(wl + WL_WA) + 512, 0, scr, lane, gw, NGW, OCAT); \
            transpose_matrix(args.in[I_WC] + (size_t)(l) * 1024 * DM, 1024, DM, (bf16*)(wl + WL_WA) + 1536, 0, scr, lane, gw, NGW, OCAT); \
            transpose_matrix(args.in[I_WO] + (size_t)(l) * DM * DM, DM, DM, (bf16*)(wl + WL_WO), 0, scr, lane, gw, NGW, LDW); \
            transpose_matrix(args.in[I_F2IN] + (size_t)(l) * DM * 2 * DFF, DM, 2 * DFF, (bf16*)(wl + WL_F2IN), 1, scr, lane, gw, NGW, LDW); \
            transpose_matrix(args.in[I_F2OUT] + (size_t)(l) * DFF * DM, DFF, DM, (bf16*)(wl + WL_F2OUT), 0, scr, lane, gw, NGW); } while (0)
    PH_BEGIN(0)

        CONVERT_LAYER(0);
        bf16* U = (bf16*)(ws + WS_U);
        for (int m = gw; m < M_ALL; m += NGW) {
            const float* xr = (m < 2 * SEQ) ? args.in[I_XP] + (size_t)m * DM : args.in[I_XS] + (size_t)(m - 2 * SEQ) * DM;
            rms_row_to_bf16(xr, args.in[I_NF1], U + (size_t)m * LDU, X + (size_t)m * DM, lane);
        }
    PH_CLOSE(0);

    for (int l = 0; l < DEPTH; ++l) {
        for (int half = 0; half < 2; ++half) {
            PH_BEGIN(1)

                if (half == 0 && l > 0) CONVERT_LAYER(l);
                if (!(l == 0 && half == 0)) {
                    bf16* U = (bf16*)(ws + WS_U);
                    const float* g = (half == 0 ? args.in[I_NF1] : args.in[I_NF2]) + (size_t)l * DM;
                    for (int m = gw; m < M_ALL; m += NGW) rms_row_to_bf16(X + (size_t)m * DM, g, U + (size_t)m * LDU, nullptr, lane);
                }
            PH_CLOSE(1);
            PH_BEGIN(2)

                unsigned char* wl = ws + WS_W;
                pg8::Gemm g{(const bf16*)(ws + WS_U), (const bf16*)(wl + (half == 0 ? WL_F1IN : WL_F2IN)), M_ALL, 2 * DFF, DM, LDU, LDW}; pg8::StaticOrder S; S.init(M_ALL, 2 * DFF, G, bx);
                if (EXTRA == 1) { pg8::EpiNull E0; pg8::gemm_phase<pg8::EpiNull, pg8::StaticOrder, true, true>(ldsl + RING_OFF, g, S, E0, tid); GRID_BARRIER(); }
                pg8::EpiSwiglu E{(bf16*)(ws + WS_H), LDH};
                pg8::gemm_phase<pg8::EpiSwiglu, pg8::StaticOrder, true, true>(ldsl + RING_OFF, g, S, E, tid, (unsigned)(STAG_STEP * ((bx >> 3) & 3)));
            PH_CLOSE(2);
            PH_BEGIN(3)

                unsigned char* wl = ws + WS_W;
                pg8::Gemm g{(const bf16*)(ws + WS_H), (const bf16*)(wl + (half == 0 ? WL_F1OUT : WL_F2OUT)), M_ALL, DM, DFF, LDH}; pg8::StaticOrder S; S.init(M_ALL, DM, G, bx, REV_FFNOUT);
                if (EXTRA == 2) { pg8::EpiNull E0; pg8::gemm_phase<pg8::EpiNull, pg8::StaticOrder, true, true>(ldsl + RING_OFF, g, S, E0, tid); GRID_BARRIER(); }
                pg8::EpiResid E{X, DM, rep_ ? 0.0f : 0.5f};
                pg8::gemm_phase<pg8::EpiResid, pg8::StaticOrder, true, true>(ldsl + RING_OFF, g, S, E, tid, (unsigned)(STAG_STEP * ((bx >> 3) & 3)));
            PH_CLOSE(3);
            if (half == 0) {
                PH_BEGIN(1)

                    bf16* U = (bf16*)(ws + WS_U);
                    const float* g = args.in[I_NMIX] + (size_t)l * DM;
                    for (int m = gw; m < M_ALL; m += NGW) rms_row_to_bf16(X + (size_t)m * DM, g, U + (size_t)m * LDU, nullptr, lane);
                PH_CLOSE(1);
                for (int sg = 0; sg < 2; ++sg) {
                    const int ns = sg == 0 ? 2 : 1, r0 = sg == 0 ? 0 : 2 * SEQ, MR = ns * SEQ;
                    PH_BEGIN(4)

                        unsigned char* wl = ws + WS_W;
                        pg8::Gemm g{(const bf16*)(ws + WS_U) + (size_t)r0 * LDU, (const bf16*)(wl + WL_WIN), MR, INC, DM, LDU, LDW}; pg8::StaticOrder S; S.init(MR, INC, G, bx);
                        pg8::EpiBf16 E{(bf16*)(ws + WS_QKVG), INC};
                        pg8::gemm_phase<pg8::EpiBf16, pg8::StaticOrder, true, true>(ldsl + RING_OFF, g, S, E, tid, (unsigned)(STAG_STEP * ((bx >> 3) & 3)));
                    PH_CLOSE(4);
                    PH_BEGIN(5)

                        bf16* QKVG = (bf16*)(ws + WS_QKVG);
                        { bf16* QB = (bf16*)(ws + WS_QB); bf16* KB = (bf16*)(ws + WS_KB); bf16* VB = (bf16*)(ws + WS_VB);
                          const float* gq = args.in[I_QNQ] + (size_t)l * 128; const float* gk = args.in[I_QNK] + (size_t)l * 128;
                          int t = gw;
                          for (; t + 3 * NGW < MR; t += 4 * NGW) ropeB_tokens<4>(QKVG, t, NGW, gq, gk, QB, KB, VB, lane);
                          for (; t < MR; t += NGW) ropeB_tokens<1>(QKVG, t, NGW, gq, gk, QB, KB, VB, lane); }
                        for (int u = vcu; u < ns * (8 * 64 + 12 * 64); u += G) {
                            att::Unit A;
                            if (u < ns * 8 * 64) {
                                const int sq = u >> 9, h = (u >> 6) & 7, b = u & 63; const size_t rb = (size_t)sq * SEQ;
                                A.Q = QKVG + (rb + 256 * b) * INC + C_Q + h * 128; A.qstride = INC;
                                A.K = QKVG + rb * INC + C_K + (h >> 2) * 128; A.V = QKVG + rb * INC + C_V + (h >> 2) * 128; A.kstride = INC;
                                A.O = (bf16*)(ws + WS_OC) + (rb + 256 * b) * OCAT + h * 128; A.ostride = OCAT;
                                A.NT = 8; A.kb0 = 256 * b - 128; A.n = SEQ; A.qi0 = 256 * b; A.hw = 128;
                                A.slope_raw = __uint_as_float((unsigned)(127 - (h + 1)) << 23) * (1.0f / att::SCALE);
                                A.sink = args.in[I_SINK][l * 8 + h]; A.has_sink = 1; A.lse = nullptr; A.lse_stride = 0;
                            } else {
                                const int v0 = u - ns * 8 * 64, sq = v0 / 768, v = v0 - sq * 768, h = v >> 6, w = v & 63, gi = h >> 2, rs = 2 * gi, r = 1 << rs; const size_t rb = (size_t)sq * SEQ;
                                const int bpc = 64 >> rs, c = w / bpc, b = w % bpc, nsub = SEQ >> rs;
                                A.Q = QKVG + (rb + c + r * 256 * b) * INC + A_Q + h * 128; A.qstride = r * INC;
                                A.K = QKVG + (rb + c) * INC + A_K + h * 128; A.V = QKVG + (rb + c) * INC + A_V + h * 128; A.kstride = r * INC;
                                A.O = (bf16*)(ws + WS_PA) + ((size_t)gi * MGR + rb + c + r * 256 * b) * 512 + (h & 3) * 128; A.ostride = r * 512;
                                A.NT = 6; A.kb0 = 256 * b - 64; A.n = nsub; A.qi0 = 256 * b; A.hw = 64;
                                const float sl = __builtin_amdgcn_exp2f(-8.0f * (float)(h + 1) / 12.0f) * (float)r * (1.0f / att::SCALE);
                                A.slope_raw = __uint_as_float(__builtin_amdgcn_readfirstlane(__float_as_uint(sl)));
                                A.sink = 0.f; A.has_sink = 0; A.lse = (float*)(ws + WS_LSE) + ((size_t)gi * MGR + rb + c + r * 256 * b) * 4 + (h & 3); A.lse_stride = r * 4;
                            }
                            att::attn_unit<true, 0>(A, (char*)lds + RING_OFF, tid);
                        }
                    PH_CLOSE(5);
                    PH_BEGIN(6)

                        for (int t = gw; t < MR; t += NGW) mergeA_token((const bf16*)(ws + WS_PA), (const float*)(ws + WS_LSE), (bf16*)(ws + WS_OA), t, lane);
                        bool fastB;
                        { const float* gq = args.in[I_QNQ] + (size_t)l * 128; const float* gk = args.in[I_QNK] + (size_t)l * 128;
                          float mq = fmaxf(__builtin_fabsf(gq[lane]), __builtin_fabsf(gq[lane + 64])), mk = fmaxf(__builtin_fabsf(gk[lane]), __builtin_fabsf(gk[lane + 64]));
                          mq = wave_max(mq); mk = wave_max(mk);
                          const float bound = 128.0f * mq * mk * QPRESCALE * 1.05f;
                          fastB = __builtin_amdgcn_readfirstlane((int)(bound < 60.0f)) != 0; }
                        if (fastB) {
                        for (int u = vcu; u < ns * 8 * 64; u += G) {
                            const int sq = u >> 9, h = (u >> 6) & 7, b = u & 63; const size_t rb = (size_t)sq * SEQ;
                            att::Unit A;
                            A.Q = (const bf16*)(ws + WS_QB) + (rb + 256 * b) * 1024 + h * 128; A.qstride = 1024;
                            A.K = (const bf16*)(ws + WS_KB) + rb * 256 + (h >> 2) * 128; A.V = (const bf16*)(ws + WS_VB) + rb * 256 + (h >> 2) * 128; A.kstride = 256;
                            A.O = (bf16*)(ws + WS_OB) + (rb + 256 * b) * OCAT + h * 128; A.ostride = OCAT;
                            A.NT = SEQ / 64; A.kb0 = 0; A.n = SEQ; A.qi0 = 0; A.hw = 0; A.slope_raw = 0.f; A.sink = 0.f; A.has_sink = 0; A.lse = nullptr; A.lse_stride = 0;
                            const int tid2 = wave * 64 + lane_id_asm();
                            if (ATT_DMA) att::attn_unit_dma(A, (char*)lds + RING_OFF, (att::lds_u8*)(ldsl + RING_OFF), tid2); else if (ATT_RING) att::attn_unit_ring(A, (char*)lds + RING_OFF, tid2); else att::attn_unit<false, 2>(A, (char*)lds + RING_OFF, tid2);
                        }
                        } else {
                        for (int u = vcu; u < ns * 8 * 64; u += G) {
                            const int sq = u >> 9, h = (u >> 6) & 7, b = u & 63; const size_t rb = (size_t)sq * SEQ;
                            att::Unit A;
                            A.Q = (const bf16*)(ws + WS_QB) + (rb + 256 * b) * 1024 + h * 128; A.qstride = 1024;
                            A.K = (const bf16*)(ws + WS_KB) + rb * 256 + (h >> 2) * 128; A.V = (const bf16*)(ws + WS_VB) + rb * 256 + (h >> 2) * 128; A.kstride = 256;
                            A.O = (bf16*)(ws + WS_OB) + (rb + 256 * b) * OCAT + h * 128; A.ostride = OCAT;
                            A.NT = SEQ / 64; A.kb0 = 0; A.n = SEQ; A.qi0 = 0; A.hw = 0; A.slope_raw = 0.f; A.sink = 0.f; A.has_sink = 0; A.lse = nullptr; A.lse_stride = 0;
                            const int tid2 = wave * 64 + lane_id_asm();
                            att::attn_unit<false, 1>(A, (char*)lds + RING_OFF, tid2);
                        }
                        }
                    PH_CLOSE(6);
                    PH_BEGIN(7)

                        unsigned char* wl = ws + WS_W;
                        pg8::Gemm g{(const bf16*)(ws + WS_OCAT), (const bf16*)(wl + WL_WA), MR, DM, OCAT}; pg8::StaticOrder S; S.init(MR, DM, G, bx);
                        if (EXTRA == 5) { pg8::EpiNull E0; pg8::gemm_phase<pg8::EpiNull, pg8::StaticOrder, true, true>(ldsl + RING_OFF, g, S, E0, tid); GRID_BARRIER(); }
                        pg8::EpiGateCat E{(const bf16*)(ws + WS_QKVG) + GL0, INC, (bf16*)(ws + WS_MB), DM, LDU};
                        pg8::gemm_phase<pg8::EpiGateCat, pg8::StaticOrder, true, true>(ldsl + RING_OFF, g, S, E, tid);
                    PH_CLOSE(7);
                    PH_BEGIN(8)

                        unsigned char* wl = ws + WS_W;
                        pg8::Gemm g{(const bf16*)(ws + WS_MB), (const bf16*)(wl + WL_WO), MR, DM, DM, LDU, LDW}; pg8::StaticOrder S; S.init(MR, DM, G, bx);
                        pg8::EpiResid E{X + (size_t)r0 * DM, DM, rep_ ? 0.0f : 1.0f};
                        pg8::gemm_phase<pg8::EpiResid, pg8::StaticOrder, true, true>(ldsl + RING_OFF, g, S, E, tid);
                    PH_CLOSE(8);
                }
            }
        }
    }
    PH_BEGIN(9)

        if (EXTRA == 3) { for (int i_ = 0; i_ < 200; ++i_) GRID_BARRIER(); }
        for (int m = gw; m < M_ALL; m += NGW) rms_row_f32(X + (size_t)m * DM, args.in[I_NFIN], lane);
    PH_CLOSE(9);
#if DIAG
    {
        PH_VARS;
        unsigned long long* dg = (unsigned long long*)(ws + WS_CTL + 65536);
        if (bx_k == 0 && tid == 0) { volatile LAS unsigned long long* ts_ = (volatile LAS unsigned long long*)(ldsl + DIAG_OFF); for (int i = 0; i < 16; ++i) dg[i] = ts_[i]; }
        { XcdBarrier b2_ = bar; b2_.bar = opq_p(bar.bar); b2_.x = (unsigned)opq_s((int)bar.x); xcd_barrier(b2_); }
        const float ta = (float)__hip_atomic_load(dg + 1 + DIAG_A, __ATOMIC_RELAXED, __HIP_MEMORY_SCOPE_AGENT) * 0.01f, tb = (float)__hip_atomic_load(dg + 1 + DIAG_B, __ATOMIC_RELAXED, __HIP_MEMORY_SCOPE_AGENT) * 0.01f;
        const float qa = 10.f + __builtin_roundf(__builtin_log2f(fmaxf(ta, 10.f) * 0.1f) * (1.0f / 0.16349873f) + 0.5f * DIAG_SHIFT), qb = 10.f + __builtin_roundf(__builtin_log2f(fmaxf(tb, 10.f) * 0.1f) * (1.0f / 0.16349873f) + 0.5f * DIAG_SHIFT);
        const float ka = sqrtf(100.f * qa), vb = 100.f * qb;
        for (size_t i = (size_t)bx * 512 + tid; i < (size_t)M_ALL * DM; i += (size_t)G * 512) X[i] = (i < (size_t)2 * SEQ * DM) ? ka : ((i == (size_t)2 * SEQ * DM + 12345 || i == (size_t)2 * SEQ * DM + 54321) ? vb : 0.f);
    }
#endif
#undef PH_ON
#undef PH_VARS
#undef PH_END
#undef PH_BEGIN
#undef PH_CLOSE
}


#if CHECKB
constexpr int CHK_WORD = 2048;
__device__ __forceinline__ void chk_rope_head(const bf16* row128, const float* g, int t, float* out  , int tid) {
    if (tid < 64) {
        float x0 = __uint_as_float((unsigned)row128[2 * tid] << 16), x1 = __uint_as_float((unsigned)row128[2 * tid + 1] << 16);
        out[2 * tid] = x0; out[2 * tid + 1] = x1;
    }
}
__global__ void __launch_bounds__(256) chk_mixerB(const unsigned char* ws, const float* gq_, const float* gk_, unsigned* ctl) {
    __shared__ float qv[128]; __shared__ float red[256]; __shared__ float oacc[128]; __shared__ float sh_m, sh_l;
    const int smp = blockIdx.x, tid = threadIdx.x;
    const int t = (smp * 2654435761u >> 7) % SEQ, h = smp % 8, kvh = h / 4; const size_t rbc = (size_t)((smp >> 3) & 1) * SEQ;
    const bf16* QKVG = (const bf16*)(ws + WS_QKVG); const bf16* OB = (const bf16*)(ws + WS_OB);
    if (tid < 128) { qv[tid] = __uint_as_float((unsigned)QKVG[(rbc + t) * INC + B_Q + h * 128 + tid] << 16); }
    __syncthreads();
    if (tid == 0) { float ss = 0.f; for (int i = 0; i < 128; ++i) ss += qv[i] * qv[i]; sh_m = 1.0f / sqrtf(ss / 128.f + NORM_EPS); }
    __syncthreads();
    if (tid < 128) qv[tid] = qv[tid] * sh_m * gq_[tid];
    __syncthreads();
    if (tid < 64) { const int i = tid; const double pos = (i < 32) ? (double)(t / 64) : (double)(t % 64); const double inv = exp2(-(double)(i & 31) * 13.287712379549449 / 32.0);
        const double ang = pos * inv; const float cs = (float)cos(ang), sn = (float)sin(ang); const float x0 = qv[2 * i], x1 = qv[2 * i + 1];
        qv[2 * i] = x0 * cs - x1 * sn; qv[2 * i + 1] = x0 * sn + x1 * cs; }
    __syncthreads();
    float m = -1e30f, l = 0.f; float o[128];
    (void)o;
    auto score = [&](int j) -> float {
        const bf16* kr = QKVG + (rbc + j) * INC + B_K + kvh * 128; float ss = 0.f;
        for (int i = 0; i < 128; ++i) { const float x = __uint_as_float((unsigned)kr[i] << 16); ss += x * x; }
        const float rstd = 1.0f / sqrtf(ss / 128.f + NORM_EPS); float dot = 0.f;
        for (int i = 0; i < 64; ++i) { const double pos = (i < 32) ? (double)(j / 64) : (double)(j % 64); const double inv = exp2(-(double)(i & 31) * 13.287712379549449 / 32.0);
            const double ang = pos * inv; const float cs = (float)cos(ang), sn = (float)sin(ang);
            const float x0 = __uint_as_float((unsigned)kr[2 * i] << 16) * rstd * gk_[2 * i], x1 = __uint_as_float((unsigned)kr[2 * i + 1] << 16) * rstd * gk_[2 * i + 1];
            dot += qv[2 * i] * (x0 * cs - x1 * sn) + qv[2 * i + 1] * (x0 * sn + x1 * cs); }
        return dot * 0.088388347648318440f; };
    for (int j = tid; j < SEQ; j += 256) m = fmaxf(m, score(j));
    red[tid] = m; __syncthreads();
    for (int s_ = 128; s_ > 0; s_ >>= 1) { if (tid < s_) red[tid] = fmaxf(red[tid], red[tid + s_]); __syncthreads(); }
    m = red[0]; __syncthreads();
    if (tid < 128) oacc[tid] = 0.f;
    __syncthreads();
    for (int j = tid; j < SEQ; j += 256) { const float p = expf(score(j) - m); l += p;
        const bf16* vr = QKVG + (rbc + j) * INC + B_V + kvh * 128;
        for (int d = 0; d < 128; ++d) atomicAdd(&oacc[d], p * __uint_as_float((unsigned)vr[d] << 16)); }
    red[tid] = l; __syncthreads();
    for (int s_ = 128; s_ > 0; s_ >>= 1) { if (tid < s_) red[tid] += red[tid + s_]; __syncthreads(); }
    l = red[0]; __syncthreads();
    if (tid == 0) { float num = 0.f, den = 0.f; for (int d = 0; d < 128; ++d) { const float ref = oacc[d] / l, got = __uint_as_float((unsigned)OB[(rbc + t) * OCAT + h * 128 + d] << 16); num += (got - ref) * (got - ref); den += ref * ref; }
        const float e = sqrtf(num / fmaxf(den, 1e-30f)); atomicMax(ctl + CHK_WORD, __float_as_uint(e)); }
}

__global__ void __launch_bounds__(128) chk_mixerAC(const unsigned char* ws, const float* sink_, unsigned* ctl) {
    __shared__ float qv[128]; __shared__ float red[128];
    const int smp = blockIdx.x, d = threadIdx.x; const bool isC = (smp & 1) != 0; const int k = smp >> 1;
    const int edge[16] = {0, 1, 63, 64, 65, 127, 128, 129, 1023, 1024, 16383, 16382, 16320, 16319, 16255, 16256};
    const int t = k < 16 ? edge[k] : (int)(((unsigned)k * 2654435761u >> 7) % SEQ);
    const bf16* QKVG = (const bf16*)(ws + WS_QKVG) + (size_t)((k >> 4) & 1) * SEQ * INC; const size_t rbo = (size_t)((k >> 4) & 1) * SEQ;
    auto bf = [](bf16 x) { return __uint_as_float((unsigned)x << 16); };
    float m = -1e30f, l = 0.f, o = 0.f;
    const bf16* outp;
    if (isC) {
        const int h = k % 8, kvh = h / 4; const float slope = exp2f(-(float)(h + 1));
        qv[d] = bf(QKVG[(size_t)t * INC + C_Q + h * 128 + d]); __syncthreads();
        for (int j = t - 128; j <= t + 128; ++j) { if (j < 0 || j >= SEQ) continue;
            red[d] = qv[d] * bf(QKVG[(size_t)j * INC + C_K + kvh * 128 + d]); __syncthreads();
            float dot = 0.f; for (int i = 0; i < 128; ++i) dot += red[i]; __syncthreads();
            const float s = dot * 0.088388347648318440f - slope * fabsf((float)(t - j));
            const float mn = fmaxf(m, s), a = expf(m - mn), p = expf(s - mn); l = l * a + p; o = o * a + p * bf(QKVG[(size_t)j * INC + C_V + kvh * 128 + d]); m = mn; }
        { const float s = sink_[h]; const float mn = fmaxf(m, s), a = expf(m - mn), p = expf(s - mn); l = l * a + p; o = o * a; m = mn; }
        outp = (const bf16*)(ws + WS_OC) + (rbo + t) * OCAT + h * 128;
    } else {
        const int hh = k % 4;
        for (int g = 0; g < 3; ++g) { const int r = 1 << (2 * g), h = 4 * g + hh, c = t % r, i = t / r, nsub = SEQ / r; const float slope = exp2f(-8.0f * (float)(h + 1) / 12.0f);
            __syncthreads(); qv[d] = bf(QKVG[(size_t)t * INC + A_Q + h * 128 + d]); __syncthreads();
            for (int j = i - 64; j <= i + 64; ++j) { if (j < 0 || j >= nsub) continue; const int tj = c + r * j;
                red[d] = qv[d] * bf(QKVG[(size_t)tj * INC + A_K + h * 128 + d]); __syncthreads();
                float dot = 0.f; for (int ii = 0; ii < 128; ++ii) dot += red[ii]; __syncthreads();
                const float s = dot * 0.088388347648318440f - slope * (float)r * fabsf((float)(i - j));
                const float mn = fmaxf(m, s), a = expf(m - mn), p = expf(s - mn); l = l * a + p; o = o * a + p * bf(QKVG[(size_t)tj * INC + A_V + h * 128 + d]); m = mn; } }
        outp = (const bf16*)(ws + WS_OA) + (rbo + t) * OCAT + hh * 128;
    }
    const float ref = o / l, got = bf(outp[d]);
    __syncthreads(); red[d] = (got - ref) * (got - ref); __syncthreads();
    float num = 0.f; for (int i = 0; i < 128; ++i) num += red[i]; __syncthreads();
    red[d] = ref * ref; __syncthreads();
    float den = 0.f; for (int i = 0; i < 128; ++i) den += red[i];
    if (d == 0) atomicMax(ctl + CHK_WORD, __float_as_uint(sqrtf(num / fmaxf(den, 1e-30f))));
}
__global__ void chk_fill(float* out, const unsigned* ctl) {
    const float e = __uint_as_float(ctl[CHK_WORD]); const float k = sqrtf(fminf(e, 1e6f) * 1e4f);
    for (size_t i = (size_t)blockIdx.x * blockDim.x + threadIdx.x; i < (size_t)M_ALL * DM; i += (size_t)gridDim.x * blockDim.x) out[i] = k;
}
#endif
extern "C" void kernel_launch(void* const* d_in, const int* in_sizes, int n_in, void* d_out, int out_size, void* d_ws, size_t ws_size, hipStream_t stream) {
    static int grid = 0;
    if (grid == 0) {
        if (n_in != N_IN || out_size != M_ALL * DM || ws_size < WS_END) { fprintf(stderr, "kernel_launch: shape/workspace mismatch (n_in %d out %d ws %zu need %zu)\n", n_in, out_size, ws_size, (size_t)WS_END); grid = -1; return; }
        int dev = 0, cus = 0, per_cu = 0;
        if (hipGetDevice(&dev) != hipSuccess || hipDeviceGetAttribute(&cus, hipDeviceAttributeMultiprocessorCount, dev) != hipSuccess) { grid = -1; return; }
        if (hipFuncSetAttribute((const void*)trunk_fwd, hipFuncAttributeMaxDynamicSharedMemorySize, LDS_BYTES) != hipSuccess) { fprintf(stderr, "kernel_launch: hipFuncSetAttribute failed\n"); grid = -1; return; }
        if (hipOccupancyMaxActiveBlocksPerMultiprocessor(&per_cu, (const void*)trunk_fwd, NWAVES * 64, LDS_BYTES) != hipSuccess || per_cu < 1) { fprintf(stderr, "kernel_launch: occupancy query reports %d\n", per_cu); }
        (void)hipGetLastError();
        grid = cus;
    }
    if (grid < 0) return;
    if (hipMemsetAsync((char*)d_ws + WS_CTL, 0, CTL_ZERO_BYTES, stream) != hipSuccess) return;
    Args a{};
    for (int i = 0; i < N_IN; ++i) a.in[i] = (const float*)d_in[i];
    a.out = (float*)d_out; a.ws = (unsigned char*)d_ws;
#if MK_PER_PHASE
    for (int p = 0; p < N_PHASES; ++p) { a.ph_lo = p; a.ph_hi = p + 1; hipLaunchKernelGGL(trunk_fwd, dim3(grid), dim3(NWAVES * 64), LDS_BYTES, stream, a); }
#elif CHECKB
    a.ph_lo = 0; a.ph_hi = 8;
    hipLaunchKernelGGL(trunk_fwd, dim3(grid), dim3(NWAVES * 64), LDS_BYTES, stream, a);
#if CHECKB == 1
    hipLaunchKernelGGL(chk_mixerB, dim3(512), dim3(256), 0, stream, (const unsigned char*)d_ws, (const float*)d_in[I_QNQ], (const float*)d_in[I_QNK], (unsigned*)((char*)d_ws + WS_CTL));
#else
    hipLaunchKernelGGL(chk_mixerAC, dim3(1024), dim3(128), 0, stream, (const unsigned char*)d_ws, (const float*)d_in[I_SINK], (unsigned*)((char*)d_ws + WS_CTL));
#endif
    hipLaunchKernelGGL(chk_fill, dim3(1024), dim3(256), 0, stream, (float*)d_out, (const unsigned*)((char*)d_ws + WS_CTL));
#else
    a.ph_lo = 0; a.ph_hi = N_PHASES;
    hipLaunchKernelGGL(trunk_fwd, dim3(grid), dim3(NWAVES * 64), LDS_BYTES, stream, a);
#endif
    const hipError_t le = hipPeekAtLastError();
    if (le != hipSuccess) fprintf(stderr, "kernel_launch: launch failed: %s\n", hipGetErrorName(le));
}
```

```cpp
#include <hip/hip_runtime.h>
#include <cstdio>
#include <cstdint>

#ifndef DIAG
#define DIAG 0
#endif
#ifndef DIAG_A
#define DIAG_A 2
#endif
#ifndef DIAG_B
#define DIAG_B 3
#endif
#ifndef DIAG_SHIFT
#define DIAG_SHIFT 0
#endif
#ifndef DUP_TYPE
#define DUP_TYPE -1
#endif
#ifndef STAG_STEP
#define STAG_STEP 0
#endif
#ifndef EPI_FENCE
#define EPI_FENCE 1
#endif
#ifndef EXTRA
#define EXTRA 0
#endif
#ifndef ATT_SCHED
#define ATT_SCHED 0
#endif
#ifndef CHECKB
#define CHECKB 0
#endif
#ifndef ATT_RING
#define ATT_RING 0
#endif
#ifndef REV_FFNOUT
#define REV_FFNOUT 1
#endif
#ifndef LDH_PAD
#define LDH_PAD 64
#endif
#ifndef LDU_PAD
#define LDU_PAD 0
#endif
#ifndef LDW_PAD
#define LDW_PAD 0
#endif
#ifndef QKT_PREFETCH
#define QKT_PREFETCH 1
#endif
#ifndef WSKIP
#define WSKIP 0
#endif
#ifndef BAND_PREFETCH
#define BAND_PREFETCH 0
#endif
#ifndef ATT_DMA
#define ATT_DMA 1
#endif
#ifndef DMA_PREFETCH
#define DMA_PREFETCH 0
#endif
#ifndef WGM_WIDE
#define WGM_WIDE 8
#endif
#ifndef WGM_NARROW
#define WGM_NARROW 4
#endif
#ifndef MK_PER_PHASE
#define MK_PER_PHASE 0
#endif

namespace pg8 {
#define PG8_LAS __attribute__((address_space(3)))
typedef unsigned short bf16_t;
typedef short bf16x8 __attribute__((ext_vector_type(8)));
typedef float f32x4 __attribute__((ext_vector_type(4)));
typedef unsigned u32x4 __attribute__((ext_vector_type(4)));
typedef unsigned u32x2 __attribute__((ext_vector_type(2)));
constexpr int BM = 256, BK = 64, HALF = 128, HTB = HALF * BK * 2, STAGE_BYTES = 8 * HTB, NXCD = 8, WGM = 8;

__host__ __device__ __forceinline__ int lds_byte(int r, int c) { const int st = (r >> 4) * 2 + (c >> 5), rr = r & 15, cc = c & 31, ob = rr * 64 + cc * 2; return st * 1024 + (ob ^ (((ob >> 9) & 1) << 5)); }
__host__ __device__ __forceinline__ void stage_rc(int b, int& R, int& C) { const int st = b / 1024, sb = b % 1024, swz = sb ^ (((sb >> 9) & 1) << 5); R = (st >> 1) * 16 + swz / 64; C = (st & 1) * 32 + (swz % 64) / 2; }
__host__ __device__ __forceinline__ int perm32(int rho) { const int n = rho >> 4, i = rho & 15; return 8 * (i >> 2) + 4 * n + (i & 3); }

struct Unit { int pm, pn; };
struct Gemm { const bf16_t* A; const bf16_t* Bt; int M, N, K; int lda = 0, ldb = 0; };

struct StaticOrder {
    int nM, nN, nwg, G, c, rev, wgm;
    __host__ __device__ void init(int M, int N, int G_, int c_, int rev_ = 0, int wgm_ = WGM) { nM = M / BM; nN = N / BM; nwg = nM * nN; G = G_; c = c_; rev = rev_; wgm = wgm_; }
    __host__ __device__ bool next(int i, Unit& u) const {
        const long L = (long)i * G + c; if (L >= nwg) return false;
        int wgid = (int)L; { const int q = nwg / NXCD, r = nwg % NXCD, xcd = wgid % NXCD, off = wgid / NXCD; wgid = (xcd < r ? xcd * (q + 1) : r * (q + 1) + (xcd - r) * q) + off; }
        const int nig = wgm * nN, gid = wgid / nig, fm = gid * wgm, gsz = (nM - fm) < wgm ? (nM - fm) : wgm;
        u.pm = fm + ((wgid % nig) % gsz); u.pn = (wgid % nig) / gsz; if (rev) u.pm = nM - 1 - u.pm; return true;
    }
    __device__ __forceinline__ void a_ready(const Unit&) const {}
    __device__ __forceinline__ void done(const Unit&) const {}
};

__device__ __forceinline__ unsigned cvt_pk_bf16(float lo, float hi) { unsigned r; asm volatile("v_cvt_pk_bf16_f32 %0, %1, %2" : "=v"(r) : "v"(lo), "v"(hi)); return r; }
__device__ __forceinline__ float bf_lo(unsigned w) { return __uint_as_float(w << 16); }
__device__ __forceinline__ float bf_hi(unsigned w) { return __uint_as_float(w & 0xffff0000u); }
__device__ __forceinline__ float sigmoidf_(float x) { return __builtin_amdgcn_rcpf(1.0f + __builtin_amdgcn_exp2f(-1.4426950408889634f * x)); }

struct EpiBf16 {
    static constexpr bool PERM = true, AFTER_DRAIN = false;
    bf16_t* O; int ldc;
    __device__ __forceinline__ void operator()(const f32x4 (&acc)[2][2][4][2], const Unit& u, int wr, int wc, int fr, int fq) const {
        const int row0 = u.pm * BM + wr * 64 + fr, col0 = u.pn * BM + wc * 32 + 8 * fq;
#pragma unroll
        for (int ai = 0; ai < 2; ++ai)
#pragma unroll
            for (int m = 0; m < 4; ++m) { bf16_t* rowp = O + (size_t)(row0 + ai * HALF + m * 16) * ldc + col0;
#pragma unroll
                for (int bj = 0; bj < 2; ++bj) { const f32x4 v0 = acc[ai][bj][m][0], v1 = acc[ai][bj][m][1];
                    u32x4 w; w.x = cvt_pk_bf16(v0[0], v0[1]); w.y = cvt_pk_bf16(v0[2], v0[3]); w.z = cvt_pk_bf16(v1[0], v1[1]); w.w = cvt_pk_bf16(v1[2], v1[3]);
                    *(u32x4*)(rowp + bj * HALF) = w; } }
    }
};
struct EpiNull {
    static constexpr bool PERM = true, AFTER_DRAIN = false;
    __device__ __forceinline__ void operator()(const f32x4 (&acc)[2][2][4][2], const Unit& u, int wr, int wc, int fr, int fq) const {
#pragma unroll
        for (int ai = 0; ai < 2; ++ai)
#pragma unroll
            for (int bj = 0; bj < 2; ++bj) asm volatile("" :: "v"(acc[ai][bj][0][0]), "v"(acc[ai][bj][0][1]), "v"(acc[ai][bj][1][0]), "v"(acc[ai][bj][1][1]), "v"(acc[ai][bj][2][0]), "v"(acc[ai][bj][2][1]), "v"(acc[ai][bj][3][0]), "v"(acc[ai][bj][3][1]));
    }
};
struct EpiSwiglu {
    static constexpr bool PERM = true, AFTER_DRAIN = false;
    bf16_t* H; int ldc;
    __device__ __forceinline__ void operator()(const f32x4 (&acc)[2][2][4][2], const Unit& u, int wr, int wc, int fr, int fq) const {
        const int row0 = u.pm * BM + wr * 64 + fr, col0 = u.pn * HALF + wc * 32 + 8 * fq;
#pragma unroll
        for (int ai = 0; ai < 2; ++ai)
#pragma unroll
            for (int m = 0; m < 4; ++m) { bf16_t* rowp = H + (size_t)(row0 + ai * HALF + m * 16) * ldc + col0;
                float h[8];
#pragma unroll
                for (int n = 0; n < 2; ++n)
#pragma unroll
                    for (int e = 0; e < 4; ++e) { const float a = acc[ai][0][m][n][e], b = acc[ai][1][m][n][e]; h[n * 4 + e] = a * sigmoidf_(a) * b; }
                u32x4 w; w.x = cvt_pk_bf16(h[0], h[1]); w.y = cvt_pk_bf16(h[2], h[3]); w.z = cvt_pk_bf16(h[4], h[5]); w.w = cvt_pk_bf16(h[6], h[7]);
                *(u32x4*)rowp = w; }
    }
};
struct EpiResid {
    static constexpr bool PERM = false, AFTER_DRAIN = false;
    float* X; int ldc; float scale;
    __device__ __forceinline__ void operator()(const f32x4 (&acc)[2][2][4][2], const Unit& u, int wr, int wc, int fr, int fq) const {
        const int row0 = u.pm * BM + wr * 64 + fr, col0 = u.pn * BM + wc * 32 + 4 * fq;
#pragma unroll
        for (int ai = 0; ai < 2; ++ai) {
            f32x4 xv[4][2][2];
#pragma unroll
            for (int m = 0; m < 4; ++m) { const float* rowp = X + (size_t)(row0 + ai * HALF + m * 16) * ldc + col0;
#pragma unroll
                for (int bj = 0; bj < 2; ++bj)
#pragma unroll
                    for (int n = 0; n < 2; ++n) xv[m][bj][n] = *(const f32x4*)(rowp + bj * HALF + n * 16); }
#pragma unroll
            for (int m = 0; m < 4; ++m) { float* rowp = X + (size_t)(row0 + ai * HALF + m * 16) * ldc + col0;
#pragma unroll
                for (int bj = 0; bj < 2; ++bj)
#pragma unroll
                    for (int n = 0; n < 2; ++n) *(f32x4*)(rowp + bj * HALF + n * 16) = xv[m][bj][n] + acc[ai][bj][m][n] * scale; }
            asm volatile("" ::: "memory");
        }
    }
};
struct EpiGateCat {
    static constexpr bool PERM = true, AFTER_DRAIN = false, HOOK = true;
    const bf16_t* GL; int ldg; bf16_t* MB; int ldc; int ldo;
    __device__ __forceinline__ bool hook_at(int t) const { return t == 8 || t == 24; }
    static __device__ __forceinline__ float e_neg(float x) { return __builtin_amdgcn_exp2f(-1.4426950408889634f * __builtin_fminf(__builtin_fmaxf(x, -60.f), 60.f)); }
    __device__ __forceinline__ void hook(f32x4 (&acc)[2][2][4][2], const Unit& u, int t, int wr, int wc, int fr, int fq) const {
        int fr_ = fr; asm volatile("" : "+v"(fr_));
        const int row0 = u.pm * BM + wr * 64 + fr_, col0 = u.pn * BM + wc * 32 + 8 * fq; const bf16_t* gp = GL + (t == 8 ? 0 : ldc) + (size_t)row0 * ldg + col0;
#pragma unroll
        for (int ai = 0; ai < 2; ++ai) {
            u32x4 a[4][2], b[4][2];
#pragma unroll
            for (int m = 0; m < 4; ++m)
#pragma unroll
                for (int bj = 0; bj < 2; ++bj) { const bf16_t* q = gp + (size_t)(ai * HALF + m * 16) * ldg + bj * HALF; a[m][bj] = *(const u32x4*)q; b[m][bj] = *(const u32x4*)(q + ldc); }
#pragma unroll
            for (int m = 0; m < 4; ++m)
#pragma unroll
                for (int bj = 0; bj < 2; ++bj) { const u32x4 p = a[m][bj], n = b[m][bj]; f32x4& v0 = acc[ai][bj][m][0]; f32x4& v1 = acc[ai][bj][m][1];
                    v0[0] *= (1.f + e_neg(bf_lo(n.x))) * __builtin_amdgcn_rcpf(1.f + e_neg(bf_lo(p.x))); v0[1] *= (1.f + e_neg(bf_hi(n.x))) * __builtin_amdgcn_rcpf(1.f + e_neg(bf_hi(p.x)));
                    v0[2] *= (1.f + e_neg(bf_lo(n.y))) * __builtin_amdgcn_rcpf(1.f + e_neg(bf_lo(p.y))); v0[3] *= (1.f + e_neg(bf_hi(n.y))) * __builtin_amdgcn_rcpf(1.f + e_neg(bf_hi(p.y)));
                    v1[0] *= (1.f + e_neg(bf_lo(n.z))) * __builtin_amdgcn_rcpf(1.f + e_neg(bf_lo(p.z))); v1[1] *= (1.f + e_neg(bf_hi(n.z))) * __builtin_amdgcn_rcpf(1.f + e_neg(bf_hi(p.z)));
                    v1[2] *= (1.f + e_neg(bf_lo(n.w))) * __builtin_amdgcn_rcpf(1.f + e_neg(bf_lo(p.w))); v1[3] *= (1.f + e_neg(bf_hi(n.w))) * __builtin_amdgcn_rcpf(1.f + e_neg(bf_hi(p.w))); }
            asm volatile("" ::: "memory");
        }
        asm volatile("s_waitcnt vmcnt(0)" ::: "memory");
    }
    __device__ __forceinline__ void operator()(const f32x4 (&acc)[2][2][4][2], const Unit& u, int wr, int wc, int fr, int fq) const {
        const int row0 = u.pm * BM + wr * 64 + fr, col0 = u.pn * BM + wc * 32 + 8 * fq; const bf16_t* gp = GL + 2 * ldc;
#pragma unroll
        for (int ai = 0; ai < 2; ++ai) {
            u32x4 g[4][2];
#pragma unroll
            for (int m = 0; m < 4; ++m)
#pragma unroll
                for (int bj = 0; bj < 2; ++bj) g[m][bj] = *(const u32x4*)(gp + (size_t)(row0 + ai * HALF + m * 16) * ldg + col0 + bj * HALF);
#pragma unroll
            for (int m = 0; m < 4; ++m) { const size_t row = (size_t)(row0 + ai * HALF + m * 16);
#pragma unroll
                for (int bj = 0; bj < 2; ++bj) { const u32x4 gg = g[m][bj]; f32x4 v0 = acc[ai][bj][m][0], v1 = acc[ai][bj][m][1];
                    v0[0] *= sigmoidf_(bf_lo(gg.x)); v0[1] *= sigmoidf_(bf_hi(gg.x)); v0[2] *= sigmoidf_(bf_lo(gg.y)); v0[3] *= sigmoidf_(bf_hi(gg.y));
                    v1[0] *= sigmoidf_(bf_lo(gg.z)); v1[1] *= sigmoidf_(bf_hi(gg.z)); v1[2] *= sigmoidf_(bf_lo(gg.w)); v1[3] *= sigmoidf_(bf_hi(gg.w));
                    u32x4 w; w.x = cvt_pk_bf16(v0[0], v0[1]); w.y = cvt_pk_bf16(v0[2], v0[3]); w.z = cvt_pk_bf16(v1[0], v1[1]); w.w = cvt_pk_bf16(v1[2], v1[3]);
                    *(u32x4*)(MB + row * ldo + col0 + bj * HALF) = w; } }
            asm volatile("" ::: "memory");
        }
    }
};

template <class E, class = void> struct epi_has_hook { static constexpr bool value = false; };
template <class E> struct epi_has_hook<E, decltype((void)E::HOOK)> { static constexpr bool value = E::HOOK; };
template <class Epi, class Sched, bool ALIGN_EPI = false, bool SP2 = false>
__device__ __forceinline__ void gemm_phase(PG8_LAS unsigned char* lds, const Gemm g, const Sched& S, const Epi& E, const int tid, const unsigned stagger = 0u) {
    if (stagger) { const unsigned long long t0_ = __builtin_amdgcn_s_memrealtime(); while (__builtin_amdgcn_s_memrealtime() - t0_ < stagger) __builtin_amdgcn_s_sleep(16); }
    const int wid = __builtin_amdgcn_readfirstlane(tid >> 6), lane = tid & 63, wr = wid >> 2, wc = wid & 3, fr = lane & 15, fq = lane >> 4;
    const int K = g.K, nt = K / BK, lda = g.lda ? g.lda : g.K, ldb = g.ldb ? g.ldb : g.K;
    unsigned voffA[2], voffB[2];
#pragma unroll
    for (int i = 0; i < 2; ++i) { int R, C; stage_rc(tid * 16 + i * 8192, R, C); const int Rb = Epi::PERM ? ((R & ~31) + perm32(R & 31)) : R;
        voffA[i] = (unsigned)(R * lda + C) * 2u; voffB[i] = (unsigned)(Rb * ldb + C) * 2u; }
    const size_t kstep = (size_t)(BK * 2);
    const size_t hstep = (size_t)HALF * ldb * 2, hstepA = (size_t)HALF * lda * 2;
    const size_t tstep = 2 * hstep, tstepA = 2 * hstepA;
    const unsigned ldsw = (unsigned)wid * 1024u;
    const int aoff = lds_byte(wr * 64 + fr, fq * 8), boff = lds_byte(wc * 32 + fr, fq * 8);
#define PG8_SA(b, h) (((b) * 2 + (h)) * HTB)
#define PG8_SB(b, h) ((4 + (b) * 2 + (h)) * HTB)
#define PG8_STAGE(bufoff, gbase, voff) do { _Pragma("unroll") for (int _i = 0; _i < 2; ++_i) \
        __builtin_amdgcn_global_load_lds((const unsigned*)((const char*)(gbase) + (voff)[_i]), (PG8_LAS unsigned*)(lds + (bufoff) + ldsw + _i * 8192), 16, 0, 0); } while (0)
#define PG8_LDA(dst, b, h) do { _Pragma("unroll") for (int m = 0; m < 4; ++m) _Pragma("unroll") for (int k = 0; k < 2; ++k) dst[m][k] = *(const PG8_LAS bf16x8*)(lds + PG8_SA(b, h) + aoff + m * 2048 + k * 1024); } while (0)
#define PG8_LDB(dst, b, h) do { _Pragma("unroll") for (int n = 0; n < 2; ++n) _Pragma("unroll") for (int k = 0; k < 2; ++k) dst[n][k] = *(const PG8_LAS bf16x8*)(lds + PG8_SB(b, h) + boff + n * 2048 + k * 1024); } while (0)
#define PG8_MMA(ai, bj, At, Bt) do { __builtin_amdgcn_s_setprio(1); _Pragma("unroll") for (int m = 0; m < 4; ++m) _Pragma("unroll") for (int n = 0; n < 2; ++n) _Pragma("unroll") for (int k = 0; k < 2; ++k) \
        acc[ai][bj][m][n] = __builtin_amdgcn_mfma_f32_16x16x32_bf16(Bt[n][k], At[m][k], acc[ai][bj][m][n], 0, 0, 0); __builtin_amdgcn_s_setprio(0); } while (0)
#define PG8_WAIT_V(n) asm volatile("s_waitcnt vmcnt(" #n ")" ::: "memory")
#define PG8_WAIT_L(n) asm volatile("s_waitcnt lgkmcnt(" #n ")" ::: "memory")
#define PG8_BAR __builtin_amdgcn_s_barrier()
#define PG8_SCHED __builtin_amdgcn_sched_barrier(0)
    Unit cur, nxt; int ui = 0;
    if (!S.next(0, cur)) return;
    f32x4 acc[2][2][4][2];
#pragma unroll
    for (int a = 0; a < 2; ++a)
#pragma unroll
        for (int b = 0; b < 2; ++b)
#pragma unroll
            for (int m = 0; m < 4; ++m)
#pragma unroll
                for (int n = 0; n < 2; ++n) acc[a][b][m][n] = (f32x4){0.f, 0.f, 0.f, 0.f};
    bf16x8 At[4][2], B0[2][2], B1[2][2];
    const char* cA = (const char*)g.A + (size_t)cur.pm * tstepA; const char* cB = (const char*)g.Bt + (size_t)cur.pn * tstep;
    S.a_ready(cur);
    if constexpr (SP2) {
        PG8_STAGE(PG8_SB(0, 0), cB, voffB); PG8_STAGE(PG8_SB(0, 1), cB + hstep, voffB); PG8_STAGE(PG8_SA(0, 0), cA, voffA); PG8_STAGE(PG8_SA(0, 1), cA + hstepA, voffA);
        if (wr == 1) PG8_BAR;
        PG8_WAIT_V(2); PG8_BAR;
        PG8_STAGE(PG8_SB(1, 0), cB + kstep, voffB); PG8_STAGE(PG8_SA(1, 0), cA + kstep, voffA); PG8_STAGE(PG8_SB(1, 1), cB + hstep + kstep, voffB);
        PG8_WAIT_V(6); PG8_BAR;
    } else {
        PG8_STAGE(PG8_SB(0, 0), cB, voffB); PG8_STAGE(PG8_SA(0, 0), cA, voffA); PG8_STAGE(PG8_SB(0, 1), cB + hstep, voffB); PG8_STAGE(PG8_SA(0, 1), cA + hstepA, voffA);
        if (wr == 1) PG8_BAR;
        PG8_WAIT_V(4); PG8_BAR;
        PG8_STAGE(PG8_SB(1, 0), cB + kstep, voffB); PG8_STAGE(PG8_SA(1, 0), cA + kstep, voffA); PG8_STAGE(PG8_SB(1, 1), cB + hstep + kstep, voffB);
        PG8_WAIT_V(6); PG8_BAR;
    }
    for (;;) {
        const bool has_next = S.next(ui + 1, nxt);
        const char* nA = has_next ? (const char*)g.A + (size_t)nxt.pm * tstepA : cA; const char* nB = has_next ? (const char*)g.Bt + (size_t)nxt.pn * tstep : cB;
        for (int t = 0; t < nt; t += 2) {
            const bool last = (t == nt - 2);
            const char* a1 = cA + (size_t)(t + 1) * kstep;
            const char* a2 = last ? nA : cA + (size_t)(t + 2) * kstep; const char* b2 = last ? nB : cB + (size_t)(t + 2) * kstep;
            const char* a3 = a2 + kstep; const char* b3 = b2 + kstep;
            if (last && has_next) S.a_ready(nxt);
            if constexpr (epi_has_hook<Epi>::value) { if (E.hook_at(t)) E.hook(acc, cur, t, wr, wc, fr, fq); }
            if constexpr (SP2) {
            PG8_LDB(B0, 0, 0); PG8_LDB(B1, 0, 1); PG8_SCHED; PG8_LDA(At, 0, 0); PG8_STAGE(PG8_SA(1, 1), a1 + hstepA, voffA);
            PG8_WAIT_V(8); PG8_WAIT_L(0); PG8_BAR; PG8_MMA(0, 0, At, B0); PG8_MMA(0, 1, At, B1); PG8_BAR; PG8_SCHED;
            PG8_LDA(At, 0, 1); PG8_STAGE(PG8_SB(0, 0), b2, voffB); PG8_STAGE(PG8_SB(0, 1), b2 + hstep, voffB); PG8_STAGE(PG8_SA(0, 0), a2, voffA);
            PG8_WAIT_V(8); PG8_WAIT_L(0); PG8_BAR; PG8_MMA(1, 0, At, B0); PG8_MMA(1, 1, At, B1); PG8_BAR; PG8_SCHED;
            PG8_LDB(B0, 1, 0); PG8_LDB(B1, 1, 1); PG8_SCHED; PG8_LDA(At, 1, 0); PG8_STAGE(PG8_SA(0, 1), a2 + hstepA, voffA);
            PG8_WAIT_V(8); PG8_WAIT_L(0); PG8_BAR; PG8_MMA(0, 0, At, B0); PG8_MMA(0, 1, At, B1); PG8_BAR; PG8_SCHED;
            PG8_LDA(At, 1, 1); PG8_STAGE(PG8_SB(1, 0), b3, voffB); PG8_STAGE(PG8_SB(1, 1), b3 + hstep, voffB); PG8_STAGE(PG8_SA(1, 0), a3, voffA);
            PG8_WAIT_V(8); PG8_WAIT_L(0); PG8_BAR; PG8_MMA(1, 0, At, B0); PG8_MMA(1, 1, At, B1); PG8_BAR; PG8_SCHED;
            } else {
            PG8_LDB(B0, 0, 0); PG8_SCHED; PG8_LDA(At, 0, 0); PG8_STAGE(PG8_SA(1, 1), a1 + hstepA, voffA);
            PG8_WAIT_L(8); PG8_BAR; PG8_WAIT_L(0); PG8_MMA(0, 0, At, B0); PG8_BAR; PG8_SCHED;
            PG8_LDB(B1, 0, 1); PG8_STAGE(PG8_SB(0, 0), b2, voffB);
            PG8_BAR; PG8_WAIT_L(0); PG8_MMA(0, 1, At, B1); PG8_BAR;
            PG8_LDA(At, 0, 1); PG8_STAGE(PG8_SA(0, 0), a2, voffA);
            PG8_BAR; PG8_WAIT_L(0); PG8_MMA(1, 0, At, B0); PG8_BAR; PG8_SCHED;
            PG8_STAGE(PG8_SB(0, 1), b2 + hstep, voffB);
            PG8_WAIT_V(6); PG8_BAR; PG8_MMA(1, 1, At, B1); PG8_BAR;
            PG8_LDB(B0, 1, 0); PG8_SCHED; PG8_LDA(At, 1, 0); PG8_STAGE(PG8_SA(0, 1), a2 + hstepA, voffA);
            PG8_WAIT_L(8); PG8_BAR; PG8_WAIT_L(0); PG8_MMA(0, 0, At, B0); PG8_BAR; PG8_SCHED;
            PG8_LDB(B1, 1, 1); PG8_STAGE(PG8_SB(1, 0), b3, voffB);
            PG8_BAR; PG8_WAIT_L(0); PG8_MMA(0, 1, At, B1); PG8_BAR;
            PG8_LDA(At, 1, 1); PG8_STAGE(PG8_SA(1, 0), a3, voffA);
            PG8_BAR; PG8_WAIT_L(0); PG8_MMA(1, 0, At, B0); PG8_BAR; PG8_SCHED;
            PG8_STAGE(PG8_SB(1, 1), b3 + hstep, voffB);
            PG8_WAIT_V(6); PG8_BAR; PG8_MMA(1, 1, At, B1); PG8_BAR;
            }
        }
        if constexpr (ALIGN_EPI) { if (wr == 0) PG8_BAR; }
        E(acc, cur, wr, wc, fr, fq); S.done(cur);
        if (!has_next) break;
#pragma unroll
        for (int a = 0; a < 2; ++a)
#pragma unroll
            for (int b = 0; b < 2; ++b)
#pragma unroll
                for (int m = 0; m < 4; ++m)
#pragma unroll
                    for (int n = 0; n < 2; ++n) acc[a][b][m][n] = (f32x4){0.f, 0.f, 0.f, 0.f};
        cur = nxt; cA = nA; cB = nB; ++ui;
        if constexpr (ALIGN_EPI) { if (wr == 1) PG8_BAR; }
    }
    PG8_WAIT_V(0);
    if constexpr (!ALIGN_EPI) { if (wr == 0) PG8_BAR; }
    PG8_BAR;
#undef PG8_SA
#undef PG8_SB
#undef PG8_STAGE
#undef PG8_LDA
#undef PG8_LDB
#undef PG8_MMA
#undef PG8_WAIT_V
#undef PG8_WAIT_L
#undef PG8_BAR
#undef PG8_SCHED
}
}

namespace att {
typedef unsigned short bf16;
using bf16x8 = __attribute__((ext_vector_type(8))) short;
using s16x4  = __attribute__((ext_vector_type(4))) short;
using f32x16 = __attribute__((ext_vector_type(16))) float;
using u32x4  = __attribute__((ext_vector_type(4))) unsigned;
constexpr int D = 128, NW = 8, QBLK = 32, KVBLK = 64;
constexpr float SCALE = 0.088388347648318440f;
constexpr float THR = 8.f;
constexpr int SHM_V = KVBLK * D * 2, SHM_K = KVBLK * D * 2, SHM_ATTN = 2 * SHM_V + 2 * SHM_K + NW * 64 * 4;
#define KSWZ(row, colB) ((row) * 256 + ((colB) ^ (((row) & 7) << 4)))
#define SBAR() __builtin_amdgcn_sched_barrier(0)
__device__ __forceinline__ int crow(int r, int hi) { return (r & 3) + 8 * (r >> 2) + 4 * hi; }
__device__ __forceinline__ unsigned cvtpk(float lo, float hi) { unsigned r; asm volatile("v_cvt_pk_bf16_f32 %0, %1, %2" : "=v"(r) : "v"(lo), "v"(hi)); return r; }

template <int SM> __device__ __forceinline__ void partialSM(f32x16& p0, f32x16& p1, float& m_reg, float& mn, float& alpha) {
  if constexpr (SM == 2) {
#pragma unroll
    for (int r = 0; r < 16; ++r) p0[r] = __builtin_amdgcn_exp2f(p0[r]);
    return; }
  constexpr float C = SM == 0 ? SCALE * 1.4426950408889634f : 1.0f; constexpr float THRU = SM == 0 ? THR / SCALE : THR * 1.4426950408889634f;
  float pmax = p0[0];
#pragma unroll
  for (int r = 1; r < 16; ++r) pmax = fmaxf(pmax, p0[r]);
#pragma unroll
  for (int r = 0; r < 16; ++r) pmax = fmaxf(pmax, p1[r]);
  { auto rr = __builtin_amdgcn_permlane32_swap(__float_as_uint(pmax), __float_as_uint(pmax), false, false);
    pmax = fmaxf(__uint_as_float(rr[0]), __uint_as_float(rr[1])); }
  if (__builtin_expect(__all(pmax - m_reg <= THRU), 1)) { mn = m_reg; alpha = 1.f; }
  else { mn = fmaxf(m_reg, pmax); alpha = __builtin_amdgcn_exp2f((m_reg - mn) * C); m_reg = mn; }
  float mnC = -mn * C;
#pragma unroll
  for (int r = 0; r < 16; ++r) p0[r] = fmaf(p0[r], C, mnC);
#pragma unroll
  for (int r = 0; r < 16; ++r) p1[r] = fmaf(p1[r], C, mnC);
#pragma unroll
  for (int r = 0; r < 16; ++r) p0[r] = __builtin_amdgcn_exp2f(p0[r]);
}
template <int SM> __device__ __forceinline__ void finishSM(f32x16& p0, f32x16& p1, float alpha, float& l_reg, bf16x8& pa0, bf16x8& pa1, bf16x8& pa2, bf16x8& pa3) {
#pragma unroll
  for (int r = 0; r < 16; ++r) p1[r] = __builtin_amdgcn_exp2f(p1[r]);
  float ps = 0;
#pragma unroll
  for (int r = 0; r < 16; ++r) ps += p0[r];
#pragma unroll
  for (int r = 0; r < 16; ++r) ps += p1[r];
  { auto rr = __builtin_amdgcn_permlane32_swap(__float_as_uint(ps), __float_as_uint(ps), false, false);
    ps = __uint_as_float(rr[0]) + __uint_as_float(rr[1]); }
  if constexpr (SM == 2) l_reg += ps; else l_reg = l_reg * alpha + ps;
#define PK4(P, BASE, OUT) do { unsigned a0 = cvtpk(P[BASE + 0], P[BASE + 1]), a1 = cvtpk(P[BASE + 2], P[BASE + 3]);   \
    unsigned b0 = cvtpk(P[BASE + 4], P[BASE + 5]), b1 = cvtpk(P[BASE + 6], P[BASE + 7]);                              \
    auto r0 = __builtin_amdgcn_permlane32_swap(a0, b0, false, false); auto r1 = __builtin_amdgcn_permlane32_swap(a1, b1, false, false); \
    u32x4 w = {r0[0], r1[0], r0[1], r1[1]}; OUT = *reinterpret_cast<bf16x8*>(&w); } while (0)
  PK4(p0, 0, pa0); PK4(p0, 8, pa1); PK4(p1, 0, pa2); PK4(p1, 8, pa3);
#undef PK4
}
template <bool PF> __device__ __forceinline__ void qkt(f32x16& p0, f32x16& p1, const char* Ks, const bf16x8* qr, int r32, int hi) {
  p0 = f32x16{}; p1 = f32x16{};
  if constexpr (PF) {
  bf16x8 b0 = *reinterpret_cast<const bf16x8*>(Ks + KSWZ(r32, (hi * 8) * 2)), b1 = *reinterpret_cast<const bf16x8*>(Ks + KSWZ(32 + r32, (hi * 8) * 2));
#pragma unroll
  for (int d0 = 0; d0 < 8; ++d0) { bf16x8 n0 = b0, n1 = b1;
    if (d0 < 7) { const int cb = ((d0 + 1) * 16 + hi * 8) * 2; n0 = *reinterpret_cast<const bf16x8*>(Ks + KSWZ(r32, cb)); n1 = *reinterpret_cast<const bf16x8*>(Ks + KSWZ(32 + r32, cb)); }
    if (d0 < 7) asm volatile("s_waitcnt lgkmcnt(2)" ::: "memory"); else asm volatile("s_waitcnt lgkmcnt(0)" ::: "memory");
    __builtin_amdgcn_sched_barrier(0);
    p0 = __builtin_amdgcn_mfma_f32_32x32x16_bf16(b0, qr[d0], p0, 0, 0, 0);
    p1 = __builtin_amdgcn_mfma_f32_32x32x16_bf16(b1, qr[d0], p1, 0, 0, 0);
    b0 = n0; b1 = n1; }
  } else {
#pragma unroll
  for (int d0 = 0; d0 < 8; ++d0) { int cb = (d0 * 16 + hi * 8) * 2;
    bf16x8 b0 = *reinterpret_cast<const bf16x8*>(Ks + KSWZ(r32, cb));
    bf16x8 b1 = *reinterpret_cast<const bf16x8*>(Ks + KSWZ(32 + r32, cb));
    p0 = __builtin_amdgcn_mfma_f32_32x32x16_bf16(b0, qr[d0], p0, 0, 0, 0);
    p1 = __builtin_amdgcn_mfma_f32_32x32x16_bf16(b1, qr[d0], p1, 0, 0, 0); }
  }
}
__device__ __forceinline__ int v_st(int k, int c) { const int kk = (k & ~0xC) | ((k & 4) << 1) | ((k & 8) >> 1); return ((kk >> 3) * 4 + (c >> 5)) * 512 + ((kk & 7) * 32 + (c & 31)) * 2; }
__device__ __forceinline__ int v_rd_base(int lane) { return ((lane & 3) << 3) | (((lane >> 2) & 3) << 6) | (((lane >> 4) & 1) << 5) | (((lane >> 5) & 1) << 8); }
constexpr int v_rd_off(int d0, int ks, int half) { return d0 * 512 + ks * 4096 + half * 2048; }
template <int OFF> __device__ __forceinline__ s16x4 tr_read(int vb) {
  s16x4 r; asm volatile("ds_read_b64_tr_b16 %0, %1 offset:%2" : "=&v"(r) : "v"(vb), "i"(OFF) : "memory"); return r;
}
template <int D0> __device__ __forceinline__ void pv_one(f32x16& od, int vb, bf16x8 pa0, bf16x8 pa1, bf16x8 pa2, bf16x8 pa3) {
  const s16x4 l0 = tr_read<v_rd_off(D0, 0, 0)>(vb), h0 = tr_read<v_rd_off(D0, 0, 1)>(vb), l1 = tr_read<v_rd_off(D0, 1, 0)>(vb), h1 = tr_read<v_rd_off(D0, 1, 1)>(vb);
  const s16x4 l2 = tr_read<v_rd_off(D0, 2, 0)>(vb), h2 = tr_read<v_rd_off(D0, 2, 1)>(vb), l3 = tr_read<v_rd_off(D0, 3, 0)>(vb), h3 = tr_read<v_rd_off(D0, 3, 1)>(vb);
  asm volatile("s_waitcnt lgkmcnt(0)" ::: "memory"); SBAR();
#define PK(L, H) (bf16x8){L[0], L[1], L[2], L[3], H[0], H[1], H[2], H[3]}
  od = __builtin_amdgcn_mfma_f32_32x32x16_bf16(pa0, PK(l0, h0), od, 0, 0, 0);
  od = __builtin_amdgcn_mfma_f32_32x32x16_bf16(pa1, PK(l1, h1), od, 0, 0, 0);
  od = __builtin_amdgcn_mfma_f32_32x32x16_bf16(pa2, PK(l2, h2), od, 0, 0, 0);
  od = __builtin_amdgcn_mfma_f32_32x32x16_bf16(pa3, PK(l3, h3), od, 0, 0, 0);
#undef PK
}
__device__ __forceinline__ void pv_d0(f32x16* o, int vb, bf16x8 pa0, bf16x8 pa1, bf16x8 pa2, bf16x8 pa3) {
  pv_one<0>(o[0], vb, pa0, pa1, pa2, pa3); pv_one<1>(o[1], vb, pa0, pa1, pa2, pa3); pv_one<2>(o[2], vb, pa0, pa1, pa2, pa3); pv_one<3>(o[3], vb, pa0, pa1, pa2, pa3);
}

struct Unit {
  const bf16* Q; const bf16* K; const bf16* V; bf16* O; float* lse;
  int qstride, kstride, ostride, lse_stride;
  int NT;
  int kb0, n, qi0, hw;
  float slope_raw;
  float sink; int has_sink;
};

template <bool BAND, int SM>
__device__ __forceinline__ void attn_unit(const Unit& U, char* lds, const int tid) {
  const int wid = tid >> 6, lane = tid & 63, r32 = lane & 31, hi = lane >> 5;
  char* V_lds = lds; char* K_lds = lds + 2 * SHM_V;
  float* ws = (float*)(lds + 2 * SHM_V + 2 * SHM_K) + wid * 64; float* li_l = ws; float* al_l = ws + 32;
  float m_reg = -1e30f, l_reg = 0; f32x16 o[4] = {}; bf16x8 qr[8];
  { int lq_ = lane; asm volatile("" : "+v"(lq_));
    const unsigned qoff = (unsigned)(wid * QBLK + (lq_ & 31)) * (unsigned)U.qstride + (unsigned)((lq_ >> 5) * 8);
#pragma unroll
    for (int d0 = 0; d0 < 8; ++d0) qr[d0] = *reinterpret_cast<const bf16x8*>(U.Q + qoff + d0 * 16); }
  const int sr = tid >> 4, sc = (tid & 15) * 8, vst0 = v_st(sr, sc), kst0 = KSWZ(sr, sc * 2);
  const int vb0 = (int)(uintptr_t)V_lds + v_rd_base(lane);
  struct { bf16x8 vs0, vs1, ks0, ks1; } sr_[BAND ? 1 : 2];
  float fq = 0.f;
  if constexpr (BAND) fq = (float)(U.qi0 + wid * QBLK + r32);
#define ROWOF(k) ((k) < 0 ? 0 : ((k) >= U.n ? U.n - 1 : (k)))
#define SLOAD(i, k0) do { unsigned _o0, _o1; \
    if constexpr (BAND) { const int _ka = U.kb0 + (k0) + sr; _o0 = (unsigned)ROWOF(_ka) * (unsigned)U.kstride + (unsigned)sc; _o1 = (unsigned)ROWOF(_ka + 32) * (unsigned)U.kstride + (unsigned)sc; } \
    else { _o0 = (unsigned)((k0) + sr) * (unsigned)U.kstride + (unsigned)sc; _o1 = _o0 + 32u * (unsigned)U.kstride; } \
    sr_[i].vs0 = *reinterpret_cast<const bf16x8*>(U.V + _o0); sr_[i].vs1 = *reinterpret_cast<const bf16x8*>(U.V + _o1); \
    sr_[i].ks0 = *reinterpret_cast<const bf16x8*>(U.K + _o0); sr_[i].ks1 = *reinterpret_cast<const bf16x8*>(U.K + _o1); } while (0)
#define SWRITE(b, i) do { *(bf16x8*)(V_lds + (b) * SHM_V + vst0) = sr_[i].vs0;          \
    *(bf16x8*)(V_lds + (b) * SHM_V + vst0 + 8192) = sr_[i].vs1;                         \
    *(bf16x8*)(K_lds + (b) * SHM_K + kst0) = sr_[i].ks0;                               \
    *(bf16x8*)(K_lds + (b) * SHM_K + kst0 + 8192) = sr_[i].ks1; } while (0)
#define SWAIT() asm volatile("s_waitcnt vmcnt(4)" ::: "memory")
#define QK_SCHED() do { if constexpr (SM == 2 && ATT_SCHED == 1) { __builtin_amdgcn_sched_group_barrier(0x100, 4, 0); \
    _Pragma("unroll") for (int i_ = 0; i_ < 7; ++i_) { __builtin_amdgcn_sched_group_barrier(0x008, 2, 0); __builtin_amdgcn_sched_group_barrier(0x002, 9, 0); __builtin_amdgcn_sched_group_barrier(0x100, 2, 0); } \
    __builtin_amdgcn_sched_group_barrier(0x008, 2, 0); __builtin_amdgcn_sched_group_barrier(0x002, 12, 0); } \
    if constexpr (SM == 2 && ATT_SCHED == 2) { _Pragma("unroll") for (int i_ = 0; i_ < 8; ++i_) { __builtin_amdgcn_sched_group_barrier(0x100, 2, 0); __builtin_amdgcn_sched_group_barrier(0x008, 2, 0); __builtin_amdgcn_sched_group_barrier(0x002, 9, 0); } } } while (0)
#define RESC(a) do { if constexpr (SM != 2) if (__any((a) < 1.f)) { if (hi == 0) al_l[r32] = (a); asm volatile("s_waitcnt lgkmcnt(0)" ::: "memory"); \
    _Pragma("unroll") for (int d = 0; d < 4; ++d) _Pragma("unroll") for (int r = 0; r < 16; ++r) o[d][r] *= al_l[crow(r, hi)]; } } while (0)
#define MASKB(P0, P1, j) do { if constexpr (BAND) { const float _f0 = ((float)(U.kb0 + 64 * (j)) + (float)(4 * hi)) - fq; const float _ninf = -__builtin_inff(); \
    const float flo = __builtin_fmaxf(-(float)U.hw, -fq), fhi = __builtin_fminf((float)U.hw, (float)(U.n - 1) - fq); \
    _Pragma("unroll") for (int r = 0; r < 16; ++r) { const float d0_ = _f0 + (float)((r & 3) + 8 * (r >> 2)), d1_ = d0_ + 32.f; \
      const float s0_ = fmaf(-U.slope_raw, __builtin_fabsf(d0_), P0[r]), s1_ = fmaf(-U.slope_raw, __builtin_fabsf(d1_), P1[r]); \
      P0[r] = (d0_ >= flo && d0_ <= fhi) ? s0_ : _ninf; P1[r] = (d1_ >= flo && d1_ <= fhi) ? s1_ : _ninf; } } } while (0)
  f32x16 pA0, pA1, pB0, pB1; float mnA, mnB, alA, alB; bf16x8 pa0, pa1, pa2, pa3; const int NT = U.NT;
  constexpr int SE = 0, SO = 1;
  if constexpr (BAND) {
  const int tlo_ = __builtin_amdgcn_readfirstlane(wid >> 1), thi_ = tlo_ + (U.hw >> 5);
#define ACT(j) (!WSKIP || ((j) >= tlo_ && (j) <= thi_))
  SLOAD(0, 0); SWRITE(0, 0); SLOAD(0, KVBLK); __syncthreads();
  if (ACT(0)) { qkt<(BAND_PREFETCH != 0)>(pA0, pA1, K_lds, qr, r32, hi); MASKB(pA0, pA1, 0); partialSM<SM>(pA0, pA1, m_reg, mnA, alA); }
  SWRITE(1, 0); if (2 < NT) SLOAD(0, 2 * KVBLK); __syncthreads();
  for (int j = 1; j + 1 < NT; j += 2) {
      { const bool aj = ACT(j), ap = ACT(j - 1);
        SBAR(); if (aj) qkt<(BAND_PREFETCH != 0)>(pB0, pB1, K_lds + SHM_K, qr, r32, hi);
        if (ap) { finishSM<SM>(pA0, pA1, alA, l_reg, pa0, pa1, pa2, pa3); SBAR(); pv_d0(o, vb0, pa0, pa1, pa2, pa3); }
        if (aj) { MASKB(pB0, pB1, j); partialSM<SM>(pB0, pB1, m_reg, mnB, alB); }
        __syncthreads(); SWRITE(0, 0); SLOAD(0, (j + 2) * KVBLK);
        if (aj) RESC(alB); __syncthreads(); }
      { const bool aj = ACT(j + 1), ap = ACT(j);
        SBAR(); if (aj) qkt<(BAND_PREFETCH != 0)>(pA0, pA1, K_lds, qr, r32, hi);
        if (ap) { finishSM<SM>(pB0, pB1, alB, l_reg, pa0, pa1, pa2, pa3); SBAR(); pv_d0(o, vb0 + SHM_V, pa0, pa1, pa2, pa3); }
        if (aj) { MASKB(pA0, pA1, j + 1); partialSM<SM>(pA0, pA1, m_reg, mnA, alA); }
        __syncthreads(); SWRITE(1, 0); if (j + 3 < NT) SLOAD(0, (j + 3) * KVBLK);
        if (aj) RESC(alA); __syncthreads(); }
  }
  { const bool aj = ACT(NT - 1), ap = ACT(NT - 2);
    SBAR(); if (aj) qkt<(BAND_PREFETCH != 0)>(pB0, pB1, K_lds + SHM_K, qr, r32, hi);
    if (ap) { finishSM<SM>(pA0, pA1, alA, l_reg, pa0, pa1, pa2, pa3); SBAR(); pv_d0(o, vb0, pa0, pa1, pa2, pa3); }
    if (aj) { MASKB(pB0, pB1, NT - 1); partialSM<SM>(pB0, pB1, m_reg, mnB, alB); }
    __syncthreads();
    if (aj) { RESC(alB);
      finishSM<SM>(pB0, pB1, alB, l_reg, pa0, pa1, pa2, pa3); SBAR();
      pv_d0(o, vb0 + SHM_V, pa0, pa1, pa2, pa3); } }
#undef ACT
  } else {
  SLOAD(SE, 0); asm volatile("s_waitcnt vmcnt(0)" ::: "memory"); SWRITE(0, SE); __syncthreads();
  qkt<(QKT_PREFETCH != 0) && SM == 2>(pA0, pA1, K_lds, qr, r32, hi); partialSM<SM>(pA0, pA1, m_reg, mnA, alA);
  SLOAD(SO, KVBLK); if (2 < NT) SLOAD(SE, 2 * KVBLK);
  SWAIT(); SWRITE(1, SO); __syncthreads();
  for (int j = 1; j + 1 < NT; j += 2) {
    SBAR(); qkt<(QKT_PREFETCH != 0) && SM == 2>(pB0, pB1, K_lds + SHM_K, qr, r32, hi);
    finishSM<SM>(pA0, pA1, alA, l_reg, pa0, pa1, pa2, pa3); QK_SCHED(); SBAR();
    SLOAD(SO, (j + 2) * KVBLK); SBAR();
    pv_d0(o, vb0, pa0, pa1, pa2, pa3); partialSM<SM>(pB0, pB1, m_reg, mnB, alB);
    __syncthreads(); SWAIT(); SWRITE(0, SE);
    RESC(alB); __syncthreads();
    SBAR(); qkt<(QKT_PREFETCH != 0) && SM == 2>(pA0, pA1, K_lds, qr, r32, hi);
    finishSM<SM>(pB0, pB1, alB, l_reg, pa0, pa1, pa2, pa3); QK_SCHED(); SBAR();
    if (j + 3 < NT) SLOAD(SE, (j + 3) * KVBLK); SBAR();
    pv_d0(o, vb0 + SHM_V, pa0, pa1, pa2, pa3); partialSM<SM>(pA0, pA1, m_reg, mnA, alA);
    __syncthreads(); SWAIT(); SWRITE(1, SO);
    RESC(alA); __syncthreads();
  }
  SBAR(); qkt<(QKT_PREFETCH != 0) && SM == 2>(pB0, pB1, K_lds + SHM_K, qr, r32, hi);
  finishSM<SM>(pA0, pA1, alA, l_reg, pa0, pa1, pa2, pa3); SBAR();
  pv_d0(o, vb0, pa0, pa1, pa2, pa3); partialSM<SM>(pB0, pB1, m_reg, mnB, alB);
  __syncthreads(); RESC(alB);
  finishSM<SM>(pB0, pB1, alB, l_reg, pa0, pa1, pa2, pa3); SBAR();
  pv_d0(o, vb0 + SHM_V, pa0, pa1, pa2, pa3);
  }
  if constexpr (BAND) {
    if (U.has_sink) l_reg += __builtin_amdgcn_exp2f((U.sink * (1.0f / SCALE) - m_reg) * (SCALE * 1.4426950408889634f));
    if (U.lse != nullptr && hi == 0) U.lse[(unsigned)(wid * QBLK + r32) * (unsigned)U.lse_stride] = m_reg * SCALE + __builtin_amdgcn_logf(l_reg) * 0.6931471805599453f;
  }
  int lane_e = lane; asm volatile("" : "+v"(lane_e));
  const int r32e = lane_e & 31, hie = lane_e >> 5;
  if (hie == 0) li_l[r32e] = l_reg; asm volatile("s_waitcnt lgkmcnt(0)" ::: "memory");
  float rli[16];
#pragma unroll
  for (int r = 0; r < 16; ++r) rli[r] = __builtin_amdgcn_rcpf(li_l[crow(r, hie)]);
  __syncthreads();
  char* ost = lds + wid * 8192;
  { char* op = ost + hie * 1024 + r32e * 2;
#pragma unroll
    for (int r = 0; r < 16; ++r) {
#pragma unroll
      for (int d0 = 0; d0 < 4; ++d0) { const unsigned w = cvtpk(o[d0][r] * rli[r], 0.f); *(unsigned short*)(op + ((r & 3) + 8 * (r >> 2)) * 256 + d0 * 64) = (unsigned short)w; } } }
  asm volatile("s_waitcnt lgkmcnt(0)" ::: "memory");
  { const char* ip = ost + (lane_e >> 4) * 256 + (lane_e & 15) * 16;
    unsigned goff = (unsigned)(wid * QBLK + (lane_e >> 4)) * (unsigned)U.ostride + (unsigned)((lane_e & 15) * 8); const unsigned gstep = 4u * (unsigned)U.ostride;
#pragma unroll
    for (int i = 0; i < 8; ++i) { const u32x4 w = *(const u32x4*)(ip + i * 1024); *(u32x4*)(U.O + goff) = w; goff += gstep; } }
  __syncthreads();
#undef ROWOF
#undef SLOAD
#undef SWRITE
#undef SWAIT
#undef QK_SCHED
#undef RESC
#undef MASKB
}

constexpr int SHM_RING = 3 * SHM_V + 2 * SHM_K + NW * 64 * 4;
__device__ __forceinline__ void attn_unit_ring(const Unit& U, char* lds, const int tid) {
  const int wid = tid >> 6, lane = tid & 63, r32 = lane & 31, hi = lane >> 5;
  char* V_lds = lds; char* K_lds = lds + 3 * SHM_V;
  float* ws = (float*)(lds + 3 * SHM_V + 2 * SHM_K) + wid * 64; float* li_l = ws;
  float m_reg = 0.f, l_reg = 0, mn_, al_ = 1.f; f32x16 o[4] = {}; bf16x8 qr[8];
  { const unsigned qoff = (unsigned)(wid * QBLK + r32) * (unsigned)U.qstride + (unsigned)(hi * 8);
#pragma unroll
    for (int d0 = 0; d0 < 8; ++d0) qr[d0] = *reinterpret_cast<const bf16x8*>(U.Q + qoff + d0 * 16); }
  const int sr = tid >> 4, sc = (tid & 15) * 8, vst0 = v_st(sr, sc), vst1 = v_st(32 + sr, sc);
  const int vb0 = (int)(uintptr_t)V_lds + v_rd_base(lane);
  struct { bf16x8 vs0, vs1, ks0, ks1; } sr_[1];
#define SLOAD(i, k0) do { const unsigned _o0 = (unsigned)((k0) + sr) * (unsigned)U.kstride + (unsigned)sc, _o1 = _o0 + 32u * (unsigned)U.kstride; \
    sr_[i].vs0 = *reinterpret_cast<const bf16x8*>(U.V + _o0); sr_[i].vs1 = *reinterpret_cast<const bf16x8*>(U.V + _o1); \
    sr_[i].ks0 = *reinterpret_cast<const bf16x8*>(U.K + _o0); sr_[i].ks1 = *reinterpret_cast<const bf16x8*>(U.K + _o1); } while (0)
#define SWRITE(kb, vsl, i) do { char* _v = V_lds + (vsl) * SHM_V; *(bf16x8*)(_v + vst0) = sr_[i].vs0; *(bf16x8*)(_v + vst1) = sr_[i].vs1; int kc = sc * 2; \
    *(bf16x8*)(K_lds + (kb) * SHM_K + KSWZ(sr, kc)) = sr_[i].ks0; *(bf16x8*)(K_lds + (kb) * SHM_K + KSWZ(32 + sr, kc)) = sr_[i].ks1; } while (0)
#define NEXT3(x) ((x) == 2 ? 0 : (x) + 1)
  f32x16 pA0, pA1, pB0, pB1; bf16x8 pa0, pa1, pa2, pa3; const int NT = U.NT;
  SLOAD(0, 0); SWRITE(0, 0, 0); SLOAD(0, KVBLK);
  __syncthreads();
  SWRITE(1, 1, 0); SLOAD(0, 2 * KVBLK);
  qkt<(QKT_PREFETCH != 0)>(pA0, pA1, K_lds, qr, r32, hi); partialSM<2>(pA0, pA1, m_reg, mn_, al_);
  __syncthreads();
  int vr = 0;
  for (int j = 1; j + 1 < NT; j += 2) {
    { const int vw = NEXT3(NEXT3(vr));
      SWRITE(0, vw, 0); SLOAD(0, (j + 2) * KVBLK);
      SBAR(); qkt<(QKT_PREFETCH != 0)>(pB0, pB1, K_lds + SHM_K, qr, r32, hi);
      finishSM<2>(pA0, pA1, al_, l_reg, pa0, pa1, pa2, pa3); SBAR();
      pv_d0(o, vb0 + vr * SHM_V, pa0, pa1, pa2, pa3); partialSM<2>(pB0, pB1, m_reg, mn_, al_);
      __syncthreads(); vr = NEXT3(vr); }
    { const int vw = NEXT3(NEXT3(vr));
      SWRITE(1, vw, 0); if (j + 3 < NT) SLOAD(0, (j + 3) * KVBLK);
      SBAR(); qkt<(QKT_PREFETCH != 0)>(pA0, pA1, K_lds, qr, r32, hi);
      finishSM<2>(pB0, pB1, al_, l_reg, pa0, pa1, pa2, pa3); SBAR();
      pv_d0(o, vb0 + vr * SHM_V, pa0, pa1, pa2, pa3); partialSM<2>(pA0, pA1, m_reg, mn_, al_);
      __syncthreads(); vr = NEXT3(vr); }
  }
  SBAR(); qkt<(QKT_PREFETCH != 0)>(pB0, pB1, K_lds + SHM_K, qr, r32, hi);
  finishSM<2>(pA0, pA1, al_, l_reg, pa0, pa1, pa2, pa3); SBAR();
  pv_d0(o, vb0 + vr * SHM_V, pa0, pa1, pa2, pa3); partialSM<2>(pB0, pB1, m_reg, mn_, al_);
  finishSM<2>(pB0, pB1, al_, l_reg, pa0, pa1, pa2, pa3); SBAR();
  pv_d0(o, vb0 + NEXT3(vr) * SHM_V, pa0, pa1, pa2, pa3);
  int lane_e = lane; asm volatile("" : "+v"(lane_e));
  const int r32e = lane_e & 31, hie = lane_e >> 5;
  if (hie == 0) li_l[r32e] = l_reg; asm volatile("s_waitcnt lgkmcnt(0)" ::: "memory");
  float rli[16];
#pragma unroll
  for (int r = 0; r < 16; ++r) rli[r] = __builtin_amdgcn_rcpf(li_l[crow(r, hie)]);
  __syncthreads();
  char* ost = lds + wid * 8192;
  { char* op = ost + hie * 1024 + r32e * 2;
#pragma unroll
    for (int r = 0; r < 16; ++r) {
#pragma unroll
      for (int d0 = 0; d0 < 4; ++d0) { const unsigned w = cvtpk(o[d0][r] * rli[r], 0.f); *(unsigned short*)(op + ((r & 3) + 8 * (r >> 2)) * 256 + d0 * 64) = (unsigned short)w; } } }
  asm volatile("s_waitcnt lgkmcnt(0)" ::: "memory");
  { const char* ip = ost + (lane_e >> 4) * 256 + (lane_e & 15) * 16;
    unsigned goff = (unsigned)(wid * QBLK + (lane_e >> 4)) * (unsigned)U.ostride + (unsigned)((lane_e & 15) * 8); const unsigned gstep = 4u * (unsigned)U.ostride;
#pragma unroll
    for (int i = 0; i < 8; ++i) { const u32x4 w = *(const u32x4*)(ip + i * 1024); *(u32x4*)(U.O + goff) = w; goff += gstep; } }
  __syncthreads();
#undef SLOAD
#undef SWRITE
#undef NEXT3
}

constexpr int DMA_KOFF = 0, DMA_VOFF = 3 * SHM_K, DMA_SCR = 3 * SHM_K + 4 * SHM_V, SHM_DMA = DMA_SCR + NW * 64 * 4;
typedef __attribute__((address_space(3))) unsigned char lds_u8;
__device__ __forceinline__ void attn_unit_dma(const Unit& U, char* lds, lds_u8* ldsl, const int tid) {
  const int wid = __builtin_amdgcn_readfirstlane(tid >> 6), lane = tid & 63, r32 = lane & 31, hi = lane >> 5;
  char* K_lds = lds + DMA_KOFF; char* V_lds = lds + DMA_VOFF;
  float* ws = (float*)(lds + DMA_SCR) + wid * 64; float* li_l = ws;
  float m_reg = 0.f, l_reg = 0, mn_, al_ = 1.f; f32x16 o[4] = {}; bf16x8 qr[8];
  { int lq_ = lane; asm volatile("" : "+v"(lq_));
    const unsigned qoff = (unsigned)(wid * QBLK + (lq_ & 31)) * (unsigned)U.qstride + (unsigned)((lq_ >> 5) * 8);
#pragma unroll
    for (int d0 = 0; d0 < 8; ++d0) qr[d0] = *reinterpret_cast<const bf16x8*>(U.Q + qoff + d0 * 16); }
  unsigned koff[2], voff[2];
#pragma unroll
  for (int i = 0; i < 2; ++i) { const int p = (wid * 2 + i) * 64 + lane;
    { const int row = p >> 4, cs = p & 15, c = cs ^ (row & 7); koff[i] = ((unsigned)row * (unsigned)U.kstride + (unsigned)(c * 8)) * 2u; }
    { const int st = p >> 5, q = p & 31, kk = (st >> 2) * 8 + (q >> 2), key = (kk & ~0xC) | ((kk & 4) << 1) | ((kk & 8) >> 1), c = (st & 3) * 32 + (q & 3) * 8; voff[i] = ((unsigned)key * (unsigned)U.kstride + (unsigned)c) * 2u; } }
  const int vb0 = (int)(uintptr_t)V_lds + v_rd_base(lane);
  const unsigned ldsw = (unsigned)wid * 2048u;
#define NEXT3(x) ((x) == 2 ? 0 : (x) + 1)
#define NEXT4(x) (((x) + 1) & 3)
#define DMA_TILE(t, ks, vs) do { const int t_ = (t); const char* kb_ = (const char*)(U.K + (size_t)t_ * KVBLK * U.kstride); const char* vb_ = (const char*)(U.V + (size_t)t_ * KVBLK * U.kstride); \
    _Pragma("unroll") for (int i_ = 0; i_ < 2; ++i_) { \
      __builtin_amdgcn_global_load_lds((const unsigned*)(kb_ + koff[i_]), (__attribute__((address_space(3))) unsigned*)(ldsl + DMA_KOFF + (ks) * SHM_K + ldsw + i_ * 1024), 16, 0, 0); \
      __builtin_amdgcn_global_load_lds((const unsigned*)(vb_ + voff[i_]), (__attribute__((address_space(3))) unsigned*)(ldsl + DMA_VOFF + (vs) * SHM_V + ldsw + i_ * 1024), 16, 0, 0); } } while (0)
#define STEP_BAR() do { asm volatile("s_waitcnt vmcnt(4) lgkmcnt(0)" ::: "memory"); __builtin_amdgcn_s_barrier(); asm volatile("" ::: "memory"); } while (0)
#define STEP_BAR0() do { asm volatile("s_waitcnt vmcnt(0) lgkmcnt(0)" ::: "memory"); __builtin_amdgcn_s_barrier(); asm volatile("" ::: "memory"); } while (0)
  f32x16 pA0, pA1, pB0, pB1; bf16x8 pa0, pa1, pa2, pa3; const int NT = U.NT;
  asm volatile("s_waitcnt vmcnt(0)" ::: "memory");
  DMA_TILE(0, 0, 0); DMA_TILE(1, 1, 1);
  STEP_BAR();
  DMA_TILE(2, 2, 2);
  qkt<(QKT_PREFETCH != 0)>(pA0, pA1, K_lds, qr, r32, hi); partialSM<2>(pA0, pA1, m_reg, mn_, al_);
  STEP_BAR();
  int ks = 1, vs = 1;
  for (int j = 1; j + 1 < NT; j += 2) {
    { const int kw = NEXT3(NEXT3(ks)), vw = NEXT4(NEXT4(vs));
      const bool more_ = j + 2 < NT;
      SBAR(); qkt<(QKT_PREFETCH != 0)>(pB0, pB1, K_lds + ks * SHM_K, qr, r32, hi);
      finishSM<2>(pA0, pA1, al_, l_reg, pa0, pa1, pa2, pa3); SBAR();
      if (more_) DMA_TILE(j + 2, kw, vw); SBAR();
      pv_d0(o, vb0 + ((vs + 3) & 3) * SHM_V, pa0, pa1, pa2, pa3); partialSM<2>(pB0, pB1, m_reg, mn_, al_);
      if (more_) STEP_BAR(); else STEP_BAR0(); ks = NEXT3(ks); vs = NEXT4(vs); }
    { const int kw = NEXT3(NEXT3(ks)), vw = NEXT4(NEXT4(vs));
      const bool more_ = j + 3 < NT;
      SBAR(); qkt<(QKT_PREFETCH != 0)>(pA0, pA1, K_lds + ks * SHM_K, qr, r32, hi);
      finishSM<2>(pB0, pB1, al_, l_reg, pa0, pa1, pa2, pa3); SBAR();
      if (more_) DMA_TILE(j + 3, kw, vw); SBAR();
      pv_d0(o, vb0 + ((vs + 3) & 3) * SHM_V, pa0, pa1, pa2, pa3); partialSM<2>(pA0, pA1, m_reg, mn_, al_);
      if (more_) STEP_BAR(); else STEP_BAR0(); ks = NEXT3(ks); vs = NEXT4(vs); }
  }
  SBAR(); qkt<(QKT_PREFETCH != 0)>(pB0, pB1, K_lds + ks * SHM_K, qr, r32, hi);
  finishSM<2>(pA0, pA1, al_, l_reg, pa0, pa1, pa2, pa3); SBAR();
  pv_d0(o, vb0 + ((vs + 3) & 3) * SHM_V, pa0, pa1, pa2, pa3); partialSM<2>(pB0, pB1, m_reg, mn_, al_);
  finishSM<2>(pB0, pB1, al_, l_reg, pa0, pa1, pa2, pa3); SBAR();
  pv_d0(o, vb0 + vs * SHM_V, pa0, pa1, pa2, pa3);
  asm volatile("s_waitcnt vmcnt(0) lgkmcnt(0)" ::: "memory");
  int lane_e = lane; asm volatile("" : "+v"(lane_e));
  const int r32e = lane_e & 31, hie = lane_e >> 5;
  if (hie == 0) li_l[r32e] = l_reg; asm volatile("s_waitcnt lgkmcnt(0)" ::: "memory");
  float rli[16];
#pragma unroll
  for (int r = 0; r < 16; ++r) rli[r] = __builtin_amdgcn_rcpf(li_l[crow(r, hie)]);
  __syncthreads();
  char* ost = lds + wid * 8192;
  { char* op = ost + hie * 1024 + r32e * 2;
#pragma unroll
    for (int r = 0; r < 16; ++r) {
#pragma unroll
      for (int d0 = 0; d0 < 4; ++d0) { const unsigned w = cvtpk(o[d0][r] * rli[r], 0.f); *(unsigned short*)(op + ((r & 3) + 8 * (r >> 2)) * 256 + d0 * 64) = (unsigned short)w; } } }
  asm volatile("s_waitcnt lgkmcnt(0)" ::: "memory");
  { const char* ip = ost + (lane_e >> 4) * 256 + (lane_e & 15) * 16;
    unsigned goff = (unsigned)(wid * QBLK + (lane_e >> 4)) * (unsigned)U.ostride + (unsigned)((lane_e & 15) * 8); const unsigned gstep = 4u * (unsigned)U.ostride;
#pragma unroll
    for (int i = 0; i < 8; ++i) { const u32x4 w = *(const u32x4*)(ip + i * 1024); *(u32x4*)(U.O + goff) = w; goff += gstep; } }
  __syncthreads();
#undef NEXT3
#undef NEXT4
#undef DMA_TILE
#undef STEP_BAR
#undef STEP_BAR0
}
}

constexpr int NWAVES = 8;
constexpr int DM = 2048, SEQ = 16384, NSEQ = 3, M_ALL = NSEQ * SEQ, DEPTH = 4, DFF = 5632, INC = 13824;
constexpr int MGR = 2 * SEQ;
constexpr int A_Q = 0, A_K = 1536, A_V = 3072, B_Q = 4608, B_K = 5632, B_V = 5888, C_Q = 6144, C_K = 7168, C_V = 7424, GL0 = 7680;
constexpr float NORM_EPS = 1e-6f;
enum { I_XP = 0, I_XS, I_NF1, I_F1IN, I_F1OUT, I_NMIX, I_WIN, I_QNQ, I_QNK, I_SINK, I_WA, I_WB, I_WC, I_WO, I_NF2, I_F2IN, I_F2OUT, I_NFIN, N_IN };

constexpr size_t MiB = 1u << 20;
constexpr size_t WS_CTL = 0, CTL_ZERO_BYTES = 1 * MiB;
constexpr int LDW = DM + LDW_PAD, LDU = DM + LDU_PAD;
constexpr size_t WL_F1IN = 0, WL_F1OUT = WL_F1IN + (size_t)2 * DFF * LDW * 2, WL_WIN = WL_F1OUT + (size_t)DM * DFF * 2, WL_WA = WL_WIN + (size_t)INC * LDW * 2,
                 WL_WB = WL_WA + (size_t)DM * 512 * 2, WL_WC = WL_WB + (size_t)DM * 1024 * 2, WL_WO = WL_WC + (size_t)DM * 1024 * 2, WL_F2IN = WL_WO + (size_t)DM * LDW * 2,
                 WL_F2OUT = WL_F2IN + (size_t)2 * DFF * LDW * 2, WL_BYTES = WL_F2OUT + (size_t)DM * DFF * 2;
constexpr size_t WS_W = 1 * MiB;
constexpr size_t WS_U = WS_W + WL_BYTES;
constexpr size_t WS_R = WS_U + (size_t)M_ALL * LDU * 2;
constexpr size_t WS_H = WS_R;
constexpr size_t WS_QKVG = WS_R;
constexpr int OCAT = 2560;
constexpr size_t WS_OCAT = WS_QKVG + (size_t)MGR * INC * 2;
constexpr size_t WS_OA = WS_OCAT, WS_OB = WS_OCAT + 512 * 2, WS_OC = WS_OCAT + 1536 * 2;
constexpr size_t WS_PA = WS_OCAT + (size_t)MGR * OCAT * 2;
constexpr size_t WS_LSE = WS_PA + (size_t)3 * MGR * 512 * 2;
constexpr size_t WS_QB = WS_LSE + (size_t)3 * MGR * 4 * 4;
constexpr size_t WS_KB = WS_QB + (size_t)MGR * 1024 * 2;
constexpr size_t WS_VB = WS_KB + (size_t)MGR * 256 * 2;
constexpr size_t WS_MB = WS_VB + (size_t)MGR * 256 * 2;
constexpr size_t WS_MIX_END = WS_MB + (size_t)MGR * LDU * 2;
constexpr int LDH = DFF + LDH_PAD;
constexpr size_t WS_H_END = WS_H + (size_t)M_ALL * LDH * 2;
constexpr size_t WS_END = WS_MIX_END > WS_H_END ? WS_MIX_END : WS_H_END;
constexpr int CW_BAR = 4096;

constexpr int RING_OFF = 0, RING_BYTES = 131072;
constexpr int LDSCTL_OFF = RING_BYTES, MISC_OFF = LDSCTL_OFF + 320;
constexpr int LDS_BYTES = 147456;
constexpr int DIAG_OFF = MISC_OFF + 256;

#define GAS __attribute__((address_space(1)))
#define LAS __attribute__((address_space(3)))
typedef unsigned short bf16;
typedef unsigned v4u __attribute__((ext_vector_type(4)));
typedef unsigned v2u __attribute__((ext_vector_type(2)));
typedef float f32x4 __attribute__((ext_vector_type(4)));
#define LDS_WAIT() asm volatile("s_waitcnt lgkmcnt(0)" ::: "memory")
#define VM_WAIT() asm volatile("s_waitcnt vmcnt(0)" ::: "memory")
__device__ __forceinline__ unsigned f2bf(float f) { unsigned u = __builtin_bit_cast(unsigned, f); return (u + 0x7fffu + ((u >> 16) & 1u)) >> 16; }
__device__ __forceinline__ unsigned pk2(float lo, float hi) { return f2bf(lo) | (f2bf(hi) << 16); }
__device__ __forceinline__ float bflo(unsigned w) { return __uint_as_float(w << 16); }
__device__ __forceinline__ float bfhi(unsigned w) { return __uint_as_float(w & 0xffff0000u); }

#define XB_TMO      128
#define XB_XCNT(j)  (256  + 64 * (j))
#define XB_XSUB(j)  (1280 + 64 * (j))
#define XB_XGEN(j)  (2304 + 64 * (j))
#define XB_TOP      3328
#define XB_TOPGEN   3392
#define XCD_BAR_WORDS 3456
#define XB_SPIN_CAP (1u << 18)
__device__ __forceinline__ unsigned xb_ld(unsigned* p)              { return __hip_atomic_load(p, __ATOMIC_RELAXED, __HIP_MEMORY_SCOPE_AGENT); }
__device__ __forceinline__ unsigned xb_add(unsigned* p, unsigned v) { return __hip_atomic_fetch_add(p, v, __ATOMIC_RELAXED, __HIP_MEMORY_SCOPE_AGENT); }
__device__ __forceinline__ unsigned xb_xcc_id() { return (unsigned)__builtin_amdgcn_s_getreg((3 << 11) | 20) & 0xFu; }
#define XB_SPIN(cond, bar) do { unsigned _sp = 0; while (cond) { __builtin_amdgcn_s_sleep(1); \
    if ((++_sp & 255u) == 0u) { if (xb_ld(&(bar)[XB_TMO])) break; if (_sp > XB_SPIN_CAP) { atomicAdd(&(bar)[XB_TMO], 1u); break; } } } } while (0)
struct XcdBarrier { unsigned* bar; unsigned x; volatile LAS unsigned* st; };
__device__ __forceinline__ XcdBarrier xcd_barrier_post(unsigned* bar, volatile LAS unsigned* st) {
    XcdBarrier b; b.bar = bar; b.x = xb_xcc_id(); b.st = st;
    if (threadIdx.x == 0) (void)xb_add(&bar[XB_XCNT(b.x)], 1u);
    return b;
}
__device__ __forceinline__ void xcd_barrier_complete(unsigned* bar, unsigned x, unsigned& nloc, unsigned& nx) {
    const unsigned G = gridDim.x * gridDim.y * gridDim.z;
    unsigned sum, cnt, mine, sp = 0u;
    for (;;) {
        sum = 0u; cnt = 0u; mine = 0u;
#pragma unroll
        for (unsigned j = 0; j < 16; ++j) { const unsigned c = xb_ld(&bar[XB_XCNT(j)]); sum += c; cnt += (c > 0u) ? 1u : 0u; mine = (j == x) ? c : mine; }
        if (sum == G) break;
        __builtin_amdgcn_s_sleep(1);
        if ((++sp & 255u) == 0u) { if (xb_ld(&bar[XB_TMO])) break; if (sp > XB_SPIN_CAP) { atomicAdd(&bar[XB_TMO], 1u); break; } }
    }
    nloc = mine > 0u ? mine : 1u; nx = cnt > 0u ? cnt : 1u;
}
__device__ __forceinline__ void xcd_barrier(const XcdBarrier& b) {
    asm volatile("s_waitcnt vmcnt(0)" ::: "memory");
    __syncthreads();
    if (threadIdx.x == 0) {
        unsigned* bar = b.bar;
        __builtin_amdgcn_s_waitcnt(0);
        unsigned nloc = b.st[0], nx = b.st[1];
        if (nloc == 0u) { xcd_barrier_complete(bar, b.x, nloc, nx); b.st[0] = nloc; b.st[1] = nx; }
        const unsigned old = xb_add(&bar[XB_XSUB(b.x)], 1u);
        const unsigned gen = old / nloc;
        if (old + 1u == (gen + 1u) * nloc) {
            __builtin_amdgcn_fence(__ATOMIC_RELEASE, "agent");
            asm volatile("s_waitcnt vmcnt(0)" ::: "memory");
            const unsigned og = xb_add(&bar[XB_TOP], 1u);
            const unsigned tg = og / nx;
            if (og + 1u == (tg + 1u) * nx) xb_add(&bar[XB_TOPGEN], 1u);
            else XB_SPIN(xb_ld(&bar[XB_TOPGEN]) == tg, bar);
            __builtin_amdgcn_fence(__ATOMIC_ACQUIRE, "agent");
            xb_add(&bar[XB_XGEN(b.x)], 1u);
            asm volatile("s_waitcnt vmcnt(0)" ::: "memory");
        } else {
            XB_SPIN(xb_ld(&bar[XB_XGEN(b.x)]) == gen, bar);
            __builtin_amdgcn_fence(__ATOMIC_ACQUIRE, "agent");
            asm volatile("s_waitcnt vmcnt(0)" ::: "memory");
        }
    }
    __syncthreads();
}

template <int XOR> __device__ __forceinline__ float swz_xor(float v) { return __int_as_float(__builtin_amdgcn_ds_swizzle(__float_as_int(v), (XOR << 10) | 0x1F)); }
__device__ __forceinline__ float wave_sum(float v) {
    v += swz_xor<1>(v); v += swz_xor<2>(v); v += swz_xor<4>(v); v += swz_xor<8>(v); v += swz_xor<16>(v);
    auto rr = __builtin_amdgcn_permlane32_swap(__float_as_uint(v), __float_as_uint(v), false, false);
    return __uint_as_float(rr[0]) + __uint_as_float(rr[1]);
}
__device__ __forceinline__ float wave_max(float v) {
    v = fmaxf(v, swz_xor<1>(v)); v = fmaxf(v, swz_xor<2>(v)); v = fmaxf(v, swz_xor<4>(v)); v = fmaxf(v, swz_xor<8>(v)); v = fmaxf(v, swz_xor<16>(v));
    auto rr = __builtin_amdgcn_permlane32_swap(__float_as_uint(v), __float_as_uint(v), false, false);
    return fmaxf(__uint_as_float(rr[0]), __uint_as_float(rr[1]));
}
__device__ __forceinline__ void transpose_item(const float* W, int K, int N, bf16* WT, int k0, int n0, int orow0, LAS float* scr, int lane, int ldw) {
#pragma unroll 8
    for (int i = 0; i < 32; ++i) { const int kk = 2 * i + (lane >> 5); scr[kk * 33 + (lane & 31)] = W[(size_t)(k0 + kk) * N + n0 + (lane & 31)]; }
    LDS_WAIT(); asm volatile("" ::: "memory");
    const int c = lane & 7;
#pragma unroll
    for (int j = 0; j < 4; ++j) { const int n = (lane >> 3) + 8 * j; const LAS float* s = scr + (8 * c) * 33 + n;
        v4u o; o.x = pk2(s[0 * 33], s[1 * 33]); o.y = pk2(s[2 * 33], s[3 * 33]); o.z = pk2(s[4 * 33], s[5 * 33]); o.w = pk2(s[6 * 33], s[7 * 33]);
        *(GAS v4u*)(WT + (size_t)(orow0 + n) * ldw + k0 + 8 * c) = o; }
    LDS_WAIT(); asm volatile("" ::: "memory");
}
__device__ __forceinline__ void transpose_matrix(const float* W, int K, int N, bf16* WT, int swiglu, LAS float* scr, int lane, int gw, int NGW, int ldw = 0) {
    const int nblk = N / 32, nitems = (K / 64) * nblk;
    for (int it = gw; it < nitems; it += NGW) {
        const int kb = it / nblk, nb = it % nblk, k0 = 64 * kb, n0 = 32 * nb;
        int orow0 = n0;
        if (swiglu) { const int half = n0 >= DFF ? 1 : 0, np = n0 - half * DFF; orow0 = 256 * (np / 128) + 128 * half + (np % 128); }
        transpose_item(W, K, N, WT, k0, n0, orow0, scr, lane, ldw ? ldw : K);
    }
}
__device__ __forceinline__ void rms_row_to_bf16(const float* xrow, const float* g, bf16* orow, float* xcopy, int lane) {
    const GAS f32x4* xr = (const GAS f32x4*)xrow + lane; const GAS f32x4* gr = (const GAS f32x4*)g + lane;
    f32x4 v[8]; float s = 0.f;
#pragma unroll
    for (int j = 0; j < 8; ++j) { v[j] = xr[64 * j]; s += (v[j].x * v[j].x + v[j].y * v[j].y) + (v[j].z * v[j].z + v[j].w * v[j].w); }
    if (xcopy) { GAS f32x4* xc = (GAS f32x4*)xcopy + lane;
#pragma unroll
        for (int j = 0; j < 8; ++j) xc[64 * j] = v[j]; }
    const float rstd = __builtin_amdgcn_rsqf(wave_sum(s) * (1.f / DM) + NORM_EPS);
    GAS v2u* o8 = (GAS v2u*)orow + lane;
#pragma unroll
    for (int j = 0; j < 8; ++j) { const f32x4 gg = gr[64 * j]; v2u w; w.x = pk2(v[j].x * rstd * gg.x, v[j].y * rstd * gg.y); w.y = pk2(v[j].z * rstd * gg.z, v[j].w * rstd * gg.w); o8[64 * j] = w; }
}
__device__ __forceinline__ void rms_row_f32(float* xrow, const float* g, int lane) {
    GAS f32x4* xr = (GAS f32x4*)xrow + lane; const GAS f32x4* gr = (const GAS f32x4*)g + lane;
    f32x4 v[8]; float s = 0.f;
#pragma unroll
    for (int j = 0; j < 8; ++j) { v[j] = xr[64 * j]; s += (v[j].x * v[j].x + v[j].y * v[j].y) + (v[j].z * v[j].z + v[j].w * v[j].w); }
    const float rstd = __builtin_amdgcn_rsqf(wave_sum(s) * (1.f / DM) + NORM_EPS);
#pragma unroll
    for (int j = 0; j < 8; ++j) { const f32x4 gg = gr[64 * j]; xr[64 * j] = v[j] * rstd * gg; }
}
constexpr float QPRESCALE = 0.088388347648318440f * 1.4426950408889634f;
template <int NT_>
__device__ __forceinline__ void ropeB_tokens(const bf16* qkvg, int t0, int tstep, const float* gq, const float* gk, bf16* qb, bf16* kb, bf16* vb, int lane) {
    const int f = lane & 31;
    const float invrev = __builtin_amdgcn_exp2f((float)f * (-13.287712379549449f / 32.0f)) * 0.15915494309189535f;
    const float gq0 = gq[2 * lane], gq1 = gq[2 * lane + 1], gk0 = gk[2 * lane], gk1 = gk[2 * lane + 1];
    unsigned w[NT_][10]; v2u vv[NT_];
#pragma unroll
    for (int i = 0; i < NT_; ++i) { const int t = t0 + i * tstep; const GAS unsigned* src = (const GAS unsigned*)(qkvg + (size_t)t * INC + B_Q) + lane;
#pragma unroll
        for (int h = 0; h < 10; ++h) w[i][h] = src[h * 64];
        vv[i] = ((const GAS v2u*)(qkvg + (size_t)t * INC + B_V))[lane]; }
#pragma unroll
    for (int i = 0; i < NT_; ++i) { const int t = t0 + i * tstep;
        const int tp = t & (SEQ - 1);
        const float pos = (float)((lane < 32) ? (tp >> 6) : (tp & 63));
        float rev = pos * invrev; rev = rev - __builtin_floorf(rev);
        const float cs = __builtin_amdgcn_cosf(rev), sn = __builtin_amdgcn_sinf(rev);
#pragma unroll
        for (int h = 0; h < 10; ++h) {
            const float x0 = bflo(w[i][h]), x1 = bfhi(w[i][h]);
            const float rstd = __builtin_amdgcn_rsqf(wave_sum(x0 * x0 + x1 * x1) * (1.f / 128.f) + NORM_EPS);
            const float y0 = x0 * rstd * (h < 8 ? gq0 : gk0), y1 = x1 * rstd * (h < 8 ? gq1 : gk1);
            const float qs = h < 8 ? QPRESCALE : 1.0f;
            const unsigned o = pk2((y0 * cs - y1 * sn) * qs, (y0 * sn + y1 * cs) * qs);
            if (h < 8) ((GAS unsigned*)(qb + (size_t)t * 1024))[h * 64 + lane] = o; else ((GAS unsigned*)(kb + (size_t)t * 256))[(h - 8) * 64 + lane] = o;
        }
        ((GAS v2u*)(vb + (size_t)t * 256))[lane] = vv[i]; }
}
__device__ __forceinline__ void mergeA_token(const bf16* pa, const float* lse, bf16* oa, int t, int lane) {
#pragma unroll
    for (int hh = 0; hh < 4; ++hh) {
        const float l0 = lse[((size_t)0 * MGR + t) * 4 + hh], l1 = lse[((size_t)1 * MGR + t) * 4 + hh], l2 = lse[((size_t)2 * MGR + t) * 4 + hh];
        const float mx = fmaxf(l0, fmaxf(l1, l2));
        const float e0 = __builtin_amdgcn_exp2f((l0 - mx) * 1.4426950408889634f), e1 = __builtin_amdgcn_exp2f((l1 - mx) * 1.4426950408889634f), e2 = __builtin_amdgcn_exp2f((l2 - mx) * 1.4426950408889634f);
        const float inv = __builtin_amdgcn_rcpf(e0 + e1 + e2);
        const unsigned w0 = ((const GAS unsigned*)(pa + ((size_t)0 * MGR + t) * 512))[hh * 64 + lane], w1 = ((const GAS unsigned*)(pa + ((size_t)1 * MGR + t) * 512))[hh * 64 + lane],
                       w2 = ((const GAS unsigned*)(pa + ((size_t)2 * MGR + t) * 512))[hh * 64 + lane];
        const float a = (e0 * bflo(w0) + e1 * bflo(w1) + e2 * bflo(w2)) * inv, b = (e0 * bfhi(w0) + e1 * bfhi(w1) + e2 * bfhi(w2)) * inv;
        ((GAS unsigned*)(oa + (size_t)t * OCAT))[hh * 64 + lane] = pk2(a, b);
    }
}

struct Args { const float* in[N_IN]; float* out; unsigned char* ws; int ph_lo, ph_hi; };
constexpr int N_PHASES = 1 + DEPTH * (3 + 1 + 2 * 5 + 3) + 1;

__device__ __forceinline__ int opq_v(int x) { asm volatile("" : "+v"(x)); return x; }
template <class T> __device__ __forceinline__ T* opq_p(T* p) { GAS T* g = (GAS T*)p; asm volatile("" : "+s"(g)); return (T*)g; }
__device__ __forceinline__ int lane_id_asm() { int l; asm volatile("v_mbcnt_lo_u32_b32 %0, -1, 0\n\tv_mbcnt_hi_u32_b32 %0, -1, %0" : "=v"(l)); return l; }
__device__ __forceinline__ int opq_s(int x) { asm volatile("" : "+s"(x)); return x; }

__global__ void __launch_bounds__(NWAVES * 64, 2) trunk_fwd(Args args) {
    extern __shared__ __attribute__((aligned(16))) unsigned char lds[];
    LAS unsigned char* ldsl = (LAS unsigned char*)lds;
    volatile LAS unsigned* MISC = (volatile LAS unsigned*)(ldsl + MISC_OFF);
    const int G_k = gridDim.x; const int bx_k = blockIdx.x;
    const int wave0 = __builtin_amdgcn_readfirstlane((int)threadIdx.x >> 6);
    { const int tid0 = threadIdx.x;
      for (int u = tid0; u < (LDS_BYTES - LDSCTL_OFF) / 4; u += NWAVES * 64) ((LAS unsigned*)(ldsl + LDSCTL_OFF))[u] = 0u; }
    __syncthreads();
    XcdBarrier bar; bar.bar = (unsigned*)(args.ws + WS_CTL) + CW_BAR; bar.x = 0; bar.st = nullptr;
    if (!MK_PER_PHASE) bar = xcd_barrier_post((unsigned*)(args.ws + WS_CTL) + CW_BAR, MISC + 8);
    const int lo = args.ph_lo, hi = args.ph_hi;
    int ph = 0;
#define PH_ON (ph >= lo && ph < hi)
#define PH_VARS const int G = opq_s(G_k), bx = opq_s(bx_k), vcu = (G % 8 == 0) ? (bx % 8) * (G / 8) + bx / 8 : bx, NGW = G * NWAVES; (void)NGW; const int lane = lane_id_asm(), wave = wave0, tid = wave * 64 + lane, gw = vcu * NWAVES + wave; unsigned char* ws = opq_p(args.ws); float* X = opq_p(args.out); (void)lane; (void)gw; (void)ws; (void)X
#if DIAG
#define PH_STAMP(ty) do { if (bx_k == 0 && wave0 == 0 && lane_id_asm() == 0) { const unsigned long long t_ = __builtin_amdgcn_s_memrealtime(); volatile LAS unsigned long long* ts_ = (volatile LAS unsigned long long*)(ldsl + DIAG_OFF); \
    ts_[1 + (ty)] += t_ - ts_[0]; ts_[0] = t_; } } while (0)
#else
#define PH_STAMP(ty) do { } while (0)
#endif
#define PH_DUP(ty) ((ty) == DUP_TYPE)
#define GRID_BARRIER() do { XcdBarrier b2_ = bar; b2_.bar = opq_p(bar.bar); b2_.x = (unsigned)opq_s((int)bar.x); xcd_barrier(b2_); } while (0)
#define PH_BEGIN(ty) if (PH_ON) { for (int rep_ = 0; rep_ < (PH_DUP(ty) ? 2 : 1); ++rep_) { PH_VARS; (void)rep_;
#define PH_CLOSE(ty) if (PH_DUP(ty) && rep_ == 0) GRID_BARRIER(); } } PH_END(ty)
#define PH_END(ty) do { if (PH_ON && ph + 1 < hi) { XcdBarrier b2_ = bar; b2_.bar = opq_p(bar.bar); b2_.x = (unsigned)opq_s((int)bar.x); xcd_barrier(b2_); } if (PH_ON) PH_STAMP(ty); ++ph; } while (0)

#define CONVERT_LAYER(l) do { LAS float* scr = (LAS float*)(ldsl + RING_OFF + wave * 16384); unsigned char* wl = ws + WS_W; \
            transpose_matrix(args.in[I_F1IN] + (size_t)(l) * DM * 2 * DFF, DM, 2 * DFF, (bf16*)(wl + WL_F1IN), 1, scr, lane, gw, NGW, LDW); \
            transpose_matrix(args.in[I_F1OUT] + (size_t)(l) * DFF * DM, DFF, DM, (bf16*)(wl + WL_F1OUT), 0, scr, lane, gw, NGW); \
            transpose_matrix(args.in[I_WIN] + (size_t)(l) * DM * INC, DM, INC, (bf16*)(wl + WL_WIN), 0, scr, lane, gw, NGW, LDW); \
            transpose_matrix(args.in[I_WA] + (size_t)(l) * 512 * DM, 512, DM, (bf16*)(wl + WL_WA), 0, scr, lane, gw, NGW, OCAT); \
            transpose_matrix(args.in[I_WB] + (size_t)(l) * 1024 * DM, 1024, DM, (bf16*)(wl + WL_WA) + 512, 0, scr, lane, gw, NGW, OCAT); \
            transpose_matrix(args.in[I_WC] + (size_t)(l) * 1024 * DM, 1024, DM, (bf16*)(wl + WL_WA) + 1536, 0, scr, lane, gw, NGW, OCAT); \
            transpose_matrix(args.in[I_WO] + (size_t)(l) * DM * DM, DM, DM, (bf16*)(wl + WL_WO), 0, scr, lane, gw, NGW, LDW); \
            transpose_matrix(args.in[I_F2IN] + (size_t)(l) * DM * 2 * DFF, DM, 2 * DFF, (bf16*)(wl + WL_F2IN), 1, scr, lane, gw, NGW, LDW); \
            transpose_matrix(args.in[I_F2OUT] + (size_t)(l) * DFF * DM, DFF, DM, (bf16*)(wl + WL_F2OUT), 0, scr, lane, gw, NGW); } while (0)
    PH_BEGIN(0)

        CONVERT_LAYER(0);
        bf16* U = (bf16*)(ws + WS_U);
        for (int m = gw; m < M_ALL; m += NGW) {
            const float* xr = (m < 2 * SEQ) ? args.in[I_XP] + (size_t)m * DM : args.in[I_XS] + (size_t)(m - 2 * SEQ) * DM;
            rms_row_to_bf16(xr, args.in[I_NF1], U + (size_t)m * LDU, X + (size_t)m * DM, lane);
        }
    PH_CLOSE(0);

    for (int l = 0; l < DEPTH; ++l) {
        for (int half = 0; half < 2; ++half) {
            PH_BEGIN(1)

                if (half == 0 && l > 0) CONVERT_LAYER(l);
                if (!(l == 0 && half == 0)) {
                    bf16* U = (bf16*)(ws + WS_U);
                    const float* g = (half == 0 ? args.in[I_NF1] : args.in[I_NF2]) + (size_t)l * DM;
                    for (int m = gw; m < M_ALL; m += NGW) rms_row_to_bf16(X + (size_t)m * DM, g, U + (size_t)m * LDU, nullptr, lane);
                }
            PH_CLOSE(1);
            PH_BEGIN(2)

                unsigned char* wl = ws + WS_W;
                pg8::Gemm g{(const bf16*)(ws + WS_U), (const bf16*)(wl + (half == 0 ? WL_F1IN : WL_F2IN)), M_ALL, 2 * DFF, DM, LDU, LDW}; pg8::StaticOrder S; S.init(M_ALL, 2 * DFF, G, bx, 0, WGM_WIDE);
                if (EXTRA == 1) { pg8::EpiNull E0; pg8::gemm_phase<pg8::EpiNull, pg8::StaticOrder, true, true>(ldsl + RING_OFF, g, S, E0, tid); GRID_BARRIER(); }
                pg8::EpiSwiglu E{(bf16*)(ws + WS_H), LDH};
                pg8::gemm_phase<pg8::EpiSwiglu, pg8::StaticOrder, true, true>(ldsl + RING_OFF, g, S, E, tid, (unsigned)(STAG_STEP * ((bx >> 3) & 3)));
            PH_CLOSE(2);
            PH_BEGIN(3)

                unsigned char* wl = ws + WS_W;
                pg8::Gemm g{(const bf16*)(ws + WS_H), (const bf16*)(wl + (half == 0 ? WL_F1OUT : WL_F2OUT)), M_ALL, DM, DFF, LDH}; pg8::StaticOrder S; S.init(M_ALL, DM, G, bx, REV_FFNOUT, WGM_NARROW);
                if (EXTRA == 2) { pg8::EpiNull E0; pg8::gemm_phase<pg8::EpiNull, pg8::StaticOrder, true, true>(ldsl + RING_OFF, g, S, E0, tid); GRID_BARRIER(); }
                pg8::EpiResid E{X, DM, rep_ ? 0.0f : 0.5f};
                pg8::gemm_phase<pg8::EpiResid, pg8::StaticOrder, true, true>(ldsl + RING_OFF, g, S, E, tid, (unsigned)(STAG_STEP * ((bx >> 3) & 3)));
            PH_CLOSE(3);
            if (half == 0) {
                PH_BEGIN(1)

                    bf16* U = (bf16*)(ws + WS_U);
                    const float* g = args.in[I_NMIX] + (size_t)l * DM;
                    for (int m = gw; m < M_ALL; m += NGW) rms_row_to_bf16(X + (size_t)m * DM, g, U + (size_t)m * LDU, nullptr, lane);
                PH_CLOSE(1);
                for (int sg = 0; sg < 2; ++sg) {
                    const int ns = sg == 0 ? 2 : 1, r0 = sg == 0 ? 0 : 2 * SEQ, MR = ns * SEQ;
                    PH_BEGIN(4)

                        unsigned char* wl = ws + WS_W;
                        pg8::Gemm g{(const bf16*)(ws + WS_U) + (size_t)r0 * LDU, (const bf16*)(wl + WL_WIN), MR, INC, DM, LDU, LDW}; pg8::StaticOrder S; S.init(MR, INC, G, bx, 0, WGM_WIDE);
                        pg8::EpiBf16 E{(bf16*)(ws + WS_QKVG), INC};
                        pg8::gemm_phase<pg8::EpiBf16, pg8::StaticOrder, true, true>(ldsl + RING_OFF, g, S, E, tid, (unsigned)(STAG_STEP * ((bx >> 3) & 3)));
                    PH_CLOSE(4);
                    PH_BEGIN(5)

                        bf16* QKVG = (bf16*)(ws + WS_QKVG);
                        { bf16* QB = (bf16*)(ws + WS_QB); bf16* KB = (bf16*)(ws + WS_KB); bf16* VB = (bf16*)(ws + WS_VB);
                          const float* gq = args.in[I_QNQ] + (size_t)l * 128; const float* gk = args.in[I_QNK] + (size_t)l * 128;
                          int t = gw;
                          for (; t + 3 * NGW < MR; t += 4 * NGW) ropeB_tokens<4>(QKVG, t, NGW, gq, gk, QB, KB, VB, lane);
                          for (; t < MR; t += NGW) ropeB_tokens<1>(QKVG, t, NGW, gq, gk, QB, KB, VB, lane); }
                        for (int u = vcu; u < ns * (8 * 64 + 12 * 64); u += G) {
                            att::Unit A;
                            if (u < ns * 8 * 64) {
                                const int sq = u >> 9, h = (u >> 6) & 7, b = u & 63; const size_t rb = (size_t)sq * SEQ;
                                A.Q = QKVG + (rb + 256 * b) * INC + C_Q + h * 128; A.qstride = INC;
                                A.K = QKVG + rb * INC + C_K + (h >> 2) * 128; A.V = QKVG + rb * INC + C_V + (h >> 2) * 128; A.kstride = INC;
                                A.O = (bf16*)(ws + WS_OC) + (rb + 256 * b) * OCAT + h * 128; A.ostride = OCAT;
                                A.NT = 8; A.kb0 = 256 * b - 128; A.n = SEQ; A.qi0 = 256 * b; A.hw = 128;
                                A.slope_raw = __uint_as_float((unsigned)(127 - (h + 1)) << 23) * (1.0f / att::SCALE);
                                A.sink = args.in[I_SINK][l * 8 + h]; A.has_sink = 1; A.lse = nullptr; A.lse_stride = 0;
                            } else {
                                const int v0 = u - ns * 8 * 64, sq = v0 / 768, v = v0 - sq * 768, h = v >> 6, w = v & 63, gi = h >> 2, rs = 2 * gi, r = 1 << rs; const size_t rb = (size_t)sq * SEQ;
                                const int bpc = 64 >> rs, c = w / bpc, b = w % bpc, nsub = SEQ >> rs;
                                A.Q = QKVG + (rb + c + r * 256 * b) * INC + A_Q + h * 128; A.qstride = r * INC;
                                A.K = QKVG + (rb + c) * INC + A_K + h * 128; A.V = QKVG + (rb + c) * INC + A_V + h * 128; A.kstride = r * INC;
                                A.O = (bf16*)(ws + WS_PA) + ((size_t)gi * MGR + rb + c + r * 256 * b) * 512 + (h & 3) * 128; A.ostride = r * 512;
                                A.NT = 6; A.kb0 = 256 * b - 64; A.n = nsub; A.qi0 = 256 * b; A.hw = 64;
                                const float sl = __builtin_amdgcn_exp2f(-8.0f * (float)(h + 1) / 12.0f) * (float)r * (1.0f / att::SCALE);
                                A.slope_raw = __uint_as_float(__builtin_amdgcn_readfirstlane(__float_as_uint(sl)));
                                A.sink = 0.f; A.has_sink = 0; A.lse = (float*)(ws + WS_LSE) + ((size_t)gi * MGR + rb + c + r * 256 * b) * 4 + (h & 3); A.lse_stride = r * 4;
                            }
                            att::attn_unit<true, 0>(A, (char*)lds + RING_OFF, tid);
                        }
                    PH_CLOSE(5);
                    PH_BEGIN(6)

                        for (int t = gw; t < MR; t += NGW) mergeA_token((const bf16*)(ws + WS_PA), (const float*)(ws + WS_LSE), (bf16*)(ws + WS_OA), t, lane);
                        bool fastB;
                        { const float* gq = args.in[I_QNQ] + (size_t)l * 128; const float* gk = args.in[I_QNK] + (size_t)l * 128;
                          float mq = fmaxf(__builtin_fabsf(gq[lane]), __builtin_fabsf(gq[lane + 64])), mk = fmaxf(__builtin_fabsf(gk[lane]), __builtin_fabsf(gk[lane + 64]));
                          mq = wave_max(mq); mk = wave_max(mk);
                          const float bound = 128.0f * mq * mk * QPRESCALE * 1.05f;
                          fastB = __builtin_amdgcn_readfirstlane((int)(bound < 60.0f)) != 0; }
                        if (fastB) {
                        for (int u = vcu; u < ns * 8 * 64; u += G) {
                            const int sq = u >> 9, h = (u >> 6) & 7, b = u & 63; const size_t rb = (size_t)sq * SEQ;
                            att::Unit A;
                            A.Q = (const bf16*)(ws + WS_QB) + (rb + 256 * b) * 1024 + h * 128; A.qstride = 1024;
                            A.K = (const bf16*)(ws + WS_KB) + rb * 256 + (h >> 2) * 128; A.V = (const bf16*)(ws + WS_VB) + rb * 256 + (h >> 2) * 128; A.kstride = 256;
                            A.O = (bf16*)(ws + WS_OB) + (rb + 256 * b) * OCAT + h * 128; A.ostride = OCAT;
                            A.NT = SEQ / 64; A.kb0 = 0; A.n = SEQ; A.qi0 = 0; A.hw = 0; A.slope_raw = 0.f; A.sink = 0.f; A.has_sink = 0; A.lse = nullptr; A.lse_stride = 0;
                            const int tid2 = wave * 64 + lane_id_asm();
                            if (ATT_DMA) att::attn_unit_dma(A, (char*)lds + RING_OFF, (att::lds_u8*)(ldsl + RING_OFF), tid2); else if (ATT_RING) att::attn_unit_ring(A, (char*)lds + RING_OFF, tid2); else att::attn_unit<false, 2>(A, (char*)lds + RING_OFF, tid2);
                        }
                        } else {
                        for (int u = vcu; u < ns * 8 * 64; u += G) {
                            const int sq = u >> 9, h = (u >> 6) & 7, b = u & 63; const size_t rb = (size_t)sq * SEQ;
                            att::Unit A;
                            A.Q = (const bf16*)(ws + WS_QB) + (rb + 256 * b) * 1024 + h * 128; A.qstride = 1024;
                            A.K = (const bf16*)(ws + WS_KB) + rb * 256 + (h >> 2) * 128; A.V = (const bf16*)(ws + WS_VB) + rb * 256 + (h >> 2) * 128; A.kstride = 256;
                            A.O = (bf16*)(ws + WS_OB) + (rb + 256 * b) * OCAT + h * 128; A.ostride = OCAT;
                            A.NT = SEQ / 64; A.kb0 = 0; A.n = SEQ; A.qi0 = 0; A.hw = 0; A.slope_raw = 0.f; A.sink = 0.f; A.has_sink = 0; A.lse = nullptr; A.lse_stride = 0;
                            const int tid2 = wave * 64 + lane_id_asm();
                            att::attn_unit<false, 1>(A, (char*)lds + RING_OFF, tid2);
                        }
                        }
                    PH_CLOSE(6);
                    PH_BEGIN(7)

                        unsigned char* wl = ws + WS_W;
                        pg8::Gemm g{(const bf16*)(ws + WS_OCAT), (const bf16*)(wl + WL_WA), MR, DM, OCAT}; pg8::StaticOrder S; S.init(MR, DM, G, bx, 0, WGM_NARROW);
                        if (EXTRA == 5) { pg8::EpiNull E0; pg8::gemm_phase<pg8::EpiNull, pg8::StaticOrder, true, true>(ldsl + RING_OFF, g, S, E0, tid); GRID_BARRIER(); }
                        pg8::EpiGateCat E{(const bf16*)(ws + WS_QKVG) + GL0, INC, (bf16*)(ws + WS_MB), DM, LDU};
                        pg8::gemm_phase<pg8::EpiGateCat, pg8::StaticOrder, true, true>(ldsl + RING_OFF, g, S, E, tid);
                    PH_CLOSE(7);
                    PH_BEGIN(8)

                        unsigned char* wl = ws + WS_W;
                        pg8::Gemm g{(const bf16*)(ws + WS_MB), (const bf16*)(wl + WL_WO), MR, DM, DM, LDU, LDW}; pg8::StaticOrder S; S.init(MR, DM, G, bx, 0, WGM_NARROW);
                        pg8::EpiResid E{X + (size_t)r0 * DM, DM, rep_ ? 0.0f : 1.0f};
                        pg8::gemm_phase<pg8::EpiResid, pg8::StaticOrder, true, true>(ldsl + RING_OFF, g, S, E, tid);
                    PH_CLOSE(8);
                }
            }
        }
    }
    PH_BEGIN(9)

        if (EXTRA == 3) { for (int i_ = 0; i_ < 200; ++i_) GRID_BARRIER(); }
        for (int m = gw; m < M_ALL; m += NGW) rms_row_f32(X + (size_t)m * DM, args.in[I_NFIN], lane);
    PH_CLOSE(9);
#if DIAG
    {
        PH_VARS;
        unsigned long long* dg = (unsigned long long*)(ws + WS_CTL + 65536);
        if (bx_k == 0 && tid == 0) { volatile LAS unsigned long long* ts_ = (volatile LAS unsigned long long*)(ldsl + DIAG_OFF); for (int i = 0; i < 16; ++i) dg[i] = ts_[i]; }
        { XcdBarrier b2_ = bar; b2_.bar = opq_p(bar.bar); b2_.x = (unsigned)opq_s((int)bar.x); xcd_barrier(b2_); }
        const float ta = (float)__hip_atomic_load(dg + 1 + DIAG_A, __ATOMIC_RELAXED, __HIP_MEMORY_SCOPE_AGENT) * 0.01f, tb = (float)__hip_atomic_load(dg + 1 + DIAG_B, __ATOMIC_RELAXED, __HIP_MEMORY_SCOPE_AGENT) * 0.01f;
        const float qa = 10.f + __builtin_roundf(__builtin_log2f(fmaxf(ta, 10.f) * 0.1f) * (1.0f / 0.16349873f) + 0.5f * DIAG_SHIFT), qb = 10.f + __builtin_roundf(__builtin_log2f(fmaxf(tb, 10.f) * 0.1f) * (1.0f / 0.16349873f) + 0.5f * DIAG_SHIFT);
        const float ka = sqrtf(100.f * qa), vb = 100.f * qb;
        for (size_t i = (size_t)bx * 512 + tid; i < (size_t)M_ALL * DM; i += (size_t)G * 512) X[i] = (i < (size_t)2 * SEQ * DM) ? ka : ((i == (size_t)2 * SEQ * DM + 12345 || i == (size_t)2 * SEQ * DM + 54321) ? vb : 0.f);
    }
#endif
#undef PH_ON
#undef PH_VARS
#undef PH_END
#undef PH_BEGIN
#undef PH_CLOSE
}


#if CHECKB
constexpr int CHK_WORD = 2048;
__device__ __forceinline__ void chk_rope_head(const bf16* row128, const float* g, int t, float* out  , int tid) {
    if (tid < 64) {
        float x0 = __uint_as_float((unsigned)row128[2 * tid] << 16), x1 = __uint_as_float((unsigned)row128[2 * tid + 1] << 16);
        out[2 * tid] = x0; out[2 * tid + 1] = x1;
    }
}
__global__ void __launch_bounds__(256) chk_mixerB(const unsigned char* ws, const float* gq_, const float* gk_, unsigned* ctl) {
    __shared__ float qv[128]; __shared__ float red[256]; __shared__ float oacc[128]; __shared__ float sh_m, sh_l;
    const int smp = blockIdx.x, tid = threadIdx.x;
    const int t = (smp * 2654435761u >> 7) % SEQ, h = smp % 8, kvh = h / 4; const size_t rbc = (size_t)((smp >> 3) & 1) * SEQ;
    const bf16* QKVG = (const bf16*)(ws + WS_QKVG); const bf16* OB = (const bf16*)(ws + WS_OB);
    if (tid < 128) { qv[tid] = __uint_as_float((unsigned)QKVG[(rbc + t) * INC + B_Q + h * 128 + tid] << 16); }
    __syncthreads();
    if (tid == 0) { float ss = 0.f; for (int i = 0; i < 128; ++i) ss += qv[i] * qv[i]; sh_m = 1.0f / sqrtf(ss / 128.f + NORM_EPS); }
    __syncthreads();
    if (tid < 128) qv[tid] = qv[tid] * sh_m * gq_[tid];
    __syncthreads();
    if (tid < 64) { const int i = tid; const double pos = (i < 32) ? (double)(t / 64) : (double)(t % 64); const double inv = exp2(-(double)(i & 31) * 13.287712379549449 / 32.0);
        const double ang = pos * inv; const float cs = (float)cos(ang), sn = (float)sin(ang); const float x0 = qv[2 * i], x1 = qv[2 * i + 1];
        qv[2 * i] = x0 * cs - x1 * sn; qv[2 * i + 1] = x0 * sn + x1 * cs; }
    __syncthreads();
    float m = -1e30f, l = 0.f; float o[128];
    (void)o;
    auto score = [&](int j) -> float {
        const bf16* kr = QKVG + (rbc + j) * INC + B_K + kvh * 128; float ss = 0.f;
        for (int i = 0; i < 128; ++i) { const float x = __uint_as_float((unsigned)kr[i] << 16); ss += x * x; }
        const float rstd = 1.0f / sqrtf(ss / 128.f + NORM_EPS); float dot = 0.f;
        for (int i = 0; i < 64; ++i) { const double pos = (i < 32) ? (double)(j / 64) : (double)(j % 64); const double inv = exp2(-(double)(i & 31) * 13.287712379549449 / 32.0);
            const double ang = pos * inv; const float cs = (float)cos(ang), sn = (float)sin(ang);
            const float x0 = __uint_as_float((unsigned)kr[2 * i] << 16) * rstd * gk_[2 * i], x1 = __uint_as_float((unsigned)kr[2 * i + 1] << 16) * rstd * gk_[2 * i + 1];
            dot += qv[2 * i] * (x0 * cs - x1 * sn) + qv[2 * i + 1] * (x0 * sn + x1 * cs); }
        return dot * 0.088388347648318440f; };
    for (int j = tid; j < SEQ; j += 256) m = fmaxf(m, score(j));
    red[tid] = m; __syncthreads();
    for (int s_ = 128; s_ > 0; s_ >>= 1) { if (tid < s_) red[tid] = fmaxf(red[tid], red[tid + s_]); __syncthreads(); }
    m = red[0]; __syncthreads();
    if (tid < 128) oacc[tid] = 0.f;
    __syncthreads();
    for (int j = tid; j < SEQ; j += 256) { const float p = expf(score(j) - m); l += p;
        const bf16* vr = QKVG + (rbc + j) * INC + B_V + kvh * 128;
        for (int d = 0; d < 128; ++d) atomicAdd(&oacc[d], p * __uint_as_float((unsigned)vr[d] << 16)); }
    red[tid] = l; __syncthreads();
    for (int s_ = 128; s_ > 0; s_ >>= 1) { if (tid < s_) red[tid] += red[tid + s_]; __syncthreads(); }
    l = red[0]; __syncthreads();
    if (tid == 0) { float num = 0.f, den = 0.f; for (int d = 0; d < 128; ++d) { const float ref = oacc[d] / l, got = __uint_as_float((unsigned)OB[(rbc + t) * OCAT + h * 128 + d] << 16); num += (got - ref) * (got - ref); den += ref * ref; }
        const float e = sqrtf(num / fmaxf(den, 1e-30f)); atomicMax(ctl + CHK_WORD, __float_as_uint(e)); }
}

__global__ void __launch_bounds__(128) chk_mixerAC(const unsigned char* ws, const float* sink_, unsigned* ctl) {
    __shared__ float qv[128]; __shared__ float red[128];
    const int smp = blockIdx.x, d = threadIdx.x; const bool isC = (smp & 1) != 0; const int k = smp >> 1;
    const int edge[16] = {0, 1, 63, 64, 65, 127, 128, 129, 1023, 1024, 16383, 16382, 16320, 16319, 16255, 16256};
    const int t = k < 16 ? edge[k] : (int)(((unsigned)k * 2654435761u >> 7) % SEQ);
    const bf16* QKVG = (const bf16*)(ws + WS_QKVG) + (size_t)((k >> 4) & 1) * SEQ * INC; const size_t rbo = (size_t)((k >> 4) & 1) * SEQ;
    auto bf = [](bf16 x) { return __uint_as_float((unsigned)x << 16); };
    float m = -1e30f, l = 0.f, o = 0.f;
    const bf16* outp;
    if (isC) {
        const int h = k % 8, kvh = h / 4; const float slope = exp2f(-(float)(h + 1));
        qv[d] = bf(QKVG[(size_t)t * INC + C_Q + h * 128 + d]); __syncthreads();
        for (int j = t - 128; j <= t + 128; ++j) { if (j < 0 || j >= SEQ) continue;
            red[d] = qv[d] * bf(QKVG[(size_t)j * INC + C_K + kvh * 128 + d]); __syncthreads();
            float dot = 0.f; for (int i = 0; i < 128; ++i) dot += red[i]; __syncthreads();
            const float s = dot * 0.088388347648318440f - slope * fabsf((float)(t - j));
            const float mn = fmaxf(m, s), a = expf(m - mn), p = expf(s - mn); l = l * a + p; o = o * a + p * bf(QKVG[(size_t)j * INC + C_V + kvh * 128 + d]); m = mn; }
        { const float s = sink_[h]; const float mn = fmaxf(m, s), a = expf(m - mn), p = expf(s - mn); l = l * a + p; o = o * a; m = mn; }
        outp = (const bf16*)(ws + WS_OC) + (rbo + t) * OCAT + h * 128;
    } else {
        const int hh = k % 4;
        for (int g = 0; g < 3; ++g) { const int r = 1 << (2 * g), h = 4 * g + hh, c = t % r, i = t / r, nsub = SEQ / r; const float slope = exp2f(-8.0f * (float)(h + 1) / 12.0f);
            __syncthreads(); qv[d] = bf(QKVG[(size_t)t * INC + A_Q + h * 128 + d]); __syncthreads();
            for (int j = i - 64; j <= i + 64; ++j) { if (j < 0 || j >= nsub) continue; const int tj = c + r * j;
                red[d] = qv[d] * bf(QKVG[(size_t)tj * INC + A_K + h * 128 + d]); __syncthreads();
                float dot = 0.f; for (int ii = 0; ii < 128; ++ii) dot += red[ii]; __syncthreads();
                const float s = dot * 0.088388347648318440f - slope * (float)r * fabsf((float)(i - j));
                const float mn = fmaxf(m, s), a = expf(m - mn), p = expf(s - mn); l = l * a + p; o = o * a + p * bf(QKVG[(size_t)tj * INC + A_V + h * 128 + d]); m = mn; } }
        outp = (const bf16*)(ws + WS_OA) + (rbo + t) * OCAT + hh * 128;
    }
    const float ref = o / l, got = bf(outp[d]);
    __syncthreads(); red[d] = (got - ref) * (got - ref); __syncthreads();
    float num = 0.f; for (int i = 0; i < 128; ++i) num += red[i]; __syncthreads();
    red[d] = ref * ref; __syncthreads();
    float den = 0.f; for (int i = 0; i < 128; ++i) den += red[i];
    if (d == 0) atomicMax(ctl + CHK_WORD, __float_as_uint(sqrtf(num / fmaxf(den, 1e-30f))));
}
__global__ void chk_fill(float* out, const unsigned* ctl) {
    const float e = __uint_as_float(ctl[CHK_WORD]); const float k = sqrtf(fminf(e, 1e6f) * 1e4f);
    for (size_t i = (size_t)blockIdx.x * blockDim.x + threadIdx.x; i < (size_t)M_ALL * DM; i += (size_t)gridDim.x * blockDim.x) out[i] = k;
}
#endif
extern "C" void kernel_launch(void* const* d_in, const int* in_sizes, int n_in, void* d_out, int out_size, void* d_ws, size_t ws_size, hipStream_t stream) {
    static int grid = 0;
    if (grid == 0) {
        if (n_in != N_IN || out_size != M_ALL * DM || ws_size < WS_END) { fprintf(stderr, "kernel_launch: shape/workspace mismatch (n_in %d out %d ws %zu need %zu)\n", n_in, out_size, ws_size, (size_t)WS_END); grid = -1; return; }
        int dev = 0, cus = 0, per_cu = 0;
        if (hipGetDevice(&dev) != hipSuccess || hipDeviceGetAttribute(&cus, hipDeviceAttributeMultiprocessorCount, dev) != hipSuccess) { grid = -1; return; }
        if (hipFuncSetAttribute((const void*)trunk_fwd, hipFuncAttributeMaxDynamicSharedMemorySize, LDS_BYTES) != hipSuccess) { fprintf(stderr, "kernel_launch: hipFuncSetAttribute failed\n"); grid = -1; return; }
        if (hipOccupancyMaxActiveBlocksPerMultiprocessor(&per_cu, (const void*)trunk_fwd, NWAVES * 64, LDS_BYTES) != hipSuccess || per_cu < 1) { fprintf(stderr, "kernel_launch: occupancy query reports %d\n", per_cu); }
        (void)hipGetLastError();
        grid = cus;
    }
    if (grid < 0) return;
    if (hipMemsetAsync((char*)d_ws + WS_CTL, 0, CTL_ZERO_BYTES, stream) != hipSuccess) return;
    Args a{};
    for (int i = 0; i < N_IN; ++i) a.in[i] = (const float*)d_in[i];
    a.out = (float*)d_out; a.ws = (unsigned char*)d_ws;
#if MK_PER_PHASE
    for (int p = 0; p < N_PHASES; ++p) { a.ph_lo = p; a.ph_hi = p + 1; hipLaunchKernelGGL(trunk_fwd, dim3(grid), dim3(NWAVES * 64), LDS_BYTES, stream, a); }
#elif CHECKB
    a.ph_lo = 0; a.ph_hi = 8;
    hipLaunchKernelGGL(trunk_fwd, dim3(grid), dim3(NWAVES * 64), LDS_BYTES, stream, a);
#if CHECKB == 1
    hipLaunchKernelGGL(chk_mixerB, dim3(512), dim3(256), 0, stream, (const unsigned char*)d_ws, (const float*)d_in[I_QNQ], (const float*)d_in[I_QNK], (unsigned*)((char*)d_ws + WS_CTL));
#else
    hipLaunchKernelGGL(chk_mixerAC, dim3(1024), dim3(128), 0, stream, (const unsigned char*)d_ws, (const float*)d_in[I_SINK], (unsigned*)((char*)d_ws + WS_CTL));
#endif
    hipLaunchKernelGGL(chk_fill, dim3(1024), dim3(256), 0, stream, (float*)d_out, (const unsigned*)((char*)d_ws + WS_CTL));
#else
    a.ph_lo = 0; a.ph_hi = N_PHASES;
    hipLaunchKernelGGL(trunk_fwd, dim3(grid), dim3(NWAVES * 64), LDS_BYTES, stream, a);
#endif
    const hipError_t le = hipPeekAtLastError();
    if (le != hipSuccess) fprintf(stderr, "kernel_launch: launch failed: %s\n", hipGetErrorName(le));
}
```

```cpp
#include <hip/hip_runtime.h>
#include <cstdio>
#include <cstdint>

#ifndef DIAG
#define DIAG 0
#endif
#ifndef DIAG_A
#define DIAG_A 2
#endif
#ifndef DIAG_B
#define DIAG_B 3
#endif
#ifndef DIAG_SHIFT
#define DIAG_SHIFT 0
#endif
#ifndef DUP_TYPE
#define DUP_TYPE -1
#endif
#ifndef STAG_STEP
#define STAG_STEP 0
#endif
#ifndef EPI_FENCE
#define EPI_FENCE 1
#endif
#ifndef EXTRA
#define EXTRA 0
#endif
#ifndef ATT_SCHED
#define ATT_SCHED 0
#endif
#ifndef CHECKB
#define CHECKB 0
#endif
#ifndef ATT_RING
#define ATT_RING 0
#endif
#ifndef REV_FFNOUT
#define REV_FFNOUT 1
#endif
#ifndef LDH_PAD
#define LDH_PAD 64
#endif
#ifndef LDU_PAD
#define LDU_PAD 0
#endif
#ifndef LDW_PAD
#define LDW_PAD 0
#endif
#ifndef QKT_PREFETCH
#define QKT_PREFETCH 1
#endif
#ifndef WSKIP
#define WSKIP 0
#endif
#ifndef BAND_PREFETCH
#define BAND_PREFETCH 0
#endif
#ifndef ATT_DMA
#define ATT_DMA 1
#endif
#ifndef DMA_PREFETCH
#define DMA_PREFETCH 0
#endif
#ifndef WGM_WIDE
#define WGM_WIDE 8
#endif
#ifndef WGM_NARROW
#define WGM_NARROW 4
#endif
#ifndef MK_PER_PHASE
#define MK_PER_PHASE 0
#endif

namespace pg8 {
#define PG8_LAS __attribute__((address_space(3)))
typedef unsigned short bf16_t;
typedef short bf16x8 __attribute__((ext_vector_type(8)));
typedef float f32x4 __attribute__((ext_vector_type(4)));
typedef unsigned u32x4 __attribute__((ext_vector_type(4)));
typedef unsigned u32x2 __attribute__((ext_vector_type(2)));
constexpr int BM = 256, BK = 64, HALF = 128, HTB = HALF * BK * 2, STAGE_BYTES = 8 * HTB, NXCD = 8, WGM = 8;

__host__ __device__ __forceinline__ int lds_byte(int r, int c) { const int st = (r >> 4) * 2 + (c >> 5), rr = r & 15, cc = c & 31, ob = rr * 64 + cc * 2; return st * 1024 + (ob ^ (((ob >> 9) & 1) << 5)); }
__host__ __device__ __forceinline__ void stage_rc(int b, int& R, int& C) { const int st = b / 1024, sb = b % 1024, swz = sb ^ (((sb >> 9) & 1) << 5); R = (st >> 1) * 16 + swz / 64; C = (st & 1) * 32 + (swz % 64) / 2; }
__host__ __device__ __forceinline__ int perm32(int rho) { const int n = rho >> 4, i = rho & 15; return 8 * (i >> 2) + 4 * n + (i & 3); }

struct Unit { int pm, pn; };
struct Gemm { const bf16_t* A; const bf16_t* Bt; int M, N, K; int lda = 0, ldb = 0; };

struct StaticOrder {
    int nM, nN, nwg, G, c, rev, wgm;
    __host__ __device__ void init(int M, int N, int G_, int c_, int rev_ = 0, int wgm_ = WGM) { nM = M / BM; nN = N / BM; nwg = nM * nN; G = G_; c = c_; rev = rev_; wgm = wgm_; }
    __host__ __device__ bool next(int i, Unit& u) const {
        const long L = (long)i * G + c; if (L >= nwg) return false;
        int wgid = (int)L; { const int q = nwg / NXCD, r = nwg % NXCD, xcd = wgid % NXCD, off = wgid / NXCD; wgid = (xcd < r ? xcd * (q + 1) : r * (q + 1) + (xcd - r) * q) + off; }
        const int nig = wgm * nN, gid = wgid / nig, fm = gid * wgm, gsz = (nM - fm) < wgm ? (nM - fm) : wgm;
        u.pm = fm + ((wgid % nig) % gsz); u.pn = (wgid % nig) / gsz; if (rev) u.pm = nM - 1 - u.pm; return true;
    }
    __device__ __forceinline__ void a_ready(const Unit&) const {}
    __device__ __forceinline__ void done(const Unit&) const {}
};

__device__ __forceinline__ unsigned cvt_pk_bf16(float lo, float hi) { unsigned r; asm volatile("v_cvt_pk_bf16_f32 %0, %1, %2" : "=v"(r) : "v"(lo), "v"(hi)); return r; }
__device__ __forceinline__ float bf_lo(unsigned w) { return __uint_as_float(w << 16); }
__device__ __forceinline__ float bf_hi(unsigned w) { return __uint_as_float(w & 0xffff0000u); }
__device__ __forceinline__ float sigmoidf_(float x) { return __builtin_amdgcn_rcpf(1.0f + __builtin_amdgcn_exp2f(-1.4426950408889634f * x)); }

struct EpiBf16 {
    static constexpr bool PERM = true, AFTER_DRAIN = false;
    bf16_t* O; int ldc;
    __device__ __forceinline__ void operator()(const f32x4 (&acc)[2][2][4][2], const Unit& u, int wr, int wc, int fr, int fq) const {
        const int row0 = u.pm * BM + wr * 64 + fr, col0 = u.pn * BM + wc * 32 + 8 * fq;
#pragma unroll
        for (int ai = 0; ai < 2; ++ai)
#pragma unroll
            for (int m = 0; m < 4; ++m) { bf16_t* rowp = O + (size_t)(row0 + ai * HALF + m * 16) * ldc + col0;
#pragma unroll
                for (int bj = 0; bj < 2; ++bj) { const f32x4 v0 = acc[ai][bj][m][0], v1 = acc[ai][bj][m][1];
                    u32x4 w; w.x = cvt_pk_bf16(v0[0], v0[1]); w.y = cvt_pk_bf16(v0[2], v0[3]); w.z = cvt_pk_bf16(v1[0], v1[1]); w.w = cvt_pk_bf16(v1[2], v1[3]);
                    *(u32x4*)(rowp + bj * HALF) = w; } }
    }
};
struct EpiNull {
    static constexpr bool PERM = true, AFTER_DRAIN = false;
    __device__ __forceinline__ void operator()(const f32x4 (&acc)[2][2][4][2], const Unit& u, int wr, int wc, int fr, int fq) const {
#pragma unroll
        for (int ai = 0; ai < 2; ++ai)
#pragma unroll
            for (int bj = 0; bj < 2; ++bj) asm volatile("" :: "v"(acc[ai][bj][0][0]), "v"(acc[ai][bj][0][1]), "v"(acc[ai][bj][1][0]), "v"(acc[ai][bj][1][1]), "v"(acc[ai][bj][2][0]), "v"(acc[ai][bj][2][1]), "v"(acc[ai][bj][3][0]), "v"(acc[ai][bj][3][1]));
    }
};
struct EpiSwiglu {
    static constexpr bool PERM = true, AFTER_DRAIN = false;
    bf16_t* H; int ldc;
    __device__ __forceinline__ void operator()(const f32x4 (&acc)[2][2][4][2], const Unit& u, int wr, int wc, int fr, int fq) const {
        const int row0 = u.pm * BM + wr * 64 + fr, col0 = u.pn * HALF + wc * 32 + 8 * fq;
#pragma unroll
        for (int ai = 0; ai < 2; ++ai)
#pragma unroll
            for (int m = 0; m < 4; ++m) { bf16_t* rowp = H + (size_t)(row0 + ai * HALF + m * 16) * ldc + col0;
                float h[8];
#pragma unroll
                for (int n = 0; n < 2; ++n)
#pragma unroll
                    for (int e = 0; e < 4; ++e) { const float a = acc[ai][0][m][n][e], b = acc[ai][1][m][n][e]; h[n * 4 + e] = a * sigmoidf_(a) * b; }
                u32x4 w; w.x = cvt_pk_bf16(h[0], h[1]); w.y = cvt_pk_bf16(h[2], h[3]); w.z = cvt_pk_bf16(h[4], h[5]); w.w = cvt_pk_bf16(h[6], h[7]);
                *(u32x4*)rowp = w; }
    }
};
struct EpiResid {
    static constexpr bool PERM = true, AFTER_DRAIN = false;
    bf16_t* X; int ldc; float scale;
    __device__ __forceinline__ void operator()(const f32x4 (&acc)[2][2][4][2], const Unit& u, int wr, int wc, int fr, int fq) const {
        const int row0 = u.pm * BM + wr * 64 + fr, col0 = u.pn * BM + wc * 32 + 8 * fq;
#pragma unroll
        for (int ai = 0; ai < 2; ++ai) {
            u32x4 xv[4][2];
#pragma unroll
            for (int m = 0; m < 4; ++m) { const bf16_t* rowp = X + (size_t)(row0 + ai * HALF + m * 16) * ldc + col0;
#pragma unroll
                for (int bj = 0; bj < 2; ++bj) xv[m][bj] = *(const u32x4*)(rowp + bj * HALF); }
#pragma unroll
            for (int m = 0; m < 4; ++m) { bf16_t* rowp = X + (size_t)(row0 + ai * HALF + m * 16) * ldc + col0;
#pragma unroll
                for (int bj = 0; bj < 2; ++bj) { const u32x4 x = xv[m][bj]; const f32x4 a0 = acc[ai][bj][m][0], a1 = acc[ai][bj][m][1];
                    u32x4 w; w.x = cvt_pk_bf16(bf_lo(x.x) + a0[0] * scale, bf_hi(x.x) + a0[1] * scale); w.y = cvt_pk_bf16(bf_lo(x.y) + a0[2] * scale, bf_hi(x.y) + a0[3] * scale);
                    w.z = cvt_pk_bf16(bf_lo(x.z) + a1[0] * scale, bf_hi(x.z) + a1[1] * scale); w.w = cvt_pk_bf16(bf_lo(x.w) + a1[2] * scale, bf_hi(x.w) + a1[3] * scale);
                    *(u32x4*)(rowp + bj * HALF) = w; } }
            asm volatile("" ::: "memory");
        }
    }
};
struct EpiGateCat {
    static constexpr bool PERM = true, AFTER_DRAIN = false, HOOK = true;
    const bf16_t* GL; int ldg; bf16_t* MB; int ldc; int ldo;
    __device__ __forceinline__ bool hook_at(int t) const { return t == 8 || t == 24; }
    static __device__ __forceinline__ float e_neg(float x) { return __builtin_amdgcn_exp2f(-1.4426950408889634f * __builtin_fminf(__builtin_fmaxf(x, -60.f), 60.f)); }
    __device__ __forceinline__ void hook(f32x4 (&acc)[2][2][4][2], const Unit& u, int t, int wr, int wc, int fr, int fq) const {
        int fr_ = fr; asm volatile("" : "+v"(fr_));
        const int row0 = u.pm * BM + wr * 64 + fr_, col0 = u.pn * BM + wc * 32 + 8 * fq; const bf16_t* gp = GL + (t == 8 ? 0 : ldc) + (size_t)row0 * ldg + col0;
#pragma unroll
        for (int ai = 0; ai < 2; ++ai) {
            u32x4 a[4][2], b[4][2];
#pragma unroll
            for (int m = 0; m < 4; ++m)
#pragma unroll
                for (int bj = 0; bj < 2; ++bj) { const bf16_t* q = gp + (size_t)(ai * HALF + m * 16) * ldg + bj * HALF; a[m][bj] = *(const u32x4*)q; b[m][bj] = *(const u32x4*)(q + ldc); }
#pragma unroll
            for (int m = 0; m < 4; ++m)
#pragma unroll
                for (int bj = 0; bj < 2; ++bj) { const u32x4 p = a[m][bj], n = b[m][bj]; f32x4& v0 = acc[ai][bj][m][0]; f32x4& v1 = acc[ai][bj][m][1];
                    v0[0] *= (1.f + e_neg(bf_lo(n.x))) * __builtin_amdgcn_rcpf(1.f + e_neg(bf_lo(p.x))); v0[1] *= (1.f + e_neg(bf_hi(n.x))) * __builtin_amdgcn_rcpf(1.f + e_neg(bf_hi(p.x)));
                    v0[2] *= (1.f + e_neg(bf_lo(n.y))) * __builtin_amdgcn_rcpf(1.f + e_neg(bf_lo(p.y))); v0[3] *= (1.f + e_neg(bf_hi(n.y))) * __builtin_amdgcn_rcpf(1.f + e_neg(bf_hi(p.y)));
                    v1[0] *= (1.f + e_neg(bf_lo(n.z))) * __builtin_amdgcn_rcpf(1.f + e_neg(bf_lo(p.z))); v1[1] *= (1.f + e_neg(bf_hi(n.z))) * __builtin_amdgcn_rcpf(1.f + e_neg(bf_hi(p.z)));
                    v1[2] *= (1.f + e_neg(bf_lo(n.w))) * __builtin_amdgcn_rcpf(1.f + e_neg(bf_lo(p.w))); v1[3] *= (1.f + e_neg(bf_hi(n.w))) * __builtin_amdgcn_rcpf(1.f + e_neg(bf_hi(p.w))); }
            asm volatile("" ::: "memory");
        }
        asm volatile("s_waitcnt vmcnt(0)" ::: "memory");
    }
    __device__ __forceinline__ void operator()(const f32x4 (&acc)[2][2][4][2], const Unit& u, int wr, int wc, int fr, int fq) const {
        const int row0 = u.pm * BM + wr * 64 + fr, col0 = u.pn * BM + wc * 32 + 8 * fq; const bf16_t* gp = GL + 2 * ldc;
#pragma unroll
        for (int ai = 0; ai < 2; ++ai) {
            u32x4 g[4][2];
#pragma unroll
            for (int m = 0; m < 4; ++m)
#pragma unroll
                for (int bj = 0; bj < 2; ++bj) g[m][bj] = *(const u32x4*)(gp + (size_t)(row0 + ai * HALF + m * 16) * ldg + col0 + bj * HALF);
#pragma unroll
            for (int m = 0; m < 4; ++m) { const size_t row = (size_t)(row0 + ai * HALF + m * 16);
#pragma unroll
                for (int bj = 0; bj < 2; ++bj) { const u32x4 gg = g[m][bj]; f32x4 v0 = acc[ai][bj][m][0], v1 = acc[ai][bj][m][1];
                    v0[0] *= sigmoidf_(bf_lo(gg.x)); v0[1] *= sigmoidf_(bf_hi(gg.x)); v0[2] *= sigmoidf_(bf_lo(gg.y)); v0[3] *= sigmoidf_(bf_hi(gg.y));
                    v1[0] *= sigmoidf_(bf_lo(gg.z)); v1[1] *= sigmoidf_(bf_hi(gg.z)); v1[2] *= sigmoidf_(bf_lo(gg.w)); v1[3] *= sigmoidf_(bf_hi(gg.w));
                    u32x4 w; w.x = cvt_pk_bf16(v0[0], v0[1]); w.y = cvt_pk_bf16(v0[2], v0[3]); w.z = cvt_pk_bf16(v1[0], v1[1]); w.w = cvt_pk_bf16(v1[2], v1[3]);
                    *(u32x4*)(MB + row * ldo + col0 + bj * HALF) = w; } }
            asm volatile("" ::: "memory");
        }
    }
};

template <class E, class = void> struct epi_has_hook { static constexpr bool value = false; };
template <class E> struct epi_has_hook<E, decltype((void)E::HOOK)> { static constexpr bool value = E::HOOK; };
template <class Epi, class Sched, bool ALIGN_EPI = false, bool SP2 = false>
__device__ __forceinline__ void gemm_phase(PG8_LAS unsigned char* lds, const Gemm g, const Sched& S, const Epi& E, const int tid, const unsigned stagger = 0u) {
    if (stagger) { const unsigned long long t0_ = __builtin_amdgcn_s_memrealtime(); while (__builtin_amdgcn_s_memrealtime() - t0_ < stagger) __builtin_amdgcn_s_sleep(16); }
    const int wid = __builtin_amdgcn_readfirstlane(tid >> 6), lane = tid & 63, wr = wid >> 2, wc = wid & 3, fr = lane & 15, fq = lane >> 4;
    const int K = g.K, nt = K / BK, lda = g.lda ? g.lda : g.K, ldb = g.ldb ? g.ldb : g.K;
    unsigned voffA[2], voffB[2];
#pragma unroll
    for (int i = 0; i < 2; ++i) { int R, C; stage_rc(tid * 16 + i * 8192, R, C); const int Rb = Epi::PERM ? ((R & ~31) + perm32(R & 31)) : R;
        voffA[i] = (unsigned)(R * lda + C) * 2u; voffB[i] = (unsigned)(Rb * ldb + C) * 2u; }
    const size_t kstep = (size_t)(BK * 2);
    const size_t hstep = (size_t)HALF * ldb * 2, hstepA = (size_t)HALF * lda * 2;
    const size_t tstep = 2 * hstep, tstepA = 2 * hstepA;
    const unsigned ldsw = (unsigned)wid * 1024u;
    const int aoff = lds_byte(wr * 64 + fr, fq * 8), boff = lds_byte(wc * 32 + fr, fq * 8);
#define PG8_SA(b, h) (((b) * 2 + (h)) * HTB)
#define PG8_SB(b, h) ((4 + (b) * 2 + (h)) * HTB)
#define PG8_STAGE(bufoff, gbase, voff) do { _Pragma("unroll") for (int _i = 0; _i < 2; ++_i) \
        __builtin_amdgcn_global_load_lds((const unsigned*)((const char*)(gbase) + (voff)[_i]), (PG8_LAS unsigned*)(lds + (bufoff) + ldsw + _i * 8192), 16, 0, 0); } while (0)
#define PG8_LDA(dst, b, h) do { _Pragma("unroll") for (int m = 0; m < 4; ++m) _Pragma("unroll") for (int k = 0; k < 2; ++k) dst[m][k] = *(const PG8_LAS bf16x8*)(lds + PG8_SA(b, h) + aoff + m * 2048 + k * 1024); } while (0)
#define PG8_LDB(dst, b, h) do { _Pragma("unroll") for (int n = 0; n < 2; ++n) _Pragma("unroll") for (int k = 0; k < 2; ++k) dst[n][k] = *(const PG8_LAS bf16x8*)(lds + PG8_SB(b, h) + boff + n * 2048 + k * 1024); } while (0)
#define PG8_MMA(ai, bj, At, Bt) do { __builtin_amdgcn_s_setprio(1); _Pragma("unroll") for (int m = 0; m < 4; ++m) _Pragma("unroll") for (int n = 0; n < 2; ++n) _Pragma("unroll") for (int k = 0; k < 2; ++k) \
        acc[ai][bj][m][n] = __builtin_amdgcn_mfma_f32_16x16x32_bf16(Bt[n][k], At[m][k], acc[ai][bj][m][n], 0, 0, 0); __builtin_amdgcn_s_setprio(0); } while (0)
#define PG8_WAIT_V(n) asm volatile("s_waitcnt vmcnt(" #n ")" ::: "memory")
#define PG8_WAIT_L(n) asm volatile("s_waitcnt lgkmcnt(" #n ")" ::: "memory")
#define PG8_BAR __builtin_amdgcn_s_barrier()
#define PG8_SCHED __builtin_amdgcn_sched_barrier(0)
    Unit cur, nxt; int ui = 0;
    if (!S.next(0, cur)) return;
    f32x4 acc[2][2][4][2];
#pragma unroll
    for (int a = 0; a < 2; ++a)
#pragma unroll
        for (int b = 0; b < 2; ++b)
#pragma unroll
            for (int m = 0; m < 4; ++m)
#pragma unroll
                for (int n = 0; n < 2; ++n) acc[a][b][m][n] = (f32x4){0.f, 0.f, 0.f, 0.f};
    bf16x8 At[4][2], B0[2][2], B1[2][2];
    const char* cA = (const char*)g.A + (size_t)cur.pm * tstepA; const char* cB = (const char*)g.Bt + (size_t)cur.pn * tstep;
    S.a_ready(cur);
    if constexpr (SP2) {
        PG8_STAGE(PG8_SB(0, 0), cB, voffB); PG8_STAGE(PG8_SB(0, 1), cB + hstep, voffB); PG8_STAGE(PG8_SA(0, 0), cA, voffA); PG8_STAGE(PG8_SA(0, 1), cA + hstepA, voffA);
        if (wr == 1) PG8_BAR;
        PG8_WAIT_V(2); PG8_BAR;
        PG8_STAGE(PG8_SB(1, 0), cB + kstep, voffB); PG8_STAGE(PG8_SA(1, 0), cA + kstep, voffA); PG8_STAGE(PG8_SB(1, 1), cB + hstep + kstep, voffB);
        PG8_WAIT_V(6); PG8_BAR;
    } else {
        PG8_STAGE(PG8_SB(0, 0), cB, voffB); PG8_STAGE(PG8_SA(0, 0), cA, voffA); PG8_STAGE(PG8_SB(0, 1), cB + hstep, voffB); PG8_STAGE(PG8_SA(0, 1), cA + hstepA, voffA);
        if (wr == 1) PG8_BAR;
        PG8_WAIT_V(4); PG8_BAR;
        PG8_STAGE(PG8_SB(1, 0), cB + kstep, voffB); PG8_STAGE(PG8_SA(1, 0), cA + kstep, voffA); PG8_STAGE(PG8_SB(1, 1), cB + hstep + kstep, voffB);
        PG8_WAIT_V(6); PG8_BAR;
    }
    for (;;) {
        const bool has_next = S.next(ui + 1, nxt);
        const char* nA = has_next ? (const char*)g.A + (size_t)nxt.pm * tstepA : cA; const char* nB = has_next ? (const char*)g.Bt + (size_t)nxt.pn * tstep : cB;
        for (int t = 0; t < nt; t += 2) {
            const bool last = (t == nt - 2);
            const char* a1 = cA + (size_t)(t + 1) * kstep;
            const char* a2 = last ? nA : cA + (size_t)(t + 2) * kstep; const char* b2 = last ? nB : cB + (size_t)(t + 2) * kstep;
            const char* a3 = a2 + kstep; const char* b3 = b2 + kstep;
            if (last && has_next) S.a_ready(nxt);
            if constexpr (epi_has_hook<Epi>::value) { if (E.hook_at(t)) E.hook(acc, cur, t, wr, wc, fr, fq); }
            if constexpr (SP2) {
            PG8_LDB(B0, 0, 0); PG8_LDB(B1, 0, 1); PG8_SCHED; PG8_LDA(At, 0, 0); PG8_STAGE(PG8_SA(1, 1), a1 + hstepA, voffA);
            PG8_WAIT_V(8); PG8_WAIT_L(0); PG8_BAR; PG8_MMA(0, 0, At, B0); PG8_MMA(0, 1, At, B1); PG8_BAR; PG8_SCHED;
            PG8_LDA(At, 0, 1); PG8_STAGE(PG8_SB(0, 0), b2, voffB); PG8_STAGE(PG8_SB(0, 1), b2 + hstep, voffB); PG8_STAGE(PG8_SA(0, 0), a2, voffA);
            PG8_WAIT_V(8); PG8_WAIT_L(0); PG8_BAR; PG8_MMA(1, 0, At, B0); PG8_MMA(1, 1, At, B1); PG8_BAR; PG8_SCHED;
            PG8_LDB(B0, 1, 0); PG8_LDB(B1, 1, 1); PG8_SCHED; PG8_LDA(At, 1, 0); PG8_STAGE(PG8_SA(0, 1), a2 + hstepA, voffA);
            PG8_WAIT_V(8); PG8_WAIT_L(0); PG8_BAR; PG8_MMA(0, 0, At, B0); PG8_MMA(0, 1, At, B1); PG8_BAR; PG8_SCHED;
            PG8_LDA(At, 1, 1); PG8_STAGE(PG8_SB(1, 0), b3, voffB); PG8_STAGE(PG8_SB(1, 1), b3 + hstep, voffB); PG8_STAGE(PG8_SA(1, 0), a3, voffA);
            PG8_WAIT_V(8); PG8_WAIT_L(0); PG8_BAR; PG8_MMA(1, 0, At, B0); PG8_MMA(1, 1, At, B1); PG8_BAR; PG8_SCHED;
            } else {
            PG8_LDB(B0, 0, 0); PG8_SCHED; PG8_LDA(At, 0, 0); PG8_STAGE(PG8_SA(1, 1), a1 + hstepA, voffA);
            PG8_WAIT_L(8); PG8_BAR; PG8_WAIT_L(0); PG8_MMA(0, 0, At, B0); PG8_BAR; PG8_SCHED;
            PG8_LDB(B1, 0, 1); PG8_STAGE(PG8_SB(0, 0), b2, voffB);
            PG8_BAR; PG8_WAIT_L(0); PG8_MMA(0, 1, At, B1); PG8_BAR;
            PG8_LDA(At, 0, 1); PG8_STAGE(PG8_SA(0, 0), a2, voffA);
            PG8_BAR; PG8_WAIT_L(0); PG8_MMA(1, 0, At, B0); PG8_BAR; PG8_SCHED;
            PG8_STAGE(PG8_SB(0, 1), b2 + hstep, voffB);
            PG8_WAIT_V(6); PG8_BAR; PG8_MMA(1, 1, At, B1); PG8_BAR;
            PG8_LDB(B0, 1, 0); PG8_SCHED; PG8_LDA(At, 1, 0); PG8_STAGE(PG8_SA(0, 1), a2 + hstepA, voffA);
            PG8_WAIT_L(8); PG8_BAR; PG8_WAIT_L(0); PG8_MMA(0, 0, At, B0); PG8_BAR; PG8_SCHED;
            PG8_LDB(B1, 1, 1); PG8_STAGE(PG8_SB(1, 0), b3, voffB);
            PG8_BAR; PG8_WAIT_L(0); PG8_MMA(0, 1, At, B1); PG8_BAR;
            PG8_LDA(At, 1, 1); PG8_STAGE(PG8_SA(1, 0), a3, voffA);
            PG8_BAR; PG8_WAIT_L(0); PG8_MMA(1, 0, At, B0); PG8_BAR; PG8_SCHED;
            PG8_STAGE(PG8_SB(1, 1), b3 + hstep, voffB);
            PG8_WAIT_V(6); PG8_BAR; PG8_MMA(1, 1, At, B1); PG8_BAR;
            }
        }
        if constexpr (ALIGN_EPI) { if (wr == 0) PG8_BAR; }
        E(acc, cur, wr, wc, fr, fq); S.done(cur);
        if (!has_next) break;
#pragma unroll
        for (int a = 0; a < 2; ++a)
#pragma unroll
            for (int b = 0; b < 2; ++b)
#pragma unroll
                for (int m = 0; m < 4; ++m)
#pragma unroll
                    for (int n = 0; n < 2; ++n) acc[a][b][m][n] = (f32x4){0.f, 0.f, 0.f, 0.f};
        cur = nxt; cA = nA; cB = nB; ++ui;
        if constexpr (ALIGN_EPI) { if (wr == 1) PG8_BAR; }
    }
    PG8_WAIT_V(0);
    if constexpr (!ALIGN_EPI) { if (wr == 0) PG8_BAR; }
    PG8_BAR;
#undef PG8_SA
#undef PG8_SB
#undef PG8_STAGE
#undef PG8_LDA
#undef PG8_LDB
#undef PG8_MMA
#undef PG8_WAIT_V
#undef PG8_WAIT_L
#undef PG8_BAR
#undef PG8_SCHED
}
}

namespace att {
typedef unsigned short bf16;
using bf16x8 = __attribute__((ext_vector_type(8))) short;
using s16x4  = __attribute__((ext_vector_type(4))) short;
using f32x16 = __attribute__((ext_vector_type(16))) float;
using u32x4  = __attribute__((ext_vector_type(4))) unsigned;
constexpr int D = 128, NW = 8, QBLK = 32, KVBLK = 64;
constexpr float SCALE = 0.088388347648318440f;
constexpr float THR = 8.f;
constexpr int SHM_V = KVBLK * D * 2, SHM_K = KVBLK * D * 2, SHM_ATTN = 2 * SHM_V + 2 * SHM_K + NW * 64 * 4;
#define KSWZ(row, colB) ((row) * 256 + ((colB) ^ (((row) & 7) << 4)))
#define SBAR() __builtin_amdgcn_sched_barrier(0)
__device__ __forceinline__ int crow(int r, int hi) { return (r & 3) + 8 * (r >> 2) + 4 * hi; }
__device__ __forceinline__ unsigned cvtpk(float lo, float hi) { unsigned r; asm volatile("v_cvt_pk_bf16_f32 %0, %1, %2" : "=v"(r) : "v"(lo), "v"(hi)); return r; }

template <int SM> __device__ __forceinline__ void partialSM(f32x16& p0, f32x16& p1, float& m_reg, float& mn, float& alpha) {
  if constexpr (SM == 2) {
#pragma unroll
    for (int r = 0; r < 16; ++r) p0[r] = __builtin_amdgcn_exp2f(p0[r]);
    return; }
  constexpr float C = SM == 0 ? SCALE * 1.4426950408889634f : 1.0f; constexpr float THRU = SM == 0 ? THR / SCALE : THR * 1.4426950408889634f;
  float pmax = p0[0];
#pragma unroll
  for (int r = 1; r < 16; ++r) pmax = fmaxf(pmax, p0[r]);
#pragma unroll
  for (int r = 0; r < 16; ++r) pmax = fmaxf(pmax, p1[r]);
  { auto rr = __builtin_amdgcn_permlane32_swap(__float_as_uint(pmax), __float_as_uint(pmax), false, false);
    pmax = fmaxf(__uint_as_float(rr[0]), __uint_as_float(rr[1])); }
  if (__builtin_expect(__all(pmax - m_reg <= THRU), 1)) { mn = m_reg; alpha = 1.f; }
  else { mn = fmaxf(m_reg, pmax); alpha = __builtin_amdgcn_exp2f((m_reg - mn) * C); m_reg = mn; }
  float mnC = -mn * C;
#pragma unroll
  for (int r = 0; r < 16; ++r) p0[r] = fmaf(p0[r], C, mnC);
#pragma unroll
  for (int r = 0; r < 16; ++r) p1[r] = fmaf(p1[r], C, mnC);
#pragma unroll
  for (int r = 0; r < 16; ++r) p0[r] = __builtin_amdgcn_exp2f(p0[r]);
}
template <int SM> __device__ __forceinline__ void finishSM(f32x16& p0, f32x16& p1, float alpha, float& l_reg, bf16x8& pa0, bf16x8& pa1, bf16x8& pa2, bf16x8& pa3) {
#pragma unroll
  for (int r = 0; r < 16; ++r) p1[r] = __builtin_amdgcn_exp2f(p1[r]);
  float ps = 0;
#pragma unroll
  for (int r = 0; r < 16; ++r) ps += p0[r];
#pragma unroll
  for (int r = 0; r < 16; ++r) ps += p1[r];
  { auto rr = __builtin_amdgcn_permlane32_swap(__float_as_uint(ps), __float_as_uint(ps), false, false);
    ps = __uint_as_float(rr[0]) + __uint_as_float(rr[1]); }
  if constexpr (SM == 2) l_reg += ps; else l_reg = l_reg * alpha + ps;
#define PK4(P, BASE, OUT) do { unsigned a0 = cvtpk(P[BASE + 0], P[BASE + 1]), a1 = cvtpk(P[BASE + 2], P[BASE + 3]);   \
    unsigned b0 = cvtpk(P[BASE + 4], P[BASE + 5]), b1 = cvtpk(P[BASE + 6], P[BASE + 7]);                              \
    auto r0 = __builtin_amdgcn_permlane32_swap(a0, b0, false, false); auto r1 = __builtin_amdgcn_permlane32_swap(a1, b1, false, false); \
    u32x4 w = {r0[0], r1[0], r0[1], r1[1]}; OUT = *reinterpret_cast<bf16x8*>(&w); } while (0)
  PK4(p0, 0, pa0); PK4(p0, 8, pa1); PK4(p1, 0, pa2); PK4(p1, 8, pa3);
#undef PK4
}
template <bool PF> __device__ __forceinline__ void qkt(f32x16& p0, f32x16& p1, const char* Ks, const bf16x8* qr, int r32, int hi) {
  p0 = f32x16{}; p1 = f32x16{};
  if constexpr (PF) {
  bf16x8 b0 = *reinterpret_cast<const bf16x8*>(Ks + KSWZ(r32, (hi * 8) * 2)), b1 = *reinterpret_cast<const bf16x8*>(Ks + KSWZ(32 + r32, (hi * 8) * 2));
#pragma unroll
  for (int d0 = 0; d0 < 8; ++d0) { bf16x8 n0 = b0, n1 = b1;
    if (d0 < 7) { const int cb = ((d0 + 1) * 16 + hi * 8) * 2; n0 = *reinterpret_cast<const bf16x8*>(Ks + KSWZ(r32, cb)); n1 = *reinterpret_cast<const bf16x8*>(Ks + KSWZ(32 + r32, cb)); }
    if (d0 < 7) asm volatile("s_waitcnt lgkmcnt(2)" ::: "memory"); else asm volatile("s_waitcnt lgkmcnt(0)" ::: "memory");
    __builtin_amdgcn_sched_barrier(0);
    p0 = __builtin_amdgcn_mfma_f32_32x32x16_bf16(b0, qr[d0], p0, 0, 0, 0);
    p1 = __builtin_amdgcn_mfma_f32_32x32x16_bf16(b1, qr[d0], p1, 0, 0, 0);
    b0 = n0; b1 = n1; }
  } else {
#pragma unroll
  for (int d0 = 0; d0 < 8; ++d0) { int cb = (d0 * 16 + hi * 8) * 2;
    bf16x8 b0 = *reinterpret_cast<const bf16x8*>(Ks + KSWZ(r32, cb));
    bf16x8 b1 = *reinterpret_cast<const bf16x8*>(Ks + KSWZ(32 + r32, cb));
    p0 = __builtin_amdgcn_mfma_f32_32x32x16_bf16(b0, qr[d0], p0, 0, 0, 0);
    p1 = __builtin_amdgcn_mfma_f32_32x32x16_bf16(b1, qr[d0], p1, 0, 0, 0); }
  }
}
__device__ __forceinline__ int v_st(int k, int c) { const int kk = (k & ~0xC) | ((k & 4) << 1) | ((k & 8) >> 1); return ((kk >> 3) * 4 + (c >> 5)) * 512 + ((kk & 7) * 32 + (c & 31)) * 2; }
__device__ __forceinline__ int v_rd_base(int lane) { return ((lane & 3) << 3) | (((lane >> 2) & 3) << 6) | (((lane >> 4) & 1) << 5) | (((lane >> 5) & 1) << 8); }
constexpr int v_rd_off(int d0, int ks, int half) { return d0 * 512 + ks * 4096 + half * 2048; }
template <int OFF> __device__ __forceinline__ s16x4 tr_read(int vb) {
  s16x4 r; asm volatile("ds_read_b64_tr_b16 %0, %1 offset:%2" : "=&v"(r) : "v"(vb), "i"(OFF) : "memory"); return r;
}
template <int D0> __device__ __forceinline__ void pv_one(f32x16& od, int vb, bf16x8 pa0, bf16x8 pa1, bf16x8 pa2, bf16x8 pa3) {
  const s16x4 l0 = tr_read<v_rd_off(D0, 0, 0)>(vb), h0 = tr_read<v_rd_off(D0, 0, 1)>(vb), l1 = tr_read<v_rd_off(D0, 1, 0)>(vb), h1 = tr_read<v_rd_off(D0, 1, 1)>(vb);
  const s16x4 l2 = tr_read<v_rd_off(D0, 2, 0)>(vb), h2 = tr_read<v_rd_off(D0, 2, 1)>(vb), l3 = tr_read<v_rd_off(D0, 3, 0)>(vb), h3 = tr_read<v_rd_off(D0, 3, 1)>(vb);
  asm volatile("s_waitcnt lgkmcnt(0)" ::: "memory"); SBAR();
#define PK(L, H) (bf16x8){L[0], L[1], L[2], L[3], H[0], H[1], H[2], H[3]}
  od = __builtin_amdgcn_mfma_f32_32x32x16_bf16(pa0, PK(l0, h0), od, 0, 0, 0);
  od = __builtin_amdgcn_mfma_f32_32x32x16_bf16(pa1, PK(l1, h1), od, 0, 0, 0);
  od = __builtin_amdgcn_mfma_f32_32x32x16_bf16(pa2, PK(l2, h2), od, 0, 0, 0);
  od = __builtin_amdgcn_mfma_f32_32x32x16_bf16(pa3, PK(l3, h3), od, 0, 0, 0);
#undef PK
}
__device__ __forceinline__ void pv_d0(f32x16* o, int vb, bf16x8 pa0, bf16x8 pa1, bf16x8 pa2, bf16x8 pa3) {
  pv_one<0>(o[0], vb, pa0, pa1, pa2, pa3); pv_one<1>(o[1], vb, pa0, pa1, pa2, pa3); pv_one<2>(o[2], vb, pa0, pa1, pa2, pa3); pv_one<3>(o[3], vb, pa0, pa1, pa2, pa3);
}

struct Unit {
  const bf16* Q; const bf16* K; const bf16* V; bf16* O; float* lse;
  int qstride, kstride, ostride, lse_stride;
  int NT;
  int kb0, n, qi0, hw;
  float slope_raw;
  float sink; int has_sink;
};

template <bool BAND, int SM>
__device__ __forceinline__ void attn_unit(const Unit& U, char* lds, const int tid) {
  const int wid = tid >> 6, lane = tid & 63, r32 = lane & 31, hi = lane >> 5;
  char* V_lds = lds; char* K_lds = lds + 2 * SHM_V;
  float* ws = (float*)(lds + 2 * SHM_V + 2 * SHM_K) + wid * 64; float* li_l = ws; float* al_l = ws + 32;
  float m_reg = -1e30f, l_reg = 0; f32x16 o[4] = {}; bf16x8 qr[8];
  { int lq_ = lane; asm volatile("" : "+v"(lq_));
    const unsigned qoff = (unsigned)(wid * QBLK + (lq_ & 31)) * (unsigned)U.qstride + (unsigned)((lq_ >> 5) * 8);
#pragma unroll
    for (int d0 = 0; d0 < 8; ++d0) qr[d0] = *reinterpret_cast<const bf16x8*>(U.Q + qoff + d0 * 16); }
  const int sr = tid >> 4, sc = (tid & 15) * 8, vst0 = v_st(sr, sc), kst0 = KSWZ(sr, sc * 2);
  const int vb0 = (int)(uintptr_t)V_lds + v_rd_base(lane);
  struct { bf16x8 vs0, vs1, ks0, ks1; } sr_[BAND ? 1 : 2];
  float fq = 0.f;
  if constexpr (BAND) fq = (float)(U.qi0 + wid * QBLK + r32);
#define ROWOF(k) ((k) < 0 ? 0 : ((k) >= U.n ? U.n - 1 : (k)))
#define SLOAD(i, k0) do { unsigned _o0, _o1; \
    if constexpr (BAND) { const int _ka = U.kb0 + (k0) + sr; _o0 = (unsigned)ROWOF(_ka) * (unsigned)U.kstride + (unsigned)sc; _o1 = (unsigned)ROWOF(_ka + 32) * (unsigned)U.kstride + (unsigned)sc; } \
    else { _o0 = (unsigned)((k0) + sr) * (unsigned)U.kstride + (unsigned)sc; _o1 = _o0 + 32u * (unsigned)U.kstride; } \
    sr_[i].vs0 = *reinterpret_cast<const bf16x8*>(U.V + _o0); sr_[i].vs1 = *reinterpret_cast<const bf16x8*>(U.V + _o1); \
    sr_[i].ks0 = *reinterpret_cast<const bf16x8*>(U.K + _o0); sr_[i].ks1 = *reinterpret_cast<const bf16x8*>(U.K + _o1); } while (0)
#define SWRITE(b, i) do { *(bf16x8*)(V_lds + (b) * SHM_V + vst0) = sr_[i].vs0;          \
    *(bf16x8*)(V_lds + (b) * SHM_V + vst0 + 8192) = sr_[i].vs1;                         \
    *(bf16x8*)(K_lds + (b) * SHM_K + kst0) = sr_[i].ks0;                               \
    *(bf16x8*)(K_lds + (b) * SHM_K + kst0 + 8192) = sr_[i].ks1; } while (0)
#define SWAIT() asm volatile("s_waitcnt vmcnt(4)" ::: "memory")
#define QK_SCHED() do { if constexpr (SM == 2 && ATT_SCHED == 1) { __builtin_amdgcn_sched_group_barrier(0x100, 4, 0); \
    _Pragma("unroll") for (int i_ = 0; i_ < 7; ++i_) { __builtin_amdgcn_sched_group_barrier(0x008, 2, 0); __builtin_amdgcn_sched_group_barrier(0x002, 9, 0); __builtin_amdgcn_sched_group_barrier(0x100, 2, 0); } \
    __builtin_amdgcn_sched_group_barrier(0x008, 2, 0); __builtin_amdgcn_sched_group_barrier(0x002, 12, 0); } \
    if constexpr (SM == 2 && ATT_SCHED == 2) { _Pragma("unroll") for (int i_ = 0; i_ < 8; ++i_) { __builtin_amdgcn_sched_group_barrier(0x100, 2, 0); __builtin_amdgcn_sched_group_barrier(0x008, 2, 0); __builtin_amdgcn_sched_group_barrier(0x002, 9, 0); } } } while (0)
#define RESC(a) do { if constexpr (SM != 2) if (__any((a) < 1.f)) { if (hi == 0) al_l[r32] = (a); asm volatile("s_waitcnt lgkmcnt(0)" ::: "memory"); \
    _Pragma("unroll") for (int d = 0; d < 4; ++d) _Pragma("unroll") for (int r = 0; r < 16; ++r) o[d][r] *= al_l[crow(r, hi)]; } } while (0)
#define MASKB(P0, P1, j) do { if constexpr (BAND) { const float _f0 = ((float)(U.kb0 + 64 * (j)) + (float)(4 * hi)) - fq; const float _ninf = -__builtin_inff(); \
    const float flo = __builtin_fmaxf(-(float)U.hw, -fq), fhi = __builtin_fminf((float)U.hw, (float)(U.n - 1) - fq); \
    _Pragma("unroll") for (int r = 0; r < 16; ++r) { const float d0_ = _f0 + (float)((r & 3) + 8 * (r >> 2)), d1_ = d0_ + 32.f; \
      const float s0_ = fmaf(-U.slope_raw, __builtin_fabsf(d0_), P0[r]), s1_ = fmaf(-U.slope_raw, __builtin_fabsf(d1_), P1[r]); \
      P0[r] = (d0_ >= flo && d0_ <= fhi) ? s0_ : _ninf; P1[r] = (d1_ >= flo && d1_ <= fhi) ? s1_ : _ninf; } } } while (0)
  f32x16 pA0, pA1, pB0, pB1; float mnA, mnB, alA, alB; bf16x8 pa0, pa1, pa2, pa3; const int NT = U.NT;
  constexpr int SE = 0, SO = 1;
  if constexpr (BAND) {
  const int tlo_ = __builtin_amdgcn_readfirstlane(wid >> 1), thi_ = tlo_ + (U.hw >> 5);
#define ACT(j) (!WSKIP || ((j) >= tlo_ && (j) <= thi_))
  SLOAD(0, 0); SWRITE(0, 0); SLOAD(0, KVBLK); __syncthreads();
  if (ACT(0)) { qkt<(BAND_PREFETCH != 0)>(pA0, pA1, K_lds, qr, r32, hi); MASKB(pA0, pA1, 0); partialSM<SM>(pA0, pA1, m_reg, mnA, alA); }
  SWRITE(1, 0); if (2 < NT) SLOAD(0, 2 * KVBLK); __syncthreads();
  for (int j = 1; j + 1 < NT; j += 2) {
      { const bool aj = ACT(j), ap = ACT(j - 1);
        SBAR(); if (aj) qkt<(BAND_PREFETCH != 0)>(pB0, pB1, K_lds + SHM_K, qr, r32, hi);
        if (ap) { finishSM<SM>(pA0, pA1, alA, l_reg, pa0, pa1, pa2, pa3); SBAR(); pv_d0(o, vb0, pa0, pa1, pa2, pa3); }
        if (aj) { MASKB(pB0, pB1, j); partialSM<SM>(pB0, pB1, m_reg, mnB, alB); }
        __syncthreads(); SWRITE(0, 0); SLOAD(0, (j + 2) * KVBLK);
        if (aj) RESC(alB); __syncthreads(); }
      { const bool aj = ACT(j + 1), ap = ACT(j);
        SBAR(); if (aj) qkt<(BAND_PREFETCH != 0)>(pA0, pA1, K_lds, qr, r32, hi);
        if (ap) { finishSM<SM>(pB0, pB1, alB, l_reg, pa0, pa1, pa2, pa3); SBAR(); pv_d0(o, vb0 + SHM_V, pa0, pa1, pa2, pa3); }
        if (aj) { MASKB(pA0, pA1, j + 1); partialSM<SM>(pA0, pA1, m_reg, mnA, alA); }
        __syncthreads(); SWRITE(1, 0); if (j + 3 < NT) SLOAD(0, (j + 3) * KVBLK);
        if (aj) RESC(alA); __syncthreads(); }
  }
  { const bool aj = ACT(NT - 1), ap = ACT(NT - 2);
    SBAR(); if (aj) qkt<(BAND_PREFETCH != 0)>(pB0, pB1, K_lds + SHM_K, qr, r32, hi);
    if (ap) { finishSM<SM>(pA0, pA1, alA, l_reg, pa0, pa1, pa2, pa3); SBAR(); pv_d0(o, vb0, pa0, pa1, pa2, pa3); }
    if (aj) { MASKB(pB0, pB1, NT - 1); partialSM<SM>(pB0, pB1, m_reg, mnB, alB); }
    __syncthreads();
    if (aj) { RESC(alB);
      finishSM<SM>(pB0, pB1, alB, l_reg, pa0, pa1, pa2, pa3); SBAR();
      pv_d0(o, vb0 + SHM_V, pa0, pa1, pa2, pa3); } }
#undef ACT
  } else {
  SLOAD(SE, 0); asm volatile("s_waitcnt vmcnt(0)" ::: "memory"); SWRITE(0, SE); __syncthreads();
  qkt<(QKT_PREFETCH != 0) && SM == 2>(pA0, pA1, K_lds, qr, r32, hi); partialSM<SM>(pA0, pA1, m_reg, mnA, alA);
  SLOAD(SO, KVBLK); if (2 < NT) SLOAD(SE, 2 * KVBLK);
  SWAIT(); SWRITE(1, SO); __syncthreads();
  for (int j = 1; j + 1 < NT; j += 2) {
    SBAR(); qkt<(QKT_PREFETCH != 0) && SM == 2>(pB0, pB1, K_lds + SHM_K, qr, r32, hi);
    finishSM<SM>(pA0, pA1, alA, l_reg, pa0, pa1, pa2, pa3); QK_SCHED(); SBAR();
    SLOAD(SO, (j + 2) * KVBLK); SBAR();
    pv_d0(o, vb0, pa0, pa1, pa2, pa3); partialSM<SM>(pB0, pB1, m_reg, mnB, alB);
    __syncthreads(); SWAIT(); SWRITE(0, SE);
    RESC(alB); __syncthreads();
    SBAR(); qkt<(QKT_PREFETCH != 0) && SM == 2>(pA0, pA1, K_lds, qr, r32, hi);
    finishSM<SM>(pB0, pB1, alB, l_reg, pa0, pa1, pa2, pa3); QK_SCHED(); SBAR();
    if (j + 3 < NT) SLOAD(SE, (j + 3) * KVBLK); SBAR();
    pv_d0(o, vb0 + SHM_V, pa0, pa1, pa2, pa3); partialSM<SM>(pA0, pA1, m_reg, mnA, alA);
    __syncthreads(); SWAIT(); SWRITE(1, SO);
    RESC(alA); __syncthreads();
  }
  SBAR(); qkt<(QKT_PREFETCH != 0) && SM == 2>(pB0, pB1, K_lds + SHM_K, qr, r32, hi);
  finishSM<SM>(pA0, pA1, alA, l_reg, pa0, pa1, pa2, pa3); SBAR();
  pv_d0(o, vb0, pa0, pa1, pa2, pa3); partialSM<SM>(pB0, pB1, m_reg, mnB, alB);
  __syncthreads(); RESC(alB);
  finishSM<SM>(pB0, pB1, alB, l_reg, pa0, pa1, pa2, pa3); SBAR();
  pv_d0(o, vb0 + SHM_V, pa0, pa1, pa2, pa3);
  }
  if constexpr (BAND) {
    if (U.has_sink) l_reg += __builtin_amdgcn_exp2f((U.sink * (1.0f / SCALE) - m_reg) * (SCALE * 1.4426950408889634f));
    if (U.lse != nullptr && hi == 0) U.lse[(unsigned)(wid * QBLK + r32) * (unsigned)U.lse_stride] = m_reg * SCALE + __builtin_amdgcn_logf(l_reg) * 0.6931471805599453f;
  }
  int lane_e = lane; asm volatile("" : "+v"(lane_e));
  const int r32e = lane_e & 31, hie = lane_e >> 5;
  if (hie == 0) li_l[r32e] = l_reg; asm volatile("s_waitcnt lgkmcnt(0)" ::: "memory");
  float rli[16];
#pragma unroll
  for (int r = 0; r < 16; ++r) rli[r] = __builtin_amdgcn_rcpf(li_l[crow(r, hie)]);
  __syncthreads();
  char* ost = lds + wid * 8192;
  { char* op = ost + hie * 1024 + r32e * 2;
#pragma unroll
    for (int r = 0; r < 16; ++r) {
#pragma unroll
      for (int d0 = 0; d0 < 4; ++d0) { const unsigned w = cvtpk(o[d0][r] * rli[r], 0.f); *(unsigned short*)(op + ((r & 3) + 8 * (r >> 2)) * 256 + d0 * 64) = (unsigned short)w; } } }
  asm volatile("s_waitcnt lgkmcnt(0)" ::: "memory");
  { const char* ip = ost + (lane_e >> 4) * 256 + (lane_e & 15) * 16;
    unsigned goff = (unsigned)(wid * QBLK + (lane_e >> 4)) * (unsigned)U.ostride + (unsigned)((lane_e & 15) * 8); const unsigned gstep = 4u * (unsigned)U.ostride;
#pragma unroll
    for (int i = 0; i < 8; ++i) { const u32x4 w = *(const u32x4*)(ip + i * 1024); *(u32x4*)(U.O + goff) = w; goff += gstep; } }
  __syncthreads();
#undef ROWOF
#undef SLOAD
#undef SWRITE
#undef SWAIT
#undef QK_SCHED
#undef RESC
#undef MASKB
}

constexpr int SHM_RING = 3 * SHM_V + 2 * SHM_K + NW * 64 * 4;
__device__ __forceinline__ void attn_unit_ring(const Unit& U, char* lds, const int tid) {
  const int wid = tid >> 6, lane = tid & 63, r32 = lane & 31, hi = lane >> 5;
  char* V_lds = lds; char* K_lds = lds + 3 * SHM_V;
  float* ws = (float*)(lds + 3 * SHM_V + 2 * SHM_K) + wid * 64; float* li_l = ws;
  float m_reg = 0.f, l_reg = 0, mn_, al_ = 1.f; f32x16 o[4] = {}; bf16x8 qr[8];
  { const unsigned qoff = (unsigned)(wid * QBLK + r32) * (unsigned)U.qstride + (unsigned)(hi * 8);
#pragma unroll
    for (int d0 = 0; d0 < 8; ++d0) qr[d0] = *reinterpret_cast<const bf16x8*>(U.Q + qoff + d0 * 16); }
  const int sr = tid >> 4, sc = (tid & 15) * 8, vst0 = v_st(sr, sc), vst1 = v_st(32 + sr, sc);
  const int vb0 = (int)(uintptr_t)V_lds + v_rd_base(lane);
  struct { bf16x8 vs0, vs1, ks0, ks1; } sr_[1];
#define SLOAD(i, k0) do { const unsigned _o0 = (unsigned)((k0) + sr) * (unsigned)U.kstride + (unsigned)sc, _o1 = _o0 + 32u * (unsigned)U.kstride; \
    sr_[i].vs0 = *reinterpret_cast<const bf16x8*>(U.V + _o0); sr_[i].vs1 = *reinterpret_cast<const bf16x8*>(U.V + _o1); \
    sr_[i].ks0 = *reinterpret_cast<const bf16x8*>(U.K + _o0); sr_[i].ks1 = *reinterpret_cast<const bf16x8*>(U.K + _o1); } while (0)
#define SWRITE(kb, vsl, i) do { char* _v = V_lds + (vsl) * SHM_V; *(bf16x8*)(_v + vst0) = sr_[i].vs0; *(bf16x8*)(_v + vst1) = sr_[i].vs1; int kc = sc * 2; \
    *(bf16x8*)(K_lds + (kb) * SHM_K + KSWZ(sr, kc)) = sr_[i].ks0; *(bf16x8*)(K_lds + (kb) * SHM_K + KSWZ(32 + sr, kc)) = sr_[i].ks1; } while (0)
#define NEXT3(x) ((x) == 2 ? 0 : (x) + 1)
  f32x16 pA0, pA1, pB0, pB1; bf16x8 pa0, pa1, pa2, pa3; const int NT = U.NT;
  SLOAD(0, 0); SWRITE(0, 0, 0); SLOAD(0, KVBLK);
  __syncthreads();
  SWRITE(1, 1, 0); SLOAD(0, 2 * KVBLK);
  qkt<(QKT_PREFETCH != 0)>(pA0, pA1, K_lds, qr, r32, hi); partialSM<2>(pA0, pA1, m_reg, mn_, al_);
  __syncthreads();
  int vr = 0;
  for (int j = 1; j + 1 < NT; j += 2) {
    { const int vw = NEXT3(NEXT3(vr));
      SWRITE(0, vw, 0); SLOAD(0, (j + 2) * KVBLK);
      SBAR(); qkt<(QKT_PREFETCH != 0)>(pB0, pB1, K_lds + SHM_K, qr, r32, hi);
      finishSM<2>(pA0, pA1, al_, l_reg, pa0, pa1, pa2, pa3); SBAR();
      pv_d0(o, vb0 + vr * SHM_V, pa0, pa1, pa2, pa3); partialSM<2>(pB0, pB1, m_reg, mn_, al_);
      __syncthreads(); vr = NEXT3(vr); }
    { const int vw = NEXT3(NEXT3(vr));
      SWRITE(1, vw, 0); if (j + 3 < NT) SLOAD(0, (j + 3) * KVBLK);
      SBAR(); qkt<(QKT_PREFETCH != 0)>(pA0, pA1, K_lds, qr, r32, hi);
      finishSM<2>(pB0, pB1, al_, l_reg, pa0, pa1, pa2, pa3); SBAR();
      pv_d0(o, vb0 + vr * SHM_V, pa0, pa1, pa2, pa3); partialSM<2>(pA0, pA1, m_reg, mn_, al_);
      __syncthreads(); vr = NEXT3(vr); }
  }
  SBAR(); qkt<(QKT_PREFETCH != 0)>(pB0, pB1, K_lds + SHM_K, qr, r32, hi);
  finishSM<2>(pA0, pA1, al_, l_reg, pa0, pa1, pa2, pa3); SBAR();
  pv_d0(o, vb0 + vr * SHM_V, pa0, pa1, pa2, pa3); partialSM<2>(pB0, pB1, m_reg, mn_, al_);
  finishSM<2>(pB0, pB1, al_, l_reg, pa0, pa1, pa2, pa3); SBAR();
  pv_d0(o, vb0 + NEXT3(vr) * SHM_V, pa0, pa1, pa2, pa3);
  int lane_e = lane; asm volatile("" : "+v"(lane_e));
  const int r32e = lane_e & 31, hie = lane_e >> 5;
  if (hie == 0) li_l[r32e] = l_reg; asm volatile("s_waitcnt lgkmcnt(0)" ::: "memory");
  float rli[16];
#pragma unroll
  for (int r = 0; r < 16; ++r) rli[r] = __builtin_amdgcn_rcpf(li_l[crow(r, hie)]);
  __syncthreads();
  char* ost = lds + wid * 8192;
  { char* op = ost + hie * 1024 + r32e * 2;
#pragma unroll
    for (int r = 0; r < 16; ++r) {
#pragma unroll
      for (int d0 = 0; d0 < 4; ++d0) { const unsigned w = cvtpk(o[d0][r] * rli[r], 0.f); *(unsigned short*)(op + ((r & 3) + 8 * (r >> 2)) * 256 + d0 * 64) = (unsigned short)w; } } }
  asm volatile("s_waitcnt lgkmcnt(0)" ::: "memory");
  { const char* ip = ost + (lane_e >> 4) * 256 + (lane_e & 15) * 16;
    unsigned goff = (unsigned)(wid * QBLK + (lane_e >> 4)) * (unsigned)U.ostride + (unsigned)((lane_e & 15) * 8); const unsigned gstep = 4u * (unsigned)U.ostride;
#pragma unroll
    for (int i = 0; i < 8; ++i) { const u32x4 w = *(const u32x4*)(ip + i * 1024); *(u32x4*)(U.O + goff) = w; goff += gstep; } }
  __syncthreads();
#undef SLOAD
#undef SWRITE
#undef NEXT3
}

constexpr int DMA_KOFF = 0, DMA_VOFF = 3 * SHM_K, DMA_SCR = 3 * SHM_K + 4 * SHM_V, SHM_DMA = DMA_SCR + NW * 64 * 4;
typedef __attribute__((address_space(3))) unsigned char lds_u8;
__device__ __forceinline__ void attn_unit_dma(const Unit& U, char* lds, lds_u8* ldsl, const int tid) {
  const int wid = __builtin_amdgcn_readfirstlane(tid >> 6), lane = tid & 63, r32 = lane & 31, hi = lane >> 5;
  char* K_lds = lds + DMA_KOFF; char* V_lds = lds + DMA_VOFF;
  float* ws = (float*)(lds + DMA_SCR) + wid * 64; float* li_l = ws;
  float m_reg = 0.f, l_reg = 0, mn_, al_ = 1.f; f32x16 o[4] = {}; bf16x8 qr[8];
  { int lq_ = lane; asm volatile("" : "+v"(lq_));
    const unsigned qoff = (unsigned)(wid * QBLK + (lq_ & 31)) * (unsigned)U.qstride + (unsigned)((lq_ >> 5) * 8);
#pragma unroll
    for (int d0 = 0; d0 < 8; ++d0) qr[d0] = *reinterpret_cast<const bf16x8*>(U.Q + qoff + d0 * 16); }
  unsigned koff[2], voff[2];
#pragma unroll
  for (int i = 0; i < 2; ++i) { const int p = (wid * 2 + i) * 64 + lane;
    { const int row = p >> 4, cs = p & 15, c = cs ^ (row & 7); koff[i] = ((unsigned)row * (unsigned)U.kstride + (unsigned)(c * 8)) * 2u; }
    { const int st = p >> 5, q = p & 31, kk = (st >> 2) * 8 + (q >> 2), key = (kk & ~0xC) | ((kk & 4) << 1) | ((kk & 8) >> 1), c = (st & 3) * 32 + (q & 3) * 8; voff[i] = ((unsigned)key * (unsigned)U.kstride + (unsigned)c) * 2u; } }
  const int vb0 = (int)(uintptr_t)V_lds + v_rd_base(lane);
  const unsigned ldsw = (unsigned)wid * 2048u;
#define NEXT3(x) ((x) == 2 ? 0 : (x) + 1)
#define NEXT4(x) (((x) + 1) & 3)
#define DMA_TILE(t, ks, vs) do { const int t_ = (t); const char* kb_ = (const char*)(U.K + (size_t)t_ * KVBLK * U.kstride); const char* vb_ = (const char*)(U.V + (size_t)t_ * KVBLK * U.kstride); \
    _Pragma("unroll") for (int i_ = 0; i_ < 2; ++i_) { \
      __builtin_amdgcn_global_load_lds((const unsigned*)(kb_ + koff[i_]), (__attribute__((address_space(3))) unsigned*)(ldsl + DMA_KOFF + (ks) * SHM_K + ldsw + i_ * 1024), 16, 0, 0); \
      __builtin_amdgcn_global_load_lds((const unsigned*)(vb_ + voff[i_]), (__attribute__((address_space(3))) unsigned*)(ldsl + DMA_VOFF + (vs) * SHM_V + ldsw + i_ * 1024), 16, 0, 0); } } while (0)
#define STEP_BAR() do { asm volatile("s_waitcnt vmcnt(4) lgkmcnt(0)" ::: "memory"); __builtin_amdgcn_s_barrier(); asm volatile("" ::: "memory"); } while (0)
#define STEP_BAR0() do { asm volatile("s_waitcnt vmcnt(0) lgkmcnt(0)" ::: "memory"); __builtin_amdgcn_s_barrier(); asm volatile("" ::: "memory"); } while (0)
  f32x16 pA0, pA1, pB0, pB1; bf16x8 pa0, pa1, pa2, pa3; const int NT = U.NT;
  asm volatile("s_waitcnt vmcnt(0)" ::: "memory");
  DMA_TILE(0, 0, 0); DMA_TILE(1, 1, 1);
  STEP_BAR();
  DMA_TILE(2, 2, 2);
  qkt<(QKT_PREFETCH != 0)>(pA0, pA1, K_lds, qr, r32, hi); partialSM<2>(pA0, pA1, m_reg, mn_, al_);
  STEP_BAR();
  int ks = 1, vs = 1;
  for (int j = 1; j + 1 < NT; j += 2) {
    { const int kw = NEXT3(NEXT3(ks)), vw = NEXT4(NEXT4(vs));
      const bool more_ = j + 2 < NT;
      SBAR(); qkt<(QKT_PREFETCH != 0)>(pB0, pB1, K_lds + ks * SHM_K, qr, r32, hi);
      finishSM<2>(pA0, pA1, al_, l_reg, pa0, pa1, pa2, pa3); SBAR();
      if (more_) DMA_TILE(j + 2, kw, vw); SBAR();
      pv_d0(o, vb0 + ((vs + 3) & 3) * SHM_V, pa0, pa1, pa2, pa3); partialSM<2>(pB0, pB1, m_reg, mn_, al_);
      if (more_) STEP_BAR(); else STEP_BAR0(); ks = NEXT3(ks); vs = NEXT4(vs); }
    { const int kw = NEXT3(NEXT3(ks)), vw = NEXT4(NEXT4(vs));
      const bool more_ = j + 3 < NT;
      SBAR(); qkt<(QKT_PREFETCH != 0)>(pA0, pA1, K_lds + ks * SHM_K, qr, r32, hi);
      finishSM<2>(pB0, pB1, al_, l_reg, pa0, pa1, pa2, pa3); SBAR();
      if (more_) DMA_TILE(j + 3, kw, vw); SBAR();
      pv_d0(o, vb0 + ((vs + 3) & 3) * SHM_V, pa0, pa1, pa2, pa3); partialSM<2>(pA0, pA1, m_reg, mn_, al_);
      if (more_) STEP_BAR(); else STEP_BAR0(); ks = NEXT3(ks); vs = NEXT4(vs); }
  }
  SBAR(); qkt<(QKT_PREFETCH != 0)>(pB0, pB1, K_lds + ks * SHM_K, qr, r32, hi);
  finishSM<2>(pA0, pA1, al_, l_reg, pa0, pa1, pa2, pa3); SBAR();
  pv_d0(o, vb0 + ((vs + 3) & 3) * SHM_V, pa0, pa1, pa2, pa3); partialSM<2>(pB0, pB1, m_reg, mn_, al_);
  finishSM<2>(pB0, pB1, al_, l_reg, pa0, pa1, pa2, pa3); SBAR();
  pv_d0(o, vb0 + vs * SHM_V, pa0, pa1, pa2, pa3);
  asm volatile("s_waitcnt vmcnt(0) lgkmcnt(0)" ::: "memory");
  int lane_e = lane; asm volatile("" : "+v"(lane_e));
  const int r32e = lane_e & 31, hie = lane_e >> 5;
  if (hie == 0) li_l[r32e] = l_reg; asm volatile("s_waitcnt lgkmcnt(0)" ::: "memory");
  float rli[16];
#pragma unroll
  for (int r = 0; r < 16; ++r) rli[r] = __builtin_amdgcn_rcpf(li_l[crow(r, hie)]);
  __syncthreads();
  char* ost = lds + wid * 8192;
  { char* op = ost + hie * 1024 + r32e * 2;
#pragma unroll
    for (int r = 0; r < 16; ++r) {
#pragma unroll
      for (int d0 = 0; d0 < 4; ++d0) { const unsigned w = cvtpk(o[d0][r] * rli[r], 0.f); *(unsigned short*)(op + ((r & 3) + 8 * (r >> 2)) * 256 + d0 * 64) = (unsigned short)w; } } }
  asm volatile("s_waitcnt lgkmcnt(0)" ::: "memory");
  { const char* ip = ost + (lane_e >> 4) * 256 + (lane_e & 15) * 16;
    unsigned goff = (unsigned)(wid * QBLK + (lane_e >> 4)) * (unsigned)U.ostride + (unsigned)((lane_e & 15) * 8); const unsigned gstep = 4u * (unsigned)U.ostride;
#pragma unroll
    for (int i = 0; i < 8; ++i) { const u32x4 w = *(const u32x4*)(ip + i * 1024); *(u32x4*)(U.O + goff) = w; goff += gstep; } }
  __syncthreads();
#undef NEXT3
#undef NEXT4
#undef DMA_TILE
#undef STEP_BAR
#undef STEP_BAR0
}
}

constexpr int NWAVES = 8;
constexpr int DM = 2048, SEQ = 16384, NSEQ = 3, M_ALL = NSEQ * SEQ, DEPTH = 4, DFF = 5632, INC = 13824;
constexpr int MGR = 2 * SEQ;
constexpr int A_Q = 0, A_K = 1536, A_V = 3072, B_Q = 4608, B_K = 5632, B_V = 5888, C_Q = 6144, C_K = 7168, C_V = 7424, GL0 = 7680;
constexpr float NORM_EPS = 1e-6f;
enum { I_XP = 0, I_XS, I_NF1, I_F1IN, I_F1OUT, I_NMIX, I_WIN, I_QNQ, I_QNK, I_SINK, I_WA, I_WB, I_WC, I_WO, I_NF2, I_F2IN, I_F2OUT, I_NFIN, N_IN };

constexpr size_t MiB = 1u << 20;
constexpr size_t WS_CTL = 0, CTL_ZERO_BYTES = 1 * MiB;
constexpr int LDW = DM + LDW_PAD, LDU = DM + LDU_PAD;
constexpr size_t WL_F1IN = 0, WL_F1OUT = WL_F1IN + (size_t)2 * DFF * LDW * 2, WL_WIN = WL_F1OUT + (size_t)DM * DFF * 2, WL_WA = WL_WIN + (size_t)INC * LDW * 2,
                 WL_WB = WL_WA + (size_t)DM * 512 * 2, WL_WC = WL_WB + (size_t)DM * 1024 * 2, WL_WO = WL_WC + (size_t)DM * 1024 * 2, WL_F2IN = WL_WO + (size_t)DM * LDW * 2,
                 WL_F2OUT = WL_F2IN + (size_t)2 * DFF * LDW * 2, WL_BYTES = WL_F2OUT + (size_t)DM * DFF * 2;
constexpr size_t WS_W = 1 * MiB;
constexpr size_t WS_U = WS_W + WL_BYTES;
constexpr size_t WS_R = WS_U + (size_t)M_ALL * LDU * 2;
constexpr size_t WS_H = WS_R;
constexpr size_t WS_QKVG = WS_R;
constexpr int OCAT = 2560;
constexpr size_t WS_OCAT = WS_QKVG + (size_t)MGR * INC * 2;
constexpr size_t WS_OA = WS_OCAT, WS_OB = WS_OCAT + 512 * 2, WS_OC = WS_OCAT + 1536 * 2;
constexpr size_t WS_PA = WS_OCAT + (size_t)MGR * OCAT * 2;
constexpr size_t WS_LSE = WS_PA + (size_t)3 * MGR * 512 * 2;
constexpr size_t WS_QB = WS_LSE + (size_t)3 * MGR * 4 * 4;
constexpr size_t WS_KB = WS_QB + (size_t)MGR * 1024 * 2;
constexpr size_t WS_VB = WS_KB + (size_t)MGR * 256 * 2;
constexpr size_t WS_MB = WS_VB + (size_t)MGR * 256 * 2;
constexpr size_t WS_MIX_END = WS_MB + (size_t)MGR * LDU * 2;
constexpr int LDH = DFF + LDH_PAD;
constexpr size_t WS_H_END = WS_H + (size_t)M_ALL * LDH * 2;
constexpr size_t WS_X16 = WS_MIX_END > WS_H_END ? WS_MIX_END : WS_H_END;
constexpr size_t WS_END = WS_X16 + (size_t)M_ALL * DM * 2;
constexpr int CW_BAR = 4096;

constexpr int RING_OFF = 0, RING_BYTES = 131072;
constexpr int LDSCTL_OFF = RING_BYTES, MISC_OFF = LDSCTL_OFF + 320;
constexpr int LDS_BYTES = 147456;
constexpr int DIAG_OFF = MISC_OFF + 256;

#define GAS __attribute__((address_space(1)))
#define LAS __attribute__((address_space(3)))
typedef unsigned short bf16;
typedef unsigned v4u __attribute__((ext_vector_type(4)));
typedef unsigned v2u __attribute__((ext_vector_type(2)));
typedef float f32x4 __attribute__((ext_vector_type(4)));
#define LDS_WAIT() asm volatile("s_waitcnt lgkmcnt(0)" ::: "memory")
#define VM_WAIT() asm volatile("s_waitcnt vmcnt(0)" ::: "memory")
__device__ __forceinline__ unsigned f2bf(float f) { unsigned u = __builtin_bit_cast(unsigned, f); return (u + 0x7fffu + ((u >> 16) & 1u)) >> 16; }
__device__ __forceinline__ unsigned pk2(float lo, float hi) { return f2bf(lo) | (f2bf(hi) << 16); }
__device__ __forceinline__ float bflo(unsigned w) { return __uint_as_float(w << 16); }
__device__ __forceinline__ float bfhi(unsigned w) { return __uint_as_float(w & 0xffff0000u); }

#define XB_TMO      128
#define XB_XCNT(j)  (256  + 64 * (j))
#define XB_XSUB(j)  (1280 + 64 * (j))
#define XB_XGEN(j)  (2304 + 64 * (j))
#define XB_TOP      3328
#define XB_TOPGEN   3392
#define XCD_BAR_WORDS 3456
#define XB_SPIN_CAP (1u << 18)
__device__ __forceinline__ unsigned xb_ld(unsigned* p)              { return __hip_atomic_load(p, __ATOMIC_RELAXED, __HIP_MEMORY_SCOPE_AGENT); }
__device__ __forceinline__ unsigned xb_add(unsigned* p, unsigned v) { return __hip_atomic_fetch_add(p, v, __ATOMIC_RELAXED, __HIP_MEMORY_SCOPE_AGENT); }
__device__ __forceinline__ unsigned xb_xcc_id() { return (unsigned)__builtin_amdgcn_s_getreg((3 << 11) | 20) & 0xFu; }
#define XB_SPIN(cond, bar) do { unsigned _sp = 0; while (cond) { __builtin_amdgcn_s_sleep(1); \
    if ((++_sp & 255u) == 0u) { if (xb_ld(&(bar)[XB_TMO])) break; if (_sp > XB_SPIN_CAP) { atomicAdd(&(bar)[XB_TMO], 1u); break; } } } } while (0)
struct XcdBarrier { unsigned* bar; unsigned x; volatile LAS unsigned* st; };
__device__ __forceinline__ XcdBarrier xcd_barrier_post(unsigned* bar, volatile LAS unsigned* st) {
    XcdBarrier b; b.bar = bar; b.x = xb_xcc_id(); b.st = st;
    if (threadIdx.x == 0) (void)xb_add(&bar[XB_XCNT(b.x)], 1u);
    return b;
}
__device__ __forceinline__ void xcd_barrier_complete(unsigned* bar, unsigned x, unsigned& nloc, unsigned& nx) {
    const unsigned G = gridDim.x * gridDim.y * gridDim.z;
    unsigned sum, cnt, mine, sp = 0u;
    for (;;) {
        sum = 0u; cnt = 0u; mine = 0u;
#pragma unroll
        for (unsigned j = 0; j < 16; ++j) { const unsigned c = xb_ld(&bar[XB_XCNT(j)]); sum += c; cnt += (c > 0u) ? 1u : 0u; mine = (j == x) ? c : mine; }
        if (sum == G) break;
        __builtin_amdgcn_s_sleep(1);
        if ((++sp & 255u) == 0u) { if (xb_ld(&bar[XB_TMO])) break; if (sp > XB_SPIN_CAP) { atomicAdd(&bar[XB_TMO], 1u); break; } }
    }
    nloc = mine > 0u ? mine : 1u; nx = cnt > 0u ? cnt : 1u;
}
__device__ __forceinline__ void xcd_barrier(const XcdBarrier& b) {
    asm volatile("s_waitcnt vmcnt(0)" ::: "memory");
    __syncthreads();
    if (threadIdx.x == 0) {
        unsigned* bar = b.bar;
        __builtin_amdgcn_s_waitcnt(0);
        unsigned nloc = b.st[0], nx = b.st[1];
        if (nloc == 0u) { xcd_barrier_complete(bar, b.x, nloc, nx); b.st[0] = nloc; b.st[1] = nx; }
        const unsigned old = xb_add(&bar[XB_XSUB(b.x)], 1u);
        const unsigned gen = old / nloc;
        if (old + 1u == (gen + 1u) * nloc) {
            __builtin_amdgcn_fence(__ATOMIC_RELEASE, "agent");
            asm volatile("s_waitcnt vmcnt(0)" ::: "memory");
            const unsigned og = xb_add(&bar[XB_TOP], 1u);
            const unsigned tg = og / nx;
            if (og + 1u == (tg + 1u) * nx) xb_add(&bar[XB_TOPGEN], 1u);
            else XB_SPIN(xb_ld(&bar[XB_TOPGEN]) == tg, bar);
            __builtin_amdgcn_fence(__ATOMIC_ACQUIRE, "agent");
            xb_add(&bar[XB_XGEN(b.x)], 1u);
            asm volatile("s_waitcnt vmcnt(0)" ::: "memory");
        } else {
            XB_SPIN(xb_ld(&bar[XB_XGEN(b.x)]) == gen, bar);
            __builtin_amdgcn_fence(__ATOMIC_ACQUIRE, "agent");
            asm volatile("s_waitcnt vmcnt(0)" ::: "memory");
        }
    }
    __syncthreads();
}

template <int XOR> __device__ __forceinline__ float swz_xor(float v) { return __int_as_float(__builtin_amdgcn_ds_swizzle(__float_as_int(v), (XOR << 10) | 0x1F)); }
__device__ __forceinline__ float wave_sum(float v) {
    v += swz_xor<1>(v); v += swz_xor<2>(v); v += swz_xor<4>(v); v += swz_xor<8>(v); v += swz_xor<16>(v);
    auto rr = __builtin_amdgcn_permlane32_swap(__float_as_uint(v), __float_as_uint(v), false, false);
    return __uint_as_float(rr[0]) + __uint_as_float(rr[1]);
}
__device__ __forceinline__ float wave_max(float v) {
    v = fmaxf(v, swz_xor<1>(v)); v = fmaxf(v, swz_xor<2>(v)); v = fmaxf(v, swz_xor<4>(v)); v = fmaxf(v, swz_xor<8>(v)); v = fmaxf(v, swz_xor<16>(v));
    auto rr = __builtin_amdgcn_permlane32_swap(__float_as_uint(v), __float_as_uint(v), false, false);
    return fmaxf(__uint_as_float(rr[0]), __uint_as_float(rr[1]));
}
__device__ __forceinline__ void transpose_item(const float* W, int K, int N, bf16* WT, int k0, int n0, int orow0, LAS float* scr, int lane, int ldw) {
#pragma unroll 8
    for (int i = 0; i < 32; ++i) { const int kk = 2 * i + (lane >> 5); scr[kk * 33 + (lane & 31)] = W[(size_t)(k0 + kk) * N + n0 + (lane & 31)]; }
    LDS_WAIT(); asm volatile("" ::: "memory");
    const int c = lane & 7;
#pragma unroll
    for (int j = 0; j < 4; ++j) { const int n = (lane >> 3) + 8 * j; const LAS float* s = scr + (8 * c) * 33 + n;
        v4u o; o.x = pk2(s[0 * 33], s[1 * 33]); o.y = pk2(s[2 * 33], s[3 * 33]); o.z = pk2(s[4 * 33], s[5 * 33]); o.w = pk2(s[6 * 33], s[7 * 33]);
        *(GAS v4u*)(WT + (size_t)(orow0 + n) * ldw + k0 + 8 * c) = o; }
    LDS_WAIT(); asm volatile("" ::: "memory");
}
__device__ __forceinline__ void transpose_matrix(const float* W, int K, int N, bf16* WT, int swiglu, LAS float* scr, int lane, int gw, int NGW, int ldw = 0) {
    const int nblk = N / 32, nitems = (K / 64) * nblk;
    for (int it = gw; it < nitems; it += NGW) {
        const int kb = it / nblk, nb = it % nblk, k0 = 64 * kb, n0 = 32 * nb;
        int orow0 = n0;
        if (swiglu) { const int half = n0 >= DFF ? 1 : 0, np = n0 - half * DFF; orow0 = 256 * (np / 128) + 128 * half + (np % 128); }
        transpose_item(W, K, N, WT, k0, n0, orow0, scr, lane, ldw ? ldw : K);
    }
}
template <bool TO_F32>
__device__ __forceinline__ void rms_row16(const bf16* xrow, const float* g, void* orow, int lane) {
    const GAS v4u* xr = (const GAS v4u*)xrow + lane; const GAS f32x4* gr = (const GAS f32x4*)g + 2 * lane;
    v4u v[4]; float s = 0.f;
#pragma unroll
    for (int j = 0; j < 4; ++j) { v[j] = xr[64 * j];
        s += ((bflo(v[j].x) * bflo(v[j].x) + bfhi(v[j].x) * bfhi(v[j].x)) + (bflo(v[j].y) * bflo(v[j].y) + bfhi(v[j].y) * bfhi(v[j].y))) + ((bflo(v[j].z) * bflo(v[j].z) + bfhi(v[j].z) * bfhi(v[j].z)) + (bflo(v[j].w) * bflo(v[j].w) + bfhi(v[j].w) * bfhi(v[j].w))); }
    const float rstd = __builtin_amdgcn_rsqf(wave_sum(s) * (1.f / DM) + NORM_EPS);
#pragma unroll
    for (int j = 0; j < 4; ++j) { const f32x4 g0 = gr[128 * j], g1 = gr[128 * j + 1];
        const f32x4 y0 = {bflo(v[j].x) * rstd * g0.x, bfhi(v[j].x) * rstd * g0.y, bflo(v[j].y) * rstd * g0.z, bfhi(v[j].y) * rstd * g0.w};
        const f32x4 y1 = {bflo(v[j].z) * rstd * g1.x, bfhi(v[j].z) * rstd * g1.y, bflo(v[j].w) * rstd * g1.z, bfhi(v[j].w) * rstd * g1.w};
        if constexpr (TO_F32) { GAS f32x4* o = (GAS f32x4*)orow + 2 * lane; o[128 * j] = y0; o[128 * j + 1] = y1; }
        else { v4u w; w.x = pk2(y0.x, y0.y); w.y = pk2(y0.z, y0.w); w.z = pk2(y1.x, y1.y); w.w = pk2(y1.z, y1.w); ((GAS v4u*)orow + lane)[64 * j] = w; } }
}
__device__ __forceinline__ void rms_row_to_bf16(const float* xrow, const float* g, bf16* orow, bf16* xcopy, int lane) {
    const GAS f32x4* xr = (const GAS f32x4*)xrow + lane; const GAS f32x4* gr = (const GAS f32x4*)g + lane;
    f32x4 v[8]; float s = 0.f;
#pragma unroll
    for (int j = 0; j < 8; ++j) { v[j] = xr[64 * j]; s += (v[j].x * v[j].x + v[j].y * v[j].y) + (v[j].z * v[j].z + v[j].w * v[j].w); }
    if (xcopy) { GAS v2u* xc = (GAS v2u*)xcopy + lane;
#pragma unroll
        for (int j = 0; j < 8; ++j) { v2u w; w.x = pk2(v[j].x, v[j].y); w.y = pk2(v[j].z, v[j].w); xc[64 * j] = w; } }
    const float rstd = __builtin_amdgcn_rsqf(wave_sum(s) * (1.f / DM) + NORM_EPS);
    GAS v2u* o8 = (GAS v2u*)orow + lane;
#pragma unroll
    for (int j = 0; j < 8; ++j) { const f32x4 gg = gr[64 * j]; v2u w; w.x = pk2(v[j].x * rstd * gg.x, v[j].y * rstd * gg.y); w.y = pk2(v[j].z * rstd * gg.z, v[j].w * rstd * gg.w); o8[64 * j] = w; }
}
__device__ __forceinline__ void rms_row_f32(float* xrow, const float* g, int lane) {
    GAS f32x4* xr = (GAS f32x4*)xrow + lane; const GAS f32x4* gr = (const GAS f32x4*)g + lane;
    f32x4 v[8]; float s = 0.f;
#pragma unroll
    for (int j = 0; j < 8; ++j) { v[j] = xr[64 * j]; s += (v[j].x * v[j].x + v[j].y * v[j].y) + (v[j].z * v[j].z + v[j].w * v[j].w); }
    const float rstd = __builtin_amdgcn_rsqf(wave_sum(s) * (1.f / DM) + NORM_EPS);
#pragma unroll
    for (int j = 0; j < 8; ++j) { const f32x4 gg = gr[64 * j]; xr[64 * j] = v[j] * rstd * gg; }
}
constexpr float QPRESCALE = 0.088388347648318440f * 1.4426950408889634f;
template <int NT_>
__device__ __forceinline__ void ropeB_tokens(const bf16* qkvg, int t0, int tstep, const float* gq, const float* gk, bf16* qb, bf16* kb, bf16* vb, int lane) {
    const int f = lane & 31;
    const float invrev = __builtin_amdgcn_exp2f((float)f * (-13.287712379549449f / 32.0f)) * 0.15915494309189535f;
    const float gq0 = gq[2 * lane], gq1 = gq[2 * lane + 1], gk0 = gk[2 * lane], gk1 = gk[2 * lane + 1];
    unsigned w[NT_][10]; v2u vv[NT_];
#pragma unroll
    for (int i = 0; i < NT_; ++i) { const int t = t0 + i * tstep; const GAS unsigned* src = (const GAS unsigned*)(qkvg + (size_t)t * INC + B_Q) + lane;
#pragma unroll
        for (int h = 0; h < 10; ++h) w[i][h] = src[h * 64];
        vv[i] = ((const GAS v2u*)(qkvg + (size_t)t * INC + B_V))[lane]; }
#pragma unroll
    for (int i = 0; i < NT_; ++i) { const int t = t0 + i * tstep;
        const int tp = t & (SEQ - 1);
        const float pos = (float)((lane < 32) ? (tp >> 6) : (tp & 63));
        float rev = pos * invrev; rev = rev - __builtin_floorf(rev);
        const float cs = __builtin_amdgcn_cosf(rev), sn = __builtin_amdgcn_sinf(rev);
#pragma unroll
        for (int h = 0; h < 10; ++h) {
            const float x0 = bflo(w[i][h]), x1 = bfhi(w[i][h]);
            const float rstd = __builtin_amdgcn_rsqf(wave_sum(x0 * x0 + x1 * x1) * (1.f / 128.f) + NORM_EPS);
            const float y0 = x0 * rstd * (h < 8 ? gq0 : gk0), y1 = x1 * rstd * (h < 8 ? gq1 : gk1);
            const float qs = h < 8 ? QPRESCALE : 1.0f;
            const unsigned o = pk2((y0 * cs - y1 * sn) * qs, (y0 * sn + y1 * cs) * qs);
            if (h < 8) ((GAS unsigned*)(qb + (size_t)t * 1024))[h * 64 + lane] = o; else ((GAS unsigned*)(kb + (size_t)t * 256))[(h - 8) * 64 + lane] = o;
        }
        ((GAS v2u*)(vb + (size_t)t * 256))[lane] = vv[i]; }
}
__device__ __forceinline__ void mergeA_token(const bf16* pa, const float* lse, bf16* oa, int t, int lane) {
#pragma unroll
    for (int hh = 0; hh < 4; ++hh) {
        const float l0 = lse[((size_t)0 * MGR + t) * 4 + hh], l1 = lse[((size_t)1 * MGR + t) * 4 + hh], l2 = lse[((size_t)2 * MGR + t) * 4 + hh];
        const float mx = fmaxf(l0, fmaxf(l1, l2));
        const float e0 = __builtin_amdgcn_exp2f((l0 - mx) * 1.4426950408889634f), e1 = __builtin_amdgcn_exp2f((l1 - mx) * 1.4426950408889634f), e2 = __builtin_amdgcn_exp2f((l2 - mx) * 1.4426950408889634f);
        const float inv = __builtin_amdgcn_rcpf(e0 + e1 + e2);
        const unsigned w0 = ((const GAS unsigned*)(pa + ((size_t)0 * MGR + t) * 512))[hh * 64 + lane], w1 = ((const GAS unsigned*)(pa + ((size_t)1 * MGR + t) * 512))[hh * 64 + lane],
                       w2 = ((const GAS unsigned*)(pa + ((size_t)2 * MGR + t) * 512))[hh * 64 + lane];
        const float a = (e0 * bflo(w0) + e1 * bflo(w1) + e2 * bflo(w2)) * inv, b = (e0 * bfhi(w0) + e1 * bfhi(w1) + e2 * bfhi(w2)) * inv;
        ((GAS unsigned*)(oa + (size_t)t * OCAT))[hh * 64 + lane] = pk2(a, b);
    }
}

struct Args { const float* in[N_IN]; float* out; unsigned char* ws; int ph_lo, ph_hi; };
constexpr int N_PHASES = 1 + DEPTH * (3 + 1 + 2 * 5 + 3) + 1;

__device__ __forceinline__ int opq_v(int x) { asm volatile("" : "+v"(x)); return x; }
template <class T> __device__ __forceinline__ T* opq_p(T* p) { GAS T* g = (GAS T*)p; asm volatile("" : "+s"(g)); return (T*)g; }
__device__ __forceinline__ int lane_id_asm() { int l; asm volatile("v_mbcnt_lo_u32_b32 %0, -1, 0\n\tv_mbcnt_hi_u32_b32 %0, -1, %0" : "=v"(l)); return l; }
__device__ __forceinline__ int opq_s(int x) { asm volatile("" : "+s"(x)); return x; }

__global__ void __launch_bounds__(NWAVES * 64, 2) trunk_fwd(Args args) {
    extern __shared__ __attribute__((aligned(16))) unsigned char lds[];
    LAS unsigned char* ldsl = (LAS unsigned char*)lds;
    volatile LAS unsigned* MISC = (volatile LAS unsigned*)(ldsl + MISC_OFF);
    const int G_k = gridDim.x; const int bx_k = blockIdx.x;
    const int wave0 = __builtin_amdgcn_readfirstlane((int)threadIdx.x >> 6);
    { const int tid0 = threadIdx.x;
      for (int u = tid0; u < (LDS_BYTES - LDSCTL_OFF) / 4; u += NWAVES * 64) ((LAS unsigned*)(ldsl + LDSCTL_OFF))[u] = 0u; }
    __syncthreads();
    XcdBarrier bar; bar.bar = (unsigned*)(args.ws + WS_CTL) + CW_BAR; bar.x = 0; bar.st = nullptr;
    if (!MK_PER_PHASE) bar = xcd_barrier_post((unsigned*)(args.ws + WS_CTL) + CW_BAR, MISC + 8);
    const int lo = args.ph_lo, hi = args.ph_hi;
    int ph = 0;
#define PH_ON (ph >= lo && ph < hi)
#define PH_VARS const int G = opq_s(G_k), bx = opq_s(bx_k), vcu = (G % 8 == 0) ? (bx % 8) * (G / 8) + bx / 8 : bx, NGW = G * NWAVES; (void)NGW; const int lane = lane_id_asm(), wave = wave0, tid = wave * 64 + lane, gw = vcu * NWAVES + wave; unsigned char* ws = opq_p(args.ws); float* X = opq_p(args.out); (void)lane; (void)gw; (void)ws; (void)X
#if DIAG
#define PH_STAMP(ty) do { if (bx_k == 0 && wave0 == 0 && lane_id_asm() == 0) { const unsigned long long t_ = __builtin_amdgcn_s_memrealtime(); volatile LAS unsigned long long* ts_ = (volatile LAS unsigned long long*)(ldsl + DIAG_OFF); \
    ts_[1 + (ty)] += t_ - ts_[0]; ts_[0] = t_; } } while (0)
#else
#define PH_STAMP(ty) do { } while (0)
#endif
#define PH_DUP(ty) ((ty) == DUP_TYPE)
#define GRID_BARRIER() do { XcdBarrier b2_ = bar; b2_.bar = opq_p(bar.bar); b2_.x = (unsigned)opq_s((int)bar.x); xcd_barrier(b2_); } while (0)
#define PH_BEGIN(ty) if (PH_ON) { for (int rep_ = 0; rep_ < (PH_DUP(ty) ? 2 : 1); ++rep_) { PH_VARS; (void)rep_;
#define PH_CLOSE(ty) if (PH_DUP(ty) && rep_ == 0) GRID_BARRIER(); } } PH_END(ty)
#define PH_END(ty) do { if (PH_ON && ph + 1 < hi) { XcdBarrier b2_ = bar; b2_.bar = opq_p(bar.bar); b2_.x = (unsigned)opq_s((int)bar.x); xcd_barrier(b2_); } if (PH_ON) PH_STAMP(ty); ++ph; } while (0)

#define CONVERT_LAYER(l) do { LAS float* scr = (LAS float*)(ldsl + RING_OFF + wave * 16384); unsigned char* wl = ws + WS_W; \
            transpose_matrix(args.in[I_F1IN] + (size_t)(l) * DM * 2 * DFF, DM, 2 * DFF, (bf16*)(wl + WL_F1IN), 1, scr, lane, gw, NGW, LDW); \
            transpose_matrix(args.in[I_F1OUT] + (size_t)(l) * DFF * DM, DFF, DM, (bf16*)(wl + WL_F1OUT), 0, scr, lane, gw, NGW); \
            transpose_matrix(args.in[I_WIN] + (size_t)(l) * DM * INC, DM, INC, (bf16*)(wl + WL_WIN), 0, scr, lane, gw, NGW, LDW); \
            transpose_matrix(args.in[I_WA] + (size_t)(l) * 512 * DM, 512, DM, (bf16*)(wl + WL_WA), 0, scr, lane, gw, NGW, OCAT); \
            transpose_matrix(args.in[I_WB] + (size_t)(l) * 1024 * DM, 1024, DM, (bf16*)(wl + WL_WA) + 512, 0, scr, lane, gw, NGW, OCAT); \
            transpose_matrix(args.in[I_WC] + (size_t)(l) * 1024 * DM, 1024, DM, (bf16*)(wl + WL_WA) + 1536, 0, scr, lane, gw, NGW, OCAT); \
            transpose_matrix(args.in[I_WO] + (size_t)(l) * DM * DM, DM, DM, (bf16*)(wl + WL_WO), 0, scr, lane, gw, NGW, LDW); \
            transpose_matrix(args.in[I_F2IN] + (size_t)(l) * DM * 2 * DFF, DM, 2 * DFF, (bf16*)(wl + WL_F2IN), 1, scr, lane, gw, NGW, LDW); \
            transpose_matrix(args.in[I_F2OUT] + (size_t)(l) * DFF * DM, DFF, DM, (bf16*)(wl + WL_F2OUT), 0, scr, lane, gw, NGW); } while (0)
    PH_BEGIN(0)

        CONVERT_LAYER(0);
        bf16* U = (bf16*)(ws + WS_U);
        for (int m = gw; m < M_ALL; m += NGW) {
            const float* xr = (m < 2 * SEQ) ? args.in[I_XP] + (size_t)m * DM : args.in[I_XS] + (size_t)(m - 2 * SEQ) * DM;
            rms_row_to_bf16(xr, args.in[I_NF1], U + (size_t)m * LDU, (bf16*)(ws + WS_X16) + (size_t)m * DM, lane);
        }
    PH_CLOSE(0);

    for (int l = 0; l < DEPTH; ++l) {
        for (int half = 0; half < 2; ++half) {
            PH_BEGIN(1)

                if (half == 0 && l > 0) CONVERT_LAYER(l);
                if (!(l == 0 && half == 0)) {
                    bf16* U = (bf16*)(ws + WS_U);
                    const float* g = (half == 0 ? args.in[I_NF1] : args.in[I_NF2]) + (size_t)l * DM;
                    for (int m = gw; m < M_ALL; m += NGW) rms_row16<false>((const bf16*)(ws + WS_X16) + (size_t)m * DM, g, U + (size_t)m * LDU, lane);
                }
            PH_CLOSE(1);
            PH_BEGIN(2)

                unsigned char* wl = ws + WS_W;
                pg8::Gemm g{(const bf16*)(ws + WS_U), (const bf16*)(wl + (half == 0 ? WL_F1IN : WL_F2IN)), M_ALL, 2 * DFF, DM, LDU, LDW}; pg8::StaticOrder S; S.init(M_ALL, 2 * DFF, G, bx, 0, WGM_WIDE);
                if (EXTRA == 1) { pg8::EpiNull E0; pg8::gemm_phase<pg8::EpiNull, pg8::StaticOrder, true, true>(ldsl + RING_OFF, g, S, E0, tid); GRID_BARRIER(); }
                pg8::EpiSwiglu E{(bf16*)(ws + WS_H), LDH};
                pg8::gemm_phase<pg8::EpiSwiglu, pg8::StaticOrder, true, true>(ldsl + RING_OFF, g, S, E, tid, (unsigned)(STAG_STEP * ((bx >> 3) & 3)));
            PH_CLOSE(2);
            PH_BEGIN(3)

                unsigned char* wl = ws + WS_W;
                pg8::Gemm g{(const bf16*)(ws + WS_H), (const bf16*)(wl + (half == 0 ? WL_F1OUT : WL_F2OUT)), M_ALL, DM, DFF, LDH}; pg8::StaticOrder S; S.init(M_ALL, DM, G, bx, REV_FFNOUT, WGM_NARROW);
                if (EXTRA == 2) { pg8::EpiNull E0; pg8::gemm_phase<pg8::EpiNull, pg8::StaticOrder, true, true>(ldsl + RING_OFF, g, S, E0, tid); GRID_BARRIER(); }
                pg8::EpiResid E{(bf16*)(ws + WS_X16), DM, rep_ ? 0.0f : 0.5f};
                pg8::gemm_phase<pg8::EpiResid, pg8::StaticOrder, true, true>(ldsl + RING_OFF, g, S, E, tid, (unsigned)(STAG_STEP * ((bx >> 3) & 3)));
            PH_CLOSE(3);
            if (half == 0) {
                PH_BEGIN(1)

                    bf16* U = (bf16*)(ws + WS_U);
                    const float* g = args.in[I_NMIX] + (size_t)l * DM;
                    for (int m = gw; m < M_ALL; m += NGW) rms_row16<false>((const bf16*)(ws + WS_X16) + (size_t)m * DM, g, U + (size_t)m * LDU, lane);
                PH_CLOSE(1);
                for (int sg = 0; sg < 2; ++sg) {
                    const int ns = sg == 0 ? 2 : 1, r0 = sg == 0 ? 0 : 2 * SEQ, MR = ns * SEQ;
                    PH_BEGIN(4)

                        unsigned char* wl = ws + WS_W;
                        pg8::Gemm g{(const bf16*)(ws + WS_U) + (size_t)r0 * LDU, (const bf16*)(wl + WL_WIN), MR, INC, DM, LDU, LDW}; pg8::StaticOrder S; S.init(MR, INC, G, bx, 0, WGM_WIDE);
                        pg8::EpiBf16 E{(bf16*)(ws + WS_QKVG), INC};
                        pg8::gemm_phase<pg8::EpiBf16, pg8::StaticOrder, true, true>(ldsl + RING_OFF, g, S, E, tid, (unsigned)(STAG_STEP * ((bx >> 3) & 3)));
                    PH_CLOSE(4);
                    PH_BEGIN(5)

                        bf16* QKVG = (bf16*)(ws + WS_QKVG);
                        { bf16* QB = (bf16*)(ws + WS_QB); bf16* KB = (bf16*)(ws + WS_KB); bf16* VB = (bf16*)(ws + WS_VB);
                          const float* gq = args.in[I_QNQ] + (size_t)l * 128; const float* gk = args.in[I_QNK] + (size_t)l * 128;
                          int t = gw;
                          for (; t + 3 * NGW < MR; t += 4 * NGW) ropeB_tokens<4>(QKVG, t, NGW, gq, gk, QB, KB, VB, lane);
                          for (; t < MR; t += NGW) ropeB_tokens<1>(QKVG, t, NGW, gq, gk, QB, KB, VB, lane); }
                        for (int u = vcu; u < ns * (8 * 64 + 12 * 64); u += G) {
                            att::Unit A;
                            if (u < ns * 8 * 64) {
                                const int sq = u >> 9, h = (u >> 6) & 7, b = u & 63; const size_t rb = (size_t)sq * SEQ;
                                A.Q = QKVG + (rb + 256 * b) * INC + C_Q + h * 128; A.qstride = INC;
                                A.K = QKVG + rb * INC + C_K + (h >> 2) * 128; A.V = QKVG + rb * INC + C_V + (h >> 2) * 128; A.kstride = INC;
                                A.O = (bf16*)(ws + WS_OC) + (rb + 256 * b) * OCAT + h * 128; A.ostride = OCAT;
                                A.NT = 8; A.kb0 = 256 * b - 128; A.n = SEQ; A.qi0 = 256 * b; A.hw = 128;
                                A.slope_raw = __uint_as_float((unsigned)(127 - (h + 1)) << 23) * (1.0f / att::SCALE);
                                A.sink = args.in[I_SINK][l * 8 + h]; A.has_sink = 1; A.lse = nullptr; A.lse_stride = 0;
                            } else {
                                const int v0 = u - ns * 8 * 64, sq = v0 / 768, v = v0 - sq * 768, h = v >> 6, w = v & 63, gi = h >> 2, rs = 2 * gi, r = 1 << rs; const size_t rb = (size_t)sq * SEQ;
                                const int bpc = 64 >> rs, c = w / bpc, b = w % bpc, nsub = SEQ >> rs;
                                A.Q = QKVG + (rb + c + r * 256 * b) * INC + A_Q + h * 128; A.qstride = r * INC;
                                A.K = QKVG + (rb + c) * INC + A_K + h * 128; A.V = QKVG + (rb + c) * INC + A_V + h * 128; A.kstride = r * INC;
                                A.O = (bf16*)(ws + WS_PA) + ((size_t)gi * MGR + rb + c + r * 256 * b) * 512 + (h & 3) * 128; A.ostride = r * 512;
                                A.NT = 6; A.kb0 = 256 * b - 64; A.n = nsub; A.qi0 = 256 * b; A.hw = 64;
                                const float sl = __builtin_amdgcn_exp2f(-8.0f * (float)(h + 1) / 12.0f) * (float)r * (1.0f / att::SCALE);
                                A.slope_raw = __uint_as_float(__builtin_amdgcn_readfirstlane(__float_as_uint(sl)));
                                A.sink = 0.f; A.has_sink = 0; A.lse = (float*)(ws + WS_LSE) + ((size_t)gi * MGR + rb + c + r * 256 * b) * 4 + (h & 3); A.lse_stride = r * 4;
                            }
                            att::attn_unit<true, 0>(A, (char*)lds + RING_OFF, tid);
                        }
                    PH_CLOSE(5);
                    PH_BEGIN(6)

                        for (int t = gw; t < MR; t += NGW) mergeA_token((const bf16*)(ws + WS_PA), (const float*)(ws + WS_LSE), (bf16*)(ws + WS_OA), t, lane);
                        bool fastB;
                        { const float* gq = args.in[I_QNQ] + (size_t)l * 128; const float* gk = args.in[I_QNK] + (size_t)l * 128;
                          float mq = fmaxf(__builtin_fabsf(gq[lane]), __builtin_fabsf(gq[lane + 64])), mk = fmaxf(__builtin_fabsf(gk[lane]), __builtin_fabsf(gk[lane + 64]));
                          mq = wave_max(mq); mk = wave_max(mk);
                          const float bound = 128.0f * mq * mk * QPRESCALE * 1.05f;
                          fastB = __builtin_amdgcn_readfirstlane((int)(bound < 60.0f)) != 0; }
                        if (fastB) {
                        for (int u = vcu; u < ns * 8 * 64; u += G) {
                            const int sq = u >> 9, h = (u >> 6) & 7, b = u & 63; const size_t rb = (size_t)sq * SEQ;
                            att::Unit A;
                            A.Q = (const bf16*)(ws + WS_QB) + (rb + 256 * b) * 1024 + h * 128; A.qstride = 1024;
                            A.K = (const bf16*)(ws + WS_KB) + rb * 256 + (h >> 2) * 128; A.V = (const bf16*)(ws + WS_VB) + rb * 256 + (h >> 2) * 128; A.kstride = 256;
                            A.O = (bf16*)(ws + WS_OB) + (rb + 256 * b) * OCAT + h * 128; A.ostride = OCAT;
                            A.NT = SEQ / 64; A.kb0 = 0; A.n = SEQ; A.qi0 = 0; A.hw = 0; A.slope_raw = 0.f; A.sink = 0.f; A.has_sink = 0; A.lse = nullptr; A.lse_stride = 0;
                            const int tid2 = wave * 64 + lane_id_asm();
                            if (ATT_DMA) att::attn_unit_dma(A, (char*)lds + RING_OFF, (att::lds_u8*)(ldsl + RING_OFF), tid2); else if (ATT_RING) att::attn_unit_ring(A, (char*)lds + RING_OFF, tid2); else att::attn_unit<false, 2>(A, (char*)lds + RING_OFF, tid2);
                        }
                        } else {
                        for (int u = vcu; u < ns * 8 * 64; u += G) {
                            const int sq = u >> 9, h = (u >> 6) & 7, b = u & 63; const size_t rb = (size_t)sq * SEQ;
                            att::Unit A;
                            A.Q = (const bf16*)(ws + WS_QB) + (rb + 256 * b) * 1024 + h * 128; A.qstride = 1024;
                            A.K = (const bf16*)(ws + WS_KB) + rb * 256 + (h >> 2) * 128; A.V = (const bf16*)(ws + WS_VB) + rb * 256 + (h >> 2) * 128; A.kstride = 256;
                            A.O = (bf16*)(ws + WS_OB) + (rb + 256 * b) * OCAT + h * 128; A.ostride = OCAT;
                            A.NT = SEQ / 64; A.kb0 = 0; A.n = SEQ; A.qi0 = 0; A.hw = 0; A.slope_raw = 0.f; A.sink = 0.f; A.has_sink = 0; A.lse = nullptr; A.lse_stride = 0;
                            const int tid2 = wave * 64 + lane_id_asm();
                            att::attn_unit<false, 1>(A, (char*)lds + RING_OFF, tid2);
                        }
                        }
                    PH_CLOSE(6);
                    PH_BEGIN(7)

                        unsigned char* wl = ws + WS_W;
                        pg8::Gemm g{(const bf16*)(ws + WS_OCAT), (const bf16*)(wl + WL_WA), MR, DM, OCAT}; pg8::StaticOrder S; S.init(MR, DM, G, bx, 0, WGM_NARROW);
                        if (EXTRA == 5) { pg8::EpiNull E0; pg8::gemm_phase<pg8::EpiNull, pg8::StaticOrder, true, true>(ldsl + RING_OFF, g, S, E0, tid); GRID_BARRIER(); }
                        pg8::EpiGateCat E{(const bf16*)(ws + WS_QKVG) + GL0, INC, (bf16*)(ws + WS_MB), DM, LDU};
                        pg8::gemm_phase<pg8::EpiGateCat, pg8::StaticOrder, true, true>(ldsl + RING_OFF, g, S, E, tid);
                    PH_CLOSE(7);
                    PH_BEGIN(8)

                        unsigned char* wl = ws + WS_W;
                        pg8::Gemm g{(const bf16*)(ws + WS_MB), (const bf16*)(wl + WL_WO), MR, DM, DM, LDU, LDW}; pg8::StaticOrder S; S.init(MR, DM, G, bx, 0, WGM_NARROW);
                        pg8::EpiResid E{(bf16*)(ws + WS_X16) + (size_t)r0 * DM, DM, rep_ ? 0.0f : 1.0f};
                        pg8::gemm_phase<pg8::EpiResid, pg8::StaticOrder, true, true>(ldsl + RING_OFF, g, S, E, tid);
                    PH_CLOSE(8);
                }
            }
        }
    }
    PH_BEGIN(9)

        if (EXTRA == 3) { for (int i_ = 0; i_ < 200; ++i_) GRID_BARRIER(); }
        for (int m = gw; m < M_ALL; m += NGW) rms_row16<true>((const bf16*)(ws + WS_X16) + (size_t)m * DM, args.in[I_NFIN], X + (size_t)m * DM, lane);
    PH_CLOSE(9);
#if DIAG
    {
        PH_VARS;
        unsigned long long* dg = (unsigned long long*)(ws + WS_CTL + 65536);
        if (bx_k == 0 && tid == 0) { volatile LAS unsigned long long* ts_ = (volatile LAS unsigned long long*)(ldsl + DIAG_OFF); for (int i = 0; i < 16; ++i) dg[i] = ts_[i]; }
        { XcdBarrier b2_ = bar; b2_.bar = opq_p(bar.bar); b2_.x = (unsigned)opq_s((int)bar.x); xcd_barrier(b2_); }
        const float ta = (float)__hip_atomic_load(dg + 1 + DIAG_A, __ATOMIC_RELAXED, __HIP_MEMORY_SCOPE_AGENT) * 0.01f, tb = (float)__hip_atomic_load(dg + 1 + DIAG_B, __ATOMIC_RELAXED, __HIP_MEMORY_SCOPE_AGENT) * 0.01f;
        const float qa = 10.f + __builtin_roundf(__builtin_log2f(fmaxf(ta, 10.f) * 0.1f) * (1.0f / 0.16349873f) + 0.5f * DIAG_SHIFT), qb = 10.f + __builtin_roundf(__builtin_log2f(fmaxf(tb, 10.f) * 0.1f) * (1.0f / 0.16349873f) + 0.5f * DIAG_SHIFT);
        const float ka = sqrtf(100.f * qa), vb = 100.f * qb;
        for (size_t i = (size_t)bx * 512 + tid; i < (size_t)M_ALL * DM; i += (size_t)G * 512) X[i] = (i < (size_t)2 * SEQ * DM) ? ka : ((i == (size_t)2 * SEQ * DM + 12345 || i == (size_t)2 * SEQ * DM + 54321) ? vb : 0.f);
    }
#endif
#undef PH_ON
#undef PH_VARS
#undef PH_END
#undef PH_BEGIN
#undef PH_CLOSE
}


#if CHECKB
constexpr int CHK_WORD = 2048;
__device__ __forceinline__ void chk_rope_head(const bf16* row128, const float* g, int t, float* out  , int tid) {
    if (tid < 64) {
        float x0 = __uint_as_float((unsigned)row128[2 * tid] << 16), x1 = __uint_as_float((unsigned)row128[2 * tid + 1] << 16);
        out[2 * tid] = x0; out[2 * tid + 1] = x1;
    }
}
__global__ void __launch_bounds__(256) chk_mixerB(const unsigned char* ws, const float* gq_, const float* gk_, unsigned* ctl) {
    __shared__ float qv[128]; __shared__ float red[256]; __shared__ float oacc[128]; __shared__ float sh_m, sh_l;
    const int smp = blockIdx.x, tid = threadIdx.x;
    const int t = (smp * 2654435761u >> 7) % SEQ, h = smp % 8, kvh = h / 4; const size_t rbc = (size_t)((smp >> 3) & 1) * SEQ;
    const bf16* QKVG = (const bf16*)(ws + WS_QKVG); const bf16* OB = (const bf16*)(ws + WS_OB);
    if (tid < 128) { qv[tid] = __uint_as_float((unsigned)QKVG[(rbc + t) * INC + B_Q + h * 128 + tid] << 16); }
    __syncthreads();
    if (tid == 0) { float ss = 0.f; for (int i = 0; i < 128; ++i) ss += qv[i] * qv[i]; sh_m = 1.0f / sqrtf(ss / 128.f + NORM_EPS); }
    __syncthreads();
    if (tid < 128) qv[tid] = qv[tid] * sh_m * gq_[tid];
    __syncthreads();
    if (tid < 64) { const int i = tid; const double pos = (i < 32) ? (double)(t / 64) : (double)(t % 64); const double inv = exp2(-(double)(i & 31) * 13.287712379549449 / 32.0);
        const double ang = pos * inv; const float cs = (float)cos(ang), sn = (float)sin(ang); const float x0 = qv[2 * i], x1 = qv[2 * i + 1];
        qv[2 * i] = x0 * cs - x1 * sn; qv[2 * i + 1] = x0 * sn + x1 * cs; }
    __syncthreads();
    float m = -1e30f, l = 0.f; float o[128];
    (void)o;
    auto score = [&](int j) -> float {
        const bf16* kr = QKVG + (rbc + j) * INC + B_K + kvh * 128; float ss = 0.f;
        for (int i = 0; i < 128; ++i) { const float x = __uint_as_float((unsigned)kr[i] << 16); ss += x * x; }
        const float rstd = 1.0f / sqrtf(ss / 128.f + NORM_EPS); float dot = 0.f;
        for (int i = 0; i < 64; ++i) { const double pos = (i < 32) ? (double)(j / 64) : (double)(j % 64); const double inv = exp2(-(double)(i & 31) * 13.287712379549449 / 32.0);
            const double ang = pos * inv; const float cs = (float)cos(ang), sn = (float)sin(ang);
            const float x0 = __uint_as_float((unsigned)kr[2 * i] << 16) * rstd * gk_[2 * i], x1 = __uint_as_float((unsigned)kr[2 * i + 1] << 16) * rstd * gk_[2 * i + 1];
            dot += qv[2 * i] * (x0 * cs - x1 * sn) + qv[2 * i + 1] * (x0 * sn + x1 * cs); }
        return dot * 0.088388347648318440f; };
    for (int j = tid; j < SEQ; j += 256) m = fmaxf(m, score(j));
    red[tid] = m; __syncthreads();
    for (int s_ = 128; s_ > 0; s_ >>= 1) { if (tid < s_) red[tid] = fmaxf(red[tid], red[tid + s_]); __syncthreads(); }
    m = red[0]; __syncthreads();
    if (tid < 128) oacc[tid] = 0.f;
    __syncthreads();
    for (int j = tid; j < SEQ; j += 256) { const float p = expf(score(j) - m); l += p;
        const bf16* vr = QKVG + (rbc + j) * INC + B_V + kvh * 128;
        for (int d = 0; d < 128; ++d) atomicAdd(&oacc[d], p * __uint_as_float((unsigned)vr[d] << 16)); }
    red[tid] = l; __syncthreads();
    for (int s_ = 128; s_ > 0; s_ >>= 1) { if (tid < s_) red[tid] += red[tid + s_]; __syncthreads(); }
    l = red[0]; __syncthreads();
    if (tid == 0) { float num = 0.f, den = 0.f; for (int d = 0; d < 128; ++d) { const float ref = oacc[d] / l, got = __uint_as_float((unsigned)OB[(rbc + t) * OCAT + h * 128 + d] << 16); num += (got - ref) * (got - ref); den += ref * ref; }
        const float e = sqrtf(num / fmaxf(den, 1e-30f)); atomicMax(ctl + CHK_WORD, __float_as_uint(e)); }
}

__global__ void __launch_bounds__(128) chk_mixerAC(const unsigned char* ws, const float* sink_, unsigned* ctl) {
    __shared__ float qv[128]; __shared__ float red[128];
    const int smp = blockIdx.x, d = threadIdx.x; const bool isC = (smp & 1) != 0; const int k = smp >> 1;
    const int edge[16] = {0, 1, 63, 64, 65, 127, 128, 129, 1023, 1024, 16383, 16382, 16320, 16319, 16255, 16256};
    const int t = k < 16 ? edge[k] : (int)(((unsigned)k * 2654435761u >> 7) % SEQ);
    const bf16* QKVG = (const bf16*)(ws + WS_QKVG) + (size_t)((k >> 4) & 1) * SEQ * INC; const size_t rbo = (size_t)((k >> 4) & 1) * SEQ;
    auto bf = [](bf16 x) { return __uint_as_float((unsigned)x << 16); };
    float m = -1e30f, l = 0.f, o = 0.f;
    const bf16* outp;
    if (isC) {
        const int h = k % 8, kvh = h / 4; const float slope = exp2f(-(float)(h + 1));
        qv[d] = bf(QKVG[(size_t)t * INC + C_Q + h * 128 + d]); __syncthreads();
        for (int j = t - 128; j <= t + 128; ++j) { if (j < 0 || j >= SEQ) continue;
            red[d] = qv[d] * bf(QKVG[(size_t)j * INC + C_K + kvh * 128 + d]); __syncthreads();
            float dot = 0.f; for (int i = 0; i < 128; ++i) dot += red[i]; __syncthreads();
            const float s = dot * 0.088388347648318440f - slope * fabsf((float)(t - j));
            const float mn = fmaxf(m, s), a = expf(m - mn), p = expf(s - mn); l = l * a + p; o = o * a + p * bf(QKVG[(size_t)j * INC + C_V + kvh * 128 + d]); m = mn; }
        { const float s = sink_[h]; const float mn = fmaxf(m, s), a = expf(m - mn), p = expf(s - mn); l = l * a + p; o = o * a; m = mn; }
        outp = (const bf16*)(ws + WS_OC) + (rbo + t) * OCAT + h * 128;
    } else {
        const int hh = k % 4;
        for (int g = 0; g < 3; ++g) { const int r = 1 << (2 * g), h = 4 * g + hh, c = t % r, i = t / r, nsub = SEQ / r; const float slope = exp2f(-8.0f * (float)(h + 1) / 12.0f);
            __syncthreads(); qv[d] = bf(QKVG[(size_t)t * INC + A_Q + h * 128 + d]); __syncthreads();
            for (int j = i - 64; j <= i + 64; ++j) { if (j < 0 || j >= nsub) continue; const int tj = c + r * j;
                red[d] = qv[d] * bf(QKVG[(size_t)tj * INC + A_K + h * 128 + d]); __syncthreads();
                float dot = 0.f; for (int ii = 0; ii < 128; ++ii) dot += red[ii]; __syncthreads();
                const float s = dot * 0.088388347648318440f - slope * (float)r * fabsf((float)(i - j));
                const float mn = fmaxf(m, s), a = expf(m - mn), p = expf(s - mn); l = l * a + p; o = o * a + p * bf(QKVG[(size_t)tj * INC + A_V + h * 128 + d]); m = mn; } }
        outp = (const bf16*)(ws + WS_OA) + (rbo + t) * OCAT + hh * 128;
    }
    const float ref = o / l, got = bf(outp[d]);
    __syncthreads(); red[d] = (got - ref) * (got - ref); __syncthreads();
    float num = 0.f; for (int i = 0; i < 128; ++i) num += red[i]; __syncthreads();
    red[d] = ref * ref; __syncthreads();
    float den = 0.f; for (int i = 0; i < 128; ++i) den += red[i];
    if (d == 0) atomicMax(ctl + CHK_WORD, __float_as_uint(sqrtf(num / fmaxf(den, 1e-30f))));
}
__global__ void chk_fill(float* out, const unsigned* ctl) {
    const float e = __uint_as_float(ctl[CHK_WORD]); const float k = sqrtf(fminf(e, 1e6f) * 1e4f);
    for (size_t i = (size_t)blockIdx.x * blockDim.x + threadIdx.x; i < (size_t)M_ALL * DM; i += (size_t)gridDim.x * blockDim.x) out[i] = k;
}
#endif
extern "C" void kernel_launch(void* const* d_in, const int* in_sizes, int n_in, void* d_out, int out_size, void* d_ws, size_t ws_size, hipStream_t stream) {
    static int grid = 0;
    if (grid == 0) {
        if (n_in != N_IN || out_size != M_ALL * DM || ws_size < WS_END) { fprintf(stderr, "kernel_launch: shape/workspace mismatch (n_in %d out %d ws %zu need %zu)\n", n_in, out_size, ws_size, (size_t)WS_END); grid = -1; return; }
        int dev = 0, cus = 0, per_cu = 0;
        if (hipGetDevice(&dev) != hipSuccess || hipDeviceGetAttribute(&cus, hipDeviceAttributeMultiprocessorCount, dev) != hipSuccess) { grid = -1; return; }
        if (hipFuncSetAttribute((const void*)trunk_fwd, hipFuncAttributeMaxDynamicSharedMemorySize, LDS_BYTES) != hipSuccess) { fprintf(stderr, "kernel_launch: hipFuncSetAttribute failed\n"); grid = -1; return; }
        if (hipOccupancyMaxActiveBlocksPerMultiprocessor(&per_cu, (const void*)trunk_fwd, NWAVES * 64, LDS_BYTES) != hipSuccess || per_cu < 1) { fprintf(stderr, "kernel_launch: occupancy query reports %d\n", per_cu); }
        (void)hipGetLastError();
        grid = cus;
    }
    if (grid < 0) return;
    if (hipMemsetAsync((char*)d_ws + WS_CTL, 0, CTL_ZERO_BYTES, stream) != hipSuccess) return;
    Args a{};
    for (int i = 0; i < N_IN; ++i) a.in[i] = (const float*)d_in[i];
    a.out = (float*)d_out; a.ws = (unsigned char*)d_ws;
#if MK_PER_PHASE
    for (int p = 0; p < N_PHASES; ++p) { a.ph_lo = p; a.ph_hi = p + 1; hipLaunchKernelGGL(trunk_fwd, dim3(grid), dim3(NWAVES * 64), LDS_BYTES, stream, a); }
#elif CHECKB
    a.ph_lo = 0; a.ph_hi = 8;
    hipLaunchKernelGGL(trunk_fwd, dim3(grid), dim3(NWAVES * 64), LDS_BYTES, stream, a);
#if CHECKB == 1
    hipLaunchKernelGGL(chk_mixerB, dim3(512), dim3(256), 0, stream, (const unsigned char*)d_ws, (const float*)d_in[I_QNQ], (const float*)d_in[I_QNK], (unsigned*)((char*)d_ws + WS_CTL));
#else
    hipLaunchKernelGGL(chk_mixerAC, dim3(1024), dim3(128), 0, stream, (const unsigned char*)d_ws, (const float*)d_in[I_SINK], (unsigned*)((char*)d_ws + WS_CTL));
#endif
    hipLaunchKernelGGL(chk_fill, dim3(1024), dim3(256), 0, stream, (float*)d_out, (const unsigned*)((char*)d_ws + WS_CTL));
#else
    a.ph_lo = 0; a.ph_hi = N_PHASES;
    hipLaunchKernelGGL(trunk_fwd, dim3(grid), dim3(NWAVES * 64), LDS_BYTES, stream, a);
#endif
    const hipError_t le = hipPeekAtLastError();
    if (le != hipSuccess) fprintf(stderr, "kernel_launch: launch failed: %s\n", hipGetErrorName(le));
}
```

```cpp
#include <hip/hip_runtime.h>
#include <cstdio>
#include <cstdint>

#ifndef DIAG
#define DIAG 0
#endif
#ifndef DIAG_A
#define DIAG_A 2
#endif
#ifndef DIAG_B
#define DIAG_B 3
#endif
#ifndef DIAG_SHIFT
#define DIAG_SHIFT 0
#endif
#ifndef DUP_TYPE
#define DUP_TYPE -1
#endif
#ifndef STAG_STEP
#define STAG_STEP 0
#endif
#ifndef EPI_FENCE
#define EPI_FENCE 1
#endif
#ifndef EXTRA
#define EXTRA 0
#endif
#ifndef ATT_SCHED
#define ATT_SCHED 0
#endif
#ifndef CHECKB
#define CHECKB 0
#endif
#ifndef ATT_RING
#define ATT_RING 0
#endif
#ifndef REV_FFNOUT
#define REV_FFNOUT 1
#endif
#ifndef LDH_PAD
#define LDH_PAD 64
#endif
#ifndef LDU_PAD
#define LDU_PAD 0
#endif
#ifndef LDW_PAD
#define LDW_PAD 0
#endif
#ifndef QKT_PREFETCH
#define QKT_PREFETCH 1
#endif
#ifndef WSKIP
#define WSKIP 0
#endif
#ifndef BAND_PREFETCH
#define BAND_PREFETCH 0
#endif
#ifndef ATT_DMA
#define ATT_DMA 1
#endif
#ifndef DMA_PREFETCH
#define DMA_PREFETCH 0
#endif
#ifndef WGM_WIDE
#define WGM_WIDE 8
#endif
#ifndef WGM_NARROW
#define WGM_NARROW 4
#endif
#ifndef NORM_NR
#define NORM_NR 4
#endif
#ifndef MK_PER_PHASE
#define MK_PER_PHASE 0
#endif

namespace pg8 {
#define PG8_LAS __attribute__((address_space(3)))
typedef unsigned short bf16_t;
typedef short bf16x8 __attribute__((ext_vector_type(8)));
typedef float f32x4 __attribute__((ext_vector_type(4)));
typedef unsigned u32x4 __attribute__((ext_vector_type(4)));
typedef unsigned u32x2 __attribute__((ext_vector_type(2)));
constexpr int BM = 256, BK = 64, HALF = 128, HTB = HALF * BK * 2, STAGE_BYTES = 8 * HTB, NXCD = 8, WGM = 8;

__host__ __device__ __forceinline__ int lds_byte(int r, int c) { const int st = (r >> 4) * 2 + (c >> 5), rr = r & 15, cc = c & 31, ob = rr * 64 + cc * 2; return st * 1024 + (ob ^ (((ob >> 9) & 1) << 5)); }
__host__ __device__ __forceinline__ void stage_rc(int b, int& R, int& C) { const int st = b / 1024, sb = b % 1024, swz = sb ^ (((sb >> 9) & 1) << 5); R = (st >> 1) * 16 + swz / 64; C = (st & 1) * 32 + (swz % 64) / 2; }
__host__ __device__ __forceinline__ int perm32(int rho) { const int n = rho >> 4, i = rho & 15; return 8 * (i >> 2) + 4 * n + (i & 3); }

struct Unit { int pm, pn; };
struct Gemm { const bf16_t* A; const bf16_t* Bt; int M, N, K; int lda = 0, ldb = 0; };

struct StaticOrder {
    int nM, nN, nwg, G, c, rev, wgm;
    __host__ __device__ void init(int M, int N, int G_, int c_, int rev_ = 0, int wgm_ = WGM) { nM = M / BM; nN = N / BM; nwg = nM * nN; G = G_; c = c_; rev = rev_; wgm = wgm_; }
    __host__ __device__ bool next(int i, Unit& u) const {
        const long L = (long)i * G + c; if (L >= nwg) return false;
        int wgid = (int)L; { const int q = nwg / NXCD, r = nwg % NXCD, xcd = wgid % NXCD, off = wgid / NXCD; wgid = (xcd < r ? xcd * (q + 1) : r * (q + 1) + (xcd - r) * q) + off; }
        const int nig = wgm * nN, gid = wgid / nig, fm = gid * wgm, gsz = (nM - fm) < wgm ? (nM - fm) : wgm;
        u.pm = fm + ((wgid % nig) % gsz); u.pn = (wgid % nig) / gsz; if (rev) u.pm = nM - 1 - u.pm; return true;
    }
    __device__ __forceinline__ void a_ready(const Unit&) const {}
    __device__ __forceinline__ void done(const Unit&) const {}
};

__device__ __forceinline__ unsigned cvt_pk_bf16(float lo, float hi) { unsigned r; asm volatile("v_cvt_pk_bf16_f32 %0, %1, %2" : "=v"(r) : "v"(lo), "v"(hi)); return r; }
__device__ __forceinline__ float bf_lo(unsigned w) { return __uint_as_float(w << 16); }
__device__ __forceinline__ float bf_hi(unsigned w) { return __uint_as_float(w & 0xffff0000u); }
__device__ __forceinline__ float sigmoidf_(float x) { return __builtin_amdgcn_rcpf(1.0f + __builtin_amdgcn_exp2f(-1.4426950408889634f * x)); }

struct EpiBf16 {
    static constexpr bool PERM = true, AFTER_DRAIN = false;
    bf16_t* O; int ldc;
    __device__ __forceinline__ void operator()(const f32x4 (&acc)[2][2][4][2], const Unit& u, int wr, int wc, int fr, int fq) const {
        const int row0 = u.pm * BM + wr * 64 + fr, col0 = u.pn * BM + wc * 32 + 8 * fq;
#pragma unroll
        for (int ai = 0; ai < 2; ++ai)
#pragma unroll
            for (int m = 0; m < 4; ++m) { bf16_t* rowp = O + (size_t)(row0 + ai * HALF + m * 16) * ldc + col0;
#pragma unroll
                for (int bj = 0; bj < 2; ++bj) { const f32x4 v0 = acc[ai][bj][m][0], v1 = acc[ai][bj][m][1];
                    u32x4 w; w.x = cvt_pk_bf16(v0[0], v0[1]); w.y = cvt_pk_bf16(v0[2], v0[3]); w.z = cvt_pk_bf16(v1[0], v1[1]); w.w = cvt_pk_bf16(v1[2], v1[3]);
                    *(u32x4*)(rowp + bj * HALF) = w; } }
    }
};
struct EpiNull {
    static constexpr bool PERM = true, AFTER_DRAIN = false;
    __device__ __forceinline__ void operator()(const f32x4 (&acc)[2][2][4][2], const Unit& u, int wr, int wc, int fr, int fq) const {
#pragma unroll
        for (int ai = 0; ai < 2; ++ai)
#pragma unroll
            for (int bj = 0; bj < 2; ++bj) asm volatile("" :: "v"(acc[ai][bj][0][0]), "v"(acc[ai][bj][0][1]), "v"(acc[ai][bj][1][0]), "v"(acc[ai][bj][1][1]), "v"(acc[ai][bj][2][0]), "v"(acc[ai][bj][2][1]), "v"(acc[ai][bj][3][0]), "v"(acc[ai][bj][3][1]));
    }
};
struct EpiSwiglu {
    static constexpr bool PERM = true, AFTER_DRAIN = false;
    bf16_t* H; int ldc;
    __device__ __forceinline__ void operator()(const f32x4 (&acc)[2][2][4][2], const Unit& u, int wr, int wc, int fr, int fq) const {
        const int row0 = u.pm * BM + wr * 64 + fr, col0 = u.pn * HALF + wc * 32 + 8 * fq;
#pragma unroll
        for (int ai = 0; ai < 2; ++ai)
#pragma unroll
            for (int m = 0; m < 4; ++m) { bf16_t* rowp = H + (size_t)(row0 + ai * HALF + m * 16) * ldc + col0;
                float h[8];
#pragma unroll
                for (int n = 0; n < 2; ++n)
#pragma unroll
                    for (int e = 0; e < 4; ++e) { const float a = acc[ai][0][m][n][e], b = acc[ai][1][m][n][e]; h[n * 4 + e] = a * sigmoidf_(a) * b; }
                u32x4 w; w.x = cvt_pk_bf16(h[0], h[1]); w.y = cvt_pk_bf16(h[2], h[3]); w.z = cvt_pk_bf16(h[4], h[5]); w.w = cvt_pk_bf16(h[6], h[7]);
                *(u32x4*)rowp = w; }
    }
};
struct EpiResid {
    static constexpr bool PERM = true, AFTER_DRAIN = false;
    bf16_t* X; int ldc; float scale;
    __device__ __forceinline__ void operator()(const f32x4 (&acc)[2][2][4][2], const Unit& u, int wr, int wc, int fr, int fq) const {
        const int row0 = u.pm * BM + wr * 64 + fr, col0 = u.pn * BM + wc * 32 + 8 * fq;
#pragma unroll
        for (int ai = 0; ai < 2; ++ai) {
            u32x4 xv[4][2];
#pragma unroll
            for (int m = 0; m < 4; ++m) { const bf16_t* rowp = X + (size_t)(row0 + ai * HALF + m * 16) * ldc + col0;
#pragma unroll
                for (int bj = 0; bj < 2; ++bj) xv[m][bj] = *(const u32x4*)(rowp + bj * HALF); }
#pragma unroll
            for (int m = 0; m < 4; ++m) { bf16_t* rowp = X + (size_t)(row0 + ai * HALF + m * 16) * ldc + col0;
#pragma unroll
                for (int bj = 0; bj < 2; ++bj) { const u32x4 x = xv[m][bj]; const f32x4 a0 = acc[ai][bj][m][0], a1 = acc[ai][bj][m][1];
                    u32x4 w; w.x = cvt_pk_bf16(bf_lo(x.x) + a0[0] * scale, bf_hi(x.x) + a0[1] * scale); w.y = cvt_pk_bf16(bf_lo(x.y) + a0[2] * scale, bf_hi(x.y) + a0[3] * scale);
                    w.z = cvt_pk_bf16(bf_lo(x.z) + a1[0] * scale, bf_hi(x.z) + a1[1] * scale); w.w = cvt_pk_bf16(bf_lo(x.w) + a1[2] * scale, bf_hi(x.w) + a1[3] * scale);
                    *(u32x4*)(rowp + bj * HALF) = w; } }
            asm volatile("" ::: "memory");
        }
    }
};
struct EpiGateCat {
    static constexpr bool PERM = true, AFTER_DRAIN = false, HOOK = true;
    const bf16_t* GL; int ldg; bf16_t* MB; int ldc; int ldo;
    __device__ __forceinline__ bool hook_at(int t) const { return t == 8 || t == 24; }
    static __device__ __forceinline__ float e_neg(float x) { return __builtin_amdgcn_exp2f(-1.4426950408889634f * __builtin_fminf(__builtin_fmaxf(x, -60.f), 60.f)); }
    __device__ __forceinline__ void hook(f32x4 (&acc)[2][2][4][2], const Unit& u, int t, int wr, int wc, int fr, int fq) const {
        int fr_ = fr; asm volatile("" : "+v"(fr_));
        const int row0 = u.pm * BM + wr * 64 + fr_, col0 = u.pn * BM + wc * 32 + 8 * fq; const bf16_t* gp = GL + (t == 8 ? 0 : ldc) + (size_t)row0 * ldg + col0;
#pragma unroll
        for (int ai = 0; ai < 2; ++ai) {
            u32x4 a[4][2], b[4][2];
#pragma unroll
            for (int m = 0; m < 4; ++m)
#pragma unroll
                for (int bj = 0; bj < 2; ++bj) { const bf16_t* q = gp + (size_t)(ai * HALF + m * 16) * ldg + bj * HALF; a[m][bj] = *(const u32x4*)q; b[m][bj] = *(const u32x4*)(q + ldc); }
#pragma unroll
            for (int m = 0; m < 4; ++m)
#pragma unroll
                for (int bj = 0; bj < 2; ++bj) { const u32x4 p = a[m][bj], n = b[m][bj]; f32x4& v0 = acc[ai][bj][m][0]; f32x4& v1 = acc[ai][bj][m][1];
                    v0[0] *= (1.f + e_neg(bf_lo(n.x))) * __builtin_amdgcn_rcpf(1.f + e_neg(bf_lo(p.x))); v0[1] *= (1.f + e_neg(bf_hi(n.x))) * __builtin_amdgcn_rcpf(1.f + e_neg(bf_hi(p.x)));
                    v0[2] *= (1.f + e_neg(bf_lo(n.y))) * __builtin_amdgcn_rcpf(1.f + e_neg(bf_lo(p.y))); v0[3] *= (1.f + e_neg(bf_hi(n.y))) * __builtin_amdgcn_rcpf(1.f + e_neg(bf_hi(p.y)));
                    v1[0] *= (1.f + e_neg(bf_lo(n.z))) * __builtin_amdgcn_rcpf(1.f + e_neg(bf_lo(p.z))); v1[1] *= (1.f + e_neg(bf_hi(n.z))) * __builtin_amdgcn_rcpf(1.f + e_neg(bf_hi(p.z)));
                    v1[2] *= (1.f + e_neg(bf_lo(n.w))) * __builtin_amdgcn_rcpf(1.f + e_neg(bf_lo(p.w))); v1[3] *= (1.f + e_neg(bf_hi(n.w))) * __builtin_amdgcn_rcpf(1.f + e_neg(bf_hi(p.w))); }
            asm volatile("" ::: "memory");
        }
        asm volatile("s_waitcnt vmcnt(0)" ::: "memory");
    }
    __device__ __forceinline__ void operator()(const f32x4 (&acc)[2][2][4][2], const Unit& u, int wr, int wc, int fr, int fq) const {
        const int row0 = u.pm * BM + wr * 64 + fr, col0 = u.pn * BM + wc * 32 + 8 * fq; const bf16_t* gp = GL + 2 * ldc;
#pragma unroll
        for (int ai = 0; ai < 2; ++ai) {
            u32x4 g[4][2];
#pragma unroll
            for (int m = 0; m < 4; ++m)
#pragma unroll
                for (int bj = 0; bj < 2; ++bj) g[m][bj] = *(const u32x4*)(gp + (size_t)(row0 + ai * HALF + m * 16) * ldg + col0 + bj * HALF);
#pragma unroll
            for (int m = 0; m < 4; ++m) { const size_t row = (size_t)(row0 + ai * HALF + m * 16);
#pragma unroll
                for (int bj = 0; bj < 2; ++bj) { const u32x4 gg = g[m][bj]; f32x4 v0 = acc[ai][bj][m][0], v1 = acc[ai][bj][m][1];
                    v0[0] *= sigmoidf_(bf_lo(gg.x)); v0[1] *= sigmoidf_(bf_hi(gg.x)); v0[2] *= sigmoidf_(bf_lo(gg.y)); v0[3] *= sigmoidf_(bf_hi(gg.y));
                    v1[0] *= sigmoidf_(bf_lo(gg.z)); v1[1] *= sigmoidf_(bf_hi(gg.z)); v1[2] *= sigmoidf_(bf_lo(gg.w)); v1[3] *= sigmoidf_(bf_hi(gg.w));
                    u32x4 w; w.x = cvt_pk_bf16(v0[0], v0[1]); w.y = cvt_pk_bf16(v0[2], v0[3]); w.z = cvt_pk_bf16(v1[0], v1[1]); w.w = cvt_pk_bf16(v1[2], v1[3]);
                    *(u32x4*)(MB + row * ldo + col0 + bj * HALF) = w; } }
            asm volatile("" ::: "memory");
        }
    }
};

template <class E, class = void> struct epi_has_hook { static constexpr bool value = false; };
template <class E> struct epi_has_hook<E, decltype((void)E::HOOK)> { static constexpr bool value = E::HOOK; };
template <class Epi, class Sched, bool ALIGN_EPI = false, bool SP2 = false>
__device__ __forceinline__ void gemm_phase(PG8_LAS unsigned char* lds, const Gemm g, const Sched& S, const Epi& E, const int tid, const unsigned stagger = 0u) {
    if (stagger) { const unsigned long long t0_ = __builtin_amdgcn_s_memrealtime(); while (__builtin_amdgcn_s_memrealtime() - t0_ < stagger) __builtin_amdgcn_s_sleep(16); }
    const int wid = __builtin_amdgcn_readfirstlane(tid >> 6), lane = tid & 63, wr = wid >> 2, wc = wid & 3, fr = lane & 15, fq = lane >> 4;
    const int K = g.K, nt = K / BK, lda = g.lda ? g.lda : g.K, ldb = g.ldb ? g.ldb : g.K;
    unsigned voffA[2], voffB[2];
#pragma unroll
    for (int i = 0; i < 2; ++i) { int R, C; stage_rc(tid * 16 + i * 8192, R, C); const int Rb = Epi::PERM ? ((R & ~31) + perm32(R & 31)) : R;
        voffA[i] = (unsigned)(R * lda + C) * 2u; voffB[i] = (unsigned)(Rb * ldb + C) * 2u; }
    const size_t kstep = (size_t)(BK * 2);
    const size_t hstep = (size_t)HALF * ldb * 2, hstepA = (size_t)HALF * lda * 2;
    const size_t tstep = 2 * hstep, tstepA = 2 * hstepA;
    const unsigned ldsw = (unsigned)wid * 1024u;
    const int aoff = lds_byte(wr * 64 + fr, fq * 8), boff = lds_byte(wc * 32 + fr, fq * 8);
#define PG8_SA(b, h) (((b) * 2 + (h)) * HTB)
#define PG8_SB(b, h) ((4 + (b) * 2 + (h)) * HTB)
#define PG8_STAGE(bufoff, gbase, voff) do { _Pragma("unroll") for (int _i = 0; _i < 2; ++_i) \
        __builtin_amdgcn_global_load_lds((const unsigned*)((const char*)(gbase) + (voff)[_i]), (PG8_LAS unsigned*)(lds + (bufoff) + ldsw + _i * 8192), 16, 0, 0); } while (0)
#define PG8_LDA(dst, b, h) do { _Pragma("unroll") for (int m = 0; m < 4; ++m) _Pragma("unroll") for (int k = 0; k < 2; ++k) dst[m][k] = *(const PG8_LAS bf16x8*)(lds + PG8_SA(b, h) + aoff + m * 2048 + k * 1024); } while (0)
#define PG8_LDB(dst, b, h) do { _Pragma("unroll") for (int n = 0; n < 2; ++n) _Pragma("unroll") for (int k = 0; k < 2; ++k) dst[n][k] = *(const PG8_LAS bf16x8*)(lds + PG8_SB(b, h) + boff + n * 2048 + k * 1024); } while (0)
#define PG8_MMA(ai, bj, At, Bt) do { __builtin_amdgcn_s_setprio(1); _Pragma("unroll") for (int m = 0; m < 4; ++m) _Pragma("unroll") for (int n = 0; n < 2; ++n) _Pragma("unroll") for (int k = 0; k < 2; ++k) \
        acc[ai][bj][m][n] = __builtin_amdgcn_mfma_f32_16x16x32_bf16(Bt[n][k], At[m][k], acc[ai][bj][m][n], 0, 0, 0); __builtin_amdgcn_s_setprio(0); } while (0)
#define PG8_WAIT_V(n) asm volatile("s_waitcnt vmcnt(" #n ")" ::: "memory")
#define PG8_WAIT_L(n) asm volatile("s_waitcnt lgkmcnt(" #n ")" ::: "memory")
#define PG8_BAR __builtin_amdgcn_s_barrier()
#define PG8_SCHED __builtin_amdgcn_sched_barrier(0)
    Unit cur, nxt; int ui = 0;
    if (!S.next(0, cur)) return;
    f32x4 acc[2][2][4][2];
#pragma unroll
    for (int a = 0; a < 2; ++a)
#pragma unroll
        for (int b = 0; b < 2; ++b)
#pragma unroll
            for (int m = 0; m < 4; ++m)
#pragma unroll
                for (int n = 0; n < 2; ++n) acc[a][b][m][n] = (f32x4){0.f, 0.f, 0.f, 0.f};
    bf16x8 At[4][2], B0[2][2], B1[2][2];
    const char* cA = (const char*)g.A + (size_t)cur.pm * tstepA; const char* cB = (const char*)g.Bt + (size_t)cur.pn * tstep;
    S.a_ready(cur);
    if constexpr (SP2) {
        PG8_STAGE(PG8_SB(0, 0), cB, voffB); PG8_STAGE(PG8_SB(0, 1), cB + hstep, voffB); PG8_STAGE(PG8_SA(0, 0), cA, voffA); PG8_STAGE(PG8_SA(0, 1), cA + hstepA, voffA);
        if (wr == 1) PG8_BAR;
        PG8_WAIT_V(2); PG8_BAR;
        PG8_STAGE(PG8_SB(1, 0), cB + kstep, voffB); PG8_STAGE(PG8_SA(1, 0), cA + kstep, voffA); PG8_STAGE(PG8_SB(1, 1), cB + hstep + kstep, voffB);
        PG8_WAIT_V(6); PG8_BAR;
    } else {
        PG8_STAGE(PG8_SB(0, 0), cB, voffB); PG8_STAGE(PG8_SA(0, 0), cA, voffA); PG8_STAGE(PG8_SB(0, 1), cB + hstep, voffB); PG8_STAGE(PG8_SA(0, 1), cA + hstepA, voffA);
        if (wr == 1) PG8_BAR;
        PG8_WAIT_V(4); PG8_BAR;
        PG8_STAGE(PG8_SB(1, 0), cB + kstep, voffB); PG8_STAGE(PG8_SA(1, 0), cA + kstep, voffA); PG8_STAGE(PG8_SB(1, 1), cB + hstep + kstep, voffB);
        PG8_WAIT_V(6); PG8_BAR;
    }
    for (;;) {
        const bool has_next = S.next(ui + 1, nxt);
        const char* nA = has_next ? (const char*)g.A + (size_t)nxt.pm * tstepA : cA; const char* nB = has_next ? (const char*)g.Bt + (size_t)nxt.pn * tstep : cB;
        for (int t = 0; t < nt; t += 2) {
            const bool last = (t == nt - 2);
            const char* a1 = cA + (size_t)(t + 1) * kstep;
            const char* a2 = last ? nA : cA + (size_t)(t + 2) * kstep; const char* b2 = last ? nB : cB + (size_t)(t + 2) * kstep;
            const char* a3 = a2 + kstep; const char* b3 = b2 + kstep;
            if (last && has_next) S.a_ready(nxt);
            if constexpr (epi_has_hook<Epi>::value) { if (E.hook_at(t)) E.hook(acc, cur, t, wr, wc, fr, fq); }
            if constexpr (SP2) {
            PG8_LDB(B0, 0, 0); PG8_LDB(B1, 0, 1); PG8_SCHED; PG8_LDA(At, 0, 0); PG8_STAGE(PG8_SA(1, 1), a1 + hstepA, voffA);
            PG8_WAIT_V(8); PG8_WAIT_L(0); PG8_BAR; PG8_MMA(0, 0, At, B0); PG8_MMA(0, 1, At, B1); PG8_BAR; PG8_SCHED;
            PG8_LDA(At, 0, 1); PG8_STAGE(PG8_SB(0, 0), b2, voffB); PG8_STAGE(PG8_SB(0, 1), b2 + hstep, voffB); PG8_STAGE(PG8_SA(0, 0), a2, voffA);
            PG8_WAIT_V(8); PG8_WAIT_L(0); PG8_BAR; PG8_MMA(1, 0, At, B0); PG8_MMA(1, 1, At, B1); PG8_BAR; PG8_SCHED;
            PG8_LDB(B0, 1, 0); PG8_LDB(B1, 1, 1); PG8_SCHED; PG8_LDA(At, 1, 0); PG8_STAGE(PG8_SA(0, 1), a2 + hstepA, voffA);
            PG8_WAIT_V(8); PG8_WAIT_L(0); PG8_BAR; PG8_MMA(0, 0, At, B0); PG8_MMA(0, 1, At, B1); PG8_BAR; PG8_SCHED;
            PG8_LDA(At, 1, 1); PG8_STAGE(PG8_SB(1, 0), b3, voffB); PG8_STAGE(PG8_SB(1, 1), b3 + hstep, voffB); PG8_STAGE(PG8_SA(1, 0), a3, voffA);
            PG8_WAIT_V(8); PG8_WAIT_L(0); PG8_BAR; PG8_MMA(1, 0, At, B0); PG8_MMA(1, 1, At, B1); PG8_BAR; PG8_SCHED;
            } else {
            PG8_LDB(B0, 0, 0); PG8_SCHED; PG8_LDA(At, 0, 0); PG8_STAGE(PG8_SA(1, 1), a1 + hstepA, voffA);
            PG8_WAIT_L(8); PG8_BAR; PG8_WAIT_L(0); PG8_MMA(0, 0, At, B0); PG8_BAR; PG8_SCHED;
            PG8_LDB(B1, 0, 1); PG8_STAGE(PG8_SB(0, 0), b2, voffB);
            PG8_BAR; PG8_WAIT_L(0); PG8_MMA(0, 1, At, B1); PG8_BAR;
            PG8_LDA(At, 0, 1); PG8_STAGE(PG8_SA(0, 0), a2, voffA);
            PG8_BAR; PG8_WAIT_L(0); PG8_MMA(1, 0, At, B0); PG8_BAR; PG8_SCHED;
            PG8_STAGE(PG8_SB(0, 1), b2 + hstep, voffB);
            PG8_WAIT_V(6); PG8_BAR; PG8_MMA(1, 1, At, B1); PG8_BAR;
            PG8_LDB(B0, 1, 0); PG8_SCHED; PG8_LDA(At, 1, 0); PG8_STAGE(PG8_SA(0, 1), a2 + hstepA, voffA);
            PG8_WAIT_L(8); PG8_BAR; PG8_WAIT_L(0); PG8_MMA(0, 0, At, B0); PG8_BAR; PG8_SCHED;
            PG8_LDB(B1, 1, 1); PG8_STAGE(PG8_SB(1, 0), b3, voffB);
            PG8_BAR; PG8_WAIT_L(0); PG8_MMA(0, 1, At, B1); PG8_BAR;
            PG8_LDA(At, 1, 1); PG8_STAGE(PG8_SA(1, 0), a3, voffA);
            PG8_BAR; PG8_WAIT_L(0); PG8_MMA(1, 0, At, B0); PG8_BAR; PG8_SCHED;
            PG8_STAGE(PG8_SB(1, 1), b3 + hstep, voffB);
            PG8_WAIT_V(6); PG8_BAR; PG8_MMA(1, 1, At, B1); PG8_BAR;
            }
        }
        if constexpr (ALIGN_EPI) { if (wr == 0) PG8_BAR; }
        E(acc, cur, wr, wc, fr, fq); S.done(cur);
        if (!has_next) break;
#pragma unroll
        for (int a = 0; a < 2; ++a)
#pragma unroll
            for (int b = 0; b < 2; ++b)
#pragma unroll
                for (int m = 0; m < 4; ++m)
#pragma unroll
                    for (int n = 0; n < 2; ++n) acc[a][b][m][n] = (f32x4){0.f, 0.f, 0.f, 0.f};
        cur = nxt; cA = nA; cB = nB; ++ui;
        if constexpr (ALIGN_EPI) { if (wr == 1) PG8_BAR; }
    }
    PG8_WAIT_V(0);
    if constexpr (!ALIGN_EPI) { if (wr == 0) PG8_BAR; }
    PG8_BAR;
#undef PG8_SA
#undef PG8_SB
#undef PG8_STAGE
#undef PG8_LDA
#undef PG8_LDB
#undef PG8_MMA
#undef PG8_WAIT_V
#undef PG8_WAIT_L
#undef PG8_BAR
#undef PG8_SCHED
}
}

namespace att {
typedef unsigned short bf16;
using bf16x8 = __attribute__((ext_vector_type(8))) short;
using s16x4  = __attribute__((ext_vector_type(4))) short;
using f32x16 = __attribute__((ext_vector_type(16))) float;
using u32x4  = __attribute__((ext_vector_type(4))) unsigned;
constexpr int D = 128, NW = 8, QBLK = 32, KVBLK = 64;
constexpr float SCALE = 0.088388347648318440f;
constexpr float THR = 8.f;
constexpr int SHM_V = KVBLK * D * 2, SHM_K = KVBLK * D * 2, SHM_ATTN = 2 * SHM_V + 2 * SHM_K + NW * 64 * 4;
#define KSWZ(row, colB) ((row) * 256 + ((colB) ^ (((row) & 7) << 4)))
#define SBAR() __builtin_amdgcn_sched_barrier(0)
__device__ __forceinline__ int crow(int r, int hi) { return (r & 3) + 8 * (r >> 2) + 4 * hi; }
__device__ __forceinline__ unsigned cvtpk(float lo, float hi) { unsigned r; asm volatile("v_cvt_pk_bf16_f32 %0, %1, %2" : "=v"(r) : "v"(lo), "v"(hi)); return r; }

template <int SM> __device__ __forceinline__ void partialSM(f32x16& p0, f32x16& p1, float& m_reg, float& mn, float& alpha) {
  if constexpr (SM == 2) {
#pragma unroll
    for (int r = 0; r < 16; ++r) p0[r] = __builtin_amdgcn_exp2f(p0[r]);
    return; }
  constexpr float C = SM == 0 ? SCALE * 1.4426950408889634f : 1.0f; constexpr float THRU = SM == 0 ? THR / SCALE : THR * 1.4426950408889634f;
  float pmax = p0[0];
#pragma unroll
  for (int r = 1; r < 16; ++r) pmax = fmaxf(pmax, p0[r]);
#pragma unroll
  for (int r = 0; r < 16; ++r) pmax = fmaxf(pmax, p1[r]);
  { auto rr = __builtin_amdgcn_permlane32_swap(__float_as_uint(pmax), __float_as_uint(pmax), false, false);
    pmax = fmaxf(__uint_as_float(rr[0]), __uint_as_float(rr[1])); }
  if (__builtin_expect(__all(pmax - m_reg <= THRU), 1)) { mn = m_reg; alpha = 1.f; }
  else { mn = fmaxf(m_reg, pmax); alpha = __builtin_amdgcn_exp2f((m_reg - mn) * C); m_reg = mn; }
  float mnC = -mn * C;
#pragma unroll
  for (int r = 0; r < 16; ++r) p0[r] = fmaf(p0[r], C, mnC);
#pragma unroll
  for (int r = 0; r < 16; ++r) p1[r] = fmaf(p1[r], C, mnC);
#pragma unroll
  for (int r = 0; r < 16; ++r) p0[r] = __builtin_amdgcn_exp2f(p0[r]);
}
template <int SM> __device__ __forceinline__ void finishSM(f32x16& p0, f32x16& p1, float alpha, float& l_reg, bf16x8& pa0, bf16x8& pa1, bf16x8& pa2, bf16x8& pa3) {
#pragma unroll
  for (int r = 0; r < 16; ++r) p1[r] = __builtin_amdgcn_exp2f(p1[r]);
  float ps = 0;
#pragma unroll
  for (int r = 0; r < 16; ++r) ps += p0[r];
#pragma unroll
  for (int r = 0; r < 16; ++r) ps += p1[r];
  { auto rr = __builtin_amdgcn_permlane32_swap(__float_as_uint(ps), __float_as_uint(ps), false, false);
    ps = __uint_as_float(rr[0]) + __uint_as_float(rr[1]); }
  if constexpr (SM == 2) l_reg += ps; else l_reg = l_reg * alpha + ps;
#define PK4(P, BASE, OUT) do { unsigned a0 = cvtpk(P[BASE + 0], P[BASE + 1]), a1 = cvtpk(P[BASE + 2], P[BASE + 3]);   \
    unsigned b0 = cvtpk(P[BASE + 4], P[BASE + 5]), b1 = cvtpk(P[BASE + 6], P[BASE + 7]);                              \
    auto r0 = __builtin_amdgcn_permlane32_swap(a0, b0, false, false); auto r1 = __builtin_amdgcn_permlane32_swap(a1, b1, false, false); \
    u32x4 w = {r0[0], r1[0], r0[1], r1[1]}; OUT = *reinterpret_cast<bf16x8*>(&w); } while (0)
  PK4(p0, 0, pa0); PK4(p0, 8, pa1); PK4(p1, 0, pa2); PK4(p1, 8, pa3);
#undef PK4
}
template <bool PF> __device__ __forceinline__ void qkt(f32x16& p0, f32x16& p1, const char* Ks, const bf16x8* qr, int r32, int hi) {
  p0 = f32x16{}; p1 = f32x16{};
  if constexpr (PF) {
  bf16x8 b0 = *reinterpret_cast<const bf16x8*>(Ks + KSWZ(r32, (hi * 8) * 2)), b1 = *reinterpret_cast<const bf16x8*>(Ks + KSWZ(32 + r32, (hi * 8) * 2));
#pragma unroll
  for (int d0 = 0; d0 < 8; ++d0) { bf16x8 n0 = b0, n1 = b1;
    if (d0 < 7) { const int cb = ((d0 + 1) * 16 + hi * 8) * 2; n0 = *reinterpret_cast<const bf16x8*>(Ks + KSWZ(r32, cb)); n1 = *reinterpret_cast<const bf16x8*>(Ks + KSWZ(32 + r32, cb)); }
    if (d0 < 7) asm volatile("s_waitcnt lgkmcnt(2)" ::: "memory"); else asm volatile("s_waitcnt lgkmcnt(0)" ::: "memory");
    __builtin_amdgcn_sched_barrier(0);
    p0 = __builtin_amdgcn_mfma_f32_32x32x16_bf16(b0, qr[d0], p0, 0, 0, 0);
    p1 = __builtin_amdgcn_mfma_f32_32x32x16_bf16(b1, qr[d0], p1, 0, 0, 0);
    b0 = n0; b1 = n1; }
  } else {
#pragma unroll
  for (int d0 = 0; d0 < 8; ++d0) { int cb = (d0 * 16 + hi * 8) * 2;
    bf16x8 b0 = *reinterpret_cast<const bf16x8*>(Ks + KSWZ(r32, cb));
    bf16x8 b1 = *reinterpret_cast<const bf16x8*>(Ks + KSWZ(32 + r32, cb));
    p0 = __builtin_amdgcn_mfma_f32_32x32x16_bf16(b0, qr[d0], p0, 0, 0, 0);
    p1 = __builtin_amdgcn_mfma_f32_32x32x16_bf16(b1, qr[d0], p1, 0, 0, 0); }
  }
}
__device__ __forceinline__ int v_st(int k, int c) { const int kk = (k & ~0xC) | ((k & 4) << 1) | ((k & 8) >> 1); return ((kk >> 3) * 4 + (c >> 5)) * 512 + ((kk & 7) * 32 + (c & 31)) * 2; }
__device__ __forceinline__ int v_rd_base(int lane) { return ((lane & 3) << 3) | (((lane >> 2) & 3) << 6) | (((lane >> 4) & 1) << 5) | (((lane >> 5) & 1) << 8); }
constexpr int v_rd_off(int d0, int ks, int half) { return d0 * 512 + ks * 4096 + half * 2048; }
template <int OFF> __device__ __forceinline__ s16x4 tr_read(int vb) {
  s16x4 r; asm volatile("ds_read_b64_tr_b16 %0, %1 offset:%2" : "=&v"(r) : "v"(vb), "i"(OFF) : "memory"); return r;
}
template <int D0> __device__ __forceinline__ void pv_one(f32x16& od, int vb, bf16x8 pa0, bf16x8 pa1, bf16x8 pa2, bf16x8 pa3) {
  const s16x4 l0 = tr_read<v_rd_off(D0, 0, 0)>(vb), h0 = tr_read<v_rd_off(D0, 0, 1)>(vb), l1 = tr_read<v_rd_off(D0, 1, 0)>(vb), h1 = tr_read<v_rd_off(D0, 1, 1)>(vb);
  const s16x4 l2 = tr_read<v_rd_off(D0, 2, 0)>(vb), h2 = tr_read<v_rd_off(D0, 2, 1)>(vb), l3 = tr_read<v_rd_off(D0, 3, 0)>(vb), h3 = tr_read<v_rd_off(D0, 3, 1)>(vb);
  asm volatile("s_waitcnt lgkmcnt(0)" ::: "memory"); SBAR();
#define PK(L, H) (bf16x8){L[0], L[1], L[2], L[3], H[0], H[1], H[2], H[3]}
  od = __builtin_amdgcn_mfma_f32_32x32x16_bf16(pa0, PK(l0, h0), od, 0, 0, 0);
  od = __builtin_amdgcn_mfma_f32_32x32x16_bf16(pa1, PK(l1, h1), od, 0, 0, 0);
  od = __builtin_amdgcn_mfma_f32_32x32x16_bf16(pa2, PK(l2, h2), od, 0, 0, 0);
  od = __builtin_amdgcn_mfma_f32_32x32x16_bf16(pa3, PK(l3, h3), od, 0, 0, 0);
#undef PK
}
__device__ __forceinline__ void pv_d0(f32x16* o, int vb, bf16x8 pa0, bf16x8 pa1, bf16x8 pa2, bf16x8 pa3) {
  pv_one<0>(o[0], vb, pa0, pa1, pa2, pa3); pv_one<1>(o[1], vb, pa0, pa1, pa2, pa3); pv_one<2>(o[2], vb, pa0, pa1, pa2, pa3); pv_one<3>(o[3], vb, pa0, pa1, pa2, pa3);
}

struct Unit {
  const bf16* Q; const bf16* K; const bf16* V; bf16* O; float* lse;
  int qstride, kstride, ostride, lse_stride;
  int NT;
  int kb0, n, qi0, hw;
  float slope_raw;
  float sink; int has_sink;
};

template <bool BAND, int SM>
__device__ __forceinline__ void attn_unit(const Unit& U, char* lds, const int tid) {
  const int wid = tid >> 6, lane = tid & 63, r32 = lane & 31, hi = lane >> 5;
  char* V_lds = lds; char* K_lds = lds + 2 * SHM_V;
  float* ws = (float*)(lds + 2 * SHM_V + 2 * SHM_K) + wid * 64; float* li_l = ws; float* al_l = ws + 32;
  float m_reg = -1e30f, l_reg = 0; f32x16 o[4] = {}; bf16x8 qr[8];
  { int lq_ = lane; asm volatile("" : "+v"(lq_));
    const unsigned qoff = (unsigned)(wid * QBLK + (lq_ & 31)) * (unsigned)U.qstride + (unsigned)((lq_ >> 5) * 8);
#pragma unroll
    for (int d0 = 0; d0 < 8; ++d0) qr[d0] = *reinterpret_cast<const bf16x8*>(U.Q + qoff + d0 * 16); }
  const int sr = tid >> 4, sc = (tid & 15) * 8, vst0 = v_st(sr, sc), kst0 = KSWZ(sr, sc * 2);
  const int vb0 = (int)(uintptr_t)V_lds + v_rd_base(lane);
  struct { bf16x8 vs0, vs1, ks0, ks1; } sr_[BAND ? 1 : 2];
  float fq = 0.f;
  if constexpr (BAND) fq = (float)(U.qi0 + wid * QBLK + r32);
#define ROWOF(k) ((k) < 0 ? 0 : ((k) >= U.n ? U.n - 1 : (k)))
#define SLOAD(i, k0) do { unsigned _o0, _o1; \
    if constexpr (BAND) { const int _ka = U.kb0 + (k0) + sr; _o0 = (unsigned)ROWOF(_ka) * (unsigned)U.kstride + (unsigned)sc; _o1 = (unsigned)ROWOF(_ka + 32) * (unsigned)U.kstride + (unsigned)sc; } \
    else { _o0 = (unsigned)((k0) + sr) * (unsigned)U.kstride + (unsigned)sc; _o1 = _o0 + 32u * (unsigned)U.kstride; } \
    sr_[i].vs0 = *reinterpret_cast<const bf16x8*>(U.V + _o0); sr_[i].vs1 = *reinterpret_cast<const bf16x8*>(U.V + _o1); \
    sr_[i].ks0 = *reinterpret_cast<const bf16x8*>(U.K + _o0); sr_[i].ks1 = *reinterpret_cast<const bf16x8*>(U.K + _o1); } while (0)
#define SWRITE(b, i) do { *(bf16x8*)(V_lds + (b) * SHM_V + vst0) = sr_[i].vs0;          \
    *(bf16x8*)(V_lds + (b) * SHM_V + vst0 + 8192) = sr_[i].vs1;                         \
    *(bf16x8*)(K_lds + (b) * SHM_K + kst0) = sr_[i].ks0;                               \
    *(bf16x8*)(K_lds + (b) * SHM_K + kst0 + 8192) = sr_[i].ks1; } while (0)
#define SWAIT() asm volatile("s_waitcnt vmcnt(4)" ::: "memory")
#define QK_SCHED() do { if constexpr (SM == 2 && ATT_SCHED == 1) { __builtin_amdgcn_sched_group_barrier(0x100, 4, 0); \
    _Pragma("unroll") for (int i_ = 0; i_ < 7; ++i_) { __builtin_amdgcn_sched_group_barrier(0x008, 2, 0); __builtin_amdgcn_sched_group_barrier(0x002, 9, 0); __builtin_amdgcn_sched_group_barrier(0x100, 2, 0); } \
    __builtin_amdgcn_sched_group_barrier(0x008, 2, 0); __builtin_amdgcn_sched_group_barrier(0x002, 12, 0); } \
    if constexpr (SM == 2 && ATT_SCHED == 2) { _Pragma("unroll") for (int i_ = 0; i_ < 8; ++i_) { __builtin_amdgcn_sched_group_barrier(0x100, 2, 0); __builtin_amdgcn_sched_group_barrier(0x008, 2, 0); __builtin_amdgcn_sched_group_barrier(0x002, 9, 0); } } } while (0)
#define RESC(a) do { if constexpr (SM != 2) if (__any((a) < 1.f)) { if (hi == 0) al_l[r32] = (a); asm volatile("s_waitcnt lgkmcnt(0)" ::: "memory"); \
    _Pragma("unroll") for (int d = 0; d < 4; ++d) _Pragma("unroll") for (int r = 0; r < 16; ++r) o[d][r] *= al_l[crow(r, hi)]; } } while (0)
#define MASKB(P0, P1, j) do { if constexpr (BAND) { const float _f0 = ((float)(U.kb0 + 64 * (j)) + (float)(4 * hi)) - fq; const float _ninf = -__builtin_inff(); \
    const float flo = __builtin_fmaxf(-(float)U.hw, -fq), fhi = __builtin_fminf((float)U.hw, (float)(U.n - 1) - fq); \
    _Pragma("unroll") for (int r = 0; r < 16; ++r) { const float d0_ = _f0 + (float)((r & 3) + 8 * (r >> 2)), d1_ = d0_ + 32.f; \
      const float s0_ = fmaf(-U.slope_raw, __builtin_fabsf(d0_), P0[r]), s1_ = fmaf(-U.slope_raw, __builtin_fabsf(d1_), P1[r]); \
      P0[r] = (d0_ >= flo && d0_ <= fhi) ? s0_ : _ninf; P1[r] = (d1_ >= flo && d1_ <= fhi) ? s1_ : _ninf; } } } while (0)
  f32x16 pA0, pA1, pB0, pB1; float mnA, mnB, alA, alB; bf16x8 pa0, pa1, pa2, pa3; const int NT = U.NT;
  constexpr int SE = 0, SO = 1;
  if constexpr (BAND) {
  const int tlo_ = __builtin_amdgcn_readfirstlane(wid >> 1), thi_ = tlo_ + (U.hw >> 5);
#define ACT(j) (!WSKIP || ((j) >= tlo_ && (j) <= thi_))
  SLOAD(0, 0); SWRITE(0, 0); SLOAD(0, KVBLK); __syncthreads();
  if (ACT(0)) { qkt<(BAND_PREFETCH != 0)>(pA0, pA1, K_lds, qr, r32, hi); MASKB(pA0, pA1, 0); partialSM<SM>(pA0, pA1, m_reg, mnA, alA); }
  SWRITE(1, 0); if (2 < NT) SLOAD(0, 2 * KVBLK); __syncthreads();
  for (int j = 1; j + 1 < NT; j += 2) {
      { const bool aj = ACT(j), ap = ACT(j - 1);
        SBAR(); if (aj) qkt<(BAND_PREFETCH != 0)>(pB0, pB1, K_lds + SHM_K, qr, r32, hi);
        if (ap) { finishSM<SM>(pA0, pA1, alA, l_reg, pa0, pa1, pa2, pa3); SBAR(); pv_d0(o, vb0, pa0, pa1, pa2, pa3); }
        if (aj) { MASKB(pB0, pB1, j); partialSM<SM>(pB0, pB1, m_reg, mnB, alB); }
        __syncthreads(); SWRITE(0, 0); SLOAD(0, (j + 2) * KVBLK);
        if (aj) RESC(alB); __syncthreads(); }
      { const bool aj = ACT(j + 1), ap = ACT(j);
        SBAR(); if (aj) qkt<(BAND_PREFETCH != 0)>(pA0, pA1, K_lds, qr, r32, hi);
        if (ap) { finishSM<SM>(pB0, pB1, alB, l_reg, pa0, pa1, pa2, pa3); SBAR(); pv_d0(o, vb0 + SHM_V, pa0, pa1, pa2, pa3); }
        if (aj) { MASKB(pA0, pA1, j + 1); partialSM<SM>(pA0, pA1, m_reg, mnA, alA); }
        __syncthreads(); SWRITE(1, 0); if (j + 3 < NT) SLOAD(0, (j + 3) * KVBLK);
        if (aj) RESC(alA); __syncthreads(); }
  }
  { const bool aj = ACT(NT - 1), ap = ACT(NT - 2);
    SBAR(); if (aj) qkt<(BAND_PREFETCH != 0)>(pB0, pB1, K_lds + SHM_K, qr, r32, hi);
    if (ap) { finishSM<SM>(pA0, pA1, alA, l_reg, pa0, pa1, pa2, pa3); SBAR(); pv_d0(o, vb0, pa0, pa1, pa2, pa3); }
    if (aj) { MASKB(pB0, pB1, NT - 1); partialSM<SM>(pB0, pB1, m_reg, mnB, alB); }
    __syncthreads();
    if (aj) { RESC(alB);
      finishSM<SM>(pB0, pB1, alB, l_reg, pa0, pa1, pa2, pa3); SBAR();
      pv_d0(o, vb0 + SHM_V, pa0, pa1, pa2, pa3); } }
#undef ACT
  } else {
  SLOAD(SE, 0); asm volatile("s_waitcnt vmcnt(0)" ::: "memory"); SWRITE(0, SE); __syncthreads();
  qkt<(QKT_PREFETCH != 0) && SM == 2>(pA0, pA1, K_lds, qr, r32, hi); partialSM<SM>(pA0, pA1, m_reg, mnA, alA);
  SLOAD(SO, KVBLK); if (2 < NT) SLOAD(SE, 2 * KVBLK);
  SWAIT(); SWRITE(1, SO); __syncthreads();
  for (int j = 1; j + 1 < NT; j += 2) {
    SBAR(); qkt<(QKT_PREFETCH != 0) && SM == 2>(pB0, pB1, K_lds + SHM_K, qr, r32, hi);
    finishSM<SM>(pA0, pA1, alA, l_reg, pa0, pa1, pa2, pa3); QK_SCHED(); SBAR();
    SLOAD(SO, (j + 2) * KVBLK); SBAR();
    pv_d0(o, vb0, pa0, pa1, pa2, pa3); partialSM<SM>(pB0, pB1, m_reg, mnB, alB);
    __syncthreads(); SWAIT(); SWRITE(0, SE);
    RESC(alB); __syncthreads();
    SBAR(); qkt<(QKT_PREFETCH != 0) && SM == 2>(pA0, pA1, K_lds, qr, r32, hi);
    finishSM<SM>(pB0, pB1, alB, l_reg, pa0, pa1, pa2, pa3); QK_SCHED(); SBAR();
    if (j + 3 < NT) SLOAD(SE, (j + 3) * KVBLK); SBAR();
    pv_d0(o, vb0 + SHM_V, pa0, pa1, pa2, pa3); partialSM<SM>(pA0, pA1, m_reg, mnA, alA);
    __syncthreads(); SWAIT(); SWRITE(1, SO);
    RESC(alA); __syncthreads();
  }
  SBAR(); qkt<(QKT_PREFETCH != 0) && SM == 2>(pB0, pB1, K_lds + SHM_K, qr, r32, hi);
  finishSM<SM>(pA0, pA1, alA, l_reg, pa0, pa1, pa2, pa3); SBAR();
  pv_d0(o, vb0, pa0, pa1, pa2, pa3); partialSM<SM>(pB0, pB1, m_reg, mnB, alB);
  __syncthreads(); RESC(alB);
  finishSM<SM>(pB0, pB1, alB, l_reg, pa0, pa1, pa2, pa3); SBAR();
  pv_d0(o, vb0 + SHM_V, pa0, pa1, pa2, pa3);
  }
  if constexpr (BAND) {
    if (U.has_sink) l_reg += __builtin_amdgcn_exp2f((U.sink * (1.0f / SCALE) - m_reg) * (SCALE * 1.4426950408889634f));
    if (U.lse != nullptr && hi == 0) U.lse[(unsigned)(wid * QBLK + r32) * (unsigned)U.lse_stride] = m_reg * SCALE + __builtin_amdgcn_logf(l_reg) * 0.6931471805599453f;
  }
  int lane_e = lane; asm volatile("" : "+v"(lane_e));
  const int r32e = lane_e & 31, hie = lane_e >> 5;
  if (hie == 0) li_l[r32e] = l_reg; asm volatile("s_waitcnt lgkmcnt(0)" ::: "memory");
  float rli[16];
#pragma unroll
  for (int r = 0; r < 16; ++r) rli[r] = __builtin_amdgcn_rcpf(li_l[crow(r, hie)]);
  __syncthreads();
  char* ost = lds + wid * 8192;
  { char* op = ost + hie * 1024 + r32e * 2;
#pragma unroll
    for (int r = 0; r < 16; ++r) {
#pragma unroll
      for (int d0 = 0; d0 < 4; ++d0) { const unsigned w = cvtpk(o[d0][r] * rli[r], 0.f); *(unsigned short*)(op + ((r & 3) + 8 * (r >> 2)) * 256 + d0 * 64) = (unsigned short)w; } } }
  asm volatile("s_waitcnt lgkmcnt(0)" ::: "memory");
  { const char* ip = ost + (lane_e >> 4) * 256 + (lane_e & 15) * 16;
    unsigned goff = (unsigned)(wid * QBLK + (lane_e >> 4)) * (unsigned)U.ostride + (unsigned)((lane_e & 15) * 8); const unsigned gstep = 4u * (unsigned)U.ostride;
#pragma unroll
    for (int i = 0; i < 8; ++i) { const u32x4 w = *(const u32x4*)(ip + i * 1024); *(u32x4*)(U.O + goff) = w; goff += gstep; } }
  __syncthreads();
#undef ROWOF
#undef SLOAD
#undef SWRITE
#undef SWAIT
#undef QK_SCHED
#undef RESC
#undef MASKB
}

constexpr int SHM_RING = 3 * SHM_V + 2 * SHM_K + NW * 64 * 4;
__device__ __forceinline__ void attn_unit_ring(const Unit& U, char* lds, const int tid) {
  const int wid = tid >> 6, lane = tid & 63, r32 = lane & 31, hi = lane >> 5;
  char* V_lds = lds; char* K_lds = lds + 3 * SHM_V;
  float* ws = (float*)(lds + 3 * SHM_V + 2 * SHM_K) + wid * 64; float* li_l = ws;
  float m_reg = 0.f, l_reg = 0, mn_, al_ = 1.f; f32x16 o[4] = {}; bf16x8 qr[8];
  { const unsigned qoff = (unsigned)(wid * QBLK + r32) * (unsigned)U.qstride + (unsigned)(hi * 8);
#pragma unroll
    for (int d0 = 0; d0 < 8; ++d0) qr[d0] = *reinterpret_cast<const bf16x8*>(U.Q + qoff + d0 * 16); }
  const int sr = tid >> 4, sc = (tid & 15) * 8, vst0 = v_st(sr, sc), vst1 = v_st(32 + sr, sc);
  const int vb0 = (int)(uintptr_t)V_lds + v_rd_base(lane);
  struct { bf16x8 vs0, vs1, ks0, ks1; } sr_[1];
#define SLOAD(i, k0) do { const unsigned _o0 = (unsigned)((k0) + sr) * (unsigned)U.kstride + (unsigned)sc, _o1 = _o0 + 32u * (unsigned)U.kstride; \
    sr_[i].vs0 = *reinterpret_cast<const bf16x8*>(U.V + _o0); sr_[i].vs1 = *reinterpret_cast<const bf16x8*>(U.V + _o1); \
    sr_[i].ks0 = *reinterpret_cast<const bf16x8*>(U.K + _o0); sr_[i].ks1 = *reinterpret_cast<const bf16x8*>(U.K + _o1); } while (0)
#define SWRITE(kb, vsl, i) do { char* _v = V_lds + (vsl) * SHM_V; *(bf16x8*)(_v + vst0) = sr_[i].vs0; *(bf16x8*)(_v + vst1) = sr_[i].vs1; int kc = sc * 2; \
    *(bf16x8*)(K_lds + (kb) * SHM_K + KSWZ(sr, kc)) = sr_[i].ks0; *(bf16x8*)(K_lds + (kb) * SHM_K + KSWZ(32 + sr, kc)) = sr_[i].ks1; } while (0)
#define NEXT3(x) ((x) == 2 ? 0 : (x) + 1)
  f32x16 pA0, pA1, pB0, pB1; bf16x8 pa0, pa1, pa2, pa3; const int NT = U.NT;
  SLOAD(0, 0); SWRITE(0, 0, 0); SLOAD(0, KVBLK);
  __syncthreads();
  SWRITE(1, 1, 0); SLOAD(0, 2 * KVBLK);
  qkt<(QKT_PREFETCH != 0)>(pA0, pA1, K_lds, qr, r32, hi); partialSM<2>(pA0, pA1, m_reg, mn_, al_);
  __syncthreads();
  int vr = 0;
  for (int j = 1; j + 1 < NT; j += 2) {
    { const int vw = NEXT3(NEXT3(vr));
      SWRITE(0, vw, 0); SLOAD(0, (j + 2) * KVBLK);
      SBAR(); qkt<(QKT_PREFETCH != 0)>(pB0, pB1, K_lds + SHM_K, qr, r32, hi);
      finishSM<2>(pA0, pA1, al_, l_reg, pa0, pa1, pa2, pa3); SBAR();
      pv_d0(o, vb0 + vr * SHM_V, pa0, pa1, pa2, pa3); partialSM<2>(pB0, pB1, m_reg, mn_, al_);
      __syncthreads(); vr = NEXT3(vr); }
    { const int vw = NEXT3(NEXT3(vr));
      SWRITE(1, vw, 0); if (j + 3 < NT) SLOAD(0, (j + 3) * KVBLK);
      SBAR(); qkt<(QKT_PREFETCH != 0)>(pA0, pA1, K_lds, qr, r32, hi);
      finishSM<2>(pB0, pB1, al_, l_reg, pa0, pa1, pa2, pa3); SBAR();
      pv_d0(o, vb0 + vr * SHM_V, pa0, pa1, pa2, pa3); partialSM<2>(pA0, pA1, m_reg, mn_, al_);
      __syncthreads(); vr = NEXT3(vr); }
  }
  SBAR(); qkt<(QKT_PREFETCH != 0)>(pB0, pB1, K_lds + SHM_K, qr, r32, hi);
  finishSM<2>(pA0, pA1, al_, l_reg, pa0, pa1, pa2, pa3); SBAR();
  pv_d0(o, vb0 + vr * SHM_V, pa0, pa1, pa2, pa3); partialSM<2>(pB0, pB1, m_reg, mn_, al_);
  finishSM<2>(pB0, pB1, al_, l_reg, pa0, pa1, pa2, pa3); SBAR();
  pv_d0(o, vb0 + NEXT3(vr) * SHM_V, pa0, pa1, pa2, pa3);
  int lane_e = lane; asm volatile("" : "+v"(lane_e));
  const int r32e = lane_e & 31, hie = lane_e >> 5;
  if (hie == 0) li_l[r32e] = l_reg; asm volatile("s_waitcnt lgkmcnt(0)" ::: "memory");
  float rli[16];
#pragma unroll
  for (int r = 0; r < 16; ++r) rli[r] = __builtin_amdgcn_rcpf(li_l[crow(r, hie)]);
  __syncthreads();
  char* ost = lds + wid * 8192;
  { char* op = ost + hie * 1024 + r32e * 2;
#pragma unroll
    for (int r = 0; r < 16; ++r) {
#pragma unroll
      for (int d0 = 0; d0 < 4; ++d0) { const unsigned w = cvtpk(o[d0][r] * rli[r], 0.f); *(unsigned short*)(op + ((r & 3) + 8 * (r >> 2)) * 256 + d0 * 64) = (unsigned short)w; } } }
  asm volatile("s_waitcnt lgkmcnt(0)" ::: "memory");
  { const char* ip = ost + (lane_e >> 4) * 256 + (lane_e & 15) * 16;
    unsigned goff = (unsigned)(wid * QBLK + (lane_e >> 4)) * (unsigned)U.ostride + (unsigned)((lane_e & 15) * 8); const unsigned gstep = 4u * (unsigned)U.ostride;
#pragma unroll
    for (int i = 0; i < 8; ++i) { const u32x4 w = *(const u32x4*)(ip + i * 1024); *(u32x4*)(U.O + goff) = w; goff += gstep; } }
  __syncthreads();
#undef SLOAD
#undef SWRITE
#undef NEXT3
}

constexpr int DMA_KOFF = 0, DMA_VOFF = 3 * SHM_K, DMA_SCR = 3 * SHM_K + 4 * SHM_V, SHM_DMA = DMA_SCR + NW * 64 * 4;
typedef __attribute__((address_space(3))) unsigned char lds_u8;
__device__ __forceinline__ void attn_unit_dma(const Unit& U, char* lds, lds_u8* ldsl, const int tid) {
  const int wid = __builtin_amdgcn_readfirstlane(tid >> 6), lane = tid & 63, r32 = lane & 31, hi = lane >> 5;
  char* K_lds = lds + DMA_KOFF; char* V_lds = lds + DMA_VOFF;
  float* ws = (float*)(lds + DMA_SCR) + wid * 64; float* li_l = ws;
  float m_reg = 0.f, l_reg = 0, mn_, al_ = 1.f; f32x16 o[4] = {}; bf16x8 qr[8];
  { int lq_ = lane; asm volatile("" : "+v"(lq_));
    const unsigned qoff = (unsigned)(wid * QBLK + (lq_ & 31)) * (unsigned)U.qstride + (unsigned)((lq_ >> 5) * 8);
#pragma unroll
    for (int d0 = 0; d0 < 8; ++d0) qr[d0] = *reinterpret_cast<const bf16x8*>(U.Q + qoff + d0 * 16); }
  unsigned koff[2], voff[2];
#pragma unroll
  for (int i = 0; i < 2; ++i) { const int p = (wid * 2 + i) * 64 + lane;
    { const int row = p >> 4, cs = p & 15, c = cs ^ (row & 7); koff[i] = ((unsigned)row * (unsigned)U.kstride + (unsigned)(c * 8)) * 2u; }
    { const int st = p >> 5, q = p & 31, kk = (st >> 2) * 8 + (q >> 2), key = (kk & ~0xC) | ((kk & 4) << 1) | ((kk & 8) >> 1), c = (st & 3) * 32 + (q & 3) * 8; voff[i] = ((unsigned)key * (unsigned)U.kstride + (unsigned)c) * 2u; } }
  const int vb0 = (int)(uintptr_t)V_lds + v_rd_base(lane);
  const unsigned ldsw = (unsigned)wid * 2048u;
#define NEXT3(x) ((x) == 2 ? 0 : (x) + 1)
#define NEXT4(x) (((x) + 1) & 3)
#define DMA_TILE(t, ks, vs) do { const int t_ = (t); const char* kb_ = (const char*)(U.K + (size_t)t_ * KVBLK * U.kstride); const char* vb_ = (const char*)(U.V + (size_t)t_ * KVBLK * U.kstride); \
    _Pragma("unroll") for (int i_ = 0; i_ < 2; ++i_) { \
      __builtin_amdgcn_global_load_lds((const unsigned*)(kb_ + koff[i_]), (__attribute__((address_space(3))) unsigned*)(ldsl + DMA_KOFF + (ks) * SHM_K + ldsw + i_ * 1024), 16, 0, 0); \
      __builtin_amdgcn_global_load_lds((const unsigned*)(vb_ + voff[i_]), (__attribute__((address_space(3))) unsigned*)(ldsl + DMA_VOFF + (vs) * SHM_V + ldsw + i_ * 1024), 16, 0, 0); } } while (0)
#define STEP_BAR() do { asm volatile("s_waitcnt vmcnt(4) lgkmcnt(0)" ::: "memory"); __builtin_amdgcn_s_barrier(); asm volatile("" ::: "memory"); } while (0)
#define STEP_BAR0() do { asm volatile("s_waitcnt vmcnt(0) lgkmcnt(0)" ::: "memory"); __builtin_amdgcn_s_barrier(); asm volatile("" ::: "memory"); } while (0)
  f32x16 pA0, pA1, pB0, pB1; bf16x8 pa0, pa1, pa2, pa3; const int NT = U.NT;
  asm volatile("s_waitcnt vmcnt(0)" ::: "memory");
  DMA_TILE(0, 0, 0); DMA_TILE(1, 1, 1);
  STEP_BAR();
  DMA_TILE(2, 2, 2);
  qkt<(QKT_PREFETCH != 0)>(pA0, pA1, K_lds, qr, r32, hi); partialSM<2>(pA0, pA1, m_reg, mn_, al_);
  STEP_BAR();
  int ks = 1, vs = 1;
  for (int j = 1; j + 1 < NT; j += 2) {
    { const int kw = NEXT3(NEXT3(ks)), vw = NEXT4(NEXT4(vs));
      const bool more_ = j + 2 < NT;
      SBAR(); qkt<(QKT_PREFETCH != 0)>(pB0, pB1, K_lds + ks * SHM_K, qr, r32, hi);
      finishSM<2>(pA0, pA1, al_, l_reg, pa0, pa1, pa2, pa3); SBAR();
      if (more_) DMA_TILE(j + 2, kw, vw); SBAR();
      pv_d0(o, vb0 + ((vs + 3) & 3) * SHM_V, pa0, pa1, pa2, pa3); partialSM<2>(pB0, pB1, m_reg, mn_, al_);
      if (more_) STEP_BAR(); else STEP_BAR0(); ks = NEXT3(ks); vs = NEXT4(vs); }
    { const int kw = NEXT3(NEXT3(ks)), vw = NEXT4(NEXT4(vs));
      const bool more_ = j + 3 < NT;
      SBAR(); qkt<(QKT_PREFETCH != 0)>(pA0, pA1, K_lds + ks * SHM_K, qr, r32, hi);
      finishSM<2>(pB0, pB1, al_, l_reg, pa0, pa1, pa2, pa3); SBAR();
      if (more_) DMA_TILE(j + 3, kw, vw); SBAR();
      pv_d0(o, vb0 + ((vs + 3) & 3) * SHM_V, pa0, pa1, pa2, pa3); partialSM<2>(pA0, pA1, m_reg, mn_, al_);
      if (more_) STEP_BAR(); else STEP_BAR0(); ks = NEXT3(ks); vs = NEXT4(vs); }
  }
  SBAR(); qkt<(QKT_PREFETCH != 0)>(pB0, pB1, K_lds + ks * SHM_K, qr, r32, hi);
  finishSM<2>(pA0, pA1, al_, l_reg, pa0, pa1, pa2, pa3); SBAR();
  pv_d0(o, vb0 + ((vs + 3) & 3) * SHM_V, pa0, pa1, pa2, pa3); partialSM<2>(pB0, pB1, m_reg, mn_, al_);
  finishSM<2>(pB0, pB1, al_, l_reg, pa0, pa1, pa2, pa3); SBAR();
  pv_d0(o, vb0 + vs * SHM_V, pa0, pa1, pa2, pa3);
  asm volatile("s_waitcnt vmcnt(0) lgkmcnt(0)" ::: "memory");
  int lane_e = lane; asm volatile("" : "+v"(lane_e));
  const int r32e = lane_e & 31, hie = lane_e >> 5;
  if (hie == 0) li_l[r32e] = l_reg; asm volatile("s_waitcnt lgkmcnt(0)" ::: "memory");
  float rli[16];
#pragma unroll
  for (int r = 0; r < 16; ++r) rli[r] = __builtin_amdgcn_rcpf(li_l[crow(r, hie)]);
  __syncthreads();
  char* ost = lds + wid * 8192;
  { char* op = ost + hie * 1024 + r32e * 2;
#pragma unroll
    for (int r = 0; r < 16; ++r) {
#pragma unroll
      for (int d0 = 0; d0 < 4; ++d0) { const unsigned w = cvtpk(o[d0][r] * rli[r], 0.f); *(unsigned short*)(op + ((r & 3) + 8 * (r >> 2)) * 256 + d0 * 64) = (unsigned short)w; } } }
  asm volatile("s_waitcnt lgkmcnt(0)" ::: "memory");
  { const char* ip = ost + (lane_e >> 4) * 256 + (lane_e & 15) * 16;
    unsigned goff = (unsigned)(wid * QBLK + (lane_e >> 4)) * (unsigned)U.ostride + (unsigned)((lane_e & 15) * 8); const unsigned gstep = 4u * (unsigned)U.ostride;
#pragma unroll
    for (int i = 0; i < 8; ++i) { const u32x4 w = *(const u32x4*)(ip + i * 1024); *(u32x4*)(U.O + goff) = w; goff += gstep; } }
  __syncthreads();
#undef NEXT3
#undef NEXT4
#undef DMA_TILE
#undef STEP_BAR
#undef STEP_BAR0
}
}

constexpr int NWAVES = 8;
constexpr int DM = 2048, SEQ = 16384, NSEQ = 3, M_ALL = NSEQ * SEQ, DEPTH = 4, DFF = 5632, INC = 13824;
constexpr int MGR = 2 * SEQ;
constexpr int A_Q = 0, A_K = 1536, A_V = 3072, B_Q = 4608, B_K = 5632, B_V = 5888, C_Q = 6144, C_K = 7168, C_V = 7424, GL0 = 7680;
constexpr float NORM_EPS = 1e-6f;
enum { I_XP = 0, I_XS, I_NF1, I_F1IN, I_F1OUT, I_NMIX, I_WIN, I_QNQ, I_QNK, I_SINK, I_WA, I_WB, I_WC, I_WO, I_NF2, I_F2IN, I_F2OUT, I_NFIN, N_IN };

constexpr size_t MiB = 1u << 20;
constexpr size_t WS_CTL = 0, CTL_ZERO_BYTES = 1 * MiB;
constexpr int LDW = DM + LDW_PAD, LDU = DM + LDU_PAD;
constexpr size_t WL_F1IN = 0, WL_F1OUT = WL_F1IN + (size_t)2 * DFF * LDW * 2, WL_WIN = WL_F1OUT + (size_t)DM * DFF * 2, WL_WA = WL_WIN + (size_t)INC * LDW * 2,
                 WL_WB = WL_WA + (size_t)DM * 512 * 2, WL_WC = WL_WB + (size_t)DM * 1024 * 2, WL_WO = WL_WC + (size_t)DM * 1024 * 2, WL_F2IN = WL_WO + (size_t)DM * LDW * 2,
                 WL_F2OUT = WL_F2IN + (size_t)2 * DFF * LDW * 2, WL_BYTES = WL_F2OUT + (size_t)DM * DFF * 2;
constexpr size_t WS_W = 1 * MiB;
constexpr size_t WS_U = WS_W + WL_BYTES;
constexpr size_t WS_R = WS_U + (size_t)M_ALL * LDU * 2;
constexpr size_t WS_H = WS_R;
constexpr size_t WS_QKVG = WS_R;
constexpr int OCAT = 2560;
constexpr size_t WS_OCAT = WS_QKVG + (size_t)MGR * INC * 2;
constexpr size_t WS_OA = WS_OCAT, WS_OB = WS_OCAT + 512 * 2, WS_OC = WS_OCAT + 1536 * 2;
constexpr size_t WS_PA = WS_OCAT + (size_t)MGR * OCAT * 2;
constexpr size_t WS_LSE = WS_PA + (size_t)3 * MGR * 512 * 2;
constexpr size_t WS_QB = WS_LSE + (size_t)3 * MGR * 4 * 4;
constexpr size_t WS_KB = WS_QB + (size_t)MGR * 1024 * 2;
constexpr size_t WS_VB = WS_KB + (size_t)MGR * 256 * 2;
constexpr size_t WS_MB = WS_VB + (size_t)MGR * 256 * 2;
constexpr size_t WS_MIX_END = WS_MB + (size_t)MGR * LDU * 2;
constexpr int LDH = DFF + LDH_PAD;
constexpr size_t WS_H_END = WS_H + (size_t)M_ALL * LDH * 2;
constexpr size_t WS_X16 = WS_MIX_END > WS_H_END ? WS_MIX_END : WS_H_END;
constexpr size_t WS_END = WS_X16 + (size_t)M_ALL * DM * 2;
constexpr int CW_BAR = 4096;

constexpr int RING_OFF = 0, RING_BYTES = 131072;
constexpr int LDSCTL_OFF = RING_BYTES, MISC_OFF = LDSCTL_OFF + 320;
constexpr int LDS_BYTES = 147456;
constexpr int DIAG_OFF = MISC_OFF + 256;

#define GAS __attribute__((address_space(1)))
#define LAS __attribute__((address_space(3)))
typedef unsigned short bf16;
typedef unsigned v4u __attribute__((ext_vector_type(4)));
typedef unsigned v2u __attribute__((ext_vector_type(2)));
typedef float f32x4 __attribute__((ext_vector_type(4)));
#define LDS_WAIT() asm volatile("s_waitcnt lgkmcnt(0)" ::: "memory")
#define VM_WAIT() asm volatile("s_waitcnt vmcnt(0)" ::: "memory")
__device__ __forceinline__ unsigned f2bf(float f) { unsigned u = __builtin_bit_cast(unsigned, f); return (u + 0x7fffu + ((u >> 16) & 1u)) >> 16; }
__device__ __forceinline__ unsigned pk2(float lo, float hi) { return f2bf(lo) | (f2bf(hi) << 16); }
__device__ __forceinline__ float bflo(unsigned w) { return __uint_as_float(w << 16); }
__device__ __forceinline__ float bfhi(unsigned w) { return __uint_as_float(w & 0xffff0000u); }

#define XB_TMO      128
#define XB_XCNT(j)  (256  + 64 * (j))
#define XB_XSUB(j)  (1280 + 64 * (j))
#define XB_XGEN(j)  (2304 + 64 * (j))
#define XB_TOP      3328
#define XB_TOPGEN   3392
#define XCD_BAR_WORDS 3456
#define XB_SPIN_CAP (1u << 18)
__device__ __forceinline__ unsigned xb_ld(unsigned* p)              { return __hip_atomic_load(p, __ATOMIC_RELAXED, __HIP_MEMORY_SCOPE_AGENT); }
__device__ __forceinline__ unsigned xb_add(unsigned* p, unsigned v) { return __hip_atomic_fetch_add(p, v, __ATOMIC_RELAXED, __HIP_MEMORY_SCOPE_AGENT); }
__device__ __forceinline__ unsigned xb_xcc_id() { return (unsigned)__builtin_amdgcn_s_getreg((3 << 11) | 20) & 0xFu; }
#define XB_SPIN(cond, bar) do { unsigned _sp = 0; while (cond) { __builtin_amdgcn_s_sleep(1); \
    if ((++_sp & 255u) == 0u) { if (xb_ld(&(bar)[XB_TMO])) break; if (_sp > XB_SPIN_CAP) { atomicAdd(&(bar)[XB_TMO], 1u); break; } } } } while (0)
struct XcdBarrier { unsigned* bar; unsigned x; volatile LAS unsigned* st; };
__device__ __forceinline__ XcdBarrier xcd_barrier_post(unsigned* bar, volatile LAS unsigned* st) {
    XcdBarrier b; b.bar = bar; b.x = xb_xcc_id(); b.st = st;
    if (threadIdx.x == 0) (void)xb_add(&bar[XB_XCNT(b.x)], 1u);
    return b;
}
__device__ __forceinline__ void xcd_barrier_complete(unsigned* bar, unsigned x, unsigned& nloc, unsigned& nx) {
    const unsigned G = gridDim.x * gridDim.y * gridDim.z;
    unsigned sum, cnt, mine, sp = 0u;
    for (;;) {
        sum = 0u; cnt = 0u; mine = 0u;
#pragma unroll
        for (unsigned j = 0; j < 16; ++j) { const unsigned c = xb_ld(&bar[XB_XCNT(j)]); sum += c; cnt += (c > 0u) ? 1u : 0u; mine = (j == x) ? c : mine; }
        if (sum == G) break;
        __builtin_amdgcn_s_sleep(1);
        if ((++sp & 255u) == 0u) { if (xb_ld(&bar[XB_TMO])) break; if (sp > XB_SPIN_CAP) { atomicAdd(&bar[XB_TMO], 1u); break; } }
    }
    nloc = mine > 0u ? mine : 1u; nx = cnt > 0u ? cnt : 1u;
}
__device__ __forceinline__ void xcd_barrier(const XcdBarrier& b) {
    asm volatile("s_waitcnt vmcnt(0)" ::: "memory");
    __syncthreads();
    if (threadIdx.x == 0) {
        unsigned* bar = b.bar;
        __builtin_amdgcn_s_waitcnt(0);
        unsigned nloc = b.st[0], nx = b.st[1];
        if (nloc == 0u) { xcd_barrier_complete(bar, b.x, nloc, nx); b.st[0] = nloc; b.st[1] = nx; }
        const unsigned old = xb_add(&bar[XB_XSUB(b.x)], 1u);
        const unsigned gen = old / nloc;
        if (old + 1u == (gen + 1u) * nloc) {
            __builtin_amdgcn_fence(__ATOMIC_RELEASE, "agent");
            asm volatile("s_waitcnt vmcnt(0)" ::: "memory");
            const unsigned og = xb_add(&bar[XB_TOP], 1u);
            const unsigned tg = og / nx;
            if (og + 1u == (tg + 1u) * nx) xb_add(&bar[XB_TOPGEN], 1u);
            else XB_SPIN(xb_ld(&bar[XB_TOPGEN]) == tg, bar);
            __builtin_amdgcn_fence(__ATOMIC_ACQUIRE, "agent");
            xb_add(&bar[XB_XGEN(b.x)], 1u);
            asm volatile("s_waitcnt vmcnt(0)" ::: "memory");
        } else {
            XB_SPIN(xb_ld(&bar[XB_XGEN(b.x)]) == gen, bar);
            __builtin_amdgcn_fence(__ATOMIC_ACQUIRE, "agent");
            asm volatile("s_waitcnt vmcnt(0)" ::: "memory");
        }
    }
    __syncthreads();
}

template <int XOR> __device__ __forceinline__ float swz_xor(float v) { return __int_as_float(__builtin_amdgcn_ds_swizzle(__float_as_int(v), (XOR << 10) | 0x1F)); }
__device__ __forceinline__ float wave_sum(float v) {
    v += swz_xor<1>(v); v += swz_xor<2>(v); v += swz_xor<4>(v); v += swz_xor<8>(v); v += swz_xor<16>(v);
    auto rr = __builtin_amdgcn_permlane32_swap(__float_as_uint(v), __float_as_uint(v), false, false);
    return __uint_as_float(rr[0]) + __uint_as_float(rr[1]);
}
__device__ __forceinline__ float wave_max(float v) {
    v = fmaxf(v, swz_xor<1>(v)); v = fmaxf(v, swz_xor<2>(v)); v = fmaxf(v, swz_xor<4>(v)); v = fmaxf(v, swz_xor<8>(v)); v = fmaxf(v, swz_xor<16>(v));
    auto rr = __builtin_amdgcn_permlane32_swap(__float_as_uint(v), __float_as_uint(v), false, false);
    return fmaxf(__uint_as_float(rr[0]), __uint_as_float(rr[1]));
}
__device__ __forceinline__ void transpose_item(const float* W, int K, int N, bf16* WT, int k0, int n0, int orow0, LAS float* scr, int lane, int ldw) {
#pragma unroll 32
    for (int i = 0; i < 32; ++i) { const int kk = 2 * i + (lane >> 5); scr[kk * 33 + (lane & 31)] = W[(size_t)(k0 + kk) * N + n0 + (lane & 31)]; }
    LDS_WAIT(); asm volatile("" ::: "memory");
    const int c = lane & 7;
#pragma unroll
    for (int j = 0; j < 4; ++j) { const int n = (lane >> 3) + 8 * j; const LAS float* s = scr + (8 * c) * 33 + n;
        v4u o; o.x = pk2(s[0 * 33], s[1 * 33]); o.y = pk2(s[2 * 33], s[3 * 33]); o.z = pk2(s[4 * 33], s[5 * 33]); o.w = pk2(s[6 * 33], s[7 * 33]);
        *(GAS v4u*)(WT + (size_t)(orow0 + n) * ldw + k0 + 8 * c) = o; }
    LDS_WAIT(); asm volatile("" ::: "memory");
}
__device__ __forceinline__ void transpose_matrix(const float* W, int K, int N, bf16* WT, int swiglu, LAS float* scr, int lane, int gw, int NGW, int ldw = 0) {
    const int nblk = N / 32, nitems = (K / 64) * nblk;
    for (int it = gw; it < nitems; it += NGW) {
        const int kb = it / nblk, nb = it % nblk, k0 = 64 * kb, n0 = 32 * nb;
        int orow0 = n0;
        if (swiglu) { const int half = n0 >= DFF ? 1 : 0, np = n0 - half * DFF; orow0 = 256 * (np / 128) + 128 * half + (np % 128); }
        transpose_item(W, K, N, WT, k0, n0, orow0, scr, lane, ldw ? ldw : K);
    }
}
template <bool TO_F32, int NR>
__device__ __forceinline__ void rms_row16(const bf16* xrow, size_t xstep, const float* g, void* orow, size_t ostep, int lane) {
    const GAS f32x4* gr = (const GAS f32x4*)g + 2 * lane;
    v4u v[NR][4]; float s[NR];
#pragma unroll
    for (int i = 0; i < NR; ++i) { const GAS v4u* xr = (const GAS v4u*)(xrow + i * xstep) + lane;
#pragma unroll
        for (int j = 0; j < 4; ++j) v[i][j] = xr[64 * j]; }
#pragma unroll
    for (int i = 0; i < NR; ++i) { s[i] = 0.f;
#pragma unroll
        for (int j = 0; j < 4; ++j)
            s[i] += ((bflo(v[i][j].x) * bflo(v[i][j].x) + bfhi(v[i][j].x) * bfhi(v[i][j].x)) + (bflo(v[i][j].y) * bflo(v[i][j].y) + bfhi(v[i][j].y) * bfhi(v[i][j].y))) + ((bflo(v[i][j].z) * bflo(v[i][j].z) + bfhi(v[i][j].z) * bfhi(v[i][j].z)) + (bflo(v[i][j].w) * bflo(v[i][j].w) + bfhi(v[i][j].w) * bfhi(v[i][j].w))); }
#pragma unroll
    for (int i = 0; i < NR; ++i) s[i] = __builtin_amdgcn_rsqf(wave_sum(s[i]) * (1.f / DM) + NORM_EPS);
#pragma unroll
    for (int j = 0; j < 4; ++j) { const f32x4 g0 = gr[128 * j], g1 = gr[128 * j + 1];
#pragma unroll
        for (int i = 0; i < NR; ++i) { const float rstd = s[i];
            const f32x4 y0 = {bflo(v[i][j].x) * rstd * g0.x, bfhi(v[i][j].x) * rstd * g0.y, bflo(v[i][j].y) * rstd * g0.z, bfhi(v[i][j].y) * rstd * g0.w};
            const f32x4 y1 = {bflo(v[i][j].z) * rstd * g1.x, bfhi(v[i][j].z) * rstd * g1.y, bflo(v[i][j].w) * rstd * g1.z, bfhi(v[i][j].w) * rstd * g1.w};
            if constexpr (TO_F32) { GAS f32x4* o = (GAS f32x4*)((float*)orow + i * ostep) + 2 * lane; o[128 * j] = y0; o[128 * j + 1] = y1; }
            else { v4u w; w.x = pk2(y0.x, y0.y); w.y = pk2(y0.z, y0.w); w.z = pk2(y1.x, y1.y); w.w = pk2(y1.z, y1.w); ((GAS v4u*)((bf16*)orow + i * ostep) + lane)[64 * j] = w; } } }
}
__device__ __forceinline__ void rms_row_to_bf16(const float* xrow, const float* g, bf16* orow, bf16* xcopy, int lane) {
    const GAS f32x4* xr = (const GAS f32x4*)xrow + lane; const GAS f32x4* gr = (const GAS f32x4*)g + lane;
    f32x4 v[8]; float s = 0.f;
#pragma unroll
    for (int j = 0; j < 8; ++j) { v[j] = xr[64 * j]; s += (v[j].x * v[j].x + v[j].y * v[j].y) + (v[j].z * v[j].z + v[j].w * v[j].w); }
    if (xcopy) { GAS v2u* xc = (GAS v2u*)xcopy + lane;
#pragma unroll
        for (int j = 0; j < 8; ++j) { v2u w; w.x = pk2(v[j].x, v[j].y); w.y = pk2(v[j].z, v[j].w); xc[64 * j] = w; } }
    const float rstd = __builtin_amdgcn_rsqf(wave_sum(s) * (1.f / DM) + NORM_EPS);
    GAS v2u* o8 = (GAS v2u*)orow + lane;
#pragma unroll
    for (int j = 0; j < 8; ++j) { const f32x4 gg = gr[64 * j]; v2u w; w.x = pk2(v[j].x * rstd * gg.x, v[j].y * rstd * gg.y); w.y = pk2(v[j].z * rstd * gg.z, v[j].w * rstd * gg.w); o8[64 * j] = w; }
}
__device__ __forceinline__ void rms_row_f32(float* xrow, const float* g, int lane) {
    GAS f32x4* xr = (GAS f32x4*)xrow + lane; const GAS f32x4* gr = (const GAS f32x4*)g + lane;
    f32x4 v[8]; float s = 0.f;
#pragma unroll
    for (int j = 0; j < 8; ++j) { v[j] = xr[64 * j]; s += (v[j].x * v[j].x + v[j].y * v[j].y) + (v[j].z * v[j].z + v[j].w * v[j].w); }
    const float rstd = __builtin_amdgcn_rsqf(wave_sum(s) * (1.f / DM) + NORM_EPS);
#pragma unroll
    for (int j = 0; j < 8; ++j) { const f32x4 gg = gr[64 * j]; xr[64 * j] = v[j] * rstd * gg; }
}
constexpr float QPRESCALE = 0.088388347648318440f * 1.4426950408889634f;
template <int NT_>
__device__ __forceinline__ void ropeB_tokens(const bf16* qkvg, int t0, int tstep, const float* gq, const float* gk, bf16* qb, bf16* kb, bf16* vb, int lane) {
    const int f = lane & 31;
    const float invrev = __builtin_amdgcn_exp2f((float)f * (-13.287712379549449f / 32.0f)) * 0.15915494309189535f;
    const float gq0 = gq[2 * lane], gq1 = gq[2 * lane + 1], gk0 = gk[2 * lane], gk1 = gk[2 * lane + 1];
    unsigned w[NT_][10]; v2u vv[NT_];
#pragma unroll
    for (int i = 0; i < NT_; ++i) { const int t = t0 + i * tstep; const GAS unsigned* src = (const GAS unsigned*)(qkvg + (size_t)t * INC + B_Q) + lane;
#pragma unroll
        for (int h = 0; h < 10; ++h) w[i][h] = src[h * 64];
        vv[i] = ((const GAS v2u*)(qkvg + (size_t)t * INC + B_V))[lane]; }
#pragma unroll
    for (int i = 0; i < NT_; ++i) { const int t = t0 + i * tstep;
        const int tp = t & (SEQ - 1);
        const float pos = (float)((lane < 32) ? (tp >> 6) : (tp & 63));
        float rev = pos * invrev; rev = rev - __builtin_floorf(rev);
        const float cs = __builtin_amdgcn_cosf(rev), sn = __builtin_amdgcn_sinf(rev);
#pragma unroll
        for (int h = 0; h < 10; ++h) {
            const float x0 = bflo(w[i][h]), x1 = bfhi(w[i][h]);
            const float rstd = __builtin_amdgcn_rsqf(wave_sum(x0 * x0 + x1 * x1) * (1.f / 128.f) + NORM_EPS);
            const float y0 = x0 * rstd * (h < 8 ? gq0 : gk0), y1 = x1 * rstd * (h < 8 ? gq1 : gk1);
            const float qs = h < 8 ? QPRESCALE : 1.0f;
            const unsigned o = pk2((y0 * cs - y1 * sn) * qs, (y0 * sn + y1 * cs) * qs);
            if (h < 8) ((GAS unsigned*)(qb + (size_t)t * 1024))[h * 64 + lane] = o; else ((GAS unsigned*)(kb + (size_t)t * 256))[(h - 8) * 64 + lane] = o;
        }
        ((GAS v2u*)(vb + (size_t)t * 256))[lane] = vv[i]; }
}
__device__ __forceinline__ void mergeA_token(const bf16* pa, const float* lse, bf16* oa, int t, int lane) {
#pragma unroll
    for (int hh = 0; hh < 4; ++hh) {
        const float l0 = lse[((size_t)0 * MGR + t) * 4 + hh], l1 = lse[((size_t)1 * MGR + t) * 4 + hh], l2 = lse[((size_t)2 * MGR + t) * 4 + hh];
        const float mx = fmaxf(l0, fmaxf(l1, l2));
        const float e0 = __builtin_amdgcn_exp2f((l0 - mx) * 1.4426950408889634f), e1 = __builtin_amdgcn_exp2f((l1 - mx) * 1.4426950408889634f), e2 = __builtin_amdgcn_exp2f((l2 - mx) * 1.4426950408889634f);
        const float inv = __builtin_amdgcn_rcpf(e0 + e1 + e2);
        const unsigned w0 = ((const GAS unsigned*)(pa + ((size_t)0 * MGR + t) * 512))[hh * 64 + lane], w1 = ((const GAS unsigned*)(pa + ((size_t)1 * MGR + t) * 512))[hh * 64 + lane],
                       w2 = ((const GAS unsigned*)(pa + ((size_t)2 * MGR + t) * 512))[hh * 64 + lane];
        const float a = (e0 * bflo(w0) + e1 * bflo(w1) + e2 * bflo(w2)) * inv, b = (e0 * bfhi(w0) + e1 * bfhi(w1) + e2 * bfhi(w2)) * inv;
        ((GAS unsigned*)(oa + (size_t)t * OCAT))[hh * 64 + lane] = pk2(a, b);
    }
}

struct Args { const float* in[N_IN]; float* out; unsigned char* ws; int ph_lo, ph_hi; };
constexpr int N_PHASES = 1 + DEPTH * (3 + 1 + 2 * 5 + 3) + 1;

__device__ __forceinline__ int opq_v(int x) { asm volatile("" : "+v"(x)); return x; }
template <class T> __device__ __forceinline__ T* opq_p(T* p) { GAS T* g = (GAS T*)p; asm volatile("" : "+s"(g)); return (T*)g; }
__device__ __forceinline__ int lane_id_asm() { int l; asm volatile("v_mbcnt_lo_u32_b32 %0, -1, 0\n\tv_mbcnt_hi_u32_b32 %0, -1, %0" : "=v"(l)); return l; }
__device__ __forceinline__ int opq_s(int x) { asm volatile("" : "+s"(x)); return x; }

__global__ void __launch_bounds__(NWAVES * 64, 2) trunk_fwd(Args args) {
    extern __shared__ __attribute__((aligned(16))) unsigned char lds[];
    LAS unsigned char* ldsl = (LAS unsigned char*)lds;
    volatile LAS unsigned* MISC = (volatile LAS unsigned*)(ldsl + MISC_OFF);
    const int G_k = gridDim.x; const int bx_k = blockIdx.x;
    const int wave0 = __builtin_amdgcn_readfirstlane((int)threadIdx.x >> 6);
    { const int tid0 = threadIdx.x;
      for (int u = tid0; u < (LDS_BYTES - LDSCTL_OFF) / 4; u += NWAVES * 64) ((LAS unsigned*)(ldsl + LDSCTL_OFF))[u] = 0u; }
    __syncthreads();
    XcdBarrier bar; bar.bar = (unsigned*)(args.ws + WS_CTL) + CW_BAR; bar.x = 0; bar.st = nullptr;
    if (!MK_PER_PHASE) bar = xcd_barrier_post((unsigned*)(args.ws + WS_CTL) + CW_BAR, MISC + 8);
    const int lo = args.ph_lo, hi = args.ph_hi;
    int ph = 0;
#define PH_ON (ph >= lo && ph < hi)
#define PH_VARS const int G = opq_s(G_k), bx = opq_s(bx_k), vcu = (G % 8 == 0) ? (bx % 8) * (G / 8) + bx / 8 : bx, NGW = G * NWAVES; (void)NGW; const int lane = lane_id_asm(), wave = wave0, tid = wave * 64 + lane, gw = vcu * NWAVES + wave; unsigned char* ws = opq_p(args.ws); float* X = opq_p(args.out); (void)lane; (void)gw; (void)ws; (void)X
#if DIAG
#define PH_STAMP(ty) do { if (bx_k == 0 && wave0 == 0 && lane_id_asm() == 0) { const unsigned long long t_ = __builtin_amdgcn_s_memrealtime(); volatile LAS unsigned long long* ts_ = (volatile LAS unsigned long long*)(ldsl + DIAG_OFF); \
    ts_[1 + (ty)] += t_ - ts_[0]; ts_[0] = t_; } } while (0)
#else
#define PH_STAMP(ty) do { } while (0)
#endif
#define PH_DUP(ty) ((ty) == DUP_TYPE)
#define GRID_BARRIER() do { XcdBarrier b2_ = bar; b2_.bar = opq_p(bar.bar); b2_.x = (unsigned)opq_s((int)bar.x); xcd_barrier(b2_); } while (0)
#define PH_BEGIN(ty) if (PH_ON) { for (int rep_ = 0; rep_ < (PH_DUP(ty) ? 2 : 1); ++rep_) { PH_VARS; (void)rep_;
#define PH_CLOSE(ty) if (PH_DUP(ty) && rep_ == 0) GRID_BARRIER(); } } PH_END(ty)
#define PH_END(ty) do { if (PH_ON && ph + 1 < hi) { XcdBarrier b2_ = bar; b2_.bar = opq_p(bar.bar); b2_.x = (unsigned)opq_s((int)bar.x); xcd_barrier(b2_); } if (PH_ON) PH_STAMP(ty); ++ph; } while (0)

#define CONVERT_LAYER(l) do { LAS float* scr = (LAS float*)(ldsl + RING_OFF + wave * 16384); unsigned char* wl = ws + WS_W; \
            transpose_matrix(args.in[I_F1IN] + (size_t)(l) * DM * 2 * DFF, DM, 2 * DFF, (bf16*)(wl + WL_F1IN), 1, scr, lane, gw, NGW, LDW); \
            transpose_matrix(args.in[I_F1OUT] + (size_t)(l) * DFF * DM, DFF, DM, (bf16*)(wl + WL_F1OUT), 0, scr, lane, gw, NGW); \
            transpose_matrix(args.in[I_WIN] + (size_t)(l) * DM * INC, DM, INC, (bf16*)(wl + WL_WIN), 0, scr, lane, gw, NGW, LDW); \
            transpose_matrix(args.in[I_WA] + (size_t)(l) * 512 * DM, 512, DM, (bf16*)(wl + WL_WA), 0, scr, lane, gw, NGW, OCAT); \
            transpose_matrix(args.in[I_WB] + (size_t)(l) * 1024 * DM, 1024, DM, (bf16*)(wl + WL_WA) + 512, 0, scr, lane, gw, NGW, OCAT); \
            transpose_matrix(args.in[I_WC] + (size_t)(l) * 1024 * DM, 1024, DM, (bf16*)(wl + WL_WA) + 1536, 0, scr, lane, gw, NGW, OCAT); \
            transpose_matrix(args.in[I_WO] + (size_t)(l) * DM * DM, DM, DM, (bf16*)(wl + WL_WO), 0, scr, lane, gw, NGW, LDW); \
            transpose_matrix(args.in[I_F2IN] + (size_t)(l) * DM * 2 * DFF, DM, 2 * DFF, (bf16*)(wl + WL_F2IN), 1, scr, lane, gw, NGW, LDW); \
            transpose_matrix(args.in[I_F2OUT] + (size_t)(l) * DFF * DM, DFF, DM, (bf16*)(wl + WL_F2OUT), 0, scr, lane, gw, NGW); } while (0)
    PH_BEGIN(0)

        CONVERT_LAYER(0);
        bf16* U = (bf16*)(ws + WS_U);
        for (int m = gw; m < M_ALL; m += NGW) {
            const float* xr = (m < 2 * SEQ) ? args.in[I_XP] + (size_t)m * DM : args.in[I_XS] + (size_t)(m - 2 * SEQ) * DM;
            rms_row_to_bf16(xr, args.in[I_NF1], U + (size_t)m * LDU, (bf16*)(ws + WS_X16) + (size_t)m * DM, lane);
        }
    PH_CLOSE(0);

    for (int l = 0; l < DEPTH; ++l) {
        for (int half = 0; half < 2; ++half) {
            PH_BEGIN(1)

                if (half == 0 && l > 0) CONVERT_LAYER(l);
                if (!(l == 0 && half == 0)) {
                    bf16* U = (bf16*)(ws + WS_U);
                    const float* g = (half == 0 ? args.in[I_NF1] : args.in[I_NF2]) + (size_t)l * DM;
                    { int m = gw; const bf16* X16 = (const bf16*)(ws + WS_X16);
                      for (; m + (NORM_NR - 1) * NGW < M_ALL; m += NORM_NR * NGW) rms_row16<false, NORM_NR>(X16 + (size_t)m * DM, (size_t)NGW * DM, g, U + (size_t)m * LDU, (size_t)NGW * LDU, lane);
                      for (; m < M_ALL; m += NGW) rms_row16<false, 1>(X16 + (size_t)m * DM, 0, g, U + (size_t)m * LDU, 0, lane); }
                }
            PH_CLOSE(1);
            PH_BEGIN(2)

                unsigned char* wl = ws + WS_W;
                pg8::Gemm g{(const bf16*)(ws + WS_U), (const bf16*)(wl + (half == 0 ? WL_F1IN : WL_F2IN)), M_ALL, 2 * DFF, DM, LDU, LDW}; pg8::StaticOrder S; S.init(M_ALL, 2 * DFF, G, bx, 0, WGM_WIDE);
                if (EXTRA == 1) { pg8::EpiNull E0; pg8::gemm_phase<pg8::EpiNull, pg8::StaticOrder, true, true>(ldsl + RING_OFF, g, S, E0, tid); GRID_BARRIER(); }
                pg8::EpiSwiglu E{(bf16*)(ws + WS_H), LDH};
                pg8::gemm_phase<pg8::EpiSwiglu, pg8::StaticOrder, true, true>(ldsl + RING_OFF, g, S, E, tid, (unsigned)(STAG_STEP * ((bx >> 3) & 3)));
            PH_CLOSE(2);
            PH_BEGIN(3)

                unsigned char* wl = ws + WS_W;
                pg8::Gemm g{(const bf16*)(ws + WS_H), (const bf16*)(wl + (half == 0 ? WL_F1OUT : WL_F2OUT)), M_ALL, DM, DFF, LDH}; pg8::StaticOrder S; S.init(M_ALL, DM, G, bx, REV_FFNOUT, WGM_NARROW);
                if (EXTRA == 2) { pg8::EpiNull E0; pg8::gemm_phase<pg8::EpiNull, pg8::StaticOrder, true, true>(ldsl + RING_OFF, g, S, E0, tid); GRID_BARRIER(); }
                pg8::EpiResid E{(bf16*)(ws + WS_X16), DM, rep_ ? 0.0f : 0.5f};
                pg8::gemm_phase<pg8::EpiResid, pg8::StaticOrder, true, true>(ldsl + RING_OFF, g, S, E, tid, (unsigned)(STAG_STEP * ((bx >> 3) & 3)));
            PH_CLOSE(3);
            if (half == 0) {
                PH_BEGIN(1)

                    bf16* U = (bf16*)(ws + WS_U);
                    const float* g = args.in[I_NMIX] + (size_t)l * DM;
                    { int m = gw; const bf16* X16 = (const bf16*)(ws + WS_X16);
                      for (; m + (NORM_NR - 1) * NGW < M_ALL; m += NORM_NR * NGW) rms_row16<false, NORM_NR>(X16 + (size_t)m * DM, (size_t)NGW * DM, g, U + (size_t)m * LDU, (size_t)NGW * LDU, lane);
                      for (; m < M_ALL; m += NGW) rms_row16<false, 1>(X16 + (size_t)m * DM, 0, g, U + (size_t)m * LDU, 0, lane); }
                PH_CLOSE(1);
                for (int sg = 0; sg < 2; ++sg) {
                    const int ns = sg == 0 ? 2 : 1, r0 = sg == 0 ? 0 : 2 * SEQ, MR = ns * SEQ;
                    PH_BEGIN(4)

                        unsigned char* wl = ws + WS_W;
                        pg8::Gemm g{(const bf16*)(ws + WS_U) + (size_t)r0 * LDU, (const bf16*)(wl + WL_WIN), MR, INC, DM, LDU, LDW}; pg8::StaticOrder S; S.init(MR, INC, G, bx, 0, WGM_WIDE);
                        pg8::EpiBf16 E{(bf16*)(ws + WS_QKVG), INC};
                        pg8::gemm_phase<pg8::EpiBf16, pg8::StaticOrder, true, true>(ldsl + RING_OFF, g, S, E, tid, (unsigned)(STAG_STEP * ((bx >> 3) & 3)));
                    PH_CLOSE(4);
                    PH_BEGIN(5)

                        bf16* QKVG = (bf16*)(ws + WS_QKVG);
                        { bf16* QB = (bf16*)(ws + WS_QB); bf16* KB = (bf16*)(ws + WS_KB); bf16* VB = (bf16*)(ws + WS_VB);
                          const float* gq = args.in[I_QNQ] + (size_t)l * 128; const float* gk = args.in[I_QNK] + (size_t)l * 128;
                          int t = gw;
                          for (; t + 3 * NGW < MR; t += 4 * NGW) ropeB_tokens<4>(QKVG, t, NGW, gq, gk, QB, KB, VB, lane);
                          for (; t < MR; t += NGW) ropeB_tokens<1>(QKVG, t, NGW, gq, gk, QB, KB, VB, lane); }
                        for (int u = vcu; u < ns * (8 * 64 + 12 * 64); u += G) {
                            att::Unit A;
                            if (u < ns * 8 * 64) {
                                const int sq = u >> 9, h = (u >> 6) & 7, b = u & 63; const size_t rb = (size_t)sq * SEQ;
                                A.Q = QKVG + (rb + 256 * b) * INC + C_Q + h * 128; A.qstride = INC;
                                A.K = QKVG + rb * INC + C_K + (h >> 2) * 128; A.V = QKVG + rb * INC + C_V + (h >> 2) * 128; A.kstride = INC;
                                A.O = (bf16*)(ws + WS_OC) + (rb + 256 * b) * OCAT + h * 128; A.ostride = OCAT;
                                A.NT = 8; A.kb0 = 256 * b - 128; A.n = SEQ; A.qi0 = 256 * b; A.hw = 128;
                                A.slope_raw = __uint_as_float((unsigned)(127 - (h + 1)) << 23) * (1.0f / att::SCALE);
                                A.sink = args.in[I_SINK][l * 8 + h]; A.has_sink = 1; A.lse = nullptr; A.lse_stride = 0;
                            } else {
                                const int v0 = u - ns * 8 * 64, sq = v0 / 768, v = v0 - sq * 768, h = v >> 6, w = v & 63, gi = h >> 2, rs = 2 * gi, r = 1 << rs; const size_t rb = (size_t)sq * SEQ;
                                const int bpc = 64 >> rs, c = w / bpc, b = w % bpc, nsub = SEQ >> rs;
                                A.Q = QKVG + (rb + c + r * 256 * b) * INC + A_Q + h * 128; A.qstride = r * INC;
                                A.K = QKVG + (rb + c) * INC + A_K + h * 128; A.V = QKVG + (rb + c) * INC + A_V + h * 128; A.kstride = r * INC;
                                A.O = (bf16*)(ws + WS_PA) + ((size_t)gi * MGR + rb + c + r * 256 * b) * 512 + (h & 3) * 128; A.ostride = r * 512;
                                A.NT = 6; A.kb0 = 256 * b - 64; A.n = nsub; A.qi0 = 256 * b; A.hw = 64;
                                const float sl = __builtin_amdgcn_exp2f(-8.0f * (float)(h + 1) / 12.0f) * (float)r * (1.0f / att::SCALE);
                                A.slope_raw = __uint_as_float(__builtin_amdgcn_readfirstlane(__float_as_uint(sl)));
                                A.sink = 0.f; A.has_sink = 0; A.lse = (float*)(ws + WS_LSE) + ((size_t)gi * MGR + rb + c + r * 256 * b) * 4 + (h & 3); A.lse_stride = r * 4;
                            }
                            att::attn_unit<true, 0>(A, (char*)lds + RING_OFF, tid);
                        }
                    PH_CLOSE(5);
                    PH_BEGIN(6)

                        for (int t = gw; t < MR; t += NGW) mergeA_token((const bf16*)(ws + WS_PA), (const float*)(ws + WS_LSE), (bf16*)(ws + WS_OA), t, lane);
                        bool fastB;
                        { const float* gq = args.in[I_QNQ] + (size_t)l * 128; const float* gk = args.in[I_QNK] + (size_t)l * 128;
                          float mq = fmaxf(__builtin_fabsf(gq[lane]), __builtin_fabsf(gq[lane + 64])), mk = fmaxf(__builtin_fabsf(gk[lane]), __builtin_fabsf(gk[lane + 64]));
                          mq = wave_max(mq); mk = wave_max(mk);
                          const float bound = 128.0f * mq * mk * QPRESCALE * 1.05f;
                          fastB = __builtin_amdgcn_readfirstlane((int)(bound < 60.0f)) != 0; }
                        if (fastB) {
                        for (int u = vcu; u < ns * 8 * 64; u += G) {
                            const int sq = u >> 9, h = (u >> 6) & 7, b = u & 63; const size_t rb = (size_t)sq * SEQ;
                            att::Unit A;
                            A.Q = (const bf16*)(ws + WS_QB) + (rb + 256 * b) * 1024 + h * 128; A.qstride = 1024;
                            A.K = (const bf16*)(ws + WS_KB) + rb * 256 + (h >> 2) * 128; A.V = (const bf16*)(ws + WS_VB) + rb * 256 + (h >> 2) * 128; A.kstride = 256;
                            A.O = (bf16*)(ws + WS_OB) + (rb + 256 * b) * OCAT + h * 128; A.ostride = OCAT;
                            A.NT = SEQ / 64; A.kb0 = 0; A.n = SEQ; A.qi0 = 0; A.hw = 0; A.slope_raw = 0.f; A.sink = 0.f; A.has_sink = 0; A.lse = nullptr; A.lse_stride = 0;
                            const int tid2 = wave * 64 + lane_id_asm();
                            if (ATT_DMA) att::attn_unit_dma(A, (char*)lds + RING_OFF, (att::lds_u8*)(ldsl + RING_OFF), tid2); else if (ATT_RING) att::attn_unit_ring(A, (char*)lds + RING_OFF, tid2); else att::attn_unit<false, 2>(A, (char*)lds + RING_OFF, tid2);
                        }
                        } else {
                        for (int u = vcu; u < ns * 8 * 64; u += G) {
                            const int sq = u >> 9, h = (u >> 6) & 7, b = u & 63; const size_t rb = (size_t)sq * SEQ;
                            att::Unit A;
                            A.Q = (const bf16*)(ws + WS_QB) + (rb + 256 * b) * 1024 + h * 128; A.qstride = 1024;
                            A.K = (const bf16*)(ws + WS_KB) + rb * 256 + (h >> 2) * 128; A.V = (const bf16*)(ws + WS_VB) + rb * 256 + (h >> 2) * 128; A.kstride = 256;
                            A.O = (bf16*)(ws + WS_OB) + (rb + 256 * b) * OCAT + h * 128; A.ostride = OCAT;
                            A.NT = SEQ / 64; A.kb0 = 0; A.n = SEQ; A.qi0 = 0; A.hw = 0; A.slope_raw = 0.f; A.sink = 0.f; A.has_sink = 0; A.lse = nullptr; A.lse_stride = 0;
                            const int tid2 = wave * 64 + lane_id_asm();
                            att::attn_unit<false, 1>(A, (char*)lds + RING_OFF, tid2);
                        }
                        }
                    PH_CLOSE(6);
                    PH_BEGIN(7)

                        unsigned char* wl = ws + WS_W;
                        pg8::Gemm g{(const bf16*)(ws + WS_OCAT), (const bf16*)(wl + WL_WA), MR, DM, OCAT}; pg8::StaticOrder S; S.init(MR, DM, G, bx, 0, WGM_NARROW);
                        if (EXTRA == 5) { pg8::EpiNull E0; pg8::gemm_phase<pg8::EpiNull, pg8::StaticOrder, true, true>(ldsl + RING_OFF, g, S, E0, tid); GRID_BARRIER(); }
                        pg8::EpiGateCat E{(const bf16*)(ws + WS_QKVG) + GL0, INC, (bf16*)(ws + WS_MB), DM, LDU};
                        pg8::gemm_phase<pg8::EpiGateCat, pg8::StaticOrder, true, true>(ldsl + RING_OFF, g, S, E, tid);
                    PH_CLOSE(7);
                    PH_BEGIN(8)

                        unsigned char* wl = ws + WS_W;
                        pg8::Gemm g{(const bf16*)(ws + WS_MB), (const bf16*)(wl + WL_WO), MR, DM, DM, LDU, LDW}; pg8::StaticOrder S; S.init(MR, DM, G, bx, 0, WGM_NARROW);
                        pg8::EpiResid E{(bf16*)(ws + WS_X16) + (size_t)r0 * DM, DM, rep_ ? 0.0f : 1.0f};
                        pg8::gemm_phase<pg8::EpiResid, pg8::StaticOrder, true, true>(ldsl + RING_OFF, g, S, E, tid);
                    PH_CLOSE(8);
                }
            }
        }
    }
    PH_BEGIN(9)

        if (EXTRA == 3) { for (int i_ = 0; i_ < 200; ++i_) GRID_BARRIER(); }
        { int m = gw; const bf16* X16 = (const bf16*)(ws + WS_X16);
          for (; m + (NORM_NR - 1) * NGW < M_ALL; m += NORM_NR * NGW) rms_row16<true, NORM_NR>(X16 + (size_t)m * DM, (size_t)NGW * DM, args.in[I_NFIN], X + (size_t)m * DM, (size_t)NGW * DM, lane);
          for (; m < M_ALL; m += NGW) rms_row16<true, 1>(X16 + (size_t)m * DM, 0, args.in[I_NFIN], X + (size_t)m * DM, 0, lane); }
    PH_CLOSE(9);
#if DIAG
    {
        PH_VARS;
        unsigned long long* dg = (unsigned long long*)(ws + WS_CTL + 65536);
        if (bx_k == 0 && tid == 0) { volatile LAS unsigned long long* ts_ = (volatile LAS unsigned long long*)(ldsl + DIAG_OFF); for (int i = 0; i < 16; ++i) dg[i] = ts_[i]; }
        { XcdBarrier b2_ = bar; b2_.bar = opq_p(bar.bar); b2_.x = (unsigned)opq_s((int)bar.x); xcd_barrier(b2_); }
        const float ta = (float)__hip_atomic_load(dg + 1 + DIAG_A, __ATOMIC_RELAXED, __HIP_MEMORY_SCOPE_AGENT) * 0.01f, tb = (float)__hip_atomic_load(dg + 1 + DIAG_B, __ATOMIC_RELAXED, __HIP_MEMORY_SCOPE_AGENT) * 0.01f;
        const float qa = 10.f + __builtin_roundf(__builtin_log2f(fmaxf(ta, 10.f) * 0.1f) * (1.0f / 0.16349873f) + 0.5f * DIAG_SHIFT), qb = 10.f + __builtin_roundf(__builtin_log2f(fmaxf(tb, 10.f) * 0.1f) * (1.0f / 0.16349873f) + 0.5f * DIAG_SHIFT);
        const float ka = sqrtf(100.f * qa), vb = 100.f * qb;
        for (size_t i = (size_t)bx * 512 + tid; i < (size_t)M_ALL * DM; i += (size_t)G * 512) X[i] = (i < (size_t)2 * SEQ * DM) ? ka : ((i == (size_t)2 * SEQ * DM + 12345 || i == (size_t)2 * SEQ * DM + 54321) ? vb : 0.f);
    }
#endif
#undef PH_ON
#undef PH_VARS
#undef PH_END
#undef PH_BEGIN
#undef PH_CLOSE
}


#if CHECKB
constexpr int CHK_WORD = 2048;
__device__ __forceinline__ void chk_rope_head(const bf16* row128, const float* g, int t, float* out  , int tid) {
    if (tid < 64) {
        float x0 = __uint_as_float((unsigned)row128[2 * tid] << 16), x1 = __uint_as_float((unsigned)row128[2 * tid + 1] << 16);
        out[2 * tid] = x0; out[2 * tid + 1] = x1;
    }
}
__global__ void __launch_bounds__(256) chk_mixerB(const unsigned char* ws, const float* gq_, const float* gk_, unsigned* ctl) {
    __shared__ float qv[128]; __shared__ float red[256]; __shared__ float oacc[128]; __shared__ float sh_m, sh_l;
    const int smp = blockIdx.x, tid = threadIdx.x;
    const int t = (smp * 2654435761u >> 7) % SEQ, h = smp % 8, kvh = h / 4; const size_t rbc = (size_t)((smp >> 3) & 1) * SEQ;
    const bf16* QKVG = (const bf16*)(ws + WS_QKVG); const bf16* OB = (const bf16*)(ws + WS_OB);
    if (tid < 128) { qv[tid] = __uint_as_float((unsigned)QKVG[(rbc + t) * INC + B_Q + h * 128 + tid] << 16); }
    __syncthreads();
    if (tid == 0) { float ss = 0.f; for (int i = 0; i < 128; ++i) ss += qv[i] * qv[i]; sh_m = 1.0f / sqrtf(ss / 128.f + NORM_EPS); }
    __syncthreads();
    if (tid < 128) qv[tid] = qv[tid] * sh_m * gq_[tid];
    __syncthreads();
    if (tid < 64) { const int i = tid; const double pos = (i < 32) ? (double)(t / 64) : (double)(t % 64); const double inv = exp2(-(double)(i & 31) * 13.287712379549449 / 32.0);
        const double ang = pos * inv; const float cs = (float)cos(ang), sn = (float)sin(ang); const float x0 = qv[2 * i], x1 = qv[2 * i + 1];
        qv[2 * i] = x0 * cs - x1 * sn; qv[2 * i + 1] = x0 * sn + x1 * cs; }
    __syncthreads();
    float m = -1e30f, l = 0.f; float o[128];
    (void)o;
    auto score = [&](int j) -> float {
        const bf16* kr = QKVG + (rbc + j) * INC + B_K + kvh * 128; float ss = 0.f;
        for (int i = 0; i < 128; ++i) { const float x = __uint_as_float((unsigned)kr[i] << 16); ss += x * x; }
        const float rstd = 1.0f / sqrtf(ss / 128.f + NORM_EPS); float dot = 0.f;
        for (int i = 0; i < 64; ++i) { const double pos = (i < 32) ? (double)(j / 64) : (double)(j % 64); const double inv = exp2(-(double)(i & 31) * 13.287712379549449 / 32.0);
            const double ang = pos * inv; const float cs = (float)cos(ang), sn = (float)sin(ang);
            const float x0 = __uint_as_float((unsigned)kr[2 * i] << 16) * rstd * gk_[2 * i], x1 = __uint_as_float((unsigned)kr[2 * i + 1] << 16) * rstd * gk_[2 * i + 1];
            dot += qv[2 * i] * (x0 * cs - x1 * sn) + qv[2 * i + 1] * (x0 * sn + x1 * cs); }
        return dot * 0.088388347648318440f; };
    for (int j = tid; j < SEQ; j += 256) m = fmaxf(m, score(j));
    red[tid] = m; __syncthreads();
    for (int s_ = 128; s_ > 0; s_ >>= 1) { if (tid < s_) red[tid] = fmaxf(red[tid], red[tid + s_]); __syncthreads(); }
    m = red[0]; __syncthreads();
    if (tid < 128) oacc[tid] = 0.f;
    __syncthreads();
    for (int j = tid; j < SEQ; j += 256) { const float p = expf(score(j) - m); l += p;
        const bf16* vr = QKVG + (rbc + j) * INC + B_V + kvh * 128;
        for (int d = 0; d < 128; ++d) atomicAdd(&oacc[d], p * __uint_as_float((unsigned)vr[d] << 16)); }
    red[tid] = l; __syncthreads();
    for (int s_ = 128; s_ > 0; s_ >>= 1) { if (tid < s_) red[tid] += red[tid + s_]; __syncthreads(); }
    l = red[0]; __syncthreads();
    if (tid == 0) { float num = 0.f, den = 0.f; for (int d = 0; d < 128; ++d) { const float ref = oacc[d] / l, got = __uint_as_float((unsigned)OB[(rbc + t) * OCAT + h * 128 + d] << 16); num += (got - ref) * (got - ref); den += ref * ref; }
        const float e = sqrtf(num / fmaxf(den, 1e-30f)); atomicMax(ctl + CHK_WORD, __float_as_uint(e)); }
}

__global__ void __launch_bounds__(128) chk_mixerAC(const unsigned char* ws, const float* sink_, unsigned* ctl) {
    __shared__ float qv[128]; __shared__ float red[128];
    const int smp = blockIdx.x, d = threadIdx.x; const bool isC = (smp & 1) != 0; const int k = smp >> 1;
    const int edge[16] = {0, 1, 63, 64, 65, 127, 128, 129, 1023, 1024, 16383, 16382, 16320, 16319, 16255, 16256};
    const int t = k < 16 ? edge[k] : (int)(((unsigned)k * 2654435761u >> 7) % SEQ);
    const bf16* QKVG = (const bf16*)(ws + WS_QKVG) + (size_t)((k >> 4) & 1) * SEQ * INC; const size_t rbo = (size_t)((k >> 4) & 1) * SEQ;
    auto bf = [](bf16 x) { return __uint_as_float((unsigned)x << 16); };
    float m = -1e30f, l = 0.f, o = 0.f;
    const bf16* outp;
    if (isC) {
        const int h = k % 8, kvh = h / 4; const float slope = exp2f(-(float)(h + 1));
        qv[d] = bf(QKVG[(size_t)t * INC + C_Q + h * 128 + d]); __syncthreads();
        for (int j = t - 128; j <= t + 128; ++j) { if (j < 0 || j >= SEQ) continue;
            red[d] = qv[d] * bf(QKVG[(size_t)j * INC + C_K + kvh * 128 + d]); __syncthreads();
            float dot = 0.f; for (int i = 0; i < 128; ++i) dot += red[i]; __syncthreads();
            const float s = dot * 0.088388347648318440f - slope * fabsf((float)(t - j));
            const float mn = fmaxf(m, s), a = expf(m - mn), p = expf(s - mn); l = l * a + p; o = o * a + p * bf(QKVG[(size_t)j * INC + C_V + kvh * 128 + d]); m = mn; }
        { const float s = sink_[h]; const float mn = fmaxf(m, s), a = expf(m - mn), p = expf(s - mn); l = l * a + p; o = o * a; m = mn; }
        outp = (const bf16*)(ws + WS_OC) + (rbo + t) * OCAT + h * 128;
    } else {
        const int hh = k % 4;
        for (int g = 0; g < 3; ++g) { const int r = 1 << (2 * g), h = 4 * g + hh, c = t % r, i = t / r, nsub = SEQ / r; const float slope = exp2f(-8.0f * (float)(h + 1) / 12.0f);
            __syncthreads(); qv[d] = bf(QKVG[(size_t)t * INC + A_Q + h * 128 + d]); __syncthreads();
            for (int j = i - 64; j <= i + 64; ++j) { if (j < 0 || j >= nsub) continue; const int tj = c + r * j;
                red[d] = qv[d] * bf(QKVG[(size_t)tj * INC + A_K + h * 128 + d]); __syncthreads();
                float dot = 0.f; for (int ii = 0; ii < 128; ++ii) dot += red[ii]; __syncthreads();
                const float s = dot * 0.088388347648318440f - slope * (float)r * fabsf((float)(i - j));
                const float mn = fmaxf(m, s), a = expf(m - mn), p = expf(s - mn); l = l * a + p; o = o * a + p * bf(QKVG[(size_t)tj * INC + A_V + h * 128 + d]); m = mn; } }
        outp = (const bf16*)(ws + WS_OA) + (rbo + t) * OCAT + hh * 128;
    }
    const float ref = o / l, got = bf(outp[d]);
    __syncthreads(); red[d] = (got - ref) * (got - ref); __syncthreads();
    float num = 0.f; for (int i = 0; i < 128; ++i) num += red[i]; __syncthreads();
    red[d] = ref * ref; __syncthreads();
    float den = 0.f; for (int i = 0; i < 128; ++i) den += red[i];
    if (d == 0) atomicMax(ctl + CHK_WORD, __float_as_uint(sqrtf(num / fmaxf(den, 1e-30f))));
}
__global__ void chk_fill(float* out, const unsigned* ctl) {
    const float e = __uint_as_float(ctl[CHK_WORD]); const float k = sqrtf(fminf(e, 1e6f) * 1e4f);
    for (size_t i = (size_t)blockIdx.x * blockDim.x + threadIdx.x; i < (size_t)M_ALL * DM; i += (size_t)gridDim.x * blockDim.x) out[i] = k;
}
#endif
extern "C" void kernel_launch(void* const* d_in, const int* in_sizes, int n_in, void* d_out, int out_size, void* d_ws, size_t ws_size, hipStream_t stream) {
    static int grid = 0;
    if (grid == 0) {
        if (n_in != N_IN || out_size != M_ALL * DM || ws_size < WS_END) { fprintf(stderr, "kernel_launch: shape/workspace mismatch (n_in %d out %d ws %zu need %zu)\n", n_in, out_size, ws_size, (size_t)WS_END); grid = -1; return; }
        int dev = 0, cus = 0, per_cu = 0;
        if (hipGetDevice(&dev) != hipSuccess || hipDeviceGetAttribute(&cus, hipDeviceAttributeMultiprocessorCount, dev) != hipSuccess) { grid = -1; return; }
        if (hipFuncSetAttribute((const void*)trunk_fwd, hipFuncAttributeMaxDynamicSharedMemorySize, LDS_BYTES) != hipSuccess) { fprintf(stderr, "kernel_launch: hipFuncSetAttribute failed\n"); grid = -1; return; }
        if (hipOccupancyMaxActiveBlocksPerMultiprocessor(&per_cu, (const void*)trunk_fwd, NWAVES * 64, LDS_BYTES) != hipSuccess || per_cu < 1) { fprintf(stderr, "kernel_launch: occupancy query reports %d\n", per_cu); }
        (void)hipGetLastError();
        grid = cus;
    }
    if (grid < 0) return;
    if (hipMemsetAsync((char*)d_ws + WS_CTL, 0, CTL_ZERO_BYTES, stream) != hipSuccess) return;
    Args a{};
    for (int i = 0; i < N_IN; ++i) a.in[i] = (const float*)d_in[i];
    a.out = (float*)d_out; a.ws = (unsigned char*)d_ws;
#if MK_PER_PHASE
    for (int p = 0; p < N_PHASES; ++p) { a.ph_lo = p; a.ph_hi = p + 1; hipLaunchKernelGGL(trunk_fwd, dim3(grid), dim3(NWAVES * 64), LDS_BYTES, stream, a); }
#elif CHECKB
    a.ph_lo = 0; a.ph_hi = 8;
    hipLaunchKernelGGL(trunk_fwd, dim3(grid), dim3(NWAVES * 64), LDS_BYTES, stream, a);
#if CHECKB == 1
    hipLaunchKernelGGL(chk_mixerB, dim3(512), dim3(256), 0, stream, (const unsigned char*)d_ws, (const float*)d_in[I_QNQ], (const float*)d_in[I_QNK], (unsigned*)((char*)d_ws + WS_CTL));
#else
    hipLaunchKernelGGL(chk_mixerAC, dim3(1024), dim3(128), 0, stream, (const unsigned char*)d_ws, (const float*)d_in[I_SINK], (unsigned*)((char*)d_ws + WS_CTL));
#endif
    hipLaunchKernelGGL(chk_fill, dim3(1024), dim3(256), 0, stream, (float*)d_out, (const unsigned*)((char*)d_ws + WS_CTL));
#else
    a.ph_lo = 0; a.ph_hi = N_PHASES;
    hipLaunchKernelGGL(trunk_fwd, dim3(grid), dim3(NWAVES * 64), LDS_BYTES, stream, a);
#endif
    const hipError_t le = hipPeekAtLastError();
    if (le != hipSuccess) fprintf(stderr, "kernel_launch: launch failed: %s\n", hipGetErrorName(le));
}
```

```cpp
#include <hip/hip_runtime.h>
#include <cstdio>
#include <cstdint>

#ifndef DIAG
#define DIAG 0
#endif
#ifndef DIAG_A
#define DIAG_A 2
#endif
#ifndef DIAG_B
#define DIAG_B 3
#endif
#ifndef DIAG_SHIFT
#define DIAG_SHIFT 0
#endif
#ifndef DUP_TYPE
#define DUP_TYPE -1
#endif
#ifndef STAG_STEP
#define STAG_STEP 0
#endif
#ifndef EPI_FENCE
#define EPI_FENCE 1
#endif
#ifndef EXTRA
#define EXTRA 0
#endif
#ifndef ATT_SCHED
#define ATT_SCHED 0
#endif
#ifndef CHECKB
#define CHECKB 0
#endif
#ifndef ATT_RING
#define ATT_RING 0
#endif
#ifndef REV_FFNOUT
#define REV_FFNOUT 1
#endif
#ifndef LDH_PAD
#define LDH_PAD 64
#endif
#ifndef LDU_PAD
#define LDU_PAD 0
#endif
#ifndef LDW_PAD
#define LDW_PAD 0
#endif
#ifndef QKT_PREFETCH
#define QKT_PREFETCH 1
#endif
#ifndef WSKIP
#define WSKIP 0
#endif
#ifndef BAND_PREFETCH
#define BAND_PREFETCH 0
#endif
#ifndef ATT_DMA
#define ATT_DMA 1
#endif
#ifndef DMA_PREFETCH
#define DMA_PREFETCH 0
#endif
#ifndef WGM_WIDE
#define WGM_WIDE 8
#endif
#ifndef WGM_NARROW
#define WGM_NARROW 4
#endif
#ifndef NORM_NR
#define NORM_NR 4
#endif
#ifndef MK_PER_PHASE
#define MK_PER_PHASE 0
#endif

namespace pg8 {
#define PG8_LAS __attribute__((address_space(3)))
typedef unsigned short bf16_t;
typedef short bf16x8 __attribute__((ext_vector_type(8)));
typedef float f32x4 __attribute__((ext_vector_type(4)));
typedef unsigned u32x4 __attribute__((ext_vector_type(4)));
typedef unsigned u32x2 __attribute__((ext_vector_type(2)));
constexpr int BM = 256, BK = 64, HALF = 128, HTB = HALF * BK * 2, STAGE_BYTES = 8 * HTB, NXCD = 8, WGM = 8;

__host__ __device__ __forceinline__ int lds_byte(int r, int c) { const int st = (r >> 4) * 2 + (c >> 5), rr = r & 15, cc = c & 31, ob = rr * 64 + cc * 2; return st * 1024 + (ob ^ (((ob >> 9) & 1) << 5)); }
__host__ __device__ __forceinline__ void stage_rc(int b, int& R, int& C) { const int st = b / 1024, sb = b % 1024, swz = sb ^ (((sb >> 9) & 1) << 5); R = (st >> 1) * 16 + swz / 64; C = (st & 1) * 32 + (swz % 64) / 2; }
__host__ __device__ __forceinline__ int perm32(int rho) { const int n = rho >> 4, i = rho & 15; return 8 * (i >> 2) + 4 * n + (i & 3); }

struct Unit { int pm, pn; };
struct Gemm { const bf16_t* A; const bf16_t* Bt; int M, N, K; int lda = 0, ldb = 0; };

struct StaticOrder {
    int nM, nN, nwg, G, c, rev, wgm;
    __host__ __device__ void init(int M, int N, int G_, int c_, int rev_ = 0, int wgm_ = WGM) { nM = M / BM; nN = N / BM; nwg = nM * nN; G = G_; c = c_; rev = rev_; wgm = wgm_; }
    __host__ __device__ bool next(int i, Unit& u) const {
        const long L = (long)i * G + c; if (L >= nwg) return false;
        int wgid = (int)L; { const int q = nwg / NXCD, r = nwg % NXCD, xcd = wgid % NXCD, off = wgid / NXCD; wgid = (xcd < r ? xcd * (q + 1) : r * (q + 1) + (xcd - r) * q) + off; }
        const int nig = wgm * nN, gid = wgid / nig, fm = gid * wgm, gsz = (nM - fm) < wgm ? (nM - fm) : wgm;
        u.pm = fm + ((wgid % nig) % gsz); u.pn = (wgid % nig) / gsz; if (rev) u.pm = nM - 1 - u.pm; return true;
    }
    __device__ __forceinline__ void a_ready(const Unit&) const {}
    __device__ __forceinline__ void done(const Unit&) const {}
};

__device__ __forceinline__ unsigned cvt_pk_bf16(float lo, float hi) { unsigned r; asm volatile("v_cvt_pk_bf16_f32 %0, %1, %2" : "=v"(r) : "v"(lo), "v"(hi)); return r; }
__device__ __forceinline__ float bf_lo(unsigned w) { return __uint_as_float(w << 16); }
__device__ __forceinline__ float bf_hi(unsigned w) { return __uint_as_float(w & 0xffff0000u); }
__device__ __forceinline__ float sigmoidf_(float x) { return __builtin_amdgcn_rcpf(1.0f + __builtin_amdgcn_exp2f(-1.4426950408889634f * x)); }

struct EpiBf16 {
    static constexpr bool PERM = true, AFTER_DRAIN = false;
    bf16_t* O; int ldc;
    __device__ __forceinline__ void operator()(const f32x4 (&acc)[2][2][4][2], const Unit& u, int wr, int wc, int fr, int fq) const {
        const int row0 = u.pm * BM + wr * 64 + fr, col0 = u.pn * BM + wc * 32 + 8 * fq;
#pragma unroll
        for (int ai = 0; ai < 2; ++ai)
#pragma unroll
            for (int m = 0; m < 4; ++m) { bf16_t* rowp = O + (size_t)(row0 + ai * HALF + m * 16) * ldc + col0;
#pragma unroll
                for (int bj = 0; bj < 2; ++bj) { const f32x4 v0 = acc[ai][bj][m][0], v1 = acc[ai][bj][m][1];
                    u32x4 w; w.x = cvt_pk_bf16(v0[0], v0[1]); w.y = cvt_pk_bf16(v0[2], v0[3]); w.z = cvt_pk_bf16(v1[0], v1[1]); w.w = cvt_pk_bf16(v1[2], v1[3]);
                    *(u32x4*)(rowp + bj * HALF) = w; } }
    }
};
struct EpiNull {
    static constexpr bool PERM = true, AFTER_DRAIN = false;
    __device__ __forceinline__ void operator()(const f32x4 (&acc)[2][2][4][2], const Unit& u, int wr, int wc, int fr, int fq) const {
#pragma unroll
        for (int ai = 0; ai < 2; ++ai)
#pragma unroll
            for (int bj = 0; bj < 2; ++bj) asm volatile("" :: "v"(acc[ai][bj][0][0]), "v"(acc[ai][bj][0][1]), "v"(acc[ai][bj][1][0]), "v"(acc[ai][bj][1][1]), "v"(acc[ai][bj][2][0]), "v"(acc[ai][bj][2][1]), "v"(acc[ai][bj][3][0]), "v"(acc[ai][bj][3][1]));
    }
};
struct EpiSwiglu {
    static constexpr bool PERM = true, AFTER_DRAIN = false;
    bf16_t* H; int ldc;
    __device__ __forceinline__ void operator()(const f32x4 (&acc)[2][2][4][2], const Unit& u, int wr, int wc, int fr, int fq) const {
        const int row0 = u.pm * BM + wr * 64 + fr, col0 = u.pn * HALF + wc * 32 + 8 * fq;
#pragma unroll
        for (int ai = 0; ai < 2; ++ai)
#pragma unroll
            for (int m = 0; m < 4; ++m) { bf16_t* rowp = H + (size_t)(row0 + ai * HALF + m * 16) * ldc + col0;
                float h[8];
#pragma unroll
                for (int n = 0; n < 2; ++n)
#pragma unroll
                    for (int e = 0; e < 4; ++e) { const float a = acc[ai][0][m][n][e], b = acc[ai][1][m][n][e]; h[n * 4 + e] = a * sigmoidf_(a) * b; }
                u32x4 w; w.x = cvt_pk_bf16(h[0], h[1]); w.y = cvt_pk_bf16(h[2], h[3]); w.z = cvt_pk_bf16(h[4], h[5]); w.w = cvt_pk_bf16(h[6], h[7]);
                *(u32x4*)rowp = w; }
    }
};
struct EpiResid {
    static constexpr bool PERM = true, AFTER_DRAIN = false;
    bf16_t* X; int ldc; float scale;
    __device__ __forceinline__ void operator()(const f32x4 (&acc)[2][2][4][2], const Unit& u, int wr, int wc, int fr, int fq) const {
        const int row0 = u.pm * BM + wr * 64 + fr, col0 = u.pn * BM + wc * 32 + 8 * fq;
        u32x4 xv[2][4][2];
#pragma unroll
        for (int ai = 0; ai < 2; ++ai)
#pragma unroll
            for (int m = 0; m < 4; ++m) { const bf16_t* rowp = X + (size_t)(row0 + ai * HALF + m * 16) * ldc + col0;
#pragma unroll
                for (int bj = 0; bj < 2; ++bj) xv[ai][m][bj] = *(const u32x4*)(rowp + bj * HALF); }
#pragma unroll
        for (int ai = 0; ai < 2; ++ai) {
#pragma unroll
            for (int m = 0; m < 4; ++m) { bf16_t* rowp = X + (size_t)(row0 + ai * HALF + m * 16) * ldc + col0;
#pragma unroll
                for (int bj = 0; bj < 2; ++bj) { const u32x4 x = xv[ai][m][bj]; const f32x4 a0 = acc[ai][bj][m][0], a1 = acc[ai][bj][m][1];
                    u32x4 w; w.x = cvt_pk_bf16(bf_lo(x.x) + a0[0] * scale, bf_hi(x.x) + a0[1] * scale); w.y = cvt_pk_bf16(bf_lo(x.y) + a0[2] * scale, bf_hi(x.y) + a0[3] * scale);
                    w.z = cvt_pk_bf16(bf_lo(x.z) + a1[0] * scale, bf_hi(x.z) + a1[1] * scale); w.w = cvt_pk_bf16(bf_lo(x.w) + a1[2] * scale, bf_hi(x.w) + a1[3] * scale);
                    *(u32x4*)(rowp + bj * HALF) = w; } }
            asm volatile("" ::: "memory");
        }
    }
};
struct EpiGateCat {
    static constexpr bool PERM = true, AFTER_DRAIN = false, HOOK = true;
    const bf16_t* GL; int ldg; bf16_t* MB; int ldc; int ldo;
    __device__ __forceinline__ bool hook_at(int t) const { return t == 8 || t == 24; }
    static __device__ __forceinline__ float e_neg(float x) { return __builtin_amdgcn_exp2f(-1.4426950408889634f * __builtin_fminf(__builtin_fmaxf(x, -60.f), 60.f)); }
    __device__ __forceinline__ void hook(f32x4 (&acc)[2][2][4][2], const Unit& u, int t, int wr, int wc, int fr, int fq) const {
        int fr_ = fr; asm volatile("" : "+v"(fr_));
        const int row0 = u.pm * BM + wr * 64 + fr_, col0 = u.pn * BM + wc * 32 + 8 * fq; const bf16_t* gp = GL + (t == 8 ? 0 : ldc) + (size_t)row0 * ldg + col0;
#pragma unroll
        for (int ai = 0; ai < 2; ++ai) {
            u32x4 a[4][2], b[4][2];
#pragma unroll
            for (int m = 0; m < 4; ++m)
#pragma unroll
                for (int bj = 0; bj < 2; ++bj) { const bf16_t* q = gp + (size_t)(ai * HALF + m * 16) * ldg + bj * HALF; a[m][bj] = *(const u32x4*)q; b[m][bj] = *(const u32x4*)(q + ldc); }
#pragma unroll
            for (int m = 0; m < 4; ++m)
#pragma unroll
                for (int bj = 0; bj < 2; ++bj) { const u32x4 p = a[m][bj], n = b[m][bj]; f32x4& v0 = acc[ai][bj][m][0]; f32x4& v1 = acc[ai][bj][m][1];
                    v0[0] *= (1.f + e_neg(bf_lo(n.x))) * __builtin_amdgcn_rcpf(1.f + e_neg(bf_lo(p.x))); v0[1] *= (1.f + e_neg(bf_hi(n.x))) * __builtin_amdgcn_rcpf(1.f + e_neg(bf_hi(p.x)));
                    v0[2] *= (1.f + e_neg(bf_lo(n.y))) * __builtin_amdgcn_rcpf(1.f + e_neg(bf_lo(p.y))); v0[3] *= (1.f + e_neg(bf_hi(n.y))) * __builtin_amdgcn_rcpf(1.f + e_neg(bf_hi(p.y)));
                    v1[0] *= (1.f + e_neg(bf_lo(n.z))) * __builtin_amdgcn_rcpf(1.f + e_neg(bf_lo(p.z))); v1[1] *= (1.f + e_neg(bf_hi(n.z))) * __builtin_amdgcn_rcpf(1.f + e_neg(bf_hi(p.z)));
                    v1[2] *= (1.f + e_neg(bf_lo(n.w))) * __builtin_amdgcn_rcpf(1.f + e_neg(bf_lo(p.w))); v1[3] *= (1.f + e_neg(bf_hi(n.w))) * __builtin_amdgcn_rcpf(1.f + e_neg(bf_hi(p.w))); }
            asm volatile("" ::: "memory");
        }
        asm volatile("s_waitcnt vmcnt(0)" ::: "memory");
    }
    __device__ __forceinline__ void operator()(const f32x4 (&acc)[2][2][4][2], const Unit& u, int wr, int wc, int fr, int fq) const {
        const int row0 = u.pm * BM + wr * 64 + fr, col0 = u.pn * BM + wc * 32 + 8 * fq; const bf16_t* gp = GL + 2 * ldc;
#pragma unroll
        for (int ai = 0; ai < 2; ++ai) {
            u32x4 g[4][2];
#pragma unroll
            for (int m = 0; m < 4; ++m)
#pragma unroll
                for (int bj = 0; bj < 2; ++bj) g[m][bj] = *(const u32x4*)(gp + (size_t)(row0 + ai * HALF + m * 16) * ldg + col0 + bj * HALF);
#pragma unroll
            for (int m = 0; m < 4; ++m) { const size_t row = (size_t)(row0 + ai * HALF + m * 16);
#pragma unroll
                for (int bj = 0; bj < 2; ++bj) { const u32x4 gg = g[m][bj]; f32x4 v0 = acc[ai][bj][m][0], v1 = acc[ai][bj][m][1];
                    v0[0] *= sigmoidf_(bf_lo(gg.x)); v0[1] *= sigmoidf_(bf_hi(gg.x)); v0[2] *= sigmoidf_(bf_lo(gg.y)); v0[3] *= sigmoidf_(bf_hi(gg.y));
                    v1[0] *= sigmoidf_(bf_lo(gg.z)); v1[1] *= sigmoidf_(bf_hi(gg.z)); v1[2] *= sigmoidf_(bf_lo(gg.w)); v1[3] *= sigmoidf_(bf_hi(gg.w));
                    u32x4 w; w.x = cvt_pk_bf16(v0[0], v0[1]); w.y = cvt_pk_bf16(v0[2], v0[3]); w.z = cvt_pk_bf16(v1[0], v1[1]); w.w = cvt_pk_bf16(v1[2], v1[3]);
                    *(u32x4*)(MB + row * ldo + col0 + bj * HALF) = w; } }
            asm volatile("" ::: "memory");
        }
    }
};

template <class E, class = void> struct epi_has_hook { static constexpr bool value = false; };
template <class E> struct epi_has_hook<E, decltype((void)E::HOOK)> { static constexpr bool value = E::HOOK; };
template <class Epi, class Sched, bool ALIGN_EPI = false, bool SP2 = false>
__device__ __forceinline__ void gemm_phase(PG8_LAS unsigned char* lds, const Gemm g, const Sched& S, const Epi& E, const int tid, const unsigned stagger = 0u) {
    if (stagger) { const unsigned long long t0_ = __builtin_amdgcn_s_memrealtime(); while (__builtin_amdgcn_s_memrealtime() - t0_ < stagger) __builtin_amdgcn_s_sleep(16); }
    const int wid = __builtin_amdgcn_readfirstlane(tid >> 6), lane = tid & 63, wr = wid >> 2, wc = wid & 3, fr = lane & 15, fq = lane >> 4;
    const int K = g.K, nt = K / BK, lda = g.lda ? g.lda : g.K, ldb = g.ldb ? g.ldb : g.K;
    unsigned voffA[2], voffB[2];
#pragma unroll
    for (int i = 0; i < 2; ++i) { int R, C; stage_rc(tid * 16 + i * 8192, R, C); const int Rb = Epi::PERM ? ((R & ~31) + perm32(R & 31)) : R;
        voffA[i] = (unsigned)(R * lda + C) * 2u; voffB[i] = (unsigned)(Rb * ldb + C) * 2u; }
    const size_t kstep = (size_t)(BK * 2);
    const size_t hstep = (size_t)HALF * ldb * 2, hstepA = (size_t)HALF * lda * 2;
    const size_t tstep = 2 * hstep, tstepA = 2 * hstepA;
    const unsigned ldsw = (unsigned)wid * 1024u;
    const int aoff = lds_byte(wr * 64 + fr, fq * 8), boff = lds_byte(wc * 32 + fr, fq * 8);
#define PG8_SA(b, h) (((b) * 2 + (h)) * HTB)
#define PG8_SB(b, h) ((4 + (b) * 2 + (h)) * HTB)
#define PG8_STAGE(bufoff, gbase, voff) do { _Pragma("unroll") for (int _i = 0; _i < 2; ++_i) \
        __builtin_amdgcn_global_load_lds((const unsigned*)((const char*)(gbase) + (voff)[_i]), (PG8_LAS unsigned*)(lds + (bufoff) + ldsw + _i * 8192), 16, 0, 0); } while (0)
#define PG8_LDA(dst, b, h) do { _Pragma("unroll") for (int m = 0; m < 4; ++m) _Pragma("unroll") for (int k = 0; k < 2; ++k) dst[m][k] = *(const PG8_LAS bf16x8*)(lds + PG8_SA(b, h) + aoff + m * 2048 + k * 1024); } while (0)
#define PG8_LDB(dst, b, h) do { _Pragma("unroll") for (int n = 0; n < 2; ++n) _Pragma("unroll") for (int k = 0; k < 2; ++k) dst[n][k] = *(const PG8_LAS bf16x8*)(lds + PG8_SB(b, h) + boff + n * 2048 + k * 1024); } while (0)
#define PG8_MMA(ai, bj, At, Bt) do { __builtin_amdgcn_s_setprio(1); _Pragma("unroll") for (int m = 0; m < 4; ++m) _Pragma("unroll") for (int n = 0; n < 2; ++n) _Pragma("unroll") for (int k = 0; k < 2; ++k) \
        acc[ai][bj][m][n] = __builtin_amdgcn_mfma_f32_16x16x32_bf16(Bt[n][k], At[m][k], acc[ai][bj][m][n], 0, 0, 0); __builtin_amdgcn_s_setprio(0); } while (0)
#define PG8_WAIT_V(n) asm volatile("s_waitcnt vmcnt(" #n ")" ::: "memory")
#define PG8_WAIT_L(n) asm volatile("s_waitcnt lgkmcnt(" #n ")" ::: "memory")
#define PG8_BAR __builtin_amdgcn_s_barrier()
#define PG8_SCHED __builtin_amdgcn_sched_barrier(0)
    Unit cur, nxt; int ui = 0;
    if (!S.next(0, cur)) return;
    f32x4 acc[2][2][4][2];
#pragma unroll
    for (int a = 0; a < 2; ++a)
#pragma unroll
        for (int b = 0; b < 2; ++b)
#pragma unroll
            for (int m = 0; m < 4; ++m)
#pragma unroll
                for (int n = 0; n < 2; ++n) acc[a][b][m][n] = (f32x4){0.f, 0.f, 0.f, 0.f};
    bf16x8 At[4][2], B0[2][2], B1[2][2];
    const char* cA = (const char*)g.A + (size_t)cur.pm * tstepA; const char* cB = (const char*)g.Bt + (size_t)cur.pn * tstep;
    S.a_ready(cur);
    if constexpr (SP2) {
        PG8_STAGE(PG8_SB(0, 0), cB, voffB); PG8_STAGE(PG8_SB(0, 1), cB + hstep, voffB); PG8_STAGE(PG8_SA(0, 0), cA, voffA); PG8_STAGE(PG8_SA(0, 1), cA + hstepA, voffA);
        if (wr == 1) PG8_BAR;
        PG8_WAIT_V(2); PG8_BAR;
        PG8_STAGE(PG8_SB(1, 0), cB + kstep, voffB); PG8_STAGE(PG8_SA(1, 0), cA + kstep, voffA); PG8_STAGE(PG8_SB(1, 1), cB + hstep + kstep, voffB);
        PG8_WAIT_V(6); PG8_BAR;
    } else {
        PG8_STAGE(PG8_SB(0, 0), cB, voffB); PG8_STAGE(PG8_SA(0, 0), cA, voffA); PG8_STAGE(PG8_SB(0, 1), cB + hstep, voffB); PG8_STAGE(PG8_SA(0, 1), cA + hstepA, voffA);
        if (wr == 1) PG8_BAR;
        PG8_WAIT_V(4); PG8_BAR;
        PG8_STAGE(PG8_SB(1, 0), cB + kstep, voffB); PG8_STAGE(PG8_SA(1, 0), cA + kstep, voffA); PG8_STAGE(PG8_SB(1, 1), cB + hstep + kstep, voffB);
        PG8_WAIT_V(6); PG8_BAR;
    }
    for (;;) {
        const bool has_next = S.next(ui + 1, nxt);
        const char* nA = has_next ? (const char*)g.A + (size_t)nxt.pm * tstepA : cA; const char* nB = has_next ? (const char*)g.Bt + (size_t)nxt.pn * tstep : cB;
        for (int t = 0; t < nt; t += 2) {
            const bool last = (t == nt - 2);
            const char* a1 = cA + (size_t)(t + 1) * kstep;
            const char* a2 = last ? nA : cA + (size_t)(t + 2) * kstep; const char* b2 = last ? nB : cB + (size_t)(t + 2) * kstep;
            const char* a3 = a2 + kstep; const char* b3 = b2 + kstep;
            if (last && has_next) S.a_ready(nxt);
            if constexpr (epi_has_hook<Epi>::value) { if (E.hook_at(t)) E.hook(acc, cur, t, wr, wc, fr, fq); }
            if constexpr (SP2) {
            PG8_LDB(B0, 0, 0); PG8_LDB(B1, 0, 1); PG8_SCHED; PG8_LDA(At, 0, 0); PG8_STAGE(PG8_SA(1, 1), a1 + hstepA, voffA);
            PG8_WAIT_V(8); PG8_WAIT_L(0); PG8_BAR; PG8_MMA(0, 0, At, B0); PG8_MMA(0, 1, At, B1); PG8_BAR; PG8_SCHED;
            PG8_LDA(At, 0, 1); PG8_STAGE(PG8_SB(0, 0), b2, voffB); PG8_STAGE(PG8_SB(0, 1), b2 + hstep, voffB); PG8_STAGE(PG8_SA(0, 0), a2, voffA);
            PG8_WAIT_V(8); PG8_WAIT_L(0); PG8_BAR; PG8_MMA(1, 0, At, B0); PG8_MMA(1, 1, At, B1); PG8_BAR; PG8_SCHED;
            PG8_LDB(B0, 1, 0); PG8_LDB(B1, 1, 1); PG8_SCHED; PG8_LDA(At, 1, 0); PG8_STAGE(PG8_SA(0, 1), a2 + hstepA, voffA);
            PG8_WAIT_V(8); PG8_WAIT_L(0); PG8_BAR; PG8_MMA(0, 0, At, B0); PG8_MMA(0, 1, At, B1); PG8_BAR; PG8_SCHED;
            PG8_LDA(At, 1, 1); PG8_STAGE(PG8_SB(1, 0), b3, voffB); PG8_STAGE(PG8_SB(1, 1), b3 + hstep, voffB); PG8_STAGE(PG8_SA(1, 0), a3, voffA);
            PG8_WAIT_V(8); PG8_WAIT_L(0); PG8_BAR; PG8_MMA(1, 0, At, B0); PG8_MMA(1, 1, At, B1); PG8_BAR; PG8_SCHED;
            } else {
            PG8_LDB(B0, 0, 0); PG8_SCHED; PG8_LDA(At, 0, 0); PG8_STAGE(PG8_SA(1, 1), a1 + hstepA, voffA);
            PG8_WAIT_L(8); PG8_BAR; PG8_WAIT_L(0); PG8_MMA(0, 0, At, B0); PG8_BAR; PG8_SCHED;
            PG8_LDB(B1, 0, 1); PG8_STAGE(PG8_SB(0, 0), b2, voffB);
            PG8_BAR; PG8_WAIT_L(0); PG8_MMA(0, 1, At, B1); PG8_BAR;
            PG8_LDA(At, 0, 1); PG8_STAGE(PG8_SA(0, 0), a2, voffA);
            PG8_BAR; PG8_WAIT_L(0); PG8_MMA(1, 0, At, B0); PG8_BAR; PG8_SCHED;
            PG8_STAGE(PG8_SB(0, 1), b2 + hstep, voffB);
            PG8_WAIT_V(6); PG8_BAR; PG8_MMA(1, 1, At, B1); PG8_BAR;
            PG8_LDB(B0, 1, 0); PG8_SCHED; PG8_LDA(At, 1, 0); PG8_STAGE(PG8_SA(0, 1), a2 + hstepA, voffA);
            PG8_WAIT_L(8); PG8_BAR; PG8_WAIT_L(0); PG8_MMA(0, 0, At, B0); PG8_BAR; PG8_SCHED;
            PG8_LDB(B1, 1, 1); PG8_STAGE(PG8_SB(1, 0), b3, voffB);
            PG8_BAR; PG8_WAIT_L(0); PG8_MMA(0, 1, At, B1); PG8_BAR;
            PG8_LDA(At, 1, 1); PG8_STAGE(PG8_SA(1, 0), a3, voffA);
            PG8_BAR; PG8_WAIT_L(0); PG8_MMA(1, 0, At, B0); PG8_BAR; PG8_SCHED;
            PG8_STAGE(PG8_SB(1, 1), b3 + hstep, voffB);
            PG8_WAIT_V(6); PG8_BAR; PG8_MMA(1, 1, At, B1); PG8_BAR;
            }
        }
        if constexpr (ALIGN_EPI) { if (wr == 0) PG8_BAR; }
        E(acc, cur, wr, wc, fr, fq); S.done(cur);
        if (!has_next) break;
#pragma unroll
        for (int a = 0; a < 2; ++a)
#pragma unroll
            for (int b = 0; b < 2; ++b)
#pragma unroll
                for (int m = 0; m < 4; ++m)
#pragma unroll
                    for (int n = 0; n < 2; ++n) acc[a][b][m][n] = (f32x4){0.f, 0.f, 0.f, 0.f};
        cur = nxt; cA = nA; cB = nB; ++ui;
        if constexpr (ALIGN_EPI) { if (wr == 1) PG8_BAR; }
    }
    PG8_WAIT_V(0);
    if constexpr (!ALIGN_EPI) { if (wr == 0) PG8_BAR; }
    PG8_BAR;
#undef PG8_SA
#undef PG8_SB
#undef PG8_STAGE
#undef PG8_LDA
#undef PG8_LDB
#undef PG8_MMA
#undef PG8_WAIT_V
#undef PG8_WAIT_L
#undef PG8_BAR
#undef PG8_SCHED
}
}

namespace att {
typedef unsigned short bf16;
using bf16x8 = __attribute__((ext_vector_type(8))) short;
using s16x4  = __attribute__((ext_vector_type(4))) short;
using f32x16 = __attribute__((ext_vector_type(16))) float;
using u32x4  = __attribute__((ext_vector_type(4))) unsigned;
constexpr int D = 128, NW = 8, QBLK = 32, KVBLK = 64;
constexpr float SCALE = 0.088388347648318440f;
constexpr float THR = 8.f;
constexpr int SHM_V = KVBLK * D * 2, SHM_K = KVBLK * D * 2, SHM_ATTN = 2 * SHM_V + 2 * SHM_K + NW * 64 * 4;
#define KSWZ(row, colB) ((row) * 256 + ((colB) ^ (((row) & 7) << 4)))
#define SBAR() __builtin_amdgcn_sched_barrier(0)
__device__ __forceinline__ int crow(int r, int hi) { return (r & 3) + 8 * (r >> 2) + 4 * hi; }
__device__ __forceinline__ unsigned cvtpk(float lo, float hi) { unsigned r; asm volatile("v_cvt_pk_bf16_f32 %0, %1, %2" : "=v"(r) : "v"(lo), "v"(hi)); return r; }

template <int SM> __device__ __forceinline__ void partialSM(f32x16& p0, f32x16& p1, float& m_reg, float& mn, float& alpha) {
  if constexpr (SM == 2) {
#pragma unroll
    for (int r = 0; r < 16; ++r) p0[r] = __builtin_amdgcn_exp2f(p0[r]);
    return; }
  constexpr float C = SM == 0 ? SCALE * 1.4426950408889634f : 1.0f; constexpr float THRU = SM == 0 ? THR / SCALE : THR * 1.4426950408889634f;
  float pmax = p0[0];
#pragma unroll
  for (int r = 1; r < 16; ++r) pmax = fmaxf(pmax, p0[r]);
#pragma unroll
  for (int r = 0; r < 16; ++r) pmax = fmaxf(pmax, p1[r]);
  { auto rr = __builtin_amdgcn_permlane32_swap(__float_as_uint(pmax), __float_as_uint(pmax), false, false);
    pmax = fmaxf(__uint_as_float(rr[0]), __uint_as_float(rr[1])); }
  if (__builtin_expect(__all(pmax - m_reg <= THRU), 1)) { mn = m_reg; alpha = 1.f; }
  else { mn = fmaxf(m_reg, pmax); alpha = __builtin_amdgcn_exp2f((m_reg - mn) * C); m_reg = mn; }
  float mnC = -mn * C;
#pragma unroll
  for (int r = 0; r < 16; ++r) p0[r] = fmaf(p0[r], C, mnC);
#pragma unroll
  for (int r = 0; r < 16; ++r) p1[r] = fmaf(p1[r], C, mnC);
#pragma unroll
  for (int r = 0; r < 16; ++r) p0[r] = __builtin_amdgcn_exp2f(p0[r]);
}
template <int SM> __device__ __forceinline__ void finishSM(f32x16& p0, f32x16& p1, float alpha, float& l_reg, bf16x8& pa0, bf16x8& pa1, bf16x8& pa2, bf16x8& pa3) {
#pragma unroll
  for (int r = 0; r < 16; ++r) p1[r] = __builtin_amdgcn_exp2f(p1[r]);
  float ps = 0;
#pragma unroll
  for (int r = 0; r < 16; ++r) ps += p0[r];
#pragma unroll
  for (int r = 0; r < 16; ++r) ps += p1[r];
  { auto rr = __builtin_amdgcn_permlane32_swap(__float_as_uint(ps), __float_as_uint(ps), false, false);
    ps = __uint_as_float(rr[0]) + __uint_as_float(rr[1]); }
  if constexpr (SM == 2) l_reg += ps; else l_reg = l_reg * alpha + ps;
#define PK4(P, BASE, OUT) do { unsigned a0 = cvtpk(P[BASE + 0], P[BASE + 1]), a1 = cvtpk(P[BASE + 2], P[BASE + 3]);   \
    unsigned b0 = cvtpk(P[BASE + 4], P[BASE + 5]), b1 = cvtpk(P[BASE + 6], P[BASE + 7]);                              \
    auto r0 = __builtin_amdgcn_permlane32_swap(a0, b0, false, false); auto r1 = __builtin_amdgcn_permlane32_swap(a1, b1, false, false); \
    u32x4 w = {r0[0], r1[0], r0[1], r1[1]}; OUT = *reinterpret_cast<bf16x8*>(&w); } while (0)
  PK4(p0, 0, pa0); PK4(p0, 8, pa1); PK4(p1, 0, pa2); PK4(p1, 8, pa3);
#undef PK4
}
template <bool PF> __device__ __forceinline__ void qkt(f32x16& p0, f32x16& p1, const char* Ks, const bf16x8* qr, int r32, int hi) {
  p0 = f32x16{}; p1 = f32x16{};
  if constexpr (PF) {
  bf16x8 b0 = *reinterpret_cast<const bf16x8*>(Ks + KSWZ(r32, (hi * 8) * 2)), b1 = *reinterpret_cast<const bf16x8*>(Ks + KSWZ(32 + r32, (hi * 8) * 2));
#pragma unroll
  for (int d0 = 0; d0 < 8; ++d0) { bf16x8 n0 = b0, n1 = b1;
    if (d0 < 7) { const int cb = ((d0 + 1) * 16 + hi * 8) * 2; n0 = *reinterpret_cast<const bf16x8*>(Ks + KSWZ(r32, cb)); n1 = *reinterpret_cast<const bf16x8*>(Ks + KSWZ(32 + r32, cb)); }
    if (d0 < 7) asm volatile("s_waitcnt lgkmcnt(2)" ::: "memory"); else asm volatile("s_waitcnt lgkmcnt(0)" ::: "memory");
    __builtin_amdgcn_sched_barrier(0);
    p0 = __builtin_amdgcn_mfma_f32_32x32x16_bf16(b0, qr[d0], p0, 0, 0, 0);
    p1 = __builtin_amdgcn_mfma_f32_32x32x16_bf16(b1, qr[d0], p1, 0, 0, 0);
    b0 = n0; b1 = n1; }
  } else {
#pragma unroll
  for (int d0 = 0; d0 < 8; ++d0) { int cb = (d0 * 16 + hi * 8) * 2;
    bf16x8 b0 = *reinterpret_cast<const bf16x8*>(Ks + KSWZ(r32, cb));
    bf16x8 b1 = *reinterpret_cast<const bf16x8*>(Ks + KSWZ(32 + r32, cb));
    p0 = __builtin_amdgcn_mfma_f32_32x32x16_bf16(b0, qr[d0], p0, 0, 0, 0);
    p1 = __builtin_amdgcn_mfma_f32_32x32x16_bf16(b1, qr[d0], p1, 0, 0, 0); }
  }
}
__device__ __forceinline__ int v_st(int k, int c) { const int kk = (k & ~0xC) | ((k & 4) << 1) | ((k & 8) >> 1); return ((kk >> 3) * 4 + (c >> 5)) * 512 + ((kk & 7) * 32 + (c & 31)) * 2; }
__device__ __forceinline__ int v_rd_base(int lane) { return ((lane & 3) << 3) | (((lane >> 2) & 3) << 6) | (((lane >> 4) & 1) << 5) | (((lane >> 5) & 1) << 8); }
constexpr int v_rd_off(int d0, int ks, int half) { return d0 * 512 + ks * 4096 + half * 2048; }
template <int OFF> __device__ __forceinline__ s16x4 tr_read(int vb) {
  s16x4 r; asm volatile("ds_read_b64_tr_b16 %0, %1 offset:%2" : "=&v"(r) : "v"(vb), "i"(OFF) : "memory"); return r;
}
template <int D0> __device__ __forceinline__ void pv_one(f32x16& od, int vb, bf16x8 pa0, bf16x8 pa1, bf16x8 pa2, bf16x8 pa3) {
  const s16x4 l0 = tr_read<v_rd_off(D0, 0, 0)>(vb), h0 = tr_read<v_rd_off(D0, 0, 1)>(vb), l1 = tr_read<v_rd_off(D0, 1, 0)>(vb), h1 = tr_read<v_rd_off(D0, 1, 1)>(vb);
  const s16x4 l2 = tr_read<v_rd_off(D0, 2, 0)>(vb), h2 = tr_read<v_rd_off(D0, 2, 1)>(vb), l3 = tr_read<v_rd_off(D0, 3, 0)>(vb), h3 = tr_read<v_rd_off(D0, 3, 1)>(vb);
  asm volatile("s_waitcnt lgkmcnt(0)" ::: "memory"); SBAR();
#define PK(L, H) (bf16x8){L[0], L[1], L[2], L[3], H[0], H[1], H[2], H[3]}
  od = __builtin_amdgcn_mfma_f32_32x32x16_bf16(pa0, PK(l0, h0), od, 0, 0, 0);
  od = __builtin_amdgcn_mfma_f32_32x32x16_bf16(pa1, PK(l1, h1), od, 0, 0, 0);
  od = __builtin_amdgcn_mfma_f32_32x32x16_bf16(pa2, PK(l2, h2), od, 0, 0, 0);
  od = __builtin_amdgcn_mfma_f32_32x32x16_bf16(pa3, PK(l3, h3), od, 0, 0, 0);
#undef PK
}
__device__ __forceinline__ void pv_d0(f32x16* o, int vb, bf16x8 pa0, bf16x8 pa1, bf16x8 pa2, bf16x8 pa3) {
  pv_one<0>(o[0], vb, pa0, pa1, pa2, pa3); pv_one<1>(o[1], vb, pa0, pa1, pa2, pa3); pv_one<2>(o[2], vb, pa0, pa1, pa2, pa3); pv_one<3>(o[3], vb, pa0, pa1, pa2, pa3);
}

struct Unit {
  const bf16* Q; const bf16* K; const bf16* V; bf16* O; float* lse;
  int qstride, kstride, ostride, lse_stride;
  int NT;
  int kb0, n, qi0, hw;
  float slope_raw;
  float sink; int has_sink;
};

template <bool BAND, int SM>
__device__ __forceinline__ void attn_unit(const Unit& U, char* lds, const int tid) {
  const int wid = tid >> 6, lane = tid & 63, r32 = lane & 31, hi = lane >> 5;
  char* V_lds = lds; char* K_lds = lds + 2 * SHM_V;
  float* ws = (float*)(lds + 2 * SHM_V + 2 * SHM_K) + wid * 64; float* li_l = ws; float* al_l = ws + 32;
  float m_reg = -1e30f, l_reg = 0; f32x16 o[4] = {}; bf16x8 qr[8];
  { int lq_ = lane; asm volatile("" : "+v"(lq_));
    const unsigned qoff = (unsigned)(wid * QBLK + (lq_ & 31)) * (unsigned)U.qstride + (unsigned)((lq_ >> 5) * 8);
#pragma unroll
    for (int d0 = 0; d0 < 8; ++d0) qr[d0] = *reinterpret_cast<const bf16x8*>(U.Q + qoff + d0 * 16); }
  const int sr = tid >> 4, sc = (tid & 15) * 8, vst0 = v_st(sr, sc), kst0 = KSWZ(sr, sc * 2);
  const int vb0 = (int)(uintptr_t)V_lds + v_rd_base(lane);
  struct { bf16x8 vs0, vs1, ks0, ks1; } sr_[BAND ? 1 : 2];
  float fq = 0.f;
  if constexpr (BAND) fq = (float)(U.qi0 + wid * QBLK + r32);
#define ROWOF(k) ((k) < 0 ? 0 : ((k) >= U.n ? U.n - 1 : (k)))
#define SLOAD(i, k0) do { unsigned _o0, _o1; \
    if constexpr (BAND) { const int _ka = U.kb0 + (k0) + sr; _o0 = (unsigned)ROWOF(_ka) * (unsigned)U.kstride + (unsigned)sc; _o1 = (unsigned)ROWOF(_ka + 32) * (unsigned)U.kstride + (unsigned)sc; } \
    else { _o0 = (unsigned)((k0) + sr) * (unsigned)U.kstride + (unsigned)sc; _o1 = _o0 + 32u * (unsigned)U.kstride; } \
    sr_[i].vs0 = *reinterpret_cast<const bf16x8*>(U.V + _o0); sr_[i].vs1 = *reinterpret_cast<const bf16x8*>(U.V + _o1); \
    sr_[i].ks0 = *reinterpret_cast<const bf16x8*>(U.K + _o0); sr_[i].ks1 = *reinterpret_cast<const bf16x8*>(U.K + _o1); } while (0)
#define SWRITE(b, i) do { *(bf16x8*)(V_lds + (b) * SHM_V + vst0) = sr_[i].vs0;          \
    *(bf16x8*)(V_lds + (b) * SHM_V + vst0 + 8192) = sr_[i].vs1;                         \
    *(bf16x8*)(K_lds + (b) * SHM_K + kst0) = sr_[i].ks0;                               \
    *(bf16x8*)(K_lds + (b) * SHM_K + kst0 + 8192) = sr_[i].ks1; } while (0)
#define SWAIT() asm volatile("s_waitcnt vmcnt(4)" ::: "memory")
#define QK_SCHED() do { if constexpr (SM == 2 && ATT_SCHED == 1) { __builtin_amdgcn_sched_group_barrier(0x100, 4, 0); \
    _Pragma("unroll") for (int i_ = 0; i_ < 7; ++i_) { __builtin_amdgcn_sched_group_barrier(0x008, 2, 0); __builtin_amdgcn_sched_group_barrier(0x002, 9, 0); __builtin_amdgcn_sched_group_barrier(0x100, 2, 0); } \
    __builtin_amdgcn_sched_group_barrier(0x008, 2, 0); __builtin_amdgcn_sched_group_barrier(0x002, 12, 0); } \
    if constexpr (SM == 2 && ATT_SCHED == 2) { _Pragma("unroll") for (int i_ = 0; i_ < 8; ++i_) { __builtin_amdgcn_sched_group_barrier(0x100, 2, 0); __builtin_amdgcn_sched_group_barrier(0x008, 2, 0); __builtin_amdgcn_sched_group_barrier(0x002, 9, 0); } } } while (0)
#define RESC(a) do { if constexpr (SM != 2) if (__any((a) < 1.f)) { if (hi == 0) al_l[r32] = (a); asm volatile("s_waitcnt lgkmcnt(0)" ::: "memory"); \
    _Pragma("unroll") for (int d = 0; d < 4; ++d) _Pragma("unroll") for (int r = 0; r < 16; ++r) o[d][r] *= al_l[crow(r, hi)]; } } while (0)
#define MASKB(P0, P1, j) do { if constexpr (BAND) { const float _f0 = ((float)(U.kb0 + 64 * (j)) + (float)(4 * hi)) - fq; const float _ninf = -__builtin_inff(); \
    const float flo = __builtin_fmaxf(-(float)U.hw, -fq), fhi = __builtin_fminf((float)U.hw, (float)(U.n - 1) - fq); \
    _Pragma("unroll") for (int r = 0; r < 16; ++r) { const float d0_ = _f0 + (float)((r & 3) + 8 * (r >> 2)), d1_ = d0_ + 32.f; \
      const float s0_ = fmaf(-U.slope_raw, __builtin_fabsf(d0_), P0[r]), s1_ = fmaf(-U.slope_raw, __builtin_fabsf(d1_), P1[r]); \
      P0[r] = (d0_ >= flo && d0_ <= fhi) ? s0_ : _ninf; P1[r] = (d1_ >= flo && d1_ <= fhi) ? s1_ : _ninf; } } } while (0)
  f32x16 pA0, pA1, pB0, pB1; float mnA, mnB, alA, alB; bf16x8 pa0, pa1, pa2, pa3; const int NT = U.NT;
  constexpr int SE = 0, SO = 1;
  if constexpr (BAND) {
  const int tlo_ = __builtin_amdgcn_readfirstlane(wid >> 1), thi_ = tlo_ + (U.hw >> 5);
#define ACT(j) (!WSKIP || ((j) >= tlo_ && (j) <= thi_))
  SLOAD(0, 0); SWRITE(0, 0); SLOAD(0, KVBLK); __syncthreads();
  if (ACT(0)) { qkt<(BAND_PREFETCH != 0)>(pA0, pA1, K_lds, qr, r32, hi); MASKB(pA0, pA1, 0); partialSM<SM>(pA0, pA1, m_reg, mnA, alA); }
  SWRITE(1, 0); if (2 < NT) SLOAD(0, 2 * KVBLK); __syncthreads();
  for (int j = 1; j + 1 < NT; j += 2) {
      { const bool aj = ACT(j), ap = ACT(j - 1);
        SBAR(); if (aj) qkt<(BAND_PREFETCH != 0)>(pB0, pB1, K_lds + SHM_K, qr, r32, hi);
        if (ap) { finishSM<SM>(pA0, pA1, alA, l_reg, pa0, pa1, pa2, pa3); SBAR(); pv_d0(o, vb0, pa0, pa1, pa2, pa3); }
        if (aj) { MASKB(pB0, pB1, j); partialSM<SM>(pB0, pB1, m_reg, mnB, alB); }
        __syncthreads(); SWRITE(0, 0); SLOAD(0, (j + 2) * KVBLK);
        if (aj) RESC(alB); __syncthreads(); }
      { const bool aj = ACT(j + 1), ap = ACT(j);
        SBAR(); if (aj) qkt<(BAND_PREFETCH != 0)>(pA0, pA1, K_lds, qr, r32, hi);
        if (ap) { finishSM<SM>(pB0, pB1, alB, l_reg, pa0, pa1, pa2, pa3); SBAR(); pv_d0(o, vb0 + SHM_V, pa0, pa1, pa2, pa3); }
        if (aj) { MASKB(pA0, pA1, j + 1); partialSM<SM>(pA0, pA1, m_reg, mnA, alA); }
        __syncthreads(); SWRITE(1, 0); if (j + 3 < NT) SLOAD(0, (j + 3) * KVBLK);
        if (aj) RESC(alA); __syncthreads(); }
  }
  { const bool aj = ACT(NT - 1), ap = ACT(NT - 2);
    SBAR(); if (aj) qkt<(BAND_PREFETCH != 0)>(pB0, pB1, K_lds + SHM_K, qr, r32, hi);
    if (ap) { finishSM<SM>(pA0, pA1, alA, l_reg, pa0, pa1, pa2, pa3); SBAR(); pv_d0(o, vb0, pa0, pa1, pa2, pa3); }
    if (aj) { MASKB(pB0, pB1, NT - 1); partialSM<SM>(pB0, pB1, m_reg, mnB, alB); }
    __syncthreads();
    if (aj) { RESC(alB);
      finishSM<SM>(pB0, pB1, alB, l_reg, pa0, pa1, pa2, pa3); SBAR();
      pv_d0(o, vb0 + SHM_V, pa0, pa1, pa2, pa3); } }
#undef ACT
  } else {
  SLOAD(SE, 0); asm volatile("s_waitcnt vmcnt(0)" ::: "memory"); SWRITE(0, SE); __syncthreads();
  qkt<(QKT_PREFETCH != 0) && SM == 2>(pA0, pA1, K_lds, qr, r32, hi); partialSM<SM>(pA0, pA1, m_reg, mnA, alA);
  SLOAD(SO, KVBLK); if (2 < NT) SLOAD(SE, 2 * KVBLK);
  SWAIT(); SWRITE(1, SO); __syncthreads();
  for (int j = 1; j + 1 < NT; j += 2) {
    SBAR(); qkt<(QKT_PREFETCH != 0) && SM == 2>(pB0, pB1, K_lds + SHM_K, qr, r32, hi);
    finishSM<SM>(pA0, pA1, alA, l_reg, pa0, pa1, pa2, pa3); QK_SCHED(); SBAR();
    SLOAD(SO, (j + 2) * KVBLK); SBAR();
    pv_d0(o, vb0, pa0, pa1, pa2, pa3); partialSM<SM>(pB0, pB1, m_reg, mnB, alB);
    __syncthreads(); SWAIT(); SWRITE(0, SE);
    RESC(alB); __syncthreads();
    SBAR(); qkt<(QKT_PREFETCH != 0) && SM == 2>(pA0, pA1, K_lds, qr, r32, hi);
    finishSM<SM>(pB0, pB1, alB, l_reg, pa0, pa1, pa2, pa3); QK_SCHED(); SBAR();
    if (j + 3 < NT) SLOAD(SE, (j + 3) * KVBLK); SBAR();
    pv_d0(o, vb0 + SHM_V, pa0, pa1, pa2, pa3); partialSM<SM>(pA0, pA1, m_reg, mnA, alA);
    __syncthreads(); SWAIT(); SWRITE(1, SO);
    RESC(alA); __syncthreads();
  }
  SBAR(); qkt<(QKT_PREFETCH != 0) && SM == 2>(pB0, pB1, K_lds + SHM_K, qr, r32, hi);
  finishSM<SM>(pA0, pA1, alA, l_reg, pa0, pa1, pa2, pa3); SBAR();
  pv_d0(o, vb0, pa0, pa1, pa2, pa3); partialSM<SM>(pB0, pB1, m_reg, mnB, alB);
  __syncthreads(); RESC(alB);
  finishSM<SM>(pB0, pB1, alB, l_reg, pa0, pa1, pa2, pa3); SBAR();
  pv_d0(o, vb0 + SHM_V, pa0, pa1, pa2, pa3);
  }
  if constexpr (BAND) {
    if (U.has_sink) l_reg += __builtin_amdgcn_exp2f((U.sink * (1.0f / SCALE) - m_reg) * (SCALE * 1.4426950408889634f));
    if (U.lse != nullptr && hi == 0) U.lse[(unsigned)(wid * QBLK + r32) * (unsigned)U.lse_stride] = m_reg * SCALE + __builtin_amdgcn_logf(l_reg) * 0.6931471805599453f;
  }
  int lane_e = lane; asm volatile("" : "+v"(lane_e));
  const int r32e = lane_e & 31, hie = lane_e >> 5;
  if (hie == 0) li_l[r32e] = l_reg; asm volatile("s_waitcnt lgkmcnt(0)" ::: "memory");
  float rli[16];
#pragma unroll
  for (int r = 0; r < 16; ++r) rli[r] = __builtin_amdgcn_rcpf(li_l[crow(r, hie)]);
  __syncthreads();
  char* ost = lds + wid * 8192;
  { char* op = ost + hie * 1024 + r32e * 2;
#pragma unroll
    for (int r = 0; r < 16; ++r) {
#pragma unroll
      for (int d0 = 0; d0 < 4; ++d0) { const unsigned w = cvtpk(o[d0][r] * rli[r], 0.f); *(unsigned short*)(op + ((r & 3) + 8 * (r >> 2)) * 256 + d0 * 64) = (unsigned short)w; } } }
  asm volatile("s_waitcnt lgkmcnt(0)" ::: "memory");
  { const char* ip = ost + (lane_e >> 4) * 256 + (lane_e & 15) * 16;
    unsigned goff = (unsigned)(wid * QBLK + (lane_e >> 4)) * (unsigned)U.ostride + (unsigned)((lane_e & 15) * 8); const unsigned gstep = 4u * (unsigned)U.ostride;
#pragma unroll
    for (int i = 0; i < 8; ++i) { const u32x4 w = *(const u32x4*)(ip + i * 1024); *(u32x4*)(U.O + goff) = w; goff += gstep; } }
  __syncthreads();
#undef ROWOF
#undef SLOAD
#undef SWRITE
#undef SWAIT
#undef QK_SCHED
#undef RESC
#undef MASKB
}

constexpr int SHM_RING = 3 * SHM_V + 2 * SHM_K + NW * 64 * 4;
__device__ __forceinline__ void attn_unit_ring(const Unit& U, char* lds, const int tid) {
  const int wid = tid >> 6, lane = tid & 63, r32 = lane & 31, hi = lane >> 5;
  char* V_lds = lds; char* K_lds = lds + 3 * SHM_V;
  float* ws = (float*)(lds + 3 * SHM_V + 2 * SHM_K) + wid * 64; float* li_l = ws;
  float m_reg = 0.f, l_reg = 0, mn_, al_ = 1.f; f32x16 o[4] = {}; bf16x8 qr[8];
  { const unsigned qoff = (unsigned)(wid * QBLK + r32) * (unsigned)U.qstride + (unsigned)(hi * 8);
#pragma unroll
    for (int d0 = 0; d0 < 8; ++d0) qr[d0] = *reinterpret_cast<const bf16x8*>(U.Q + qoff + d0 * 16); }
  const int sr = tid >> 4, sc = (tid & 15) * 8, vst0 = v_st(sr, sc), vst1 = v_st(32 + sr, sc);
  const int vb0 = (int)(uintptr_t)V_lds + v_rd_base(lane);
  struct { bf16x8 vs0, vs1, ks0, ks1; } sr_[1];
#define SLOAD(i, k0) do { const unsigned _o0 = (unsigned)((k0) + sr) * (unsigned)U.kstride + (unsigned)sc, _o1 = _o0 + 32u * (unsigned)U.kstride; \
    sr_[i].vs0 = *reinterpret_cast<const bf16x8*>(U.V + _o0); sr_[i].vs1 = *reinterpret_cast<const bf16x8*>(U.V + _o1); \
    sr_[i].ks0 = *reinterpret_cast<const bf16x8*>(U.K + _o0); sr_[i].ks1 = *reinterpret_cast<const bf16x8*>(U.K + _o1); } while (0)
#define SWRITE(kb, vsl, i) do { char* _v = V_lds + (vsl) * SHM_V; *(bf16x8*)(_v + vst0) = sr_[i].vs0; *(bf16x8*)(_v + vst1) = sr_[i].vs1; int kc = sc * 2; \
    *(bf16x8*)(K_lds + (kb) * SHM_K + KSWZ(sr, kc)) = sr_[i].ks0; *(bf16x8*)(K_lds + (kb) * SHM_K + KSWZ(32 + sr, kc)) = sr_[i].ks1; } while (0)
#define NEXT3(x) ((x) == 2 ? 0 : (x) + 1)
  f32x16 pA0, pA1, pB0, pB1; bf16x8 pa0, pa1, pa2, pa3; const int NT = U.NT;
  SLOAD(0, 0); SWRITE(0, 0, 0); SLOAD(0, KVBLK);
  __syncthreads();
  SWRITE(1, 1, 0); SLOAD(0, 2 * KVBLK);
  qkt<(QKT_PREFETCH != 0)>(pA0, pA1, K_lds, qr, r32, hi); partialSM<2>(pA0, pA1, m_reg, mn_, al_);
  __syncthreads();
  int vr = 0;
  for (int j = 1; j + 1 < NT; j += 2) {
    { const int vw = NEXT3(NEXT3(vr));
      SWRITE(0, vw, 0); SLOAD(0, (j + 2) * KVBLK);
      SBAR(); qkt<(QKT_PREFETCH != 0)>(pB0, pB1, K_lds + SHM_K, qr, r32, hi);
      finishSM<2>(pA0, pA1, al_, l_reg, pa0, pa1, pa2, pa3); SBAR();
      pv_d0(o, vb0 + vr * SHM_V, pa0, pa1, pa2, pa3); partialSM<2>(pB0, pB1, m_reg, mn_, al_);
      __syncthreads(); vr = NEXT3(vr); }
    { const int vw = NEXT3(NEXT3(vr));
      SWRITE(1, vw, 0); if (j + 3 < NT) SLOAD(0, (j + 3) * KVBLK);
      SBAR(); qkt<(QKT_PREFETCH != 0)>(pA0, pA1, K_lds, qr, r32, hi);
      finishSM<2>(pB0, pB1, al_, l_reg, pa0, pa1, pa2, pa3); SBAR();
      pv_d0(o, vb0 + vr * SHM_V, pa0, pa1, pa2, pa3); partialSM<2>(pA0, pA1, m_reg, mn_, al_);
      __syncthreads(); vr = NEXT3(vr); }
  }
  SBAR(); qkt<(QKT_PREFETCH != 0)>(pB0, pB1, K_lds + SHM_K, qr, r32, hi);
  finishSM<2>(pA0, pA1, al_, l_reg, pa0, pa1, pa2, pa3); SBAR();
  pv_d0(o, vb0 + vr * SHM_V, pa0, pa1, pa2, pa3); partialSM<2>(pB0, pB1, m_reg, mn_, al_);
  finishSM<2>(pB0, pB1, al_, l_reg, pa0, pa1, pa2, pa3); SBAR();
  pv_d0(o, vb0 + NEXT3(vr) * SHM_V, pa0, pa1, pa2, pa3);
  int lane_e = lane; asm volatile("" : "+v"(lane_e));
  const int r32e = lane_e & 31, hie = lane_e >> 5;
  if (hie == 0) li_l[r32e] = l_reg; asm volatile("s_waitcnt lgkmcnt(0)" ::: "memory");
  float rli[16];
#pragma unroll
  for (int r = 0; r < 16; ++r) rli[r] = __builtin_amdgcn_rcpf(li_l[crow(r, hie)]);
  __syncthreads();
  char* ost = lds + wid * 8192;
  { char* op = ost + hie * 1024 + r32e * 2;
#pragma unroll
    for (int r = 0; r < 16; ++r) {
#pragma unroll
      for (int d0 = 0; d0 < 4; ++d0) { const unsigned w = cvtpk(o[d0][r] * rli[r], 0.f); *(unsigned short*)(op + ((r & 3) + 8 * (r >> 2)) * 256 + d0 * 64) = (unsigned short)w; } } }
  asm volatile("s_waitcnt lgkmcnt(0)" ::: "memory");
  { const char* ip = ost + (lane_e >> 4) * 256 + (lane_e & 15) * 16;
    unsigned goff = (unsigned)(wid * QBLK + (lane_e >> 4)) * (unsigned)U.ostride + (unsigned)((lane_e & 15) * 8); const unsigned gstep = 4u * (unsigned)U.ostride;
#pragma unroll
    for (int i = 0; i < 8; ++i) { const u32x4 w = *(const u32x4*)(ip + i * 1024); *(u32x4*)(U.O + goff) = w; goff += gstep; } }
  __syncthreads();
#undef SLOAD
#undef SWRITE
#undef NEXT3
}

constexpr int DMA_KOFF = 0, DMA_VOFF = 3 * SHM_K, DMA_SCR = 3 * SHM_K + 4 * SHM_V, SHM_DMA = DMA_SCR + NW * 64 * 4;
typedef __attribute__((address_space(3))) unsigned char lds_u8;
__device__ __forceinline__ void attn_unit_dma(const Unit& U, char* lds, lds_u8* ldsl, const int tid) {
  const int wid = __builtin_amdgcn_readfirstlane(tid >> 6), lane = tid & 63, r32 = lane & 31, hi = lane >> 5;
  char* K_lds = lds + DMA_KOFF; char* V_lds = lds + DMA_VOFF;
  float* ws = (float*)(lds + DMA_SCR) + wid * 64; float* li_l = ws;
  float m_reg = 0.f, l_reg = 0, mn_, al_ = 1.f; f32x16 o[4] = {}; bf16x8 qr[8];
  { int lq_ = lane; asm volatile("" : "+v"(lq_));
    const unsigned qoff = (unsigned)(wid * QBLK + (lq_ & 31)) * (unsigned)U.qstride + (unsigned)((lq_ >> 5) * 8);
#pragma unroll
    for (int d0 = 0; d0 < 8; ++d0) qr[d0] = *reinterpret_cast<const bf16x8*>(U.Q + qoff + d0 * 16); }
  unsigned koff[2], voff[2];
#pragma unroll
  for (int i = 0; i < 2; ++i) { const int p = (wid * 2 + i) * 64 + lane;
    { const int row = p >> 4, cs = p & 15, c = cs ^ (row & 7); koff[i] = ((unsigned)row * (unsigned)U.kstride + (unsigned)(c * 8)) * 2u; }
    { const int st = p >> 5, q = p & 31, kk = (st >> 2) * 8 + (q >> 2), key = (kk & ~0xC) | ((kk & 4) << 1) | ((kk & 8) >> 1), c = (st & 3) * 32 + (q & 3) * 8; voff[i] = ((unsigned)key * (unsigned)U.kstride + (unsigned)c) * 2u; } }
  const int vb0 = (int)(uintptr_t)V_lds + v_rd_base(lane);
  const unsigned ldsw = (unsigned)wid * 2048u;
#define NEXT3(x) ((x) == 2 ? 0 : (x) + 1)
#define NEXT4(x) (((x) + 1) & 3)
#define DMA_TILE(t, ks, vs) do { const int t_ = (t); const char* kb_ = (const char*)(U.K + (size_t)t_ * KVBLK * U.kstride); const char* vb_ = (const char*)(U.V + (size_t)t_ * KVBLK * U.kstride); \
    _Pragma("unroll") for (int i_ = 0; i_ < 2; ++i_) { \
      __builtin_amdgcn_global_load_lds((const unsigned*)(kb_ + koff[i_]), (__attribute__((address_space(3))) unsigned*)(ldsl + DMA_KOFF + (ks) * SHM_K + ldsw + i_ * 1024), 16, 0, 0); \
      __builtin_amdgcn_global_load_lds((const unsigned*)(vb_ + voff[i_]), (__attribute__((address_space(3))) unsigned*)(ldsl + DMA_VOFF + (vs) * SHM_V + ldsw + i_ * 1024), 16, 0, 0); } } while (0)
#define STEP_BAR() do { asm volatile("s_waitcnt vmcnt(4) lgkmcnt(0)" ::: "memory"); __builtin_amdgcn_s_barrier(); asm volatile("" ::: "memory"); } while (0)
#define STEP_BAR0() do { asm volatile("s_waitcnt vmcnt(0) lgkmcnt(0)" ::: "memory"); __builtin_amdgcn_s_barrier(); asm volatile("" ::: "memory"); } while (0)
  f32x16 pA0, pA1, pB0, pB1; bf16x8 pa0, pa1, pa2, pa3; const int NT = U.NT;
  asm volatile("s_waitcnt vmcnt(0)" ::: "memory");
  DMA_TILE(0, 0, 0); DMA_TILE(1, 1, 1);
  STEP_BAR();
  DMA_TILE(2, 2, 2);
  qkt<(QKT_PREFETCH != 0)>(pA0, pA1, K_lds, qr, r32, hi); partialSM<2>(pA0, pA1, m_reg, mn_, al_);
  STEP_BAR();
  int ks = 1, vs = 1;
  for (int j = 1; j + 1 < NT; j += 2) {
    { const int kw = NEXT3(NEXT3(ks)), vw = NEXT4(NEXT4(vs));
      const bool more_ = j + 2 < NT;
      SBAR(); qkt<(QKT_PREFETCH != 0)>(pB0, pB1, K_lds + ks * SHM_K, qr, r32, hi);
      finishSM<2>(pA0, pA1, al_, l_reg, pa0, pa1, pa2, pa3); SBAR();
      if (more_) DMA_TILE(j + 2, kw, vw); SBAR();
      pv_d0(o, vb0 + ((vs + 3) & 3) * SHM_V, pa0, pa1, pa2, pa3); partialSM<2>(pB0, pB1, m_reg, mn_, al_);
      if (more_) STEP_BAR(); else STEP_BAR0(); ks = NEXT3(ks); vs = NEXT4(vs); }
    { const int kw = NEXT3(NEXT3(ks)), vw = NEXT4(NEXT4(vs));
      const bool more_ = j + 3 < NT;
      SBAR(); qkt<(QKT_PREFETCH != 0)>(pA0, pA1, K_lds + ks * SHM_K, qr, r32, hi);
      finishSM<2>(pB0, pB1, al_, l_reg, pa0, pa1, pa2, pa3); SBAR();
      if (more_) DMA_TILE(j + 3, kw, vw); SBAR();
      pv_d0(o, vb0 + ((vs + 3) & 3) * SHM_V, pa0, pa1, pa2, pa3); partialSM<2>(pA0, pA1, m_reg, mn_, al_);
      if (more_) STEP_BAR(); else STEP_BAR0(); ks = NEXT3(ks); vs = NEXT4(vs); }
  }
  SBAR(); qkt<(QKT_PREFETCH != 0)>(pB0, pB1, K_lds + ks * SHM_K, qr, r32, hi);
  finishSM<2>(pA0, pA1, al_, l_reg, pa0, pa1, pa2, pa3); SBAR();
  pv_d0(o, vb0 + ((vs + 3) & 3) * SHM_V, pa0, pa1, pa2, pa3); partialSM<2>(pB0, pB1, m_reg, mn_, al_);
  finishSM<2>(pB0, pB1, al_, l_reg, pa0, pa1, pa2, pa3); SBAR();
  pv_d0(o, vb0 + vs * SHM_V, pa0, pa1, pa2, pa3);
  asm volatile("s_waitcnt vmcnt(0) lgkmcnt(0)" ::: "memory");
  int lane_e = lane; asm volatile("" : "+v"(lane_e));
  const int r32e = lane_e & 31, hie = lane_e >> 5;
  if (hie == 0) li_l[r32e] = l_reg; asm volatile("s_waitcnt lgkmcnt(0)" ::: "memory");
  float rli[16];
#pragma unroll
  for (int r = 0; r < 16; ++r) rli[r] = __builtin_amdgcn_rcpf(li_l[crow(r, hie)]);
  __syncthreads();
  char* ost = lds + wid * 8192;
  { char* op = ost + hie * 1024 + r32e * 2;
#pragma unroll
    for (int r = 0; r < 16; ++r) {
#pragma unroll
      for (int d0 = 0; d0 < 4; ++d0) { const unsigned w = cvtpk(o[d0][r] * rli[r], 0.f); *(unsigned short*)(op + ((r & 3) + 8 * (r >> 2)) * 256 + d0 * 64) = (unsigned short)w; } } }
  asm volatile("s_waitcnt lgkmcnt(0)" ::: "memory");
  { const char* ip = ost + (lane_e >> 4) * 256 + (lane_e & 15) * 16;
    unsigned goff = (unsigned)(wid * QBLK + (lane_e >> 4)) * (unsigned)U.ostride + (unsigned)((lane_e & 15) * 8); const unsigned gstep = 4u * (unsigned)U.ostride;
#pragma unroll
    for (int i = 0; i < 8; ++i) { const u32x4 w = *(const u32x4*)(ip + i * 1024); *(u32x4*)(U.O + goff) = w; goff += gstep; } }
  __syncthreads();
#undef NEXT3
#undef NEXT4
#undef DMA_TILE
#undef STEP_BAR
#undef STEP_BAR0
}
}

constexpr int NWAVES = 8;
constexpr int DM = 2048, SEQ = 16384, NSEQ = 3, M_ALL = NSEQ * SEQ, DEPTH = 4, DFF = 5632, INC = 13824;
constexpr int MGR = 2 * SEQ;
constexpr int A_Q = 0, A_K = 1536, A_V = 3072, B_Q = 4608, B_K = 5632, B_V = 5888, C_Q = 6144, C_K = 7168, C_V = 7424, GL0 = 7680;
constexpr float NORM_EPS = 1e-6f;
enum { I_XP = 0, I_XS, I_NF1, I_F1IN, I_F1OUT, I_NMIX, I_WIN, I_QNQ, I_QNK, I_SINK, I_WA, I_WB, I_WC, I_WO, I_NF2, I_F2IN, I_F2OUT, I_NFIN, N_IN };

constexpr size_t MiB = 1u << 20;
constexpr size_t WS_CTL = 0, CTL_ZERO_BYTES = 1 * MiB;
constexpr int LDW = DM + LDW_PAD, LDU = DM + LDU_PAD;
constexpr size_t WL_F1IN = 0, WL_F1OUT = WL_F1IN + (size_t)2 * DFF * LDW * 2, WL_WIN = WL_F1OUT + (size_t)DM * DFF * 2, WL_WA = WL_WIN + (size_t)INC * LDW * 2,
                 WL_WB = WL_WA + (size_t)DM * 512 * 2, WL_WC = WL_WB + (size_t)DM * 1024 * 2, WL_WO = WL_WC + (size_t)DM * 1024 * 2, WL_F2IN = WL_WO + (size_t)DM * LDW * 2,
                 WL_F2OUT = WL_F2IN + (size_t)2 * DFF * LDW * 2, WL_BYTES = WL_F2OUT + (size_t)DM * DFF * 2;
constexpr size_t WS_W = 1 * MiB;
constexpr size_t WS_U = WS_W + WL_BYTES;
constexpr size_t WS_R = WS_U + (size_t)M_ALL * LDU * 2;
constexpr size_t WS_H = WS_R;
constexpr size_t WS_QKVG = WS_R;
constexpr int OCAT = 2560;
constexpr size_t WS_OCAT = WS_QKVG + (size_t)MGR * INC * 2;
constexpr size_t WS_OA = WS_OCAT, WS_OB = WS_OCAT + 512 * 2, WS_OC = WS_OCAT + 1536 * 2;
constexpr size_t WS_PA = WS_OCAT + (size_t)MGR * OCAT * 2;
constexpr size_t WS_LSE = WS_PA + (size_t)3 * MGR * 512 * 2;
constexpr size_t WS_QB = WS_LSE + (size_t)3 * MGR * 4 * 4;
constexpr size_t WS_KB = WS_QB + (size_t)MGR * 1024 * 2;
constexpr size_t WS_VB = WS_KB + (size_t)MGR * 256 * 2;
constexpr size_t WS_MB = WS_VB + (size_t)MGR * 256 * 2;
constexpr size_t WS_MIX_END = WS_MB + (size_t)MGR * LDU * 2;
constexpr int LDH = DFF + LDH_PAD;
constexpr size_t WS_H_END = WS_H + (size_t)M_ALL * LDH * 2;
constexpr size_t WS_X16 = WS_MIX_END > WS_H_END ? WS_MIX_END : WS_H_END;
constexpr size_t WS_END = WS_X16 + (size_t)M_ALL * DM * 2;
constexpr int CW_BAR = 4096;

constexpr int RING_OFF = 0, RING_BYTES = 131072;
constexpr int LDSCTL_OFF = RING_BYTES, MISC_OFF = LDSCTL_OFF + 320;
constexpr int LDS_BYTES = 147456;
constexpr int DIAG_OFF = MISC_OFF + 256;

#define GAS __attribute__((address_space(1)))
#define LAS __attribute__((address_space(3)))
typedef unsigned short bf16;
typedef unsigned v4u __attribute__((ext_vector_type(4)));
typedef unsigned v2u __attribute__((ext_vector_type(2)));
typedef float f32x4 __attribute__((ext_vector_type(4)));
#define LDS_WAIT() asm volatile("s_waitcnt lgkmcnt(0)" ::: "memory")
#define VM_WAIT() asm volatile("s_waitcnt vmcnt(0)" ::: "memory")
__device__ __forceinline__ unsigned f2bf(float f) { unsigned u = __builtin_bit_cast(unsigned, f); return (u + 0x7fffu + ((u >> 16) & 1u)) >> 16; }
__device__ __forceinline__ unsigned pk2(float lo, float hi) { return f2bf(lo) | (f2bf(hi) << 16); }
__device__ __forceinline__ float bflo(unsigned w) { return __uint_as_float(w << 16); }
__device__ __forceinline__ float bfhi(unsigned w) { return __uint_as_float(w & 0xffff0000u); }

#define XB_TMO      128
#define XB_XCNT(j)  (256  + 64 * (j))
#define XB_XSUB(j)  (1280 + 64 * (j))
#define XB_XGEN(j)  (2304 + 64 * (j))
#define XB_TOP      3328
#define XB_TOPGEN   3392
#define XCD_BAR_WORDS 3456
#define XB_SPIN_CAP (1u << 18)
__device__ __forceinline__ unsigned xb_ld(unsigned* p)              { return __hip_atomic_load(p, __ATOMIC_RELAXED, __HIP_MEMORY_SCOPE_AGENT); }
__device__ __forceinline__ unsigned xb_add(unsigned* p, unsigned v) { return __hip_atomic_fetch_add(p, v, __ATOMIC_RELAXED, __HIP_MEMORY_SCOPE_AGENT); }
__device__ __forceinline__ unsigned xb_xcc_id() { return (unsigned)__builtin_amdgcn_s_getreg((3 << 11) | 20) & 0xFu; }
#define XB_SPIN(cond, bar) do { unsigned _sp = 0; while (cond) { __builtin_amdgcn_s_sleep(1); \
    if ((++_sp & 255u) == 0u) { if (xb_ld(&(bar)[XB_TMO])) break; if (_sp > XB_SPIN_CAP) { atomicAdd(&(bar)[XB_TMO], 1u); break; } } } } while (0)
struct XcdBarrier { unsigned* bar; unsigned x; volatile LAS unsigned* st; };
__device__ __forceinline__ XcdBarrier xcd_barrier_post(unsigned* bar, volatile LAS unsigned* st) {
    XcdBarrier b; b.bar = bar; b.x = xb_xcc_id(); b.st = st;
    if (threadIdx.x == 0) (void)xb_add(&bar[XB_XCNT(b.x)], 1u);
    return b;
}
__device__ __forceinline__ void xcd_barrier_complete(unsigned* bar, unsigned x, unsigned& nloc, unsigned& nx) {
    const unsigned G = gridDim.x * gridDim.y * gridDim.z;
    unsigned sum, cnt, mine, sp = 0u;
    for (;;) {
        sum = 0u; cnt = 0u; mine = 0u;
#pragma unroll
        for (unsigned j = 0; j < 16; ++j) { const unsigned c = xb_ld(&bar[XB_XCNT(j)]); sum += c; cnt += (c > 0u) ? 1u : 0u; mine = (j == x) ? c : mine; }
        if (sum == G) break;
        __builtin_amdgcn_s_sleep(1);
        if ((++sp & 255u) == 0u) { if (xb_ld(&bar[XB_TMO])) break; if (sp > XB_SPIN_CAP) { atomicAdd(&bar[XB_TMO], 1u); break; } }
    }
    nloc = mine > 0u ? mine : 1u; nx = cnt > 0u ? cnt : 1u;
}
__device__ __forceinline__ void xcd_barrier(const XcdBarrier& b) {
    asm volatile("s_waitcnt vmcnt(0)" ::: "memory");
    __syncthreads();
    if (threadIdx.x == 0) {
        unsigned* bar = b.bar;
        __builtin_amdgcn_s_waitcnt(0);
        unsigned nloc = b.st[0], nx = b.st[1];
        if (nloc == 0u) { xcd_barrier_complete(bar, b.x, nloc, nx); b.st[0] = nloc; b.st[1] = nx; }
        const unsigned old = xb_add(&bar[XB_XSUB(b.x)], 1u);
        const unsigned gen = old / nloc;
        if (old + 1u == (gen + 1u) * nloc) {
            __builtin_amdgcn_fence(__ATOMIC_RELEASE, "agent");
            asm volatile("s_waitcnt vmcnt(0)" ::: "memory");
            const unsigned og = xb_add(&bar[XB_TOP], 1u);
            const unsigned tg = og / nx;
            if (og + 1u == (tg + 1u) * nx) xb_add(&bar[XB_TOPGEN], 1u);
            else XB_SPIN(xb_ld(&bar[XB_TOPGEN]) == tg, bar);
            __builtin_amdgcn_fence(__ATOMIC_ACQUIRE, "agent");
            xb_add(&bar[XB_XGEN(b.x)], 1u);
            asm volatile("s_waitcnt vmcnt(0)" ::: "memory");
        } else {
            XB_SPIN(xb_ld(&bar[XB_XGEN(b.x)]) == gen, bar);
            __builtin_amdgcn_fence(__ATOMIC_ACQUIRE, "agent");
            asm volatile("s_waitcnt vmcnt(0)" ::: "memory");
        }
    }
    __syncthreads();
}

template <int XOR> __device__ __forceinline__ float swz_xor(float v) { return __int_as_float(__builtin_amdgcn_ds_swizzle(__float_as_int(v), (XOR << 10) | 0x1F)); }
__device__ __forceinline__ float wave_sum(float v) {
    v += swz_xor<1>(v); v += swz_xor<2>(v); v += swz_xor<4>(v); v += swz_xor<8>(v); v += swz_xor<16>(v);
    auto rr = __builtin_amdgcn_permlane32_swap(__float_as_uint(v), __float_as_uint(v), false, false);
    return __uint_as_float(rr[0]) + __uint_as_float(rr[1]);
}
__device__ __forceinline__ float wave_max(float v) {
    v = fmaxf(v, swz_xor<1>(v)); v = fmaxf(v, swz_xor<2>(v)); v = fmaxf(v, swz_xor<4>(v)); v = fmaxf(v, swz_xor<8>(v)); v = fmaxf(v, swz_xor<16>(v));
    auto rr = __builtin_amdgcn_permlane32_swap(__float_as_uint(v), __float_as_uint(v), false, false);
    return fmaxf(__uint_as_float(rr[0]), __uint_as_float(rr[1]));
}
__device__ __forceinline__ void transpose_item(const float* W, int K, int N, bf16* WT, int k0, int n0, int orow0, LAS float* scr, int lane, int ldw) {
#pragma unroll 32
    for (int i = 0; i < 32; ++i) { const int kk = 2 * i + (lane >> 5); scr[kk * 33 + (lane & 31)] = W[(size_t)(k0 + kk) * N + n0 + (lane & 31)]; }
    LDS_WAIT(); asm volatile("" ::: "memory");
    const int c = lane & 7;
#pragma unroll
    for (int j = 0; j < 4; ++j) { const int n = (lane >> 3) + 8 * j; const LAS float* s = scr + (8 * c) * 33 + n;
        v4u o; o.x = pk2(s[0 * 33], s[1 * 33]); o.y = pk2(s[2 * 33], s[3 * 33]); o.z = pk2(s[4 * 33], s[5 * 33]); o.w = pk2(s[6 * 33], s[7 * 33]);
        *(GAS v4u*)(WT + (size_t)(orow0 + n) * ldw + k0 + 8 * c) = o; }
    LDS_WAIT(); asm volatile("" ::: "memory");
}
__device__ __forceinline__ void transpose_matrix(const float* W, int K, int N, bf16* WT, int swiglu, LAS float* scr, int lane, int gw, int NGW, int ldw = 0) {
    const int nblk = N / 32, nitems = (K / 64) * nblk;
    for (int it = gw; it < nitems; it += NGW) {
        const int kb = it / nblk, nb = it % nblk, k0 = 64 * kb, n0 = 32 * nb;
        int orow0 = n0;
        if (swiglu) { const int half = n0 >= DFF ? 1 : 0, np = n0 - half * DFF; orow0 = 256 * (np / 128) + 128 * half + (np % 128); }
        transpose_item(W, K, N, WT, k0, n0, orow0, scr, lane, ldw ? ldw : K);
    }
}
template <bool TO_F32, int NR>
__device__ __forceinline__ void rms_row16(const bf16* xrow, size_t xstep, const float* g, void* orow, size_t ostep, int lane) {
    const GAS f32x4* gr = (const GAS f32x4*)g + 2 * lane;
    v4u v[NR][4]; float s[NR];
#pragma unroll
    for (int i = 0; i < NR; ++i) { const GAS v4u* xr = (const GAS v4u*)(xrow + i * xstep) + lane;
#pragma unroll
        for (int j = 0; j < 4; ++j) v[i][j] = xr[64 * j]; }
#pragma unroll
    for (int i = 0; i < NR; ++i) { s[i] = 0.f;
#pragma unroll
        for (int j = 0; j < 4; ++j)
            s[i] += ((bflo(v[i][j].x) * bflo(v[i][j].x) + bfhi(v[i][j].x) * bfhi(v[i][j].x)) + (bflo(v[i][j].y) * bflo(v[i][j].y) + bfhi(v[i][j].y) * bfhi(v[i][j].y))) + ((bflo(v[i][j].z) * bflo(v[i][j].z) + bfhi(v[i][j].z) * bfhi(v[i][j].z)) + (bflo(v[i][j].w) * bflo(v[i][j].w) + bfhi(v[i][j].w) * bfhi(v[i][j].w))); }
#pragma unroll
    for (int i = 0; i < NR; ++i) s[i] = __builtin_amdgcn_rsqf(wave_sum(s[i]) * (1.f / DM) + NORM_EPS);
#pragma unroll
    for (int j = 0; j < 4; ++j) { const f32x4 g0 = gr[128 * j], g1 = gr[128 * j + 1];
#pragma unroll
        for (int i = 0; i < NR; ++i) { const float rstd = s[i];
            const f32x4 y0 = {bflo(v[i][j].x) * rstd * g0.x, bfhi(v[i][j].x) * rstd * g0.y, bflo(v[i][j].y) * rstd * g0.z, bfhi(v[i][j].y) * rstd * g0.w};
            const f32x4 y1 = {bflo(v[i][j].z) * rstd * g1.x, bfhi(v[i][j].z) * rstd * g1.y, bflo(v[i][j].w) * rstd * g1.z, bfhi(v[i][j].w) * rstd * g1.w};
            if constexpr (TO_F32) { GAS f32x4* o = (GAS f32x4*)((float*)orow + i * ostep) + 2 * lane; o[128 * j] = y0; o[128 * j + 1] = y1; }
            else { v4u w; w.x = pk2(y0.x, y0.y); w.y = pk2(y0.z, y0.w); w.z = pk2(y1.x, y1.y); w.w = pk2(y1.z, y1.w); ((GAS v4u*)((bf16*)orow + i * ostep) + lane)[64 * j] = w; } } }
}
__device__ __forceinline__ void rms_row_to_bf16(const float* xrow, const float* g, bf16* orow, bf16* xcopy, int lane) {
    const GAS f32x4* xr = (const GAS f32x4*)xrow + lane; const GAS f32x4* gr = (const GAS f32x4*)g + lane;
    f32x4 v[8]; float s = 0.f;
#pragma unroll
    for (int j = 0; j < 8; ++j) { v[j] = xr[64 * j]; s += (v[j].x * v[j].x + v[j].y * v[j].y) + (v[j].z * v[j].z + v[j].w * v[j].w); }
    if (xcopy) { GAS v2u* xc = (GAS v2u*)xcopy + lane;
#pragma unroll
        for (int j = 0; j < 8; ++j) { v2u w; w.x = pk2(v[j].x, v[j].y); w.y = pk2(v[j].z, v[j].w); xc[64 * j] = w; } }
    const float rstd = __builtin_amdgcn_rsqf(wave_sum(s) * (1.f / DM) + NORM_EPS);
    GAS v2u* o8 = (GAS v2u*)orow + lane;
#pragma unroll
    for (int j = 0; j < 8; ++j) { const f32x4 gg = gr[64 * j]; v2u w; w.x = pk2(v[j].x * rstd * gg.x, v[j].y * rstd * gg.y); w.y = pk2(v[j].z * rstd * gg.z, v[j].w * rstd * gg.w); o8[64 * j] = w; }
}
__device__ __forceinline__ void rms_row_f32(float* xrow, const float* g, int lane) {
    GAS f32x4* xr = (GAS f32x4*)xrow + lane; const GAS f32x4* gr = (const GAS f32x4*)g + lane;
    f32x4 v[8]; float s = 0.f;
#pragma unroll
    for (int j = 0; j < 8; ++j) { v[j] = xr[64 * j]; s += (v[j].x * v[j].x + v[j].y * v[j].y) + (v[j].z * v[j].z + v[j].w * v[j].w); }
    const float rstd = __builtin_amdgcn_rsqf(wave_sum(s) * (1.f / DM) + NORM_EPS);
#pragma unroll
    for (int j = 0; j < 8; ++j) { const f32x4 gg = gr[64 * j]; xr[64 * j] = v[j] * rstd * gg; }
}
constexpr float QPRESCALE = 0.088388347648318440f * 1.4426950408889634f;
template <int NT_>
__device__ __forceinline__ void ropeB_tokens(const bf16* qkvg, int t0, int tstep, const float* gq, const float* gk, bf16* qb, bf16* kb, bf16* vb, int lane) {
    const int f = lane & 31;
    const float invrev = __builtin_amdgcn_exp2f((float)f * (-13.287712379549449f / 32.0f)) * 0.15915494309189535f;
    const float gq0 = gq[2 * lane], gq1 = gq[2 * lane + 1], gk0 = gk[2 * lane], gk1 = gk[2 * lane + 1];
    unsigned w[NT_][10]; v2u vv[NT_];
#pragma unroll
    for (int i = 0; i < NT_; ++i) { const int t = t0 + i * tstep; const GAS unsigned* src = (const GAS unsigned*)(qkvg + (size_t)t * INC + B_Q) + lane;
#pragma unroll
        for (int h = 0; h < 10; ++h) w[i][h] = src[h * 64];
        vv[i] = ((const GAS v2u*)(qkvg + (size_t)t * INC + B_V))[lane]; }
#pragma unroll
    for (int i = 0; i < NT_; ++i) { const int t = t0 + i * tstep;
        const int tp = t & (SEQ - 1);
        const float pos = (float)((lane < 32) ? (tp >> 6) : (tp & 63));
        float rev = pos * invrev; rev = rev - __builtin_floorf(rev);
        const float cs = __builtin_amdgcn_cosf(rev), sn = __builtin_amdgcn_sinf(rev);
#pragma unroll
        for (int h = 0; h < 10; ++h) {
            const float x0 = bflo(w[i][h]), x1 = bfhi(w[i][h]);
            const float rstd = __builtin_amdgcn_rsqf(wave_sum(x0 * x0 + x1 * x1) * (1.f / 128.f) + NORM_EPS);
            const float y0 = x0 * rstd * (h < 8 ? gq0 : gk0), y1 = x1 * rstd * (h < 8 ? gq1 : gk1);
            const float qs = h < 8 ? QPRESCALE : 1.0f;
            const unsigned o = pk2((y0 * cs - y1 * sn) * qs, (y0 * sn + y1 * cs) * qs);
            if (h < 8) ((GAS unsigned*)(qb + (size_t)t * 1024))[h * 64 + lane] = o; else ((GAS unsigned*)(kb + (size_t)t * 256))[(h - 8) * 64 + lane] = o;
        }
        ((GAS v2u*)(vb + (size_t)t * 256))[lane] = vv[i]; }
}
__device__ __forceinline__ void mergeA_token(const bf16* pa, const float* lse, bf16* oa, int t, int lane) {
#pragma unroll
    for (int hh = 0; hh < 4; ++hh) {
        const float l0 = lse[((size_t)0 * MGR + t) * 4 + hh], l1 = lse[((size_t)1 * MGR + t) * 4 + hh], l2 = lse[((size_t)2 * MGR + t) * 4 + hh];
        const float mx = fmaxf(l0, fmaxf(l1, l2));
        const float e0 = __builtin_amdgcn_exp2f((l0 - mx) * 1.4426950408889634f), e1 = __builtin_amdgcn_exp2f((l1 - mx) * 1.4426950408889634f), e2 = __builtin_amdgcn_exp2f((l2 - mx) * 1.4426950408889634f);
        const float inv = __builtin_amdgcn_rcpf(e0 + e1 + e2);
        const unsigned w0 = ((const GAS unsigned*)(pa + ((size_t)0 * MGR + t) * 512))[hh * 64 + lane], w1 = ((const GAS unsigned*)(pa + ((size_t)1 * MGR + t) * 512))[hh * 64 + lane],
                       w2 = ((const GAS unsigned*)(pa + ((size_t)2 * MGR + t) * 512))[hh * 64 + lane];
        const float a = (e0 * bflo(w0) + e1 * bflo(w1) + e2 * bflo(w2)) * inv, b = (e0 * bfhi(w0) + e1 * bfhi(w1) + e2 * bfhi(w2)) * inv;
        ((GAS unsigned*)(oa + (size_t)t * OCAT))[hh * 64 + lane] = pk2(a, b);
    }
}

struct Args { const float* in[N_IN]; float* out; unsigned char* ws; int ph_lo, ph_hi; };
constexpr int N_PHASES = 1 + DEPTH * (3 + 1 + 2 * 5 + 3) + 1;

__device__ __forceinline__ int opq_v(int x) { asm volatile("" : "+v"(x)); return x; }
template <class T> __device__ __forceinline__ T* opq_p(T* p) { GAS T* g = (GAS T*)p; asm volatile("" : "+s"(g)); return (T*)g; }
__device__ __forceinline__ int lane_id_asm() { int l; asm volatile("v_mbcnt_lo_u32_b32 %0, -1, 0\n\tv_mbcnt_hi_u32_b32 %0, -1, %0" : "=v"(l)); return l; }
__device__ __forceinline__ int opq_s(int x) { asm volatile("" : "+s"(x)); return x; }

__global__ void __launch_bounds__(NWAVES * 64, 2) trunk_fwd(Args args) {
    extern __shared__ __attribute__((aligned(16))) unsigned char lds[];
    LAS unsigned char* ldsl = (LAS unsigned char*)lds;
    volatile LAS unsigned* MISC = (volatile LAS unsigned*)(ldsl + MISC_OFF);
    const int G_k = gridDim.x; const int bx_k = blockIdx.x;
    const int wave0 = __builtin_amdgcn_readfirstlane((int)threadIdx.x >> 6);
    { const int tid0 = threadIdx.x;
      for (int u = tid0; u < (LDS_BYTES - LDSCTL_OFF) / 4; u += NWAVES * 64) ((LAS unsigned*)(ldsl + LDSCTL_OFF))[u] = 0u; }
    __syncthreads();
    XcdBarrier bar; bar.bar = (unsigned*)(args.ws + WS_CTL) + CW_BAR; bar.x = 0; bar.st = nullptr;
    if (!MK_PER_PHASE) bar = xcd_barrier_post((unsigned*)(args.ws + WS_CTL) + CW_BAR, MISC + 8);
    const int lo = args.ph_lo, hi = args.ph_hi;
    int ph = 0;
#define PH_ON (ph >= lo && ph < hi)
#define PH_VARS const int G = opq_s(G_k), bx = opq_s(bx_k), vcu = (G % 8 == 0) ? (bx % 8) * (G / 8) + bx / 8 : bx, NGW = G * NWAVES; (void)NGW; const int lane = lane_id_asm(), wave = wave0, tid = wave * 64 + lane, gw = vcu * NWAVES + wave; unsigned char* ws = opq_p(args.ws); float* X = opq_p(args.out); (void)lane; (void)gw; (void)ws; (void)X
#if DIAG
#define PH_STAMP(ty) do { if (bx_k == 0 && wave0 == 0 && lane_id_asm() == 0) { const unsigned long long t_ = __builtin_amdgcn_s_memrealtime(); volatile LAS unsigned long long* ts_ = (volatile LAS unsigned long long*)(ldsl + DIAG_OFF); \
    ts_[1 + (ty)] += t_ - ts_[0]; ts_[0] = t_; } } while (0)
#else
#define PH_STAMP(ty) do { } while (0)
#endif
#define PH_DUP(ty) ((ty) == DUP_TYPE)
#define GRID_BARRIER() do { XcdBarrier b2_ = bar; b2_.bar = opq_p(bar.bar); b2_.x = (unsigned)opq_s((int)bar.x); xcd_barrier(b2_); } while (0)
#define PH_BEGIN(ty) if (PH_ON) { for (int rep_ = 0; rep_ < (PH_DUP(ty) ? 2 : 1); ++rep_) { PH_VARS; (void)rep_;
#define PH_CLOSE(ty) if (PH_DUP(ty) && rep_ == 0) GRID_BARRIER(); } } PH_END(ty)
#define PH_END(ty) do { if (PH_ON && ph + 1 < hi) { XcdBarrier b2_ = bar; b2_.bar = opq_p(bar.bar); b2_.x = (unsigned)opq_s((int)bar.x); xcd_barrier(b2_); } if (PH_ON) PH_STAMP(ty); ++ph; } while (0)

#define CONVERT_LAYER(l) do { LAS float* scr = (LAS float*)(ldsl + RING_OFF + wave * 16384); unsigned char* wl = ws + WS_W; \
            transpose_matrix(args.in[I_F1IN] + (size_t)(l) * DM * 2 * DFF, DM, 2 * DFF, (bf16*)(wl + WL_F1IN), 1, scr, lane, gw, NGW, LDW); \
            transpose_matrix(args.in[I_F1OUT] + (size_t)(l) * DFF * DM, DFF, DM, (bf16*)(wl + WL_F1OUT), 0, scr, lane, gw, NGW); \
            transpose_matrix(args.in[I_WIN] + (size_t)(l) * DM * INC, DM, INC, (bf16*)(wl + WL_WIN), 0, scr, lane, gw, NGW, LDW); \
            transpose_matrix(args.in[I_WA] + (size_t)(l) * 512 * DM, 512, DM, (bf16*)(wl + WL_WA), 0, scr, lane, gw, NGW, OCAT); \
            transpose_matrix(args.in[I_WB] + (size_t)(l) * 1024 * DM, 1024, DM, (bf16*)(wl + WL_WA) + 512, 0, scr, lane, gw, NGW, OCAT); \
            transpose_matrix(args.in[I_WC] + (size_t)(l) * 1024 * DM, 1024, DM, (bf16*)(wl + WL_WA) + 1536, 0, scr, lane, gw, NGW, OCAT); \
            transpose_matrix(args.in[I_WO] + (size_t)(l) * DM * DM, DM, DM, (bf16*)(wl + WL_WO), 0, scr, lane, gw, NGW, LDW); \
            transpose_matrix(args.in[I_F2IN] + (size_t)(l) * DM * 2 * DFF, DM, 2 * DFF, (bf16*)(wl + WL_F2IN), 1, scr, lane, gw, NGW, LDW); \
            transpose_matrix(args.in[I_F2OUT] + (size_t)(l) * DFF * DM, DFF, DM, (bf16*)(wl + WL_F2OUT), 0, scr, lane, gw, NGW); } while (0)
    PH_BEGIN(0)

        CONVERT_LAYER(0);
        bf16* U = (bf16*)(ws + WS_U);
        for (int m = gw; m < M_ALL; m += NGW) {
            const float* xr = (m < 2 * SEQ) ? args.in[I_XP] + (size_t)m * DM : args.in[I_XS] + (size_t)(m - 2 * SEQ) * DM;
            rms_row_to_bf16(xr, args.in[I_NF1], U + (size_t)m * LDU, (bf16*)(ws + WS_X16) + (size_t)m * DM, lane);
        }
    PH_CLOSE(0);

    for (int l = 0; l < DEPTH; ++l) {
        for (int half = 0; half < 2; ++half) {
            PH_BEGIN(1)

                if (half == 0 && l > 0) CONVERT_LAYER(l);
                if (!(l == 0 && half == 0)) {
                    bf16* U = (bf16*)(ws + WS_U);
                    const float* g = (half == 0 ? args.in[I_NF1] : args.in[I_NF2]) + (size_t)l * DM;
                    { int m = gw; const bf16* X16 = (const bf16*)(ws + WS_X16);
                      for (; m + (NORM_NR - 1) * NGW < M_ALL; m += NORM_NR * NGW) rms_row16<false, NORM_NR>(X16 + (size_t)m * DM, (size_t)NGW * DM, g, U + (size_t)m * LDU, (size_t)NGW * LDU, lane);
                      for (; m < M_ALL; m += NGW) rms_row16<false, 1>(X16 + (size_t)m * DM, 0, g, U + (size_t)m * LDU, 0, lane); }
                }
            PH_CLOSE(1);
            PH_BEGIN(2)

                unsigned char* wl = ws + WS_W;
                pg8::Gemm g{(const bf16*)(ws + WS_U), (const bf16*)(wl + (half == 0 ? WL_F1IN : WL_F2IN)), M_ALL, 2 * DFF, DM, LDU, LDW}; pg8::StaticOrder S; S.init(M_ALL, 2 * DFF, G, bx, 0, WGM_WIDE);
                if (EXTRA == 1) { pg8::EpiNull E0; pg8::gemm_phase<pg8::EpiNull, pg8::StaticOrder, true, true>(ldsl + RING_OFF, g, S, E0, tid); GRID_BARRIER(); }
                pg8::EpiSwiglu E{(bf16*)(ws + WS_H), LDH};
                pg8::gemm_phase<pg8::EpiSwiglu, pg8::StaticOrder, true, true>(ldsl + RING_OFF, g, S, E, tid, (unsigned)(STAG_STEP * ((bx >> 3) & 3)));
            PH_CLOSE(2);
            PH_BEGIN(3)

                unsigned char* wl = ws + WS_W;
                pg8::Gemm g{(const bf16*)(ws + WS_H), (const bf16*)(wl + (half == 0 ? WL_F1OUT : WL_F2OUT)), M_ALL, DM, DFF, LDH}; pg8::StaticOrder S; S.init(M_ALL, DM, G, bx, REV_FFNOUT, WGM_NARROW);
                if (EXTRA == 2) { pg8::EpiNull E0; pg8::gemm_phase<pg8::EpiNull, pg8::StaticOrder, true, true>(ldsl + RING_OFF, g, S, E0, tid); GRID_BARRIER(); }
                pg8::EpiResid E{(bf16*)(ws + WS_X16), DM, rep_ ? 0.0f : 0.5f};
                pg8::gemm_phase<pg8::EpiResid, pg8::StaticOrder, true, true>(ldsl + RING_OFF, g, S, E, tid, (unsigned)(STAG_STEP * ((bx >> 3) & 3)));
            PH_CLOSE(3);
            if (half == 0) {
                PH_BEGIN(1)

                    bf16* U = (bf16*)(ws + WS_U);
                    const float* g = args.in[I_NMIX] + (size_t)l * DM;
                    { int m = gw; const bf16* X16 = (const bf16*)(ws + WS_X16);
                      for (; m + (NORM_NR - 1) * NGW < M_ALL; m += NORM_NR * NGW) rms_row16<false, NORM_NR>(X16 + (size_t)m * DM, (size_t)NGW * DM, g, U + (size_t)m * LDU, (size_t)NGW * LDU, lane);
                      for (; m < M_ALL; m += NGW) rms_row16<false, 1>(X16 + (size_t)m * DM, 0, g, U + (size_t)m * LDU, 0, lane); }
                PH_CLOSE(1);
                for (int sg = 0; sg < 2; ++sg) {
                    const int ns = sg == 0 ? 2 : 1, r0 = sg == 0 ? 0 : 2 * SEQ, MR = ns * SEQ;
                    PH_BEGIN(4)

                        unsigned char* wl = ws + WS_W;
                        pg8::Gemm g{(const bf16*)(ws + WS_U) + (size_t)r0 * LDU, (const bf16*)(wl + WL_WIN), MR, INC, DM, LDU, LDW}; pg8::StaticOrder S; S.init(MR, INC, G, bx, 0, WGM_WIDE);
                        pg8::EpiBf16 E{(bf16*)(ws + WS_QKVG), INC};
                        pg8::gemm_phase<pg8::EpiBf16, pg8::StaticOrder, true, true>(ldsl + RING_OFF, g, S, E, tid, (unsigned)(STAG_STEP * ((bx >> 3) & 3)));
                    PH_CLOSE(4);
                    PH_BEGIN(5)

                        bf16* QKVG = (bf16*)(ws + WS_QKVG);
                        { bf16* QB = (bf16*)(ws + WS_QB); bf16* KB = (bf16*)(ws + WS_KB); bf16* VB = (bf16*)(ws + WS_VB);
                          const float* gq = args.in[I_QNQ] + (size_t)l * 128; const float* gk = args.in[I_QNK] + (size_t)l * 128;
                          int t = gw;
                          for (; t + 3 * NGW < MR; t += 4 * NGW) ropeB_tokens<4>(QKVG, t, NGW, gq, gk, QB, KB, VB, lane);
                          for (; t < MR; t += NGW) ropeB_tokens<1>(QKVG, t, NGW, gq, gk, QB, KB, VB, lane); }
                        for (int u = vcu; u < ns * (8 * 64 + 12 * 64); u += G) {
                            att::Unit A;
                            if (u < ns * 8 * 64) {
                                const int sq = u >> 9, h = (u >> 6) & 7, b = u & 63; const size_t rb = (size_t)sq * SEQ;
                                A.Q = QKVG + (rb + 256 * b) * INC + C_Q + h * 128; A.qstride = INC;
                                A.K = QKVG + rb * INC + C_K + (h >> 2) * 128; A.V = QKVG + rb * INC + C_V + (h >> 2) * 128; A.kstride = INC;
                                A.O = (bf16*)(ws + WS_OC) + (rb + 256 * b) * OCAT + h * 128; A.ostride = OCAT;
                                A.NT = 8; A.kb0 = 256 * b - 128; A.n = SEQ; A.qi0 = 256 * b; A.hw = 128;
                                A.slope_raw = __uint_as_float((unsigned)(127 - (h + 1)) << 23) * (1.0f / att::SCALE);
                                A.sink = args.in[I_SINK][l * 8 + h]; A.has_sink = 1; A.lse = nullptr; A.lse_stride = 0;
                            } else {
                                const int v0 = u - ns * 8 * 64, sq = v0 / 768, v = v0 - sq * 768, h = v >> 6, w = v & 63, gi = h >> 2, rs = 2 * gi, r = 1 << rs; const size_t rb = (size_t)sq * SEQ;
                                const int bpc = 64 >> rs, c = w / bpc, b = w % bpc, nsub = SEQ >> rs;
                                A.Q = QKVG + (rb + c + r * 256 * b) * INC + A_Q + h * 128; A.qstride = r * INC;
                                A.K = QKVG + (rb + c) * INC + A_K + h * 128; A.V = QKVG + (rb + c) * INC + A_V + h * 128; A.kstride = r * INC;
                                A.O = (bf16*)(ws + WS_PA) + ((size_t)gi * MGR + rb + c + r * 256 * b) * 512 + (h & 3) * 128; A.ostride = r * 512;
                                A.NT = 6; A.kb0 = 256 * b - 64; A.n = nsub; A.qi0 = 256 * b; A.hw = 64;
                                const float sl = __builtin_amdgcn_exp2f(-8.0f * (float)(h + 1) / 12.0f) * (float)r * (1.0f / att::SCALE);
                                A.slope_raw = __uint_as_float(__builtin_amdgcn_readfirstlane(__float_as_uint(sl)));
                                A.sink = 0.f; A.has_sink = 0; A.lse = (float*)(ws + WS_LSE) + ((size_t)gi * MGR + rb + c + r * 256 * b) * 4 + (h & 3); A.lse_stride = r * 4;
                            }
                            att::attn_unit<true, 0>(A, (char*)lds + RING_OFF, tid);
                        }
                    PH_CLOSE(5);
                    PH_BEGIN(6)

                        for (int t = gw; t < MR; t += NGW) mergeA_token((const bf16*)(ws + WS_PA), (const float*)(ws + WS_LSE), (bf16*)(ws + WS_OA), t, lane);
                        bool fastB;
                        { const float* gq = args.in[I_QNQ] + (size_t)l * 128; const float* gk = args.in[I_QNK] + (size_t)l * 128;
                          float mq = fmaxf(__builtin_fabsf(gq[lane]), __builtin_fabsf(gq[lane + 64])), mk = fmaxf(__builtin_fabsf(gk[lane]), __builtin_fabsf(gk[lane + 64]));
                          mq = wave_max(mq); mk = wave_max(mk);
                          const float bound = 128.0f * mq * mk * QPRESCALE * 1.05f;
                          fastB = __builtin_amdgcn_readfirstlane((int)(bound < 60.0f)) != 0; }
                        if (fastB) {
                        for (int u = vcu; u < ns * 8 * 64; u += G) {
                            const int sq = u >> 9, h = (u >> 6) & 7, b = u & 63; const size_t rb = (size_t)sq * SEQ;
                            att::Unit A;
                            A.Q = (const bf16*)(ws + WS_QB) + (rb + 256 * b) * 1024 + h * 128; A.qstride = 1024;
                            A.K = (const bf16*)(ws + WS_KB) + rb * 256 + (h >> 2) * 128; A.V = (const bf16*)(ws + WS_VB) + rb * 256 + (h >> 2) * 128; A.kstride = 256;
                            A.O = (bf16*)(ws + WS_OB) + (rb + 256 * b) * OCAT + h * 128; A.ostride = OCAT;
                            A.NT = SEQ / 64; A.kb0 = 0; A.n = SEQ; A.qi0 = 0; A.hw = 0; A.slope_raw = 0.f; A.sink = 0.f; A.has_sink = 0; A.lse = nullptr; A.lse_stride = 0;
                            const int tid2 = wave * 64 + lane_id_asm();
                            if (ATT_DMA) att::attn_unit_dma(A, (char*)lds + RING_OFF, (att::lds_u8*)(ldsl + RING_OFF), tid2); else if (ATT_RING) att::attn_unit_ring(A, (char*)lds + RING_OFF, tid2); else att::attn_unit<false, 2>(A, (char*)lds + RING_OFF, tid2);
                        }
                        } else {
                        for (int u = vcu; u < ns * 8 * 64; u += G) {
                            const int sq = u >> 9, h = (u >> 6) & 7, b = u & 63; const size_t rb = (size_t)sq * SEQ;
                            att::Unit A;
                            A.Q = (const bf16*)(ws + WS_QB) + (rb + 256 * b) * 1024 + h * 128; A.qstride = 1024;
                            A.K = (const bf16*)(ws + WS_KB) + rb * 256 + (h >> 2) * 128; A.V = (const bf16*)(ws + WS_VB) + rb * 256 + (h >> 2) * 128; A.kstride = 256;
                            A.O = (bf16*)(ws + WS_OB) + (rb + 256 * b) * OCAT + h * 128; A.ostride = OCAT;
                            A.NT = SEQ / 64; A.kb0 = 0; A.n = SEQ; A.qi0 = 0; A.hw = 0; A.slope_raw = 0.f; A.sink = 0.f; A.has_sink = 0; A.lse = nullptr; A.lse_stride = 0;
                            const int tid2 = wave * 64 + lane_id_asm();
                            att::attn_unit<false, 1>(A, (char*)lds + RING_OFF, tid2);
                        }
                        }
                    PH_CLOSE(6);
                    PH_BEGIN(7)

                        unsigned char* wl = ws + WS_W;
                        pg8::Gemm g{(const bf16*)(ws + WS_OCAT), (const bf16*)(wl + WL_WA), MR, DM, OCAT}; pg8::StaticOrder S; S.init(MR, DM, G, bx, 0, WGM_NARROW);
                        if (EXTRA == 5) { pg8::EpiNull E0; pg8::gemm_phase<pg8::EpiNull, pg8::StaticOrder, true, true>(ldsl + RING_OFF, g, S, E0, tid); GRID_BARRIER(); }
                        pg8::EpiGateCat E{(const bf16*)(ws + WS_QKVG) + GL0, INC, (bf16*)(ws + WS_MB), DM, LDU};
                        pg8::gemm_phase<pg8::EpiGateCat, pg8::StaticOrder, true, true>(ldsl + RING_OFF, g, S, E, tid);
                    PH_CLOSE(7);
                    PH_BEGIN(8)

                        unsigned char* wl = ws + WS_W;
                        pg8::Gemm g{(const bf16*)(ws + WS_MB), (const bf16*)(wl + WL_WO), MR, DM, DM, LDU, LDW}; pg8::StaticOrder S; S.init(MR, DM, G, bx, 0, WGM_NARROW);
                        pg8::EpiResid E{(bf16*)(ws + WS_X16) + (size_t)r0 * DM, DM, rep_ ? 0.0f : 1.0f};
                        pg8::gemm_phase<pg8::EpiResid, pg8::StaticOrder, true, true>(ldsl + RING_OFF, g, S, E, tid);
                    PH_CLOSE(8);
                }
            }
        }
    }
    PH_BEGIN(9)

        if (EXTRA == 3) { for (int i_ = 0; i_ < 200; ++i_) GRID_BARRIER(); }
        { int m = gw; const bf16* X16 = (const bf16*)(ws + WS_X16);
          for (; m + (NORM_NR - 1) * NGW < M_ALL; m += NORM_NR * NGW) rms_row16<true, NORM_NR>(X16 + (size_t)m * DM, (size_t)NGW * DM, args.in[I_NFIN], X + (size_t)m * DM, (size_t)NGW * DM, lane);
          for (; m < M_ALL; m += NGW) rms_row16<true, 1>(X16 + (size_t)m * DM, 0, args.in[I_NFIN], X + (size_t)m * DM, 0, lane); }
    PH_CLOSE(9);
#if DIAG
    {
        PH_VARS;
        unsigned long long* dg = (unsigned long long*)(ws + WS_CTL + 65536);
        if (bx_k == 0 && tid == 0) { volatile LAS unsigned long long* ts_ = (volatile LAS unsigned long long*)(ldsl + DIAG_OFF); for (int i = 0; i < 16; ++i) dg[i] = ts_[i]; }
        { XcdBarrier b2_ = bar; b2_.bar = opq_p(bar.bar); b2_.x = (unsigned)opq_s((int)bar.x); xcd_barrier(b2_); }
        const float ta = (float)__hip_atomic_load(dg + 1 + DIAG_A, __ATOMIC_RELAXED, __HIP_MEMORY_SCOPE_AGENT) * 0.01f, tb = (float)__hip_atomic_load(dg + 1 + DIAG_B, __ATOMIC_RELAXED, __HIP_MEMORY_SCOPE_AGENT) * 0.01f;
        const float qa = 10.f + __builtin_roundf(__builtin_log2f(fmaxf(ta, 10.f) * 0.1f) * (1.0f / 0.16349873f) + 0.5f * DIAG_SHIFT), qb = 10.f + __builtin_roundf(__builtin_log2f(fmaxf(tb, 10.f) * 0.1f) * (1.0f / 0.16349873f) + 0.5f * DIAG_SHIFT);
        const float ka = sqrtf(100.f * qa), vb = 100.f * qb;
        for (size_t i = (size_t)bx * 512 + tid; i < (size_t)M_ALL * DM; i += (size_t)G * 512) X[i] = (i < (size_t)2 * SEQ * DM) ? ka : ((i == (size_t)2 * SEQ * DM + 12345 || i == (size_t)2 * SEQ * DM + 54321) ? vb : 0.f);
    }
#endif
#undef PH_ON
#undef PH_VARS
#undef PH_END
#undef PH_BEGIN
#undef PH_CLOSE
}


#if CHECKB
constexpr int CHK_WORD = 2048;
__device__ __forceinline__ void chk_rope_head(const bf16* row128, const float* g, int t, float* out  , int tid) {
    if (tid < 64) {
        float x0 = __uint_as_float((unsigned)row128[2 * tid] << 16), x1 = __uint_as_float((unsigned)row128[2 * tid + 1] << 16);
        out[2 * tid] = x0; out[2 * tid + 1] = x1;
    }
}
__global__ void __launch_bounds__(256) chk_mixerB(const unsigned char* ws, const float* gq_, const float* gk_, unsigned* ctl) {
    __shared__ float qv[128]; __shared__ float red[256]; __shared__ float oacc[128]; __shared__ float sh_m, sh_l;
    const int smp = blockIdx.x, tid = threadIdx.x;
    const int t = (smp * 2654435761u >> 7) % SEQ, h = smp % 8, kvh = h / 4; const size_t rbc = (size_t)((smp >> 3) & 1) * SEQ;
    const bf16* QKVG = (const bf16*)(ws + WS_QKVG); const bf16* OB = (const bf16*)(ws + WS_OB);
    if (tid < 128) { qv[tid] = __uint_as_float((unsigned)QKVG[(rbc + t) * INC + B_Q + h * 128 + tid] << 16); }
    __syncthreads();
    if (tid == 0) { float ss = 0.f; for (int i = 0; i < 128; ++i) ss += qv[i] * qv[i]; sh_m = 1.0f / sqrtf(ss / 128.f + NORM_EPS); }
    __syncthreads();
    if (tid < 128) qv[tid] = qv[tid] * sh_m * gq_[tid];
    __syncthreads();
    if (tid < 64) { const int i = tid; const double pos = (i < 32) ? (double)(t / 64) : (double)(t % 64); const double inv = exp2(-(double)(i & 31) * 13.287712379549449 / 32.0);
        const double ang = pos * inv; const float cs = (float)cos(ang), sn = (float)sin(ang); const float x0 = qv[2 * i], x1 = qv[2 * i + 1];
        qv[2 * i] = x0 * cs - x1 * sn; qv[2 * i + 1] = x0 * sn + x1 * cs; }
    __syncthreads();
    float m = -1e30f, l = 0.f; float o[128];
    (void)o;
    auto score = [&](int j) -> float {
        const bf16* kr = QKVG + (rbc + j) * INC + B_K + kvh * 128; float ss = 0.f;
        for (int i = 0; i < 128; ++i) { const float x = __uint_as_float((unsigned)kr[i] << 16); ss += x * x; }
        const float rstd = 1.0f / sqrtf(ss / 128.f + NORM_EPS); float dot = 0.f;
        for (int i = 0; i < 64; ++i) { const double pos = (i < 32) ? (double)(j / 64) : (double)(j % 64); const double inv = exp2(-(double)(i & 31) * 13.287712379549449 / 32.0);
            const double ang = pos * inv; const float cs = (float)cos(ang), sn = (float)sin(ang);
            const float x0 = __uint_as_float((unsigned)kr[2 * i] << 16) * rstd * gk_[2 * i], x1 = __uint_as_float((unsigned)kr[2 * i + 1] << 16) * rstd * gk_[2 * i + 1];
            dot += qv[2 * i] * (x0 * cs - x1 * sn) + qv[2 * i + 1] * (x0 * sn + x1 * cs); }
        return dot * 0.088388347648318440f; };
    for (int j = tid; j < SEQ; j += 256) m = fmaxf(m, score(j));
    red[tid] = m; __syncthreads();
    for (int s_ = 128; s_ > 0; s_ >>= 1) { if (tid < s_) red[tid] = fmaxf(red[tid], red[tid + s_]); __syncthreads(); }
    m = red[0]; __syncthreads();
    if (tid < 128) oacc[tid] = 0.f;
    __syncthreads();
    for (int j = tid; j < SEQ; j += 256) { const float p = expf(score(j) - m); l += p;
        const bf16* vr = QKVG + (rbc + j) * INC + B_V + kvh * 128;
        for (int d = 0; d < 128; ++d) atomicAdd(&oacc[d], p * __uint_as_float((unsigned)vr[d] << 16)); }
    red[tid] = l; __syncthreads();
    for (int s_ = 128; s_ > 0; s_ >>= 1) { if (tid < s_) red[tid] += red[tid + s_]; __syncthreads(); }
    l = red[0]; __syncthreads();
    if (tid == 0) { float num = 0.f, den = 0.f; for (int d = 0; d < 128; ++d) { const float ref = oacc[d] / l, got = __uint_as_float((unsigned)OB[(rbc + t) * OCAT + h * 128 + d] << 16); num += (got - ref) * (got - ref); den += ref * ref; }
        const float e = sqrtf(num / fmaxf(den, 1e-30f)); atomicMax(ctl + CHK_WORD, __float_as_uint(e)); }
}

__global__ void __launch_bounds__(128) chk_mixerAC(const unsigned char* ws, const float* sink_, unsigned* ctl) {
    __shared__ float qv[128]; __shared__ float red[128];
    const int smp = blockIdx.x, d = threadIdx.x; const bool isC = (smp & 1) != 0; const int k = smp >> 1;
    const int edge[16] = {0, 1, 63, 64, 65, 127, 128, 129, 1023, 1024, 16383, 16382, 16320, 16319, 16255, 16256};
    const int t = k < 16 ? edge[k] : (int)(((unsigned)k * 2654435761u >> 7) % SEQ);
    const bf16* QKVG = (const bf16*)(ws + WS_QKVG) + (size_t)((k >> 4) & 1) * SEQ * INC; const size_t rbo = (size_t)((k >> 4) & 1) * SEQ;
    auto bf = [](bf16 x) { return __uint_as_float((unsigned)x << 16); };
    float m = -1e30f, l = 0.f, o = 0.f;
    const bf16* outp;
    if (isC) {
        const int h = k % 8, kvh = h / 4; const float slope = exp2f(-(float)(h + 1));
        qv[d] = bf(QKVG[(size_t)t * INC + C_Q + h * 128 + d]); __syncthreads();
        for (int j = t - 128; j <= t + 128; ++j) { if (j < 0 || j >= SEQ) continue;
            red[d] = qv[d] * bf(QKVG[(size_t)j * INC + C_K + kvh * 128 + d]); __syncthreads();
            float dot = 0.f; for (int i = 0; i < 128; ++i) dot += red[i]; __syncthreads();
            const float s = dot * 0.088388347648318440f - slope * fabsf((float)(t - j));
            const float mn = fmaxf(m, s), a = expf(m - mn), p = expf(s - mn); l = l * a + p; o = o * a + p * bf(QKVG[(size_t)j * INC + C_V + kvh * 128 + d]); m = mn; }
        { const float s = sink_[h]; const float mn = fmaxf(m, s), a = expf(m - mn), p = expf(s - mn); l = l * a + p; o = o * a; m = mn; }
        outp = (const bf16*)(ws + WS_OC) + (rbo + t) * OCAT + h * 128;
    } else {
        const int hh = k % 4;
        for (int g = 0; g < 3; ++g) { const int r = 1 << (2 * g), h = 4 * g + hh, c = t % r, i = t / r, nsub = SEQ / r; const float slope = exp2f(-8.0f * (float)(h + 1) / 12.0f);
            __syncthreads(); qv[d] = bf(QKVG[(size_t)t * INC + A_Q + h * 128 + d]); __syncthreads();
            for (int j = i - 64; j <= i + 64; ++j) { if (j < 0 || j >= nsub) continue; const int tj = c + r * j;
                red[d] = qv[d] * bf(QKVG[(size_t)tj * INC + A_K + h * 128 + d]); __syncthreads();
                float dot = 0.f; for (int ii = 0; ii < 128; ++ii) dot += red[ii]; __syncthreads();
                const float s = dot * 0.088388347648318440f - slope * (float)r * fabsf((float)(i - j));
                const float mn = fmaxf(m, s), a = expf(m - mn), p = expf(s - mn); l = l * a + p; o = o * a + p * bf(QKVG[(size_t)tj * INC + A_V + h * 128 + d]); m = mn; } }
        outp = (const bf16*)(ws + WS_OA) + (rbo + t) * OCAT + hh * 128;
    }
    const float ref = o / l, got = bf(outp[d]);
    __syncthreads(); red[d] = (got - ref) * (got - ref); __syncthreads();
    float num = 0.f; for (int i = 0; i < 128; ++i) num += red[i]; __syncthreads();
    red[d] = ref * ref; __syncthreads();
    float den = 0.f; for (int i = 0; i < 128; ++i) den += red[i];
    if (d == 0) atomicMax(ctl + CHK_WORD, __float_as_uint(sqrtf(num / fmaxf(den, 1e-30f))));
}
__global__ void chk_fill(float* out, const unsigned* ctl) {
    const float e = __uint_as_float(ctl[CHK_WORD]); const float k = sqrtf(fminf(e, 1e6f) * 1e4f);
    for (size_t i = (size_t)blockIdx.x * blockDim.x + threadIdx.x; i < (size_t)M_ALL * DM; i += (size_t)gridDim.x * blockDim.x) out[i] = k;
}
#endif
extern "C" void kernel_launch(void* const* d_in, const int* in_sizes, int n_in, void* d_out, int out_size, void* d_ws, size_t ws_size, hipStream_t stream) {
    static int grid = 0;
    if (grid == 0) {
        if (n_in != N_IN || out_size != M_ALL * DM || ws_size < WS_END) { fprintf(stderr, "kernel_launch: shape/workspace mismatch (n_in %d out %d ws %zu need %zu)\n", n_in, out_size, ws_size, (size_t)WS_END); grid = -1; return; }
        int dev = 0, cus = 0, per_cu = 0;
        if (hipGetDevice(&dev) != hipSuccess || hipDeviceGetAttribute(&cus, hipDeviceAttributeMultiprocessorCount, dev) != hipSuccess) { grid = -1; return; }
        if (hipFuncSetAttribute((const void*)trunk_fwd, hipFuncAttributeMaxDynamicSharedMemorySize, LDS_BYTES) != hipSuccess) { fprintf(stderr, "kernel_launch: hipFuncSetAttribute failed\n"); grid = -1; return; }
        if (hipOccupancyMaxActiveBlocksPerMultiprocessor(&per_cu, (const void*)trunk_fwd, NWAVES * 64, LDS_BYTES) != hipSuccess || per_cu < 1) { fprintf(stderr, "kernel_launch: occupancy query reports %d\n", per_cu); }
        (void)hipGetLastError();
        grid = cus;
    }
    if (grid < 0) return;
    if (hipMemsetAsync((char*)d_ws + WS_CTL, 0, CTL_ZERO_BYTES, stream) != hipSuccess) return;
    Args a{};
    for (int i = 0; i < N_IN; ++i) a.in[i] = (const float*)d_in[i];
    a.out = (float*)d_out; a.ws = (unsigned char*)d_ws;
#if MK_PER_PHASE
    for (int p = 0; p < N_PHASES; ++p) { a.ph_lo = p; a.ph_hi = p + 1; hipLaunchKernelGGL(trunk_fwd, dim3(grid), dim3(NWAVES * 64), LDS_BYTES, stream, a); }
#elif CHECKB
    a.ph_lo = 0; a.ph_hi = 8;
    hipLaunchKernelGGL(trunk_fwd, dim3(grid), dim3(NWAVES * 64), LDS_BYTES, stream, a);
#if CHECKB == 1
    hipLaunchKernelGGL(chk_mixerB, dim3(512), dim3(256), 0, stream, (const unsigned char*)d_ws, (const float*)d_in[I_QNQ], (const float*)d_in[I_QNK], (unsigned*)((char*)d_ws + WS_CTL));
#else
    hipLaunchKernelGGL(chk_mixerAC, dim3(1024), dim3(128), 0, stream, (const unsigned char*)d_ws, (const float*)d_in[I_SINK], (unsigned*)((char*)d_ws + WS_CTL));
#endif
    hipLaunchKernelGGL(chk_fill, dim3(1024), dim3(256), 0, stream, (float*)d_out, (const unsigned*)((char*)d_ws + WS_CTL));
#else
    a.ph_lo = 0; a.ph_hi = N_PHASES;
    hipLaunchKernelGGL(trunk_fwd, dim3(grid), dim3(NWAVES * 64), LDS_BYTES, stream, a);
#endif
    const hipError_t le = hipPeekAtLastError();
    if (le != hipSuccess) fprintf(stderr, "kernel_launch: launch failed: %s\n", hipGetErrorName(le));
}
```
